# Optimizing an MI355X kernel written in HIP

```python
import jax, jax.numpy as jnp
from jax import lax
import numpy as np

D_MODEL = 1024
BATCH = 16
SEQ = 256
DEPTH = 2
DEC_BATCH = 2
DEC_SEQ = 2048
PAST_LEN = 512

GRID_W = 64
NA_HEADS = 8
NA_HEAD_DIM = 64
NA_WIDTH = NA_HEADS * NA_HEAD_DIM
WIN_R = 8
WIN_C = 16
NA_QB = WIN_C
NA_KBW = 2 * WIN_C
CTX_QBLOCK = 128
NEG_INF = -1e30
RET_HEADS = 4
RET_DK = 64
RET_DV = 128
RET_QK_WIDTH = RET_HEADS * RET_DK
RET_V_WIDTH = RET_HEADS * RET_DV
RET_CHUNK = 64
RET_GN_EPS = 1e-5
ROPE_BASE = 10000.0
RWKV_HEADS = 8
RWKV_N = 64
RWKV_WIDTH = RWKV_HEADS * RWKV_N
RWKV_LORA_W = 64
RWKV_LORA_A = 64
RWKV_LORA_G = 128
RWKV_DECAY_SCALE = 0.606531
RWKV_GN_EPS = 64e-5
RWKV_SIZES = (RWKV_WIDTH, RWKV_WIDTH, RWKV_WIDTH, RWKV_LORA_W, RWKV_LORA_W, RWKV_LORA_A, RWKV_LORA_A, RWKV_LORA_G)
RWKV_SHIFT_WIDTH = 3 * RWKV_WIDTH + 2 * RWKV_LORA_W + 2 * RWKV_LORA_A + RWKV_LORA_G
N_BRANCH = 3
BRANCH_WIDTH = 512
IN_SIZES = (NA_WIDTH, NA_WIDTH, NA_WIDTH, RET_QK_WIDTH, RET_QK_WIDTH, RET_V_WIDTH, RET_V_WIDTH,
            RWKV_SHIFT_WIDTH, D_MODEL, D_MODEL, D_MODEL)
P_IN = 3 * NA_WIDTH + 2 * RET_QK_WIDTH + 2 * RET_V_WIDTH + RWKV_SHIFT_WIDTH + N_BRANCH * D_MODEL
PEER_HEADS = 8
PEER_NKEYS = 128
PEER_N_EXPERTS = PEER_NKEYS * PEER_NKEYS
PEER_DK = 128
PEER_TOPK = 16
PEER_TOK_BLOCK = 128
LN_EPS = 1e-5
DEEPNORM_ALPHA = (2 * DEPTH) ** 0.25
DEEPNORM_BETA = (8 * DEPTH) ** -0.25

kernel_name = 'hybrid_natten_retnet_rwkv7_peer_diffusion_step'


def _split_points(sizes):
    return [int(s) for s in np.cumsum(sizes)[:-1]]


def flip(t):
    return t[:, ::-1]


def layer_norm(x, g=None, b=None):
    xf = x.astype(jnp.float32)
    mu = jnp.mean(xf, -1, keepdims=True)
    var = jnp.mean(jnp.square(xf - mu), -1, keepdims=True)
    y = (xf - mu) * lax.rsqrt(var + LN_EPS)
    if g is not None:
        y = y * g.astype(jnp.float32) + b.astype(jnp.float32)
    return y.astype(x.dtype)


def head_norm(x, g, b, eps):
    bsz, t_len, nh, n = x.shape
    xf = x.astype(jnp.float32)
    mu = jnp.mean(xf, -1, keepdims=True)
    var = jnp.mean(jnp.square(xf - mu), -1, keepdims=True)
    y = ((xf - mu) * lax.rsqrt(var + eps)).reshape(bsz, t_len, nh * n)
    return y * g.astype(jnp.float32) + b.astype(jnp.float32)


def centered_shift(z, mu):
    zp = jnp.pad(z, ((0, 0), (1, 1), (0, 0)))
    return z + mu * (0.5 * (zp[:, :-2] + zp[:, 2:]) - z)


def axial_rope(x):
    t_len, d = x.shape[1], x.shape[-1]
    half, quarter = d // 2, d // 4
    pos = jnp.arange(t_len)
    freqs = 1.0 / (ROPE_BASE ** (jnp.arange(quarter, dtype=jnp.float32) / quarter))
    xf = x.astype(jnp.float32)

    def rot(part, p_axis):
        ang = p_axis.astype(jnp.float32)[:, None] * freqs[None, :]
        cos, sin = jnp.cos(ang)[None, :, None, :], jnp.sin(ang)[None, :, None, :]
        p1, p2 = part[..., :quarter], part[..., quarter:]
        return jnp.concatenate([p1 * cos - p2 * sin, p1 * sin + p2 * cos], axis=-1)

    out = jnp.concatenate([rot(xf[..., :half], pos // GRID_W), rot(xf[..., half:], pos % GRID_W)], axis=-1)
    return out.astype(x.dtype)


def ctx_attention(q, k, v):
    bsz, l_len, nh, dh = q.shape
    nb = l_len // CTX_QBLOCK
    kt, vt = k.transpose(0, 2, 1, 3), v.transpose(0, 2, 1, 3)
    qblocks = q.reshape(bsz, nb, CTX_QBLOCK, nh, dh).transpose(1, 0, 3, 2, 4)

    def blk(qb):
        s = jnp.einsum('bhqd,bhkd->bhqk', qb, kt).astype(jnp.float32) * dh ** -0.5
        p = jax.nn.softmax(s, axis=-1).astype(v.dtype)
        return jnp.einsum('bhqk,bhkd->bhqd', p, vt)

    o = lax.map(blk, qblocks)
    return o.transpose(1, 0, 3, 2, 4).reshape(bsz, l_len, nh * dh)


def na_latent(q, k, v, ctx_k, ctx_v, rpb):
    bsz, t_len, nh, dh = q.shape
    rows = t_len // GRID_W
    kr = min(WIN_R, rows)
    ncb = GRID_W // NA_QB
    scale = dh ** -0.5

    def grid(z):
        return z.reshape(bsz, rows, GRID_W, nh, dh).transpose(0, 3, 1, 2, 4)

    qg, kg, vg = grid(q), grid(k), grid(v)
    r_ar = jnp.arange(rows)
    row_idx = jnp.clip(r_ar - kr // 2, 0, rows - kr)[:, None] + jnp.arange(kr)[None, :]
    cb_start = jnp.clip(jnp.arange(ncb) * NA_QB - WIN_C // 2, 0, GRID_W - NA_KBW)
    col_idx = cb_start[:, None] + jnp.arange(NA_KBW)[None, :]
    nw = kr * NA_KBW

    def gather(z):
        zb = z[:, :, row_idx[:, :, None, None], col_idx[None, None, :, :]]
        return zb.transpose(0, 1, 2, 4, 3, 5, 6).reshape(bsz, nh, rows, ncb, nw, dh)

    kb, vb = gather(kg), gather(vg)
    qb = qg.reshape(bsz, nh, rows, ncb, NA_QB, dh)
    q_col = jnp.arange(GRID_W).reshape(ncb, NA_QB)
    q_start = jnp.clip(q_col - WIN_C // 2, 0, GRID_W - WIN_C)
    rel = col_idx[:, None, :] - q_start[:, :, None]
    valid = (rel >= 0) & (rel < WIN_C)
    valid = jnp.broadcast_to(valid[:, :, None, :], (ncb, NA_QB, kr, NA_KBW)).reshape(ncb, NA_QB, nw)
    dr_i = row_idx - r_ar[:, None] + WIN_R - 1
    dc_i = jnp.clip(col_idx[:, None, :] - q_col[:, :, None], -(WIN_C - 1), WIN_C - 1) + WIN_C - 1
    bias = rpb.astype(jnp.float32)[:, dr_i[:, None, None, :, None], dc_i[None, :, :, None, :]]
    bias = bias.reshape(nh, rows, ncb, NA_QB, nw)
    s_win = jnp.einsum('bhrcqd,bhrckd->bhrcqk', qb, kb).astype(jnp.float32) * scale + bias[None]
    s_win = jnp.where(valid[None, None, None], s_win, NEG_INF)
    s_ctx = jnp.einsum('bhrcqd,bhld->bhrcql', qb, ctx_k).astype(jnp.float32) * scale
    p = jax.nn.softmax(jnp.concatenate([s_win, s_ctx], axis=-1), axis=-1).astype(v.dtype)
    o = (jnp.einsum('bhrcqk,bhrckd->bhrcqd', p[..., :nw], vb)
         + jnp.einsum('bhrcql,bhld->bhrcqd', p[..., nw:], ctx_v))
    return o.reshape(bsz, nh, rows, GRID_W, dh).transpose(0, 2, 3, 1, 4).reshape(bsz, t_len, nh * dh)


def retention_scan(q, k, v, gamma, s0):
    bsz, t_len, nh, dk = q.shape
    dv = v.shape[-1]
    c = RET_CHUNK
    n = t_len // c
    lg = jnp.log(gamma)
    i = jnp.arange(c, dtype=jnp.float32)
    diff = i[:, None] - i[None, :]
    mask = jnp.where(diff >= 0, jnp.exp(jnp.maximum(diff, 0.0)[None] * lg[:, None, None]), 0.0)
    q_dec = jnp.exp((i + 1.0)[:, None] * lg[None, :])[None, :, :, None]
    k_dec = jnp.exp((c - 1.0 - i)[:, None] * lg[None, :])[None, :, :, None]
    c_dec = jnp.exp(c * lg)[None, :, None, None]

    def to_chunks(z):
        return z.astype(jnp.float32).reshape(bsz, n, c, nh, z.shape[-1]).transpose(1, 0, 2, 3, 4)

    def step(s, inp):
        qc, kc, vc = inp
        att = jnp.einsum('bihd,bjhd->bhij', qc, kc) * mask
        o = jnp.einsum('bhij,bjhv->bihv', att, vc) + jnp.einsum('bihd,bhdv->bihv', qc * q_dec, s)
        s = s * c_dec + jnp.einsum('bjhd,bjhv->bhdv', kc * k_dec, vc)
        return s, o

    s_fin, o = lax.scan(step, s0.astype(jnp.float32), (to_chunks(q), to_chunks(k), to_chunks(v)))
    return o.transpose(1, 0, 2, 3, 4).reshape(bsz, t_len, nh, dv), s_fin


def rwkv7_scan(r, w, k, v, kk, a, s0):
    def tm(z):
        return jnp.moveaxis(z.astype(jnp.float32), 1, 0)

    def step(s, inp):
        r_t, w_t, k_t, v_t, kk_t, a_t = inp
        sk = jnp.einsum('bhvk,bhk->bhv', s, kk_t)
        s = s * w_t[:, :, None, :] - sk[..., None] * (kk_t * a_t)[:, :, None, :] + v_t[..., None] * k_t[:, :, None, :]
        return s, jnp.einsum('bhvk,bhk->bhv', s, r_t)

    s_fin, o = lax.scan(step, s0.astype(jnp.float32), (tm(r), tm(w), tm(k), tm(v), tm(kk), tm(a)))
    return jnp.moveaxis(o, 0, 1), s_fin


def token_mix(h, p, ctx):
    bsz, t_len, _ = h.shape
    f32 = jnp.float32
    lat = ctx is not None

    def heads(t, nh):
        return t.reshape(bsz, t_len, nh, -1)

    z = h @ p['w_in']
    (q_na, k_na, v_na, q_rt, k_rt, v_rt, g_rt, z_rw, g_a, g_b, g_c) = jnp.split(z, _split_points(IN_SIZES), axis=-1)

    q_na, k_na, v_na = heads(q_na, NA_HEADS), heads(k_na, NA_HEADS), heads(v_na, NA_HEADS)
    if lat:
        o_na = na_latent(q_na, k_na, v_na, ctx[0], ctx[1], p['na_rpb'])
    else:
        o_na = ctx_attention(q_na, k_na, v_na)

    q_rt, k_rt, v_rt = heads(q_rt, RET_HEADS), heads(k_rt, RET_HEADS), heads(v_rt, RET_HEADS)
    if lat:
        q_rt, k_rt = axial_rope(q_rt), axial_rope(k_rt)
        s_ret0 = ctx[2]
    else:
        s_ret0 = jnp.zeros((bsz, 2, RET_HEADS, RET_DK, RET_DV), f32)
    k_rt = k_rt * RET_DK ** -0.5
    gam = jax.nn.sigmoid(p['ret_decay_logit'].astype(f32))
    o_f, s_f = retention_scan(q_rt, k_rt, v_rt, gam[0], s_ret0[:, 0])
    o_b, s_b = retention_scan(flip(q_rt), flip(k_rt), flip(v_rt), gam[1], s_ret0[:, 1])
    o_rt = (head_norm(o_f + flip(o_b), p['ret_gn_w'], p['ret_gn_b'], RET_GN_EPS)
            * jax.nn.silu(g_rt.astype(f32))).astype(h.dtype)

    z_rw = centered_shift(z_rw, p['rwkv_mu'])
    r_c, k_c, v_c, wl_f, wl_b, al_f, al_b, gl = jnp.split(z_rw, _split_points(RWKV_SIZES), axis=-1)
    g_rw = jax.nn.sigmoid(gl) @ p['rwkv_g_up']
    kk = heads((k_c * p['rwkv_k_k']).astype(f32), RWKV_HEADS)
    kk = kk * lax.rsqrt(jnp.maximum(jnp.sum(kk * kk, -1, keepdims=True), 1e-24))
    r_h, v_h, k_h = heads(r_c, RWKV_HEADS), heads(v_c, RWKV_HEADS), heads(k_c, RWKV_HEADS)
    s_rw0 = ctx[3] if lat else jnp.zeros((bsz, 2, RWKV_HEADS, RWKV_N, RWKV_N), f32)
    outs, states = [], []
    for d, (wl, al) in enumerate(((wl_f, al_f), (wl_b, al_b))):
        w = jnp.exp(-RWKV_DECAY_SCALE * jax.nn.sigmoid((p['rwkv_w0'][d] + jnp.tanh(wl) @ p['rwkv_w_up'][d]).astype(f32)))
        a = jax.nn.sigmoid((p['rwkv_a0'][d] + al @ p['rwkv_a_up'][d]).astype(f32))
        k_d = k_c.astype(f32) * (1.0 + (a - 1.0) * p['rwkv_k_a'].astype(f32))
        seq = (r_h, heads(w, RWKV_HEADS), heads(k_d, RWKV_HEADS), v_h, kk, heads(a, RWKV_HEADS))
        if d == 1:
            seq = tuple(flip(t) for t in seq)
        o, s = rwkv7_scan(*seq, s_rw0[:, d])
        outs.append(flip(o) if d == 1 else o)
        states.append(s)
    bonus = jnp.sum(r_h.astype(f32) * k_h.astype(f32) * p['rwkv_r_k'].astype(f32), -1, keepdims=True) * v_h.astype(f32)
    o_rw = ((head_norm(outs[0] + outs[1], p['rwkv_gn_w'], p['rwkv_gn_b'], RWKV_GN_EPS)
             + bonus.reshape(bsz, t_len, RWKV_WIDTH)) * g_rw.astype(f32)).astype(h.dtype)

    w_br = p['w_br']
    merged = (jax.nn.sigmoid(g_a) * (o_na @ w_br[0])
              + jax.nn.sigmoid(g_b) * (o_rt @ w_br[1])
              + jax.nn.sigmoid(g_c) * (o_rw @ w_br[2]))
    out = merged @ p['w_out']
    if lat:
        return out, None
    return out, (k_na.transpose(0, 2, 1, 3), v_na.transpose(0, 2, 1, 3),
                 jnp.stack([s_f, s_b], axis=1), jnp.stack(states, axis=1))


def peer(h, wq, keys, u, v):
    bsz, t_len, d = h.shape
    xs = h.reshape(-1, PEER_TOK_BLOCK, d)

    def blk(xb):
        n = xb.shape[0]
        q = (xb @ wq).reshape(n, PEER_HEADS, 2, PEER_DK // 2)
        s = jnp.einsum('nhpd,hpkd->nhpk', q, keys).astype(jnp.float32)
        ts, ti = lax.top_k(s, PEER_TOPK)
        cand = (ts[:, :, 0, :, None] + ts[:, :, 1, None, :]).reshape(n, PEER_HEADS, PEER_TOPK * PEER_TOPK)
        cidx = (ti[:, :, 0, :, None] * PEER_NKEYS + ti[:, :, 1, None, :]).reshape(n, PEER_HEADS, PEER_TOPK * PEER_TOPK)
        fs, fpos = lax.top_k(cand, PEER_TOPK)
        eidx = jnp.take_along_axis(cidx, fpos, axis=-1).reshape(n, PEER_HEADS * PEER_TOPK)
        g = jax.nn.softmax(fs, axis=-1).reshape(n, PEER_HEADS * PEER_TOPK)
        act = jax.nn.gelu(jnp.einsum('nkd,nd->nk', u[eidx], xb).astype(jnp.float32), approximate=False) * g
        return jnp.einsum('nk,nkd->nd', act.astype(xb.dtype), v[eidx])

    return lax.map(blk, xs).reshape(bsz, t_len, d)


def trunk_layer(x, mod, p, ctx):
    sh_a, sc_a, gt_a, sh_f, sc_f, gt_f = jnp.split(mod, 6, axis=-1)
    h = layer_norm(x) * (1.0 + sc_a) + sh_a
    t, new_ctx = token_mix(h, p, ctx)
    x = layer_norm(DEEPNORM_ALPHA * x + gt_a * t, p['ln_a_g'], p['ln_a_b'])
    h = layer_norm(x) * (1.0 + sc_f) + sh_f
    f = peer(h, p['peer_wq'], p['peer_keys'], p['peer_u'], p['peer_v'])
    x = layer_norm(DEEPNORM_ALPHA * x + gt_f * f, p['ln_f_g'], p['ln_f_b'])
    return x, new_ctx


def setup_inputs(seed: int = 0) -> dict:
    key = jax.random.key(seed)
    ks = iter(jax.random.split(key, 48))
    f32 = jnp.float32
    D = D_MODEL
    L = DEPTH

    def nrm(shape, scale):
        return jax.random.normal(next(ks), shape, f32) * scale

    ret_base = 1.0 - 2.0 ** (-5.0 - jnp.arange(RET_HEADS, dtype=f32))
    ret_logit = jnp.log(ret_base / (1.0 - ret_base))
    return {
        'x_prompt': nrm((BATCH, SEQ, D), 1.0),
        'x_sample': nrm((DEC_BATCH, DEC_SEQ, D), 1.0),
        'cache_na_k': nrm((DEC_BATCH, L, NA_HEADS, PAST_LEN, NA_HEAD_DIM), 1.0),
        'cache_na_v': nrm((DEC_BATCH, L, NA_HEADS, PAST_LEN, NA_HEAD_DIM), 1.0),
        'state_ret': nrm((DEC_BATCH, L, 2, RET_HEADS, RET_DK, RET_DV), 0.5),
        'state_rwkv': nrm((DEC_BATCH, L, 2, RWKV_HEADS, RWKV_N, RWKV_N), 0.5),
        'c': nrm((DEC_BATCH, D), 1.0),
        'c_ctx': nrm((D,), 1.0),
        'w_mod': nrm((L, D, 6 * D), D ** -0.5),
        'b_mod': nrm((L, 6 * D), 0.02),
        'w_in': nrm((L, D, P_IN), D ** -0.5),
        'na_rpb': nrm((L, NA_HEADS, 2 * WIN_R - 1, 2 * WIN_C - 1), 0.02),
        'ret_decay_logit': ret_logit[None, None, :] + nrm((L, 2, RET_HEADS), 0.1),
        'ret_gn_w': 1.0 + nrm((L, RET_V_WIDTH), 0.02),
        'ret_gn_b': nrm((L, RET_V_WIDTH), 0.02),
        'rwkv_mu': jax.random.uniform(next(ks), (L, RWKV_SHIFT_WIDTH), f32),
        'rwkv_w0': nrm((L, 2, RWKV_WIDTH), 0.5),
        'rwkv_w_up': nrm((L, 2, RWKV_LORA_W, RWKV_WIDTH), RWKV_LORA_W ** -0.5),
        'rwkv_a0': nrm((L, 2, RWKV_WIDTH), 0.5),
        'rwkv_a_up': nrm((L, 2, RWKV_LORA_A, RWKV_WIDTH), RWKV_LORA_A ** -0.5),
        'rwkv_g_up': nrm((L, RWKV_LORA_G, RWKV_WIDTH), RWKV_LORA_G ** -0.5),
        'rwkv_k_k': 0.85 + nrm((L, RWKV_WIDTH), 0.02),
        'rwkv_k_a': 1.0 + nrm((L, RWKV_WIDTH), 0.02),
        'rwkv_r_k': nrm((L, RWKV_HEADS, RWKV_N), 0.1),
        'rwkv_gn_w': 1.0 + nrm((L, RWKV_WIDTH), 0.02),
        'rwkv_gn_b': nrm((L, RWKV_WIDTH), 0.02),
        'w_br': nrm((L, N_BRANCH, BRANCH_WIDTH, D), BRANCH_WIDTH ** -0.5),
        'w_out': nrm((L, D, D), D ** -0.5 * DEEPNORM_BETA),
        'ln_a_g': 1.0 + nrm((L, D), 0.02),
        'ln_a_b': nrm((L, D), 0.02),
        'ln_f_g': 1.0 + nrm((L, D), 0.02),
        'ln_f_b': nrm((L, D), 0.02),
        'peer_wq': nrm((L, D, PEER_HEADS * PEER_DK), D ** -0.5),
        'peer_keys': nrm((L, PEER_HEADS, 2, PEER_NKEYS, PEER_DK // 2), (PEER_DK // 2) ** -0.5),
        'peer_u': nrm((L, PEER_N_EXPERTS, D), D ** -0.5),
        'peer_v': nrm((L, PEER_N_EXPERTS, D), (PEER_HEADS * PEER_TOPK) ** -0.5 * DEEPNORM_BETA),
    }


def reference(x_prompt, x_sample, cache_na_k, cache_na_v, state_ret, state_rwkv, c, c_ctx,
              w_mod, b_mod, w_in, na_rpb, ret_decay_logit, ret_gn_w, ret_gn_b,
              rwkv_mu, rwkv_w0, rwkv_w_up, rwkv_a0, rwkv_a_up, rwkv_g_up, rwkv_k_k, rwkv_k_a,
              rwkv_r_k, rwkv_gn_w, rwkv_gn_b, w_br, w_out, ln_a_g, ln_a_b, ln_f_g, ln_f_b,
              peer_wq, peer_keys, peer_u, peer_v):
    weights = {
        'w_in': w_in, 'na_rpb': na_rpb, 'ret_decay_logit': ret_decay_logit,
        'ret_gn_w': ret_gn_w, 'ret_gn_b': ret_gn_b, 'rwkv_mu': rwkv_mu, 'rwkv_w0': rwkv_w0,
        'rwkv_w_up': rwkv_w_up, 'rwkv_a0': rwkv_a0, 'rwkv_a_up': rwkv_a_up, 'rwkv_g_up': rwkv_g_up,
        'rwkv_k_k': rwkv_k_k, 'rwkv_k_a': rwkv_k_a, 'rwkv_r_k': rwkv_r_k, 'rwkv_gn_w': rwkv_gn_w,
        'rwkv_gn_b': rwkv_gn_b, 'w_br': w_br, 'w_out': w_out, 'ln_a_g': ln_a_g, 'ln_a_b': ln_a_b,
        'ln_f_g': ln_f_g, 'ln_f_b': ln_f_b, 'peer_wq': peer_wq, 'peer_keys': peer_keys,
        'peer_u': peer_u, 'peer_v': peer_v,
    }
    y_prompt, y_sample = x_prompt, x_sample
    nk_list, nv_list, sr_list, sw_list = [], [], [], []
    for l in range(DEPTH):
        p = {name: arr[l] for name, arr in weights.items()}
        mod_ctx = (jax.nn.silu(c_ctx) @ w_mod[l] + b_mod[l])[None, None, :]
        y_prompt, (nk, nv, sr, sw) = trunk_layer(y_prompt, mod_ctx, p, None)
        nk_list.append(nk)
        nv_list.append(nv)
        sr_list.append(sr)
        sw_list.append(sw)
        mod_lat = (jax.nn.silu(c) @ w_mod[l] + b_mod[l])[:, None, :]
        y_sample, _ = trunk_layer(y_sample, mod_lat, p,
                                  (cache_na_k[:, l], cache_na_v[:, l], state_ret[:, l], state_rwkv[:, l]))
    dt = x_prompt.dtype
    new_na_k = jnp.stack(nk_list, axis=1).astype(dt)
    new_na_v = jnp.stack(nv_list, axis=1).astype(dt)
    new_state_ret = jnp.stack(sr_list, axis=1).astype(dt)
    new_state_rwkv = jnp.stack(sw_list, axis=1).astype(dt)
    return (y_prompt, y_sample, new_na_k, new_na_v, new_state_ret, new_state_rwkv)
```

```cpp
#include <hip/hip_runtime.h>
#include <hip/hip_bf16.h>
#include <hip/hip_cooperative_groups.h>
#include <cstdio>
namespace cg = cooperative_groups;

typedef unsigned short u16;
using bf16x8 = __attribute__((ext_vector_type(8))) short;
using f32x4 = __attribute__((ext_vector_type(4))) float;
#define DEVI __device__ __forceinline__
__device__ __forceinline__ int ltid_() { int t = threadIdx.x; asm volatile("" : "+v"(t)); return t; }
#define TIDX ltid_()

constexpr int NTOK = 8192;
constexpr int PIN = 8064;
constexpr float ALPHA = 1.4142135623730951f;
constexpr size_t OUT_Y = 0;
constexpr size_t OUT_NAK = 8388608;
constexpr size_t OUT_NAV = 12582912;
constexpr size_t OUT_SRET = 16777216;
constexpr size_t OUT_SRW = 18874368;
constexpr size_t OFF_CTR = 0;
constexpr size_t OFF_TAB = 4096;
constexpr size_t OFF_MOD = 16384;
constexpr size_t OFF_WINT = 1048576;
constexpr size_t OFF_WBRT = OFF_WINT + 33030144;
constexpr size_t OFF_WOUTT = OFF_WBRT + 6291456;
constexpr size_t OFF_WQT = OFF_WOUTT + 4194304;
constexpr size_t OFF_WUPT = OFF_WQT + 4194304;
constexpr size_t OFF_AUPT = OFF_WUPT + 262144;
constexpr size_t OFF_GUPT = OFF_AUPT + 262144;
constexpr size_t OFF_UB = OFF_GUPT + 262144;
constexpr size_t OFF_VB = OFF_UB + 33554432;
constexpr size_t OFF_Z = OFF_VB + 33554432;
constexpr size_t OFF_X = OFF_Z + 132120576;
constexpr size_t OFF_H = OFF_X + 33554432;
constexpr size_t OFF_ONA = OFF_H + 16777216;
constexpr size_t OFF_ORT = OFF_ONA + 8388608;
constexpr size_t OFF_ORW = OFF_ORT + 8388608;
constexpr size_t OFF_GA = OFF_ORW + 8388608;
constexpr size_t SZB = 8388608;
constexpr size_t OFF_RWW = OFF_GA;
constexpr size_t OFF_RWR = OFF_RWW + 4 * SZB;
constexpr size_t OFF_RWV = OFF_RWR + SZB;
constexpr size_t OFF_RWKK = OFF_RWV + SZB;
constexpr size_t OFF_RWKC = OFF_RWKK + SZB;
constexpr size_t OFF_RWKD = OFF_RWKC + SZB;
constexpr size_t OFF_RWKKA = OFF_RWKD + 2 * SZB;
constexpr size_t OFF_RWG = OFF_RWKKA + 2 * SZB;
constexpr size_t OFF_RWBON = OFF_RWG + SZB;
constexpr size_t OFF_OF = OFF_RWBON + SZB;
constexpr size_t OFF_KV = OFF_OF + 4 * SZB;
constexpr size_t OFF_END = OFF_KV + 33554432;
constexpr size_t OFF_Y = OFF_GA;
constexpr size_t OFF_X1 = OFF_GA + 33554432;
constexpr size_t OFF_Q = OFF_GA + 2 * 33554432;
constexpr size_t OFF_H2 = OFF_GA + 3 * 33554432;
constexpr size_t OFF_EIDX = OFF_H2 + 16777216;
constexpr size_t OFF_GATE = OFF_EIDX + 4194304;

struct KArgs {
  const float* in[36];
  float* out;
  unsigned char* ws;
};
struct Params {
  const float* const* in;
  float* out;
  unsigned char* ws;
};
DEVI const float* uniform_ptr(const float* q) {
  unsigned long long v = (unsigned long long)q;
  unsigned lo = __builtin_amdgcn_readfirstlane((unsigned)v), hi = __builtin_amdgcn_readfirstlane((unsigned)(v >> 32));
  return (const float*)(((unsigned long long)hi << 32) | lo);
}

DEVI float bf2f(u16 h) { return __uint_as_float(((unsigned)h) << 16); }
DEVI unsigned cvtpk(float lo, float hi) {
  unsigned r;
  asm volatile("v_cvt_pk_bf16_f32 %0, %1, %2" : "=v"(r) : "v"(lo), "v"(hi));
  return r;
}
DEVI u16 f2bf(float f) { return (u16)(cvtpk(f, f) & 0xffffu); }
DEVI float sigmoidf_(float x) { return 1.f / (1.f + __expf(-x)); }
template <int CTRL> DEVI float dpp(float x) {
  return __builtin_bit_cast(float, __builtin_amdgcn_update_dpp(0, __builtin_bit_cast(int, x), CTRL, 0xf, 0xf, true));
}
DEVI float quad_sum(float x) { x += dpp<0xB1>(x); x += dpp<0x4E>(x); return x; }
DEVI float row16_sum(float x) { x = quad_sum(x); x += dpp<0x141>(x); x += dpp<0x140>(x); return x; }
DEVI float wave_sum(float x) { x = row16_sum(x); x += __shfl_xor(x, 16); x += __shfl_xor(x, 32); return x; }
DEVI void unpack8(uint4 v, float* f) {
  f[0] = __uint_as_float(v.x << 16); f[1] = __uint_as_float(v.x & 0xffff0000u);
  f[2] = __uint_as_float(v.y << 16); f[3] = __uint_as_float(v.y & 0xffff0000u);
  f[4] = __uint_as_float(v.z << 16); f[5] = __uint_as_float(v.z & 0xffff0000u);
  f[6] = __uint_as_float(v.w << 16); f[7] = __uint_as_float(v.w & 0xffff0000u);
}
DEVI void unpack4(uint2 v, float* f) {
  f[0] = __uint_as_float(v.x << 16); f[1] = __uint_as_float(v.x & 0xffff0000u);
  f[2] = __uint_as_float(v.y << 16); f[3] = __uint_as_float(v.y & 0xffff0000u);
}
DEVI uint4 pack8(const float* f) {
  uint4 r; r.x = cvtpk(f[0], f[1]); r.y = cvtpk(f[2], f[3]); r.z = cvtpk(f[4], f[5]); r.w = cvtpk(f[6], f[7]); return r;
}
DEVI f32x4 mfma16(bf16x8 a, bf16x8 b, f32x4 c) { return __builtin_amdgcn_mfma_f32_16x16x32_bf16(a, b, c, 0, 0, 0); }
DEVI int modrow(int tok) { return tok < 4096 ? 0 : 1 + ((tok - 4096) >> 11); }
DEVI const float* xin_row(const Params& p, int tok) {
  return tok < 4096 ? p.in[0] + (size_t)tok * 1024 : p.in[1] + (size_t)(tok - 4096) * 1024;
}
DEVI int clampi(int v, int lo, int hi) { return v < lo ? lo : (v > hi ? hi : v); }

template <int NT> DEVI void wave_mma(const u16* A, int lda, const u16* B, int ldb, int K, f32x4* acc) {
  const int lane = TIDX & 63, fr = lane & 15, fq = lane >> 4;
  for (int k0 = 0; k0 < K; k0 += 32) {
    bf16x8 a = *(const bf16x8*)(A + fr * lda + k0 + fq * 8);
#pragma unroll
    for (int n = 0; n < NT; ++n) {
      bf16x8 b = *(const bf16x8*)(B + (n * 16 + fr) * ldb + k0 + fq * 8);
      acc[n] = mfma16(a, b, acc[n]);
    }
  }
}

DEVI void gemm_acc(const u16* __restrict__ A, int lda, const u16* __restrict__ Bt, int ldb, int K, int m0, int n0,
                   unsigned char* sm, f32x4 (&acc)[4][4]) {
  unsigned char* SA = sm;
  unsigned char* SB = sm + 8192;
  const int tid = TIDX, lane = tid & 63, wid = tid >> 6, wr = wid >> 1, wc = wid & 1, fr = lane & 15, fq = lane >> 4;
  const int nk = K >> 5;
  for (int kt = 0; kt < nk; ++kt) {
#pragma unroll
    for (int i = 0; i < 2; ++i) {
      int b = tid * 16 + i * 4096, r = b >> 6, c = (b & 63) >> 1;
      __builtin_amdgcn_global_load_lds((const unsigned*)(A + (size_t)(m0 + r) * lda + kt * 32 + c), (__attribute__((address_space(3))) unsigned*)(SA + b), 16, 0, 0);
      __builtin_amdgcn_global_load_lds((const unsigned*)(Bt + (size_t)(n0 + r) * ldb + kt * 32 + c), (__attribute__((address_space(3))) unsigned*)(SB + b), 16, 0, 0);
    }
    asm volatile("s_waitcnt vmcnt(0)" ::: "memory");
    __syncthreads();
    bf16x8 a[4], b[4];
#pragma unroll
    for (int m = 0; m < 4; ++m) a[m] = *(const bf16x8*)(SA + (wr * 64 + m * 16 + fr) * 64 + fq * 16);
#pragma unroll
    for (int n = 0; n < 4; ++n) b[n] = *(const bf16x8*)(SB + (wc * 64 + n * 16 + fr) * 64 + fq * 16);
#pragma unroll
    for (int m = 0; m < 4; ++m)
#pragma unroll
      for (int n = 0; n < 4; ++n) acc[m][n] = mfma16(a[m], b[n], acc[m][n]);
    __syncthreads();
  }
}
#define EPI_LOOP                                                                                         \
  const int _lane = TIDX & 63, _wid = TIDX >> 6, _wr = _wid >> 1, _wc = _wid & 1, _fr = _lane & 15, \
            _fq = _lane >> 4;                                                                            \
  _Pragma("unroll") for (int m = 0; m < 4; ++m) _Pragma("unroll") for (int n = 0; n < 4; ++n)            \
      _Pragma("unroll") for (int j = 0; j < 4; ++j)
#define EPI_ROW (m0 + _wr * 64 + m * 16 + _fq * 4 + j)
#define EPI_COL (n0 + _wc * 64 + n * 16 + _fr)

DEVI void zero_acc(f32x4 (&acc)[4][4]) {
#pragma unroll
  for (int m = 0; m < 4; ++m)
#pragma unroll
    for (int n = 0; n < 4; ++n) acc[m][n] = f32x4{0.f, 0.f, 0.f, 0.f};
}

__constant__ double ROPE_FREQ[16] = {1.0, 0.5623413251903491, 0.31622776601683794, 0.1778279410038923, 0.1,
                                     0.05623413251903491, 0.03162277660168379, 0.01778279410038923, 0.01,
                                     0.005623413251903491, 0.0031622776601683794, 0.0017782794100389228, 0.001,
                                     0.0005623413251903491, 0.00031622776601683794, 0.00017782794100389227};

DEVI void transpose_tile(const float* __restrict__ src, int K, int N, u16* __restrict__ dst, int kt, int nt, unsigned char* sm) {
  float* tile = (float*)sm;
  const int tid = TIDX;
  const int k0 = kt * 64, n0 = nt * 64;
#pragma unroll
  for (int i = 0; i < 16; ++i) {
    int kk = i * 4 + (tid >> 6), nn = tid & 63;
    tile[kk * 65 + nn] = src[(size_t)(k0 + kk) * N + n0 + nn];
  }
  __syncthreads();
#pragma unroll
  for (int i = 0; i < 16; ++i) {
    int nn = i * 4 + (tid >> 6), kk = tid & 63;
    dst[(size_t)(n0 + nn) * K + k0 + kk] = f2bf(tile[kk * 65 + nn]);
  }
}

DEVI void convert_uv_item(const Params& p, int l, int it) {
  const int which = it >> 12, chunk = it & 4095;
  const float* src = p.in[34 + which] + (size_t)l * 16777216 + (size_t)chunk * 4096;
  u16* dst = (u16*)(p.ws + (which ? OFF_VB : OFF_UB)) + (size_t)chunk * 4096;
#pragma unroll
  for (int i = 0; i < 4; ++i) {
    int e = i * 1024 + TIDX * 4;
    float4 v = *(const float4*)(src + e);
    uint2 o; o.x = cvtpk(v.x, v.y); o.y = cvtpk(v.z, v.w);
    *(uint2*)(dst + e) = o;
  }
}

constexpr int P0_NT = 5920;
constexpr int P0_NUV = 8192;
constexpr int P0_NMOD = 192;
constexpr int P0_TOTAL = P0_NMOD + P0_NT + P0_NUV + 1;

DEVI void phase0_item(const Params& p, int it, unsigned char* sm) {
  const int tid = TIDX;
  if (it < P0_NMOD) {
    const int l = it / 96, n0 = (it % 96) * 64;
    const int kg = tid >> 4, c4 = (tid & 15) * 4;
    float acc[3][4];
#pragma unroll
    for (int r = 0; r < 3; ++r)
#pragma unroll
      for (int i = 0; i < 4; ++i) acc[r][i] = 0.f;
    const float* wm = p.in[8] + (size_t)l * 1024 * 6144;
    for (int k = kg * 64; k < kg * 64 + 64; ++k) {
      float4 w = *(const float4*)(wm + (size_t)k * 6144 + n0 + c4);
      float c0 = p.in[7][k], c1 = p.in[6][k], c2 = p.in[6][1024 + k];
      float s0 = c0 * sigmoidf_(c0), s1 = c1 * sigmoidf_(c1), s2 = c2 * sigmoidf_(c2);
      acc[0][0] += s0 * w.x; acc[0][1] += s0 * w.y; acc[0][2] += s0 * w.z; acc[0][3] += s0 * w.w;
      acc[1][0] += s1 * w.x; acc[1][1] += s1 * w.y; acc[1][2] += s1 * w.z; acc[1][3] += s1 * w.w;
      acc[2][0] += s2 * w.x; acc[2][1] += s2 * w.y; acc[2][2] += s2 * w.z; acc[2][3] += s2 * w.w;
    }
    float* red = (float*)sm;
#pragma unroll
    for (int r = 0; r < 3; ++r)
#pragma unroll
      for (int i = 0; i < 4; ++i) red[(kg * 3 + r) * 64 + c4 + i] = acc[r][i];
    __syncthreads();
    if (tid < 192) {
      int r = tid >> 6, col = tid & 63;
      float s = p.in[9][(size_t)l * 6144 + n0 + col];
      for (int g = 0; g < 16; ++g) s += red[(g * 3 + r) * 64 + col];
      ((float*)(p.ws + OFF_MOD))[((size_t)l * 3 + r) * 6144 + n0 + col] = s;
    }
    return;
  }
  it -= P0_NMOD;
  if (it < P0_NT) {
    int t = it;
    const float* src; u16* dst; int K, N, kt, nt;
    if (t < 4032) { int l = t / 2016, r = t % 2016; kt = r / 126; nt = r % 126; K = 1024; N = 8064;
      src = p.in[10] + (size_t)l * 1024 * 8064; dst = (u16*)(p.ws + OFF_WINT) + (size_t)l * 8064 * 1024; }
    else if ((t -= 4032) < 768) { int j = t / 128, r = t % 128; kt = r / 16; nt = r % 16; K = 512; N = 1024;
      src = p.in[26] + (size_t)j * 512 * 1024; dst = (u16*)(p.ws + OFF_WBRT) + (size_t)j * 1024 * 512; }
    else if ((t -= 768) < 512) { int l = t / 256, r = t % 256; kt = r / 16; nt = r % 16; K = 1024; N = 1024;
      src = p.in[27] + (size_t)l * 1048576; dst = (u16*)(p.ws + OFF_WOUTT) + (size_t)l * 1048576; }
    else if ((t -= 512) < 512) { int l = t / 256, r = t % 256; kt = r / 16; nt = r % 16; K = 1024; N = 1024;
      src = p.in[32] + (size_t)l * 1048576; dst = (u16*)(p.ws + OFF_WQT) + (size_t)l * 1048576; }
    else if ((t -= 512) < 32) { int j = t / 8; kt = 0; nt = t % 8; K = 64; N = 512;
      src = p.in[17] + (size_t)j * 32768; dst = (u16*)(p.ws + OFF_WUPT) + (size_t)j * 32768; }
    else if ((t -= 32) < 32) { int j = t / 8; kt = 0; nt = t % 8; K = 64; N = 512;
      src = p.in[19] + (size_t)j * 32768; dst = (u16*)(p.ws + OFF_AUPT) + (size_t)j * 32768; }
    else { t -= 32; int l = t / 16, r = t % 16; kt = r / 8; nt = r % 8; K = 128; N = 512;
      src = p.in[20] + (size_t)l * 65536; dst = (u16*)(p.ws + OFF_GUPT) + (size_t)l * 65536; }
    transpose_tile(src, K, N, dst, kt, nt, sm);
    return;
  }
  it -= P0_NT;
  if (it < P0_NUV) { convert_uv_item(p, 0, it); return; }
  float* tab = (float*)(p.ws + OFF_TAB);
  for (int e = tid; e < 1024; e += 256) {
    int pos = e >> 4, f = e & 15;
    double rev = (double)pos * ROPE_FREQ[f] * 0.15915494309189535;
    rev -= floor(rev);
    float rf = (float)rev;
    tab[e] = __builtin_amdgcn_cosf(rf);
    tab[1024 + e] = __builtin_amdgcn_sinf(rf);
  }
}

DEVI void ln1_item(const Params& p, int it) {
  const int lane = TIDX & 63, w = TIDX >> 6;
  const int tok = it * 4 + w;
  const float* x = xin_row(p, tok);
  const float* mod = (const float*)(p.ws + OFF_MOD) + (size_t)modrow(tok) * 6144;
  float4 v[4];
  float s = 0.f;
#pragma unroll
  for (int i = 0; i < 4; ++i) { v[i] = *(const float4*)(x + lane * 4 + 256 * i); s += v[i].x + v[i].y + v[i].z + v[i].w; }
  float mu = wave_sum(s) * (1.f / 1024.f);
  float q = 0.f;
#pragma unroll
  for (int i = 0; i < 4; ++i) { float a = v[i].x - mu, b = v[i].y - mu, c = v[i].z - mu, d = v[i].w - mu; q += a * a + b * b + c * c + d * d; }
  float rs = rsqrtf(wave_sum(q) * (1.f / 1024.f) + 1e-5f);
  u16* H = (u16*)(p.ws + OFF_H) + (size_t)tok * 1024;
#pragma unroll
  for (int i = 0; i < 4; ++i) {
    int c = lane * 4 + 256 * i;
    float4 sh = *(const float4*)(mod + c), sc = *(const float4*)(mod + 1024 + c);
    uint2 o;
    o.x = cvtpk((v[i].x - mu) * rs * (1.f + sc.x) + sh.x, (v[i].y - mu) * rs * (1.f + sc.y) + sh.y);
    o.y = cvtpk((v[i].z - mu) * rs * (1.f + sc.z) + sh.z, (v[i].w - mu) * rs * (1.f + sc.w) + sh.w);
    *(uint2*)(H + c) = o;
  }
}

DEVI void g1_item(const Params& p, int l, int it, unsigned char* sm) {
  const int nt = it >> 6, mt = it & 63;
  const int m0 = mt * 128, n0 = nt * 128;
  f32x4 acc[4][4];
  zero_acc(acc);
  gemm_acc((const u16*)(p.ws + OFF_H), 1024, (const u16*)(p.ws + OFF_WINT) + (size_t)l * 8064 * 1024, 1024, 1024, m0, n0, sm, acc);
  u16* Z = (u16*)(p.ws + OFF_Z);
  EPI_LOOP {
    int row = EPI_ROW, col = EPI_COL;
    float v = acc[m][n][j];
    Z[(size_t)row * PIN + col] = f2bf(v);
    if (row < 4096 && col >= 512 && col < 1536) {
      int which = (col - 512) >> 9, cc = (col - 512) & 511, h = cc >> 6, d = cc & 63, b = row >> 8, s = row & 255;
      p.out[OUT_NAK + (size_t)which * 4194304 + ((((size_t)(b * 2 + l) * 8 + h) * 256 + s) * 64 + d)] = v;
    }
  }
}
DEVI void g2_item(const Params& p, int l, int it, unsigned char* sm) {
  const int nt = it >> 6, mt = it & 63;
  const int m0 = mt * 128, n0 = nt * 128;
  f32x4 tot[4][4];
  zero_acc(tot);
  const u16* Z = (const u16*)(p.ws + OFF_Z);
  for (int i = 0; i < 3; ++i) {
    f32x4 acc[4][4];
    zero_acc(acc);
    const u16* A = (const u16*)(p.ws + (i == 0 ? OFF_ONA : (i == 1 ? OFF_ORT : OFF_ORW)));
    gemm_acc(A, 512, (const u16*)(p.ws + OFF_WBRT) + (size_t)(l * 3 + i) * 1024 * 512, 512, 512, m0, n0, sm, acc);
    EPI_LOOP {
      int row = EPI_ROW, col = EPI_COL;
      float g = bf2f(Z[(size_t)row * PIN + 4992 + i * 1024 + col]);
      tot[m][n][j] += sigmoidf_(g) * acc[m][n][j];
    }
  }
  u16* MG = (u16*)(p.ws + OFF_H);
  EPI_LOOP { MG[(size_t)EPI_ROW * 1024 + EPI_COL] = f2bf(tot[m][n][j]); }
}
DEVI void g3_item(const Params& p, int l, int it, unsigned char* sm) {
  const int nt = it >> 6, mt = it & 63;
  const int m0 = mt * 128, n0 = nt * 128;
  f32x4 acc[4][4];
  zero_acc(acc);
  gemm_acc((const u16*)(p.ws + OFF_H), 1024, (const u16*)(p.ws + OFF_WOUTT) + (size_t)l * 1048576, 1024, 1024, m0, n0, sm, acc);
  float* Y = (float*)(p.ws + OFF_Y);
  const float* mod = (const float*)(p.ws + OFF_MOD) + (size_t)l * 3 * 6144;
  const float* X = (const float*)(p.ws + OFF_X);
  EPI_LOOP {
    int row = EPI_ROW, col = EPI_COL;
    float xr = (l == 0) ? xin_row(p, row)[col] : X[(size_t)row * 1024 + col];
    float gt = mod[(size_t)modrow(row) * 6144 + 2048 + col];
    Y[(size_t)row * 1024 + col] = ALPHA * xr + gt * acc[m][n][j];
  }
}
DEVI void g4_item(const Params& p, int l, int it, unsigned char* sm) {
  const int nt = it >> 6, mt = it & 63;
  const int m0 = mt * 128, n0 = nt * 128;
  f32x4 acc[4][4];
  zero_acc(acc);
  gemm_acc((const u16*)(p.ws + OFF_H2), 1024, (const u16*)(p.ws + OFF_WQT) + (size_t)l * 1048576, 1024, 1024, m0, n0, sm, acc);
  float* Q = (float*)(p.ws + OFF_Q);
  EPI_LOOP { Q[(size_t)EPI_ROW * 1024 + EPI_COL] = acc[m][n][j]; }
}

DEVI void load_qk16(const u16* zp  , int part, bool lat, int prow, int pcol, const float* tab,
                    float scale, float* out) {
  if (!lat) {
    float t[16];
    unpack8(*(const uint4*)(zp + part * 16), t);
    unpack8(*(const uint4*)(zp + part * 16 + 8), t + 8);
#pragma unroll
    for (int i = 0; i < 16; ++i) out[i] = t[i] * scale;
    return;
  }
  const int half = part >> 1, isp2 = part & 1;
  float p1[16], p2[16];
  unpack8(*(const uint4*)(zp + half * 32), p1);
  unpack8(*(const uint4*)(zp + half * 32 + 8), p1 + 8);
  unpack8(*(const uint4*)(zp + half * 32 + 16), p2);
  unpack8(*(const uint4*)(zp + half * 32 + 24), p2 + 8);
  const int pos = half ? pcol : prow;
  const float* ct = tab + pos * 16;
  const float* st = tab + 1024 + pos * 16;
#pragma unroll
  for (int f = 0; f < 16; ++f) {
    float c = ct[f], s = st[f];
    out[f] = (isp2 ? (p1[f] * s + p2[f] * c) : (p1[f] * c - p2[f] * s)) * scale;
  }
}
struct RetItem { int lat, b, h, n, N, seqbase, kvbase; };
DEVI RetItem ret_decode(int it) {
  RetItem r;
  if (it < 256) { r.lat = 1; r.b = it >> 7; r.h = (it >> 5) & 3; r.n = it & 31; r.N = 32; r.seqbase = 4096 + r.b * 2048; r.kvbase = 256 + (r.b * 4 + r.h) * 32; }
  else { int j = it - 256; r.lat = 0; r.b = j >> 4; r.h = (j >> 2) & 3; r.n = j & 3; r.N = 4; r.seqbase = r.b * 256; r.kvbase = (r.b * 4 + r.h) * 4; }
  return r;
}
DEVI void ret_gammas(const Params& p, int l, int h, float& lgf, float& lgb) {
  float xf = p.in[12][(l * 2 + 0) * 4 + h], xb = p.in[12][(l * 2 + 1) * 4 + h];
  lgf = -log2f(1.f + expf(-xf));
  lgb = -log2f(1.f + expf(-xb));
}

DEVI void ret1_item(const Params& p, int l, int it, unsigned char* sm) {
  const RetItem r = ret_decode(it);
  const int tid = TIDX, lane = tid & 63, w = tid >> 6, fr = lane & 15, fq = lane >> 4;
  u16* KTf = (u16*)sm;
  u16* KTb = (u16*)(sm + 9216);
  u16* VT = (u16*)(sm + 18432);
  const u16* Z = (const u16*)(p.ws + OFF_Z);
  const float* tab = (const float*)(p.ws + OFF_TAB);
  float lgf, lgb;
  ret_gammas(p, l, r.h, lgf, lgb);
  const int tok0 = r.seqbase + r.n * 64;
  {
    const int j = tid >> 2, part = tid & 3;
    float kv[16];
    load_qk16(Z + (size_t)(tok0 + j) * PIN + 1792 + r.h * 64, part, r.lat, r.n, j, tab, 0.125f, kv);
    const float df = exp2f(lgf * (float)(63 - j)), db = exp2f(lgb * (float)j);
#pragma unroll
    for (int i = 0; i < 16; ++i) {
      KTf[(part * 16 + i) * 72 + j] = f2bf(kv[i] * df);
      KTb[(part * 16 + i) * 72 + j] = f2bf(kv[i] * db);
    }
    const int jj = tid & 63, vp = (tid >> 6) * 32;
    const u16* vz = Z + (size_t)(tok0 + jj) * PIN + 2048 + r.h * 128 + vp;
#pragma unroll
    for (int c = 0; c < 4; ++c) {
      uint4 raw = *(const uint4*)(vz + c * 8);
      const u16* rv = (const u16*)&raw;
#pragma unroll
      for (int i = 0; i < 8; ++i) VT[(vp + c * 8 + i) * 72 + jj] = rv[i];
    }
  }
  __syncthreads();
  float* KV = (float*)(p.ws + OFF_KV) + (size_t)(r.kvbase + r.n) * 2 * 8192;
#pragma unroll
  for (int dir = 0; dir < 2; ++dir) {
    f32x4 acc[8];
#pragma unroll
    for (int n = 0; n < 8; ++n) acc[n] = f32x4{0.f, 0.f, 0.f, 0.f};
    wave_mma<8>((dir ? KTb : KTf) + w * 16 * 72, 72, VT, 72, 64, acc);
#pragma unroll
    for (int n = 0; n < 8; ++n)
#pragma unroll
      for (int j = 0; j < 4; ++j) KV[(size_t)dir * 8192 + (w * 16 + fq * 4 + j) * 128 + n * 16 + fr] = acc[n][j];
  }
}

DEVI void ret3_item(const Params& p, int l, int it, unsigned char* sm) {
  const RetItem r = ret_decode(it);
  const int tid = TIDX, lane = tid & 63, w = tid >> 6, fr = lane & 15, fq = lane >> 4;
  u16* Qs = (u16*)sm;
  u16* Ks = (u16*)(sm + 9216);
  u16* VT = (u16*)(sm + 18432);
  u16* ST = (u16*)(sm + 36864);
  const u16* Z = (const u16*)(p.ws + OFF_Z);
  const float* tab = (const float*)(p.ws + OFF_TAB);
  float lgf, lgb;
  ret_gammas(p, l, r.h, lgf, lgb);
  const int tok0 = r.seqbase + r.n * 64;
  {
    const int i = tid >> 2, part = tid & 3;
    float t[16];
    load_qk16(Z + (size_t)(tok0 + i) * PIN + 1536 + r.h * 64, part, r.lat, r.n, i, tab, 1.f, t);
    *(uint4*)(Qs + i * 72 + part * 16) = pack8(t);
    *(uint4*)(Qs + i * 72 + part * 16 + 8) = pack8(t + 8);
    load_qk16(Z + (size_t)(tok0 + i) * PIN + 1792 + r.h * 64, part, r.lat, r.n, i, tab, 0.125f, t);
    *(uint4*)(Ks + i * 72 + part * 16) = pack8(t);
    *(uint4*)(Ks + i * 72 + part * 16 + 8) = pack8(t + 8);
    const int jj = tid & 63, vp = (tid >> 6) * 32;
    const u16* vz = Z + (size_t)(tok0 + jj) * PIN + 2048 + r.h * 128 + vp;
#pragma unroll
    for (int c = 0; c < 4; ++c) {
      uint4 raw = *(const uint4*)(vz + c * 8);
      const u16* rv = (const u16*)&raw;
#pragma unroll
      for (int e = 0; e < 8; ++e) VT[(vp + c * 8 + e) * 72 + jj] = rv[e];
    }
  }
  __syncthreads();
  f32x4 at[4];
#pragma unroll
  for (int n = 0; n < 4; ++n) at[n] = f32x4{0.f, 0.f, 0.f, 0.f};
  wave_mma<4>(Qs + w * 16 * 72, 72, Ks, 72, 64, at);
  __syncthreads();
#pragma unroll
  for (int n = 0; n < 4; ++n)
#pragma unroll
    for (int j = 0; j < 4; ++j) {
      int i = w * 16 + fq * 4 + j, jc = n * 16 + fr;
      float mval = (i > jc) ? exp2f(lgf * (float)(i - jc)) : ((i < jc) ? exp2f(lgb * (float)(jc - i)) : 2.f);
      Ks[i * 72 + jc] = f2bf(at[n][j] * mval);
    }
  __syncthreads();
  f32x4 o[8];
#pragma unroll
  for (int n = 0; n < 8; ++n) o[n] = f32x4{0.f, 0.f, 0.f, 0.f};
  wave_mma<8>(Ks + w * 16 * 72, 72, VT, 72, 64, o);
  const float* KVb_ = (const float*)(p.ws + OFF_KV);
  for (int dir = 0; dir < 2; ++dir) {
    const float lg = dir ? lgb : lgf;
    const float cdec = exp2f(lg * 64.f);
    const int nprev = dir ? (r.N - 1 - r.n) : r.n;
    __syncthreads();
#pragma unroll 4
    for (int e8 = 0; e8 < 32; ++e8) {
      int e = e8 * 256 + tid, d = e >> 7, v = e & 127;
      float S = 0.f;
      if (r.lat) S = p.in[4][((((size_t)(r.b * 2 + l) * 2 + dir) * 4 + r.h) * 64 + d) * 128 + v];
      for (int m = 0; m < nprev; ++m) {
        int ch = dir ? (r.N - 1 - m) : m;
        S = S * cdec + KVb_[((size_t)(r.kvbase + ch) * 2 + dir) * 8192 + e];
      }
      ST[v * 72 + d] = f2bf(S);
      if (!r.lat && nprev == r.N - 1) {
        float sf = S * cdec + KVb_[((size_t)(r.kvbase + r.n) * 2 + dir) * 8192 + e];
        p.out[OUT_SRET + ((((size_t)(r.b * 2 + l) * 2 + dir) * 4 + r.h) * 64 + d) * 128 + v] = sf;
      }
    }
    __syncthreads();
    f32x4 t2[8];
#pragma unroll
    for (int n = 0; n < 8; ++n) t2[n] = f32x4{0.f, 0.f, 0.f, 0.f};
    wave_mma<8>(Qs + w * 16 * 72, 72, ST, 72, 64, t2);
#pragma unroll
    for (int j = 0; j < 4; ++j) {
      int i = w * 16 + fq * 4 + j;
      float dec = dir ? exp2f(lg * (float)(64 - i)) : exp2f(lg * (float)(i + 1));
#pragma unroll
      for (int n = 0; n < 8; ++n) o[n][j] += dec * t2[n][j];
    }
  }
  const float* gw = p.in[13] + l * 512 + r.h * 128;
  const float* gb = p.in[14] + l * 512 + r.h * 128;
  u16* ORT = (u16*)(p.ws + OFF_ORT);
#pragma unroll
  for (int j = 0; j < 4; ++j) {
    float s = 0.f;
#pragma unroll
    for (int n = 0; n < 8; ++n) s += o[n][j];
    float mu = row16_sum(s) * (1.f / 128.f);
    float q = 0.f;
#pragma unroll
    for (int n = 0; n < 8; ++n) { float d = o[n][j] - mu; q += d * d; }
    float rs = rsqrtf(row16_sum(q) * (1.f / 128.f) + 1e-5f);
    const int tok = tok0 + w * 16 + fq * 4 + j;
#pragma unroll
    for (int n = 0; n < 8; ++n) {
      int v = n * 16 + fr;
      float g = bf2f(Z[(size_t)tok * PIN + 2560 + r.h * 128 + v]);
      float y = ((o[n][j] - mu) * rs * gw[v] + gb[v]) * (g * sigmoidf_(g));
      ORT[(size_t)tok * 512 + r.h * 128 + v] = f2bf(y);
    }
  }
}

DEVI void shifted8(const u16* Z, int tok, bool hasp, bool hasn, int col, const float* mu, float* out) {
  float z[8], zp[8], zn[8];
  unpack8(*(const uint4*)(Z + (size_t)tok * PIN + col), z);
  if (hasp) unpack8(*(const uint4*)(Z + (size_t)(tok - 1) * PIN + col), zp);
  else {
#pragma unroll
    for (int i = 0; i < 8; ++i) zp[i] = 0.f;
  }
  if (hasn) unpack8(*(const uint4*)(Z + (size_t)(tok + 1) * PIN + col), zn);
  else {
#pragma unroll
    for (int i = 0; i < 8; ++i) zn[i] = 0.f;
  }
  float4 m0 = *(const float4*)(mu + col - 3072), m1 = *(const float4*)(mu + col - 3072 + 4);
  float mm[8] = {m0.x, m0.y, m0.z, m0.w, m1.x, m1.y, m1.z, m1.w};
#pragma unroll
  for (int i = 0; i < 8; ++i) out[i] = z[i] + mm[i] * (0.5f * (zp[i] + zn[i]) - z[i]);
}
DEVI void tok_neighbors(int tok, bool& hasp, bool& hasn) {
  if (tok < 4096) { int s = tok & 255; hasp = s > 0; hasn = s < 255; }
  else { int s = (tok - 4096) & 2047; hasp = s > 0; hasn = s < 2047; }
}

DEVI void rwprep_item(const Params& p, int l, int it) {
  const int tid = TIDX, lane = tid & 63, w = tid >> 6, fr = lane & 15, fq = lane >> 4;
  const u16* Z = (const u16*)(p.ws + OFF_Z);
  const float* mu = p.in[15] + l * 1920;
  const int tok0 = it * 64;
  u16* R = (u16*)(p.ws + OFF_RWR);
  u16* V = (u16*)(p.ws + OFF_RWV);
  u16* KC = (u16*)(p.ws + OFF_RWKC);
  for (int e = tid; e < 64 * 192; e += 256) {
    int ti = e / 192, c8 = (e % 192) * 8;
    int tok = tok0 + ti;
    bool hp, hn;
    tok_neighbors(tok, hp, hn);
    float zs[8];
    shifted8(Z, tok, hp, hn, 3072 + c8, mu, zs);
    u16* dst = (c8 < 512) ? R : (c8 < 1024 ? KC : V);
    *(uint4*)(dst + (size_t)tok * 512 + (c8 & 511)) = pack8(zs);
  }
  __threadfence();
  __syncthreads();
  bf16x8 af[12];
  {
    const int tok = tok0 + w * 16 + fr;
    bool hp, hn;
    tok_neighbors(tok, hp, hn);
#pragma unroll
    for (int f = 0; f < 12; ++f) {
      int col = 4608 + f * 32 + fq * 8;
      float zs[8];
      shifted8(Z, tok, hp, hn, col, mu, zs);
      if (f < 4) {
#pragma unroll
        for (int i = 0; i < 8; ++i) zs[i] = tanhf(zs[i]);
      } else if (f >= 8) {
#pragma unroll
        for (int i = 0; i < 8; ++i) zs[i] = sigmoidf_(zs[i]);
      }
      uint4 pk = pack8(zs);
      af[f] = __builtin_bit_cast(bf16x8, pk);
    }
  }
  const u16* WUP = (const u16*)(p.ws + OFF_WUPT) + (size_t)l * 2 * 32768;
  const u16* AUP = (const u16*)(p.ws + OFF_AUPT) + (size_t)l * 2 * 32768;
  const u16* GUP = (const u16*)(p.ws + OFF_GUPT) + (size_t)l * 65536;
  float* Wd = (float*)(p.ws + OFF_RWW);
  u16* KK = (u16*)(p.ws + OFF_RWKK);
  u16* KD = (u16*)(p.ws + OFF_RWKD);
  u16* KKA = (u16*)(p.ws + OFF_RWKKA);
  u16* G = (u16*)(p.ws + OFF_RWG);
  u16* BON = (u16*)(p.ws + OFF_RWBON);
  const float* kkw = p.in[21] + l * 512;
  const float* kaw = p.in[22] + l * 512;
  const float* rkw = p.in[23] + l * 512;
  const float* w0 = p.in[16] + l * 1024;
  const float* a0 = p.in[18] + l * 1024;
  for (int h = 0; h < 8; ++h) {
    float inv[4], sbv[4];
#pragma unroll
    for (int j = 0; j < 4; ++j) {
      const int tok = tok0 + w * 16 + fq * 4 + j;
      float ssq = 0.f, sb = 0.f;
#pragma unroll
      for (int n = 0; n < 4; ++n) {
        int c = h * 64 + n * 16 + fr;
        float rr = bf2f(R[(size_t)tok * 512 + c]);
        float kc = bf2f(KC[(size_t)tok * 512 + c]);
        float kk = kc * kkw[c];
        ssq += kk * kk;
        sb += rr * kc * rkw[c];
      }
      ssq = row16_sum(ssq);
      sbv[j] = row16_sum(sb);
      inv[j] = rsqrtf(fmaxf(ssq, 1e-24f));
    }
#pragma unroll 1
    for (int n = 0; n < 4; ++n) {
      f32x4 acc[5];
#pragma unroll
      for (int m = 0; m < 5; ++m) acc[m] = f32x4{0.f, 0.f, 0.f, 0.f};
      const int c = h * 64 + n * 16 + fr;
#pragma unroll
      for (int ks = 0; ks < 2; ++ks) {
        acc[0] = mfma16(af[0 + ks], *(const bf16x8*)(WUP + (size_t)c * 64 + ks * 32 + fq * 8), acc[0]);
        acc[1] = mfma16(af[2 + ks], *(const bf16x8*)(WUP + 32768 + (size_t)c * 64 + ks * 32 + fq * 8), acc[1]);
        acc[2] = mfma16(af[4 + ks], *(const bf16x8*)(AUP + (size_t)c * 64 + ks * 32 + fq * 8), acc[2]);
        acc[3] = mfma16(af[6 + ks], *(const bf16x8*)(AUP + 32768 + (size_t)c * 64 + ks * 32 + fq * 8), acc[3]);
      }
#pragma unroll
      for (int ks = 0; ks < 4; ++ks)
        acc[4] = mfma16(af[8 + ks], *(const bf16x8*)(GUP + (size_t)c * 128 + ks * 32 + fq * 8), acc[4]);
      const float kkc = kkw[c], ka = kaw[c];
      const float w0f = w0[c], w0b = w0[512 + c], a0f = a0[c], a0b = a0[512 + c];
#pragma unroll
      for (int j = 0; j < 4; ++j) {
        const int tok = tok0 + w * 16 + fq * 4 + j;
        const size_t o = (size_t)tok * 512 + c;
        const float kc = bf2f(KC[o]), vv = bf2f(V[o]);
        const float kkn = kc * kkc * inv[j];
        KK[o] = f2bf(kkn);
        G[o] = f2bf(acc[4][j]);
        BON[o] = f2bf(sbv[j] * vv);
#pragma unroll
        for (int d = 0; d < 2; ++d) {
          float wv = __expf(-0.606531f * sigmoidf_((d ? w0b : w0f) + acc[d][j]));
          float a = sigmoidf_((d ? a0b : a0f) + acc[2 + d][j]);
          Wd[(size_t)d * NTOK * 512 + o] = wv;
          KD[(size_t)d * NTOK * 512 + o] = f2bf(kc * (1.f + (a - 1.f) * ka));
          KKA[(size_t)d * NTOK * 512 + o] = f2bf(kkn * a);
        }
      }
    }
  }
}

template <int KPT>
DEVI void scan_run(const Params& p, int l, bool lat, int b, int h, int dir, int rowbase, unsigned char* sm) {
  constexpr int LPR = 64 / KPT;
  const int tid = TIDX;
  const int row = rowbase + tid / LPR, ks = (tid % LPR) * KPT;
  const int T = lat ? 2048 : 256, seq0 = lat ? 4096 + b * 2048 : b * 256;
  float S[KPT];
  if (lat) {
    const float* s0 = p.in[5] + ((((size_t)(b * 2 + l) * 2 + dir) * 8 + h) * 64 + row) * 64 + ks;
#pragma unroll
    for (int i = 0; i < KPT; ++i) S[i] = s0[i];
  } else {
#pragma unroll
    for (int i = 0; i < KPT; ++i) S[i] = 0.f;
  }
  float* buf = (float*)sm;
  const float* Wd = (const float*)(p.ws + OFF_RWW) + (size_t)dir * NTOK * 512;
  const u16* R = (const u16*)(p.ws + OFF_RWR);
  const u16* V = (const u16*)(p.ws + OFF_RWV);
  const u16* KK = (const u16*)(p.ws + OFF_RWKK);
  const u16* KD = (const u16*)(p.ws + OFF_RWKD) + (size_t)dir * NTOK * 512;
  const u16* KKA = (const u16*)(p.ws + OFF_RWKKA) + (size_t)dir * NTOK * 512;
  float* O = (float*)(p.ws + OFF_OF) + (size_t)dir * NTOK * 512;
  const int pst = tid >> 4, c4 = (tid & 15) * 4;
  float4 pw; uint2 pr, pk, pv, pd, pa;
  auto issue = [&](int chunk) {
    int s = chunk * 16 + pst;
    int tok = dir ? (seq0 + T - 1 - s) : (seq0 + s);
    size_t o = (size_t)tok * 512 + h * 64 + c4;
    pw = *(const float4*)(Wd + o);
    pr = *(const uint2*)(R + o); pk = *(const uint2*)(KK + o); pv = *(const uint2*)(V + o);
    pd = *(const uint2*)(KD + o); pa = *(const uint2*)(KKA + o);
  };
  issue(0);
  const int nch = T / 16;
  for (int chunk = 0; chunk < nch; ++chunk) {
    __syncthreads();
    {
      float* bp = buf + pst * 384 + c4;
      float t[4];
      *(float4*)bp = pw;
      unpack4(pr, t); *(float4*)(bp + 64) = make_float4(t[0], t[1], t[2], t[3]);
      unpack4(pk, t); *(float4*)(bp + 128) = make_float4(t[0], t[1], t[2], t[3]);
      unpack4(pv, t); *(float4*)(bp + 192) = make_float4(t[0], t[1], t[2], t[3]);
      unpack4(pd, t); *(float4*)(bp + 256) = make_float4(t[0], t[1], t[2], t[3]);
      unpack4(pa, t); *(float4*)(bp + 320) = make_float4(t[0], t[1], t[2], t[3]);
    }
    __syncthreads();
    if (chunk + 1 < nch) issue(chunk + 1);
#pragma unroll 4
    for (int s = 0; s < 16; ++s) {
      const float* bp = buf + s * 384;
      float wv[KPT], rv[KPT], kkv[KPT], kdv[KPT], kav[KPT];
#pragma unroll
      for (int i = 0; i < KPT; i += 4) {
        *(float4*)(wv + i) = *(const float4*)(bp + ks + i);
        *(float4*)(rv + i) = *(const float4*)(bp + 64 + ks + i);
        *(float4*)(kkv + i) = *(const float4*)(bp + 128 + ks + i);
        *(float4*)(kdv + i) = *(const float4*)(bp + 256 + ks + i);
        *(float4*)(kav + i) = *(const float4*)(bp + 320 + ks + i);
      }
      const float vr = bp[192 + row];
      float sk = 0.f;
#pragma unroll
      for (int i = 0; i < KPT; ++i) sk += S[i] * kkv[i];
      sk = (LPR == 16) ? row16_sum(sk) : quad_sum(sk);
      float o = 0.f;
#pragma unroll
      for (int i = 0; i < KPT; ++i) {
        S[i] = S[i] * wv[i] - sk * kav[i] + vr * kdv[i];
        o += S[i] * rv[i];
      }
      o = (LPR == 16) ? row16_sum(o) : quad_sum(o);
      if ((tid % LPR) == 0) {
        int st = chunk * 16 + s;
        int tok = dir ? (seq0 + T - 1 - st) : (seq0 + st);
        O[(size_t)tok * 512 + h * 64 + row] = o;
      }
    }
  }
  if (!lat) {
    float* so = p.out + OUT_SRW + ((((size_t)(b * 2 + l) * 2 + dir) * 8 + h) * 64 + row) * 64 + ks;
#pragma unroll
    for (int i = 0; i < KPT; ++i) so[i] = S[i];
  }
}

DEVI void attn_item(const Params& p, int l, int it, unsigned char* sm) {
  const int tid = TIDX, lane = tid & 63, w = tid >> 6, fr = lane & 15, fq = lane >> 4;
  u16* Ks = (u16*)sm;
  u16* VT = (u16*)(sm + 9216);
  float* rpbs = (float*)(sm + 18432);
  const u16* Z = (const u16*)(p.ws + OFF_Z);
  const bool lat = it < 512;
  int b, h, r = 0, seqbase, qtok0;
  if (lat) { b = it >> 8; h = (it >> 5) & 7; r = it & 31; seqbase = 4096 + b * 2048; qtok0 = seqbase + r * 64; }
  else { int j = it - 512; b = j >> 5; h = (j >> 2) & 7; int qb = j & 3; seqbase = b * 256; qtok0 = seqbase + qb * 64; }
  bf16x8 qf[2];
#pragma unroll
  for (int ks = 0; ks < 2; ++ks) qf[ks] = *(const bf16x8*)(Z + (size_t)(qtok0 + w * 16 + fr) * PIN + h * 64 + ks * 32 + fq * 8);
  if (lat)
    for (int i = tid; i < 465; i += 256) rpbs[i] = p.in[11][(size_t)(l * 8 + h) * 465 + i];
  float m_run = -3e38f, l_run = 0.f;
  f32x4 o[4];
#pragma unroll
  for (int d = 0; d < 4; ++d) o[d] = f32x4{0.f, 0.f, 0.f, 0.f};
  const int ntiles = lat ? 16 : 4;
  const int row_start = lat ? clampi(r - 4, 0, 24) : 0;
  const int cbs = lat ? clampi(w * 16 - 8, 0, 32) : 0;
  for (int ti = 0; ti < ntiles; ++ti) {
    __syncthreads();
    const bool ctxtile = lat && ti < 8;
    if (ctxtile) {
      const float* kc = p.in[2] + ((((size_t)b * 2 + l) * 8 + h) * 512 + ti * 64) * 64;
      const float* vc = p.in[3] + ((((size_t)b * 2 + l) * 8 + h) * 512 + ti * 64) * 64;
      {
        const int key = tid >> 2, dp = (tid & 3) * 16;
        float t[16];
#pragma unroll
        for (int c = 0; c < 4; ++c) *(float4*)(t + c * 4) = *(const float4*)(kc + key * 64 + dp + c * 4);
        *(uint4*)(Ks + key * 72 + dp) = pack8(t);
        *(uint4*)(Ks + key * 72 + dp + 8) = pack8(t + 8);
      }
      {
        const int key = tid & 63, dp = (tid >> 6) * 16;
        float t[16];
#pragma unroll
        for (int c = 0; c < 4; ++c) *(float4*)(t + c * 4) = *(const float4*)(vc + key * 64 + dp + c * 4);
#pragma unroll
        for (int i = 0; i < 16; ++i) VT[(dp + i) * 72 + key] = f2bf(t[i]);
      }
    } else {
      const int trow = lat ? (row_start + ti - 8) : ti;
      const u16* zr = Z + (size_t)(seqbase + trow * 64) * PIN;
      {
        const int key = tid >> 2, dp = (tid & 3) * 16;
        const u16* src = zr + (size_t)key * PIN + 512 + h * 64 + dp;
        *(uint4*)(Ks + key * 72 + dp) = *(const uint4*)src;
        *(uint4*)(Ks + key * 72 + dp + 8) = *(const uint4*)(src + 8);
      }
      {
        const int key = tid & 63, dp = (tid >> 6) * 16;
        const u16* src = zr + (size_t)key * PIN + 1024 + h * 64 + dp;
        uint4 r0 = *(const uint4*)src, r1 = *(const uint4*)(src + 8);
        const u16* a0 = (const u16*)&r0;
        const u16* a1 = (const u16*)&r1;
#pragma unroll
        for (int i = 0; i < 8; ++i) { VT[(dp + i) * 72 + key] = a0[i]; VT[(dp + 8 + i) * 72 + key] = a1[i]; }
      }
    }
    __syncthreads();
    const bool win = lat && !ctxtile;
    const int nsteps = win ? 1 : 2;
    for (int st = 0; st < nsteps; ++st) {
      const int ko = win ? cbs : st * 32;
      f32x4 s0 = f32x4{0.f, 0.f, 0.f, 0.f}, s1 = s0;
#pragma unroll
      for (int ks = 0; ks < 2; ++ks) {
        bf16x8 a0 = *(const bf16x8*)(Ks + (ko + fr) * 72 + ks * 32 + fq * 8);
        bf16x8 a1 = *(const bf16x8*)(Ks + (ko + 16 + fr) * 72 + ks * 32 + fq * 8);
        s0 = mfma16(a0, qf[ks], s0);
        s1 = mfma16(a1, qf[ks], s1);
      }
      float sv[8];
#pragma unroll
      for (int j = 0; j < 4; ++j) { sv[j] = s0[j] * 0.125f; sv[4 + j] = s1[j] * 0.125f; }
      if (win) {
        const int qc = w * 16 + fr;
        const int dr = (row_start + ti - 8) - r + 7;
        const int qs = clampi(qc - 8, 0, 48);
#pragma unroll
        for (int e = 0; e < 8; ++e) {
          int kc_ = ko + ((e < 4) ? (fq * 4 + e) : (16 + fq * 4 + e - 4));
          int dc = clampi(kc_ - qc, -15, 15) + 15;
          int rel = kc_ - qs;
          sv[e] = (rel >= 0 && rel < 16) ? (sv[e] + rpbs[dr * 31 + dc]) : -1e30f;
        }
      }
      float mx = sv[0];
#pragma unroll
      for (int e = 1; e < 8; ++e) mx = fmaxf(mx, sv[e]);
      mx = fmaxf(mx, __shfl_xor(mx, 16));
      mx = fmaxf(mx, __shfl_xor(mx, 32));
      const float m_new = fmaxf(m_run, mx);
      const float alpha = __expf(m_run - m_new);
      float pe[8], ps = 0.f;
#pragma unroll
      for (int e = 0; e < 8; ++e) { pe[e] = __expf(sv[e] - m_new); ps += pe[e]; }
      l_run = l_run * alpha + ps;
      m_run = m_new;
#pragma unroll
      for (int d = 0; d < 4; ++d) o[d] *= alpha;
      uint4 pk = pack8(pe);
      bf16x8 pb = __builtin_bit_cast(bf16x8, pk);
#pragma unroll
      for (int d = 0; d < 4; ++d) {
        uint2 lo = *(const uint2*)(VT + (d * 16 + fr) * 72 + ko + fq * 4);
        uint2 hi = *(const uint2*)(VT + (d * 16 + fr) * 72 + ko + 16 + fq * 4);
        uint4 vv; vv.x = lo.x; vv.y = lo.y; vv.z = hi.x; vv.w = hi.y;
        o[d] = mfma16(__builtin_bit_cast(bf16x8, vv), pb, o[d]);
      }
    }
  }
  float lt = l_run + __shfl_xor(l_run, 16);
  lt += __shfl_xor(lt, 32);
  const float inv = 1.f / lt;
  u16* ONA = (u16*)(p.ws + OFF_ONA);
  const int tok = qtok0 + w * 16 + fr;
#pragma unroll
  for (int d = 0; d < 4; ++d) {
    uint2 ov; ov.x = cvtpk(o[d][0] * inv, o[d][1] * inv); ov.y = cvtpk(o[d][2] * inv, o[d][3] * inv);
    *(uint2*)(ONA + (size_t)tok * 512 + h * 64 + d * 16 + fq * 4) = ov;
  }
}

constexpr int MIX_NSCAN_LAT = 128, MIX_NSCAN_CTX = 256, MIX_NATT = 1024, MIX_NRET = 512;
constexpr int MIX_TOTAL = MIX_NSCAN_LAT + MIX_NSCAN_CTX + MIX_NATT + MIX_NRET;
#ifndef ONLYP
#define ONLYP -1
#endif
#define PH_ON(x) (ONLYP < 0 || ONLYP == (x))
DEVI void mix_item(const Params& p, int l, int it, unsigned char* sm) {
  if (it < MIX_NSCAN_LAT) {
    int ch = it >> 2, rq = it & 3;
    if (PH_ON(12)) scan_run<4>(p, l, true, ch >> 4, ch & 7, (ch >> 3) & 1, rq * 16, sm);
    return;
  }
  it -= MIX_NSCAN_LAT;
  if (it < MIX_NSCAN_CTX) { if (PH_ON(13)) scan_run<16>(p, l, false, it >> 4, it & 7, (it >> 3) & 1, 0, sm); return; }
  it -= MIX_NSCAN_CTX;
  if (it < MIX_NATT) { if (PH_ON(14)) attn_item(p, l, it, sm); return; }
  it -= MIX_NATT;
  if (PH_ON(15)) ret3_item(p, l, it, sm);
}

DEVI void fin_item(const Params& p, int l, int it) {
  const int tid = TIDX;
  const int tok = it * 2 + (tid >> 7), c4 = (tid & 127) * 4;
  const size_t o = (size_t)tok * 512 + c4;
  float4 a = *(const float4*)((const float*)(p.ws + OFF_OF) + o);
  float4 b = *(const float4*)((const float*)(p.ws + OFF_OF) + (size_t)NTOK * 512 + o);
  float x[4] = {a.x + b.x, a.y + b.y, a.z + b.z, a.w + b.w};
  float mu = row16_sum(x[0] + x[1] + x[2] + x[3]) * (1.f / 64.f);
  float q = 0.f;
#pragma unroll
  for (int i = 0; i < 4; ++i) { float d = x[i] - mu; q += d * d; }
  float rs = rsqrtf(row16_sum(q) * (1.f / 64.f) + 64e-5f);
  float4 gw = *(const float4*)(p.in[24] + l * 512 + c4), gb = *(const float4*)(p.in[25] + l * 512 + c4);
  float gwv[4] = {gw.x, gw.y, gw.z, gw.w}, gbv[4] = {gb.x, gb.y, gb.z, gb.w};
  float bon[4], g[4];
  unpack4(*(const uint2*)((const u16*)(p.ws + OFF_RWBON) + o), bon);
  unpack4(*(const uint2*)((const u16*)(p.ws + OFF_RWG) + o), g);
  float y[4];
#pragma unroll
  for (int i = 0; i < 4; ++i) y[i] = ((x[i] - mu) * rs * gwv[i] + gbv[i] + bon[i]) * g[i];
  uint2 ov; ov.x = cvtpk(y[0], y[1]); ov.y = cvtpk(y[2], y[3]);
  *(uint2*)((u16*)(p.ws + OFF_ORW) + o) = ov;
}

DEVI void ln2_item(const Params& p, int l, int it) {
  const int lane = TIDX & 63, w = TIDX >> 6;
  const int tok = it * 4 + w;
  const float* y = (const float*)(p.ws + OFF_Y) + (size_t)tok * 1024;
  const float* mod = (const float*)(p.ws + OFF_MOD) + ((size_t)l * 3 + modrow(tok)) * 6144;
  float v[16];
  float s = 0.f;
#pragma unroll
  for (int i = 0; i < 4; ++i) { *(float4*)(v + i * 4) = *(const float4*)(y + lane * 4 + 256 * i); }
#pragma unroll
  for (int i = 0; i < 16; ++i) s += v[i];
  float mu = wave_sum(s) * (1.f / 1024.f);
  float q = 0.f;
#pragma unroll
  for (int i = 0; i < 16; ++i) { float d = v[i] - mu; q += d * d; }
  float rs = rsqrtf(wave_sum(q) * (1.f / 1024.f) + 1e-5f);
  float* X1 = (float*)(p.ws + OFF_X1) + (size_t)tok * 1024;
  s = 0.f;
#pragma unroll
  for (int i = 0; i < 4; ++i) {
    int c = lane * 4 + 256 * i;
    float4 g = *(const float4*)(p.in[28] + l * 1024 + c), bb = *(const float4*)(p.in[29] + l * 1024 + c);
    v[i * 4 + 0] = (v[i * 4 + 0] - mu) * rs * g.x + bb.x;
    v[i * 4 + 1] = (v[i * 4 + 1] - mu) * rs * g.y + bb.y;
    v[i * 4 + 2] = (v[i * 4 + 2] - mu) * rs * g.z + bb.z;
    v[i * 4 + 3] = (v[i * 4 + 3] - mu) * rs * g.w + bb.w;
    *(float4*)(X1 + c) = *(float4*)(v + i * 4);
    s += v[i * 4] + v[i * 4 + 1] + v[i * 4 + 2] + v[i * 4 + 3];
  }
  mu = wave_sum(s) * (1.f / 1024.f);
  q = 0.f;
#pragma unroll
  for (int i = 0; i < 16; ++i) { float d = v[i] - mu; q += d * d; }
  rs = rsqrtf(wave_sum(q) * (1.f / 1024.f) + 1e-5f);
  u16* H2 = (u16*)(p.ws + OFF_H2) + (size_t)tok * 1024;
#pragma unroll
  for (int i = 0; i < 4; ++i) {
    int c = lane * 4 + 256 * i;
    float4 sh = *(const float4*)(mod + 3072 + c), sc = *(const float4*)(mod + 4096 + c);
    uint2 o;
    o.x = cvtpk((v[i * 4] - mu) * rs * (1.f + sc.x) + sh.x, (v[i * 4 + 1] - mu) * rs * (1.f + sc.y) + sh.y);
    o.y = cvtpk((v[i * 4 + 2] - mu) * rs * (1.f + sc.z) + sh.z, (v[i * 4 + 3] - mu) * rs * (1.f + sc.w) + sh.w);
    *(uint2*)(H2 + c) = o;
  }
}

DEVI void insert16(float (&t)[16], float x) {
#pragma unroll
  for (int i = 0; i < 16; ++i) { float hi = fmaxf(t[i], x); x = fminf(t[i], x); t[i] = hi; }
}
DEVI void route_item(const Params& p, int l, int it) {
  const int lane = TIDX & 63;
  const int w = __builtin_amdgcn_readfirstlane(TIDX >> 6);
  const int tb = it >> 1, h = (it & 1) * 4 + w;
  const int tok = tb * 64 + lane;
  const float* Q = (const float*)(p.ws + OFF_Q) + (size_t)tok * 1024 + h * 128;
  float T[2][16];
#pragma unroll
  for (int pp = 0; pp < 2; ++pp) {
    float q[64];
#pragma unroll
    for (int i = 0; i < 16; ++i) *(float4*)(q + i * 4) = *(const float4*)(Q + pp * 64 + i * 4);
#pragma unroll
    for (int i = 0; i < 16; ++i) T[pp][i] = -INFINITY;
    const float* keys = uniform_ptr(p.in[33]) + ((size_t)((l * 8 + h) * 2 + pp) * 128) * 64;
    for (int k = 0; k < 128; ++k) {
      const float* kp = keys + k * 64;
      float s0 = 0.f, s1 = 0.f;
#pragma unroll
      for (int d = 0; d < 64; d += 2) { s0 += q[d] * kp[d]; s1 += q[d + 1] * kp[d + 1]; }
      float s = s0 + s1;
      unsigned bits = (__float_as_uint(s) & ~127u) | (unsigned)(127 - k);
      insert16(T[pp], __uint_as_float(bits));
    }
  }
  float F[16];
#pragma unroll
  for (int i = 0; i < 16; ++i) F[i] = -INFINITY;
#pragma unroll
  for (int i = 0; i < 16; ++i) {
#pragma unroll
    for (int j = 0; j < 16; ++j) {
      if ((i + 1) * (j + 1) <= 16) {
        float a = __uint_as_float(__float_as_uint(T[0][i]) & ~127u), b = __uint_as_float(__float_as_uint(T[1][j]) & ~127u);
        float c = a + b;
        unsigned bits = (__float_as_uint(c) & ~255u) | (unsigned)(255 - (i * 16 + j));
        insert16(F, __uint_as_float(bits));
      }
    }
  }
  float fs[16], den = 0.f;
  const float f0 = __uint_as_float(__float_as_uint(F[0]) & ~255u);
#pragma unroll
  for (int i = 0; i < 16; ++i) { fs[i] = __expf(__uint_as_float(__float_as_uint(F[i]) & ~255u) - f0); den += fs[i]; }
  const float inv = 1.f / den;
  int* EIDX = (int*)(p.ws + OFF_EIDX) + (size_t)tok * 128 + h * 16;
  float* GATE = (float*)(p.ws + OFF_GATE) + (size_t)tok * 128 + h * 16;
#pragma unroll
  for (int i = 0; i < 16; ++i) {
    int pos = 255 - (int)(__float_as_uint(F[i]) & 255u);
    int i0 = pos >> 4, j0 = pos & 15;
    int k0 = 0, k1 = 0;
#pragma unroll
    for (int c = 0; c < 16; ++c) {
      int a0 = 127 - (int)(__float_as_uint(T[0][c]) & 127u), a1 = 127 - (int)(__float_as_uint(T[1][c]) & 127u);
      k0 = (i0 == c) ? a0 : k0;
      k1 = (j0 == c) ? a1 : k1;
    }
    EIDX[i] = k0 * 128 + k1;
    GATE[i] = fs[i] * inv;
  }
}

DEVI void expert_item(const Params& p, int l, int it) {
  const int lane = TIDX & 63;
  const int w = __builtin_amdgcn_readfirstlane(TIDX >> 6);
  const int tok = it * 4 + w;
  const u16* H2 = (const u16*)(p.ws + OFF_H2) + (size_t)tok * 1024;
  float hv[16];
  unpack8(*(const uint4*)(H2 + lane * 8), hv);
  unpack8(*(const uint4*)(H2 + 512 + lane * 8), hv + 8);
  const int* EIDX = (const int*)(p.ws + OFF_EIDX) + (size_t)tok * 128;
  const float* GATE = (const float*)(p.ws + OFF_GATE) + (size_t)tok * 128;
  const u16* UB = (const u16*)(p.ws + OFF_UB);
  const u16* VB = (const u16*)(p.ws + OFF_VB);
  float f[16];
#pragma unroll
  for (int i = 0; i < 16; ++i) f[i] = 0.f;
#pragma unroll 4
  for (int e = 0; e < 128; ++e) {
    const int idx = EIDX[e];
    const float gate = GATE[e];
    const u16* ur = UB + (size_t)idx * 1024;
    const u16* vr = VB + (size_t)idx * 1024;
    uint4 u0 = *(const uint4*)(ur + lane * 8), u1 = *(const uint4*)(ur + 512 + lane * 8);
    uint4 v0 = *(const uint4*)(vr + lane * 8), v1 = *(const uint4*)(vr + 512 + lane * 8);
    float uu[16];
    unpack8(u0, uu); unpack8(u1, uu + 8);
    float d = 0.f;
#pragma unroll
    for (int i = 0; i < 16; ++i) d += uu[i] * hv[i];
    d = wave_sum(d);
    const float act = 0.5f * d * (1.f + erff(d * 0.70710678118654752f)) * gate;
    float vv[16];
    unpack8(v0, vv); unpack8(v1, vv + 8);
#pragma unroll
    for (int i = 0; i < 16; ++i) f[i] += act * vv[i];
  }
  const float* X1 = (const float*)(p.ws + OFF_X1) + (size_t)tok * 1024;
  const float* mod = (const float*)(p.ws + OFF_MOD) + ((size_t)l * 3 + modrow(tok)) * 6144;
  float y[16];
  float s = 0.f;
#pragma unroll
  for (int hh = 0; hh < 2; ++hh)
#pragma unroll
    for (int c = 0; c < 2; ++c) {
      int col = hh * 512 + lane * 8 + c * 4;
      float4 x = *(const float4*)(X1 + col), gt = *(const float4*)(mod + 5120 + col);
      int o = hh * 8 + c * 4;
      y[o] = ALPHA * x.x + gt.x * f[o]; y[o + 1] = ALPHA * x.y + gt.y * f[o + 1];
      y[o + 2] = ALPHA * x.z + gt.z * f[o + 2]; y[o + 3] = ALPHA * x.w + gt.w * f[o + 3];
      s += y[o] + y[o + 1] + y[o + 2] + y[o + 3];
    }
  float mu = wave_sum(s) * (1.f / 1024.f);
  float q = 0.f;
#pragma unroll
  for (int i = 0; i < 16; ++i) { float d = y[i] - mu; q += d * d; }
  float rs = rsqrtf(wave_sum(q) * (1.f / 1024.f) + 1e-5f);
  float* xo = (l == 1) ? (p.out + OUT_Y + (size_t)tok * 1024) : ((float*)(p.ws + OFF_X) + (size_t)tok * 1024);
  s = 0.f;
#pragma unroll
  for (int hh = 0; hh < 2; ++hh)
#pragma unroll
    for (int c = 0; c < 2; ++c) {
      int col = hh * 512 + lane * 8 + c * 4;
      int o = hh * 8 + c * 4;
      float4 g = *(const float4*)(p.in[30] + l * 1024 + col), bb = *(const float4*)(p.in[31] + l * 1024 + col);
      y[o] = (y[o] - mu) * rs * g.x + bb.x; y[o + 1] = (y[o + 1] - mu) * rs * g.y + bb.y;
      y[o + 2] = (y[o + 2] - mu) * rs * g.z + bb.z; y[o + 3] = (y[o + 3] - mu) * rs * g.w + bb.w;
      *(float4*)(xo + col) = make_float4(y[o], y[o + 1], y[o + 2], y[o + 3]);
      s += y[o] + y[o + 1] + y[o + 2] + y[o + 3];
    }
  if (l == 0) {
    const float* mod1 = (const float*)(p.ws + OFF_MOD) + ((size_t)3 + modrow(tok)) * 6144;
    mu = wave_sum(s) * (1.f / 1024.f);
    q = 0.f;
#pragma unroll
    for (int i = 0; i < 16; ++i) { float d = y[i] - mu; q += d * d; }
    rs = rsqrtf(wave_sum(q) * (1.f / 1024.f) + 1e-5f);
    u16* H = (u16*)(p.ws + OFF_H) + (size_t)tok * 1024;
#pragma unroll
    for (int hh = 0; hh < 2; ++hh) {
      int col = hh * 512 + lane * 8;
      float t[8];
#pragma unroll
      for (int c = 0; c < 2; ++c) {
        float4 sh = *(const float4*)(mod1 + col + c * 4), sc = *(const float4*)(mod1 + 1024 + col + c * 4);
        int o = hh * 8 + c * 4;
        t[c * 4] = (y[o] - mu) * rs * (1.f + sc.x) + sh.x; t[c * 4 + 1] = (y[o + 1] - mu) * rs * (1.f + sc.y) + sh.y;
        t[c * 4 + 2] = (y[o + 2] - mu) * rs * (1.f + sc.z) + sh.z; t[c * 4 + 3] = (y[o + 3] - mu) * rs * (1.f + sc.w) + sh.w;
      }
      *(uint4*)(H + col) = pack8(t);
    }
  }
}

constexpr int NPHASES = 22;
DEVI int phase_total(int idx) {
  if (idx == 0) return P0_TOTAL;
  if (idx == 1) return 2048;
  const int l = (idx - 2) / 10, t = (idx - 2) % 10;
  switch (t) {
    case 0: return 4032 + (l == 1 ? P0_NUV : 0);
    case 1: return 128 + 512;
    case 2: return MIX_TOTAL;
    case 3: return 4096;
    case 4: return 512;
    case 5: return 512;
    case 6: return 2048;
    case 7: return 512;
    case 8: return 256;
    default: return 2048;
  }
}
DEVI void phase_item(const Params& p, int idx, int it, unsigned char* sm) {
  if (idx == 0) { if (PH_ON(0)) phase0_item(p, it, sm); return; }
  if (idx == 1) { if (PH_ON(1)) ln1_item(p, it); return; }
  const int l = (idx - 2) / 10, t = (idx - 2) % 10;
  switch (t) {
    case 0: if (PH_ON(2)) { if (it < 4032) g1_item(p, l, it, sm); else convert_uv_item(p, 1, it - 4032); } break;
    case 1: if (it < 128) { if (PH_ON(3)) rwprep_item(p, l, it); } else { if (PH_ON(4)) ret1_item(p, l, it - 128, sm); } break;
    case 2: mix_item(p, l, it, sm); break;
    case 3: if (PH_ON(5)) fin_item(p, l, it); break;
    case 4: if (PH_ON(6)) g2_item(p, l, it, sm); break;
    case 5: if (PH_ON(7)) g3_item(p, l, it, sm); break;
    case 6: if (PH_ON(8)) ln2_item(p, l, it); break;
    case 7: if (PH_ON(9)) g4_item(p, l, it, sm); break;
    case 8: if (PH_ON(10)) route_item(p, l, it); break;
    default: if (PH_ON(11)) expert_item(p, l, it); break;
  }
}

__global__ void __launch_bounds__(256, 2) mega_kernel(KArgs ka, int ph_lo, int ph_hi) {
  __shared__ __attribute__((aligned(16))) unsigned char sm[56320];
  __shared__ int s_item;
  __shared__ const float* s_in[36];
  cg::grid_group grid = cg::this_grid();
  if (threadIdx.x < 36) {
    const float* const* kp = (const float* const*)__builtin_amdgcn_kernarg_segment_ptr();
    s_in[threadIdx.x] = kp[threadIdx.x];
  }
  __syncthreads();
  Params p;
  p.in = s_in; p.out = ka.out; p.ws = ka.ws;
  int* ctr = (int*)(p.ws + OFF_CTR);
  for (int idx = ph_lo; idx < ph_hi; ++idx) {
    const int total = phase_total(idx);
    while (true) {
      __syncthreads();
      if (threadIdx.x == 0) s_item = atomicAdd(&ctr[idx], 1);
      __syncthreads();
      const int it = s_item;
      if (it >= total) break;
      Params q = p;
      asm volatile("" : "+s"(q.ws));
      asm volatile("" : "+s"(q.out));
      asm volatile("" : "+s"(q.in));
      phase_item(q, idx, it, sm);
    }
    if (idx + 1 < ph_hi) grid.sync();
  }
}

#ifndef MULTI_LAUNCH
#define MULTI_LAUNCH 0
#endif

extern "C" void kernel_launch(void* const* d_in, const int* in_sizes, int n_in, void* d_out, int out_size, void* d_ws,
                              size_t ws_size, hipStream_t stream) {
  static int grid_blocks = 0;
  if (!grid_blocks) {
    int dev = 0, cus = 0, per_cu = 0;
    hipGetDevice(&dev);
    hipDeviceGetAttribute(&cus, hipDeviceAttributeMultiprocessorCount, dev);
    hipOccupancyMaxActiveBlocksPerMultiprocessor(&per_cu, mega_kernel, 256, 0);
    if (per_cu > 2) per_cu = 2;
    if (per_cu < 1) per_cu = 1;
    grid_blocks = cus * per_cu;
  }
  KArgs p{};
  for (int i = 0; i < 36; ++i) p.in[i] = (const float*)d_in[i];
  p.out = (float*)d_out;
  p.ws = (unsigned char*)d_ws;
  if (ws_size < OFF_END) { fprintf(stderr, "workspace too small: %zu < %zu\n", ws_size, (size_t)OFF_END); return; }
  hipMemsetAsync(d_ws, 0, 1024, stream);
#if MULTI_LAUNCH
  for (int ph = 0; ph < NPHASES; ++ph) {
    hipLaunchKernelGGL(mega_kernel, dim3(grid_blocks), dim3(256), 0, stream, p, ph, ph + 1);
  }
#else
  int lo = 0, hi = NPHASES;
  void* args[] = {&p, &lo, &hi};
  hipError_t e = hipLaunchCooperativeKernel((void*)mega_kernel, dim3(grid_blocks), dim3(256), args, 0, stream);
  if (e != hipSuccess) fprintf(stderr, "cooperative launch failed: %s (grid %d)\n", hipGetErrorString(e), grid_blocks);
#endif
}
```

```cpp
#include <hip/hip_runtime.h>
#include <hip/hip_bf16.h>
#include <hip/hip_cooperative_groups.h>
#include <cstdio>
namespace cg = cooperative_groups;

typedef unsigned short u16;
using bf16x8 = __attribute__((ext_vector_type(8))) short;
using f32x4 = __attribute__((ext_vector_type(4))) float;
#define DEVI __device__ __forceinline__
__device__ __forceinline__ int ltid_() { int t = threadIdx.x; asm volatile("" : "+v"(t)); return t; }
#define TIDX ltid_()

constexpr int NTOK = 8192;
constexpr int PIN = 8064;
constexpr float ALPHA = 1.4142135623730951f;
constexpr size_t OUT_Y = 0;
constexpr size_t OUT_NAK = 8388608;
constexpr size_t OUT_NAV = 12582912;
constexpr size_t OUT_SRET = 16777216;
constexpr size_t OUT_SRW = 18874368;
constexpr size_t OFF_CTR = 0;
constexpr size_t OFF_TAB = 4096;
constexpr size_t OFF_MOD = 16384;
constexpr size_t OFF_WINT = 1048576;
constexpr size_t OFF_WBRT = OFF_WINT + 33030144;
constexpr size_t OFF_WOUTT = OFF_WBRT + 6291456;
constexpr size_t OFF_WQT = OFF_WOUTT + 4194304;
constexpr size_t OFF_WUPT = OFF_WQT + 4194304;
constexpr size_t OFF_AUPT = OFF_WUPT + 262144;
constexpr size_t OFF_GUPT = OFF_AUPT + 262144;
constexpr size_t OFF_UB = OFF_GUPT + 262144;
constexpr size_t OFF_VB = OFF_UB + 33554432;
constexpr size_t OFF_Z = OFF_VB + 33554432;
constexpr size_t OFF_X = OFF_Z + 132120576;
constexpr size_t OFF_H = OFF_X + 33554432;
constexpr size_t OFF_ONA = OFF_H + 16777216;
constexpr size_t OFF_ORT = OFF_ONA + 8388608;
constexpr size_t OFF_ORW = OFF_ORT + 8388608;
constexpr size_t OFF_GA = OFF_ORW + 8388608;
constexpr size_t SZB = 8388608;
constexpr size_t OFF_RWW = OFF_GA;
constexpr size_t OFF_RWR = OFF_RWW + 4 * SZB;
constexpr size_t OFF_RWV = OFF_RWR + SZB;
constexpr size_t OFF_RWKK = OFF_RWV + SZB;
constexpr size_t OFF_RWKC = OFF_RWKK + SZB;
constexpr size_t OFF_RWKD = OFF_RWKC + SZB;
constexpr size_t OFF_RWKKA = OFF_RWKD + 2 * SZB;
constexpr size_t OFF_RWG = OFF_RWKKA + 2 * SZB;
constexpr size_t OFF_RWBON = OFF_RWG + SZB;
constexpr size_t OFF_OF = OFF_RWBON + SZB;
constexpr size_t OFF_KV = OFF_OF + 4 * SZB;
constexpr size_t OFF_END = OFF_KV + 33554432;
constexpr size_t OFF_Y = OFF_GA;
constexpr size_t OFF_X1 = OFF_GA + 33554432;
constexpr size_t OFF_Q = OFF_GA + 2 * 33554432;
constexpr size_t OFF_H2 = OFF_GA + 3 * 33554432;
constexpr size_t OFF_EIDX = OFF_H2 + 16777216;
constexpr size_t OFF_GATE = OFF_EIDX + 4194304;

struct KArgs {
  const float* in[36];
  float* out;
  unsigned char* ws;
};
struct Params {
  const float* const* in;
  float* out;
  unsigned char* ws;
};
DEVI const float* uniform_ptr(const float* q) {
  unsigned long long v = (unsigned long long)q;
  unsigned lo = __builtin_amdgcn_readfirstlane((unsigned)v), hi = __builtin_amdgcn_readfirstlane((unsigned)(v >> 32));
  return (const float*)(((unsigned long long)hi << 32) | lo);
}

DEVI float bf2f(u16 h) { return __uint_as_float(((unsigned)h) << 16); }
DEVI unsigned cvtpk(float lo, float hi) {
  unsigned r;
  asm volatile("v_cvt_pk_bf16_f32 %0, %1, %2" : "=v"(r) : "v"(lo), "v"(hi));
  return r;
}
DEVI u16 f2bf(float f) { return (u16)(cvtpk(f, f) & 0xffffu); }
DEVI float sigmoidf_(float x) { return 1.f / (1.f + __expf(-x)); }
template <int CTRL> DEVI float dpp(float x) {
  return __builtin_bit_cast(float, __builtin_amdgcn_update_dpp(0, __builtin_bit_cast(int, x), CTRL, 0xf, 0xf, true));
}
DEVI float quad_sum(float x) { x += dpp<0xB1>(x); x += dpp<0x4E>(x); return x; }
DEVI float row16_sum(float x) { x = quad_sum(x); x += dpp<0x141>(x); x += dpp<0x140>(x); return x; }
DEVI float wave_sum(float x) { x = row16_sum(x); x += __shfl_xor(x, 16); x += __shfl_xor(x, 32); return x; }
DEVI void unpack8(uint4 v, float* f) {
  f[0] = __uint_as_float(v.x << 16); f[1] = __uint_as_float(v.x & 0xffff0000u);
  f[2] = __uint_as_float(v.y << 16); f[3] = __uint_as_float(v.y & 0xffff0000u);
  f[4] = __uint_as_float(v.z << 16); f[5] = __uint_as_float(v.z & 0xffff0000u);
  f[6] = __uint_as_float(v.w << 16); f[7] = __uint_as_float(v.w & 0xffff0000u);
}
DEVI void unpack4(uint2 v, float* f) {
  f[0] = __uint_as_float(v.x << 16); f[1] = __uint_as_float(v.x & 0xffff0000u);
  f[2] = __uint_as_float(v.y << 16); f[3] = __uint_as_float(v.y & 0xffff0000u);
}
DEVI uint4 pack8(const float* f) {
  uint4 r; r.x = cvtpk(f[0], f[1]); r.y = cvtpk(f[2], f[3]); r.z = cvtpk(f[4], f[5]); r.w = cvtpk(f[6], f[7]); return r;
}
DEVI f32x4 mfma16(bf16x8 a, bf16x8 b, f32x4 c) { return __builtin_amdgcn_mfma_f32_16x16x32_bf16(a, b, c, 0, 0, 0); }
DEVI int modrow(int tok) { return tok < 4096 ? 0 : 1 + ((tok - 4096) >> 11); }
DEVI const float* xin_row(const Params& p, int tok) {
  return tok < 4096 ? p.in[0] + (size_t)tok * 1024 : p.in[1] + (size_t)(tok - 4096) * 1024;
}
DEVI int clampi(int v, int lo, int hi) { return v < lo ? lo : (v > hi ? hi : v); }

template <int NT> DEVI void wave_mma(const u16* A, int lda, const u16* B, int ldb, int K, f32x4* acc) {
  const int lane = TIDX & 63, fr = lane & 15, fq = lane >> 4;
  for (int k0 = 0; k0 < K; k0 += 32) {
    bf16x8 a = *(const bf16x8*)(A + fr * lda + k0 + fq * 8);
#pragma unroll
    for (int n = 0; n < NT; ++n) {
      bf16x8 b = *(const bf16x8*)(B + (n * 16 + fr) * ldb + k0 + fq * 8);
      acc[n] = mfma16(a, b, acc[n]);
    }
  }
}

DEVI void gemm_acc(const u16* __restrict__ A, int lda, const u16* __restrict__ Bt, int ldb, int K, int m0, int n0,
                   unsigned char* sm, f32x4 (&acc)[4][4]) {
  const int tid = TIDX, lane = tid & 63, wid = tid >> 6, wr = wid >> 1, wc = wid & 1, fr = lane & 15, fq = lane >> 4;
  const int nk = K >> 5;
  const int b0 = tid * 16, r0 = b0 >> 6, c0 = (b0 & 63) >> 1;
  const u16* Ap = A + (size_t)(m0 + r0) * lda + c0;
  const u16* Bp = Bt + (size_t)(n0 + r0) * ldb + c0;
  auto issue = [&](int kt, int st) {
    unsigned char* SA = sm + st * 16384;
    unsigned char* SB = SA + 8192;
    __builtin_amdgcn_global_load_lds((const unsigned*)(Ap + kt * 32), (__attribute__((address_space(3))) unsigned*)(SA + b0), 16, 0, 0);
    __builtin_amdgcn_global_load_lds((const unsigned*)(Ap + (size_t)64 * lda + kt * 32), (__attribute__((address_space(3))) unsigned*)(SA + b0 + 4096), 16, 0, 0);
    __builtin_amdgcn_global_load_lds((const unsigned*)(Bp + kt * 32), (__attribute__((address_space(3))) unsigned*)(SB + b0), 16, 0, 0);
    __builtin_amdgcn_global_load_lds((const unsigned*)(Bp + (size_t)64 * ldb + kt * 32), (__attribute__((address_space(3))) unsigned*)(SB + b0 + 4096), 16, 0, 0);
  };
  issue(0, 0);
  if (nk > 1) issue(1, 1);
  int st = 0;
  for (int kt = 0; kt < nk; ++kt) {
    if (kt + 1 < nk) asm volatile("s_waitcnt vmcnt(4)\n\ts_barrier" ::: "memory");
    else asm volatile("s_waitcnt vmcnt(0)\n\ts_barrier" ::: "memory");
    if (kt + 2 < nk) { int s2 = st + 2; if (s2 >= 3) s2 -= 3; issue(kt + 2, s2); }
    const unsigned char* SA = sm + st * 16384;
    const unsigned char* SB = SA + 8192;
    bf16x8 a[4], b[4];
#pragma unroll
    for (int m = 0; m < 4; ++m) a[m] = *(const bf16x8*)(SA + (wr * 64 + m * 16 + fr) * 64 + fq * 16);
#pragma unroll
    for (int n = 0; n < 4; ++n) b[n] = *(const bf16x8*)(SB + (wc * 64 + n * 16 + fr) * 64 + fq * 16);
#pragma unroll
    for (int m = 0; m < 4; ++m)
#pragma unroll
      for (int n = 0; n < 4; ++n) acc[m][n] = mfma16(a[m], b[n], acc[m][n]);
    st = (st == 2) ? 0 : st + 1;
  }
  __syncthreads();
}
#define EPI_LOOP                                                                                         \
  const int _lane = TIDX & 63, _wid = TIDX >> 6, _wr = _wid >> 1, _wc = _wid & 1, _fr = _lane & 15, \
            _fq = _lane >> 4;                                                                            \
  _Pragma("unroll") for (int m = 0; m < 4; ++m) _Pragma("unroll") for (int n = 0; n < 4; ++n)            \
      _Pragma("unroll") for (int j = 0; j < 4; ++j)
#define EPI_ROW (m0 + _wr * 64 + m * 16 + _fq * 4 + j)
#define EPI_COL (n0 + _wc * 64 + n * 16 + _fr)

DEVI void zero_acc(f32x4 (&acc)[4][4]) {
#pragma unroll
  for (int m = 0; m < 4; ++m)
#pragma unroll
    for (int n = 0; n < 4; ++n) acc[m][n] = f32x4{0.f, 0.f, 0.f, 0.f};
}

__constant__ double ROPE_FREQ[16] = {1.0, 0.5623413251903491, 0.31622776601683794, 0.1778279410038923, 0.1,
                                     0.05623413251903491, 0.03162277660168379, 0.01778279410038923, 0.01,
                                     0.005623413251903491, 0.0031622776601683794, 0.0017782794100389228, 0.001,
                                     0.0005623413251903491, 0.00031622776601683794, 0.00017782794100389227};

DEVI void transpose_tile(const float* __restrict__ src, int K, int N, u16* __restrict__ dst, int kt, int nt, unsigned char* sm) {
  float* tile = (float*)sm;
  const int tid = TIDX;
  const int k0 = kt * 64, n0 = nt * 64;
#pragma unroll
  for (int i = 0; i < 16; ++i) {
    int kk = i * 4 + (tid >> 6), nn = tid & 63;
    tile[kk * 65 + nn] = src[(size_t)(k0 + kk) * N + n0 + nn];
  }
  __syncthreads();
#pragma unroll
  for (int i = 0; i < 16; ++i) {
    int nn = i * 4 + (tid >> 6), kk = tid & 63;
    dst[(size_t)(n0 + nn) * K + k0 + kk] = f2bf(tile[kk * 65 + nn]);
  }
}

DEVI void convert_uv_item(const Params& p, int l, int it) {
  const int which = it >> 12, chunk = it & 4095;
  const float* src = p.in[34 + which] + (size_t)l * 16777216 + (size_t)chunk * 4096;
  u16* dst = (u16*)(p.ws + (which ? OFF_VB : OFF_UB)) + (size_t)chunk * 4096;
#pragma unroll
  for (int i = 0; i < 4; ++i) {
    int e = i * 1024 + TIDX * 4;
    float4 v = *(const float4*)(src + e);
    uint2 o; o.x = cvtpk(v.x, v.y); o.y = cvtpk(v.z, v.w);
    *(uint2*)(dst + e) = o;
  }
}

constexpr int P0_NT = 5920;
constexpr int P0_NUV = 8192;
constexpr int P0_NMOD = 192;
constexpr int P0_TOTAL = P0_NMOD + P0_NT + P0_NUV + 1;

DEVI void phase0_item(const Params& p, int it, unsigned char* sm) {
  const int tid = TIDX;
  if (it < P0_NMOD) {
    const int l = it / 96, n0 = (it % 96) * 64;
    const int kg = tid >> 4, c4 = (tid & 15) * 4;
    float acc[3][4];
#pragma unroll
    for (int r = 0; r < 3; ++r)
#pragma unroll
      for (int i = 0; i < 4; ++i) acc[r][i] = 0.f;
    const float* wm = p.in[8] + (size_t)l * 1024 * 6144;
    for (int k = kg * 64; k < kg * 64 + 64; ++k) {
      float4 w = *(const float4*)(wm + (size_t)k * 6144 + n0 + c4);
      float c0 = p.in[7][k], c1 = p.in[6][k], c2 = p.in[6][1024 + k];
      float s0 = c0 * sigmoidf_(c0), s1 = c1 * sigmoidf_(c1), s2 = c2 * sigmoidf_(c2);
      acc[0][0] += s0 * w.x; acc[0][1] += s0 * w.y; acc[0][2] += s0 * w.z; acc[0][3] += s0 * w.w;
      acc[1][0] += s1 * w.x; acc[1][1] += s1 * w.y; acc[1][2] += s1 * w.z; acc[1][3] += s1 * w.w;
      acc[2][0] += s2 * w.x; acc[2][1] += s2 * w.y; acc[2][2] += s2 * w.z; acc[2][3] += s2 * w.w;
    }
    float* red = (float*)sm;
#pragma unroll
    for (int r = 0; r < 3; ++r)
#pragma unroll
      for (int i = 0; i < 4; ++i) red[(kg * 3 + r) * 64 + c4 + i] = acc[r][i];
    __syncthreads();
    if (tid < 192) {
      int r = tid >> 6, col = tid & 63;
      float s = p.in[9][(size_t)l * 6144 + n0 + col];
      for (int g = 0; g < 16; ++g) s += red[(g * 3 + r) * 64 + col];
      ((float*)(p.ws + OFF_MOD))[((size_t)l * 3 + r) * 6144 + n0 + col] = s;
    }
    return;
  }
  it -= P0_NMOD;
  if (it < P0_NT) {
    int t = it;
    const float* src; u16* dst; int K, N, kt, nt;
    if (t < 4032) { int l = t / 2016, r = t % 2016; kt = r / 126; nt = r % 126; K = 1024; N = 8064;
      src = p.in[10] + (size_t)l * 1024 * 8064; dst = (u16*)(p.ws + OFF_WINT) + (size_t)l * 8064 * 1024; }
    else if ((t -= 4032) < 768) { int j = t / 128, r = t % 128; kt = r / 16; nt = r % 16; K = 512; N = 1024;
      src = p.in[26] + (size_t)j * 512 * 1024; dst = (u16*)(p.ws + OFF_WBRT) + (size_t)j * 1024 * 512; }
    else if ((t -= 768) < 512) { int l = t / 256, r = t % 256; kt = r / 16; nt = r % 16; K = 1024; N = 1024;
      src = p.in[27] + (size_t)l * 1048576; dst = (u16*)(p.ws + OFF_WOUTT) + (size_t)l * 1048576; }
    else if ((t -= 512) < 512) { int l = t / 256, r = t % 256; kt = r / 16; nt = r % 16; K = 1024; N = 1024;
      src = p.in[32] + (size_t)l * 1048576; dst = (u16*)(p.ws + OFF_WQT) + (size_t)l * 1048576; }
    else if ((t -= 512) < 32) { int j = t / 8; kt = 0; nt = t % 8; K = 64; N = 512;
      src = p.in[17] + (size_t)j * 32768; dst = (u16*)(p.ws + OFF_WUPT) + (size_t)j * 32768; }
    else if ((t -= 32) < 32) { int j = t / 8; kt = 0; nt = t % 8; K = 64; N = 512;
      src = p.in[19] + (size_t)j * 32768; dst = (u16*)(p.ws + OFF_AUPT) + (size_t)j * 32768; }
    else { t -= 32; int l = t / 16, r = t % 16; kt = r / 8; nt = r % 8; K = 128; N = 512;
      src = p.in[20] + (size_t)l * 65536; dst = (u16*)(p.ws + OFF_GUPT) + (size_t)l * 65536; }
    transpose_tile(src, K, N, dst, kt, nt, sm);
    return;
  }
  it -= P0_NT;
  if (it < P0_NUV) { convert_uv_item(p, 0, it); return; }
  float* tab = (float*)(p.ws + OFF_TAB);
  for (int e = tid; e < 1024; e += 256) {
    int pos = e >> 4, f = e & 15;
    double rev = (double)pos * ROPE_FREQ[f] * 0.15915494309189535;
    rev -= floor(rev);
    float rf = (float)rev;
    tab[e] = __builtin_amdgcn_cosf(rf);
    tab[1024 + e] = __builtin_amdgcn_sinf(rf);
  }
}

DEVI void ln1_item(const Params& p, int it) {
  const int lane = TIDX & 63, w = TIDX >> 6;
  const int tok = it * 4 + w;
  const float* x = xin_row(p, tok);
  const float* mod = (const float*)(p.ws + OFF_MOD) + (size_t)modrow(tok) * 6144;
  float4 v[4];
  float s = 0.f;
#pragma unroll
  for (int i = 0; i < 4; ++i) { v[i] = *(const float4*)(x + lane * 4 + 256 * i); s += v[i].x + v[i].y + v[i].z + v[i].w; }
  float mu = wave_sum(s) * (1.f / 1024.f);
  float q = 0.f;
#pragma unroll
  for (int i = 0; i < 4; ++i) { float a = v[i].x - mu, b = v[i].y - mu, c = v[i].z - mu, d = v[i].w - mu; q += a * a + b * b + c * c + d * d; }
  float rs = rsqrtf(wave_sum(q) * (1.f / 1024.f) + 1e-5f);
  u16* H = (u16*)(p.ws + OFF_H) + (size_t)tok * 1024;
#pragma unroll
  for (int i = 0; i < 4; ++i) {
    int c = lane * 4 + 256 * i;
    float4 sh = *(const float4*)(mod + c), sc = *(const float4*)(mod + 1024 + c);
    uint2 o;
    o.x = cvtpk((v[i].x - mu) * rs * (1.f + sc.x) + sh.x, (v[i].y - mu) * rs * (1.f + sc.y) + sh.y);
    o.y = cvtpk((v[i].z - mu) * rs * (1.f + sc.z) + sh.z, (v[i].w - mu) * rs * (1.f + sc.w) + sh.w);
    *(uint2*)(H + c) = o;
  }
}

DEVI void g1_item(const Params& p, int l, int it, unsigned char* sm) {
  const int nt = it >> 6, mt = it & 63;
  const int m0 = mt * 128, n0 = nt * 128;
  f32x4 acc[4][4];
  zero_acc(acc);
  gemm_acc((const u16*)(p.ws + OFF_H), 1024, (const u16*)(p.ws + OFF_WINT) + (size_t)l * 8064 * 1024, 1024, 1024, m0, n0, sm, acc);
  u16* Z = (u16*)(p.ws + OFF_Z);
  EPI_LOOP {
    int row = EPI_ROW, col = EPI_COL;
    float v = acc[m][n][j];
    Z[(size_t)row * PIN + col] = f2bf(v);
    if (row < 4096 && col >= 512 && col < 1536) {
      int which = (col - 512) >> 9, cc = (col - 512) & 511, h = cc >> 6, d = cc & 63, b = row >> 8, s = row & 255;
      p.out[OUT_NAK + (size_t)which * 4194304 + ((((size_t)(b * 2 + l) * 8 + h) * 256 + s) * 64 + d)] = v;
    }
  }
}
DEVI void g2_item(const Params& p, int l, int it, unsigned char* sm) {
  const int nt = it >> 6, mt = it & 63;
  const int m0 = mt * 128, n0 = nt * 128;
  f32x4 tot[4][4];
  zero_acc(tot);
  const u16* Z = (const u16*)(p.ws + OFF_Z);
  for (int i = 0; i < 3; ++i) {
    f32x4 acc[4][4];
    zero_acc(acc);
    const u16* A = (const u16*)(p.ws + (i == 0 ? OFF_ONA : (i == 1 ? OFF_ORT : OFF_ORW)));
    gemm_acc(A, 512, (const u16*)(p.ws + OFF_WBRT) + (size_t)(l * 3 + i) * 1024 * 512, 512, 512, m0, n0, sm, acc);
    EPI_LOOP {
      int row = EPI_ROW, col = EPI_COL;
      float g = bf2f(Z[(size_t)row * PIN + 4992 + i * 1024 + col]);
      tot[m][n][j] += sigmoidf_(g) * acc[m][n][j];
    }
  }
  u16* MG = (u16*)(p.ws + OFF_H);
  EPI_LOOP { MG[(size_t)EPI_ROW * 1024 + EPI_COL] = f2bf(tot[m][n][j]); }
}
DEVI void g3_item(const Params& p, int l, int it, unsigned char* sm) {
  const int nt = it >> 6, mt = it & 63;
  const int m0 = mt * 128, n0 = nt * 128;
  f32x4 acc[4][4];
  zero_acc(acc);
  gemm_acc((const u16*)(p.ws + OFF_H), 1024, (const u16*)(p.ws + OFF_WOUTT) + (size_t)l * 1048576, 1024, 1024, m0, n0, sm, acc);
  float* Y = (float*)(p.ws + OFF_Y);
  const float* mod = (const float*)(p.ws + OFF_MOD) + (size_t)l * 3 * 6144;
  const float* X = (const float*)(p.ws + OFF_X);
  EPI_LOOP {
    int row = EPI_ROW, col = EPI_COL;
    float xr = (l == 0) ? xin_row(p, row)[col] : X[(size_t)row * 1024 + col];
    float gt = mod[(size_t)modrow(row) * 6144 + 2048 + col];
    Y[(size_t)row * 1024 + col] = ALPHA * xr + gt * acc[m][n][j];
  }
}
DEVI void g4_item(const Params& p, int l, int it, unsigned char* sm) {
  const int nt = it >> 6, mt = it & 63;
  const int m0 = mt * 128, n0 = nt * 128;
  f32x4 acc[4][4];
  zero_acc(acc);
  gemm_acc((const u16*)(p.ws + OFF_H2), 1024, (const u16*)(p.ws + OFF_WQT) + (size_t)l * 1048576, 1024, 1024, m0, n0, sm, acc);
  float* Q = (float*)(p.ws + OFF_Q);
  EPI_LOOP { Q[(size_t)EPI_ROW * 1024 + EPI_COL] = acc[m][n][j]; }
}

DEVI void load_qk16(const u16* zp  , int part, bool lat, int prow, int pcol, const float* tab,
                    float scale, float* out) {
  if (!lat) {
    float t[16];
    unpack8(*(const uint4*)(zp + part * 16), t);
    unpack8(*(const uint4*)(zp + part * 16 + 8), t + 8);
#pragma unroll
    for (int i = 0; i < 16; ++i) out[i] = t[i] * scale;
    return;
  }
  const int half = part >> 1, isp2 = part & 1;
  float p1[16], p2[16];
  unpack8(*(const uint4*)(zp + half * 32), p1);
  unpack8(*(const uint4*)(zp + half * 32 + 8), p1 + 8);
  unpack8(*(const uint4*)(zp + half * 32 + 16), p2);
  unpack8(*(const uint4*)(zp + half * 32 + 24), p2 + 8);
  const int pos = half ? pcol : prow;
  const float* ct = tab + pos * 16;
  const float* st = tab + 1024 + pos * 16;
#pragma unroll
  for (int f = 0; f < 16; ++f) {
    float c = ct[f], s = st[f];
    out[f] = (isp2 ? (p1[f] * s + p2[f] * c) : (p1[f] * c - p2[f] * s)) * scale;
  }
}
struct RetItem { int lat, b, h, n, N, seqbase, kvbase; };
DEVI RetItem ret_decode(int it) {
  RetItem r;
  if (it < 256) { r.lat = 1; r.b = it >> 7; r.h = (it >> 5) & 3; r.n = it & 31; r.N = 32; r.seqbase = 4096 + r.b * 2048; r.kvbase = 256 + (r.b * 4 + r.h) * 32; }
  else { int j = it - 256; r.lat = 0; r.b = j >> 4; r.h = (j >> 2) & 3; r.n = j & 3; r.N = 4; r.seqbase = r.b * 256; r.kvbase = (r.b * 4 + r.h) * 4; }
  return r;
}
DEVI void ret_gammas(const Params& p, int l, int h, float& lgf, float& lgb) {
  float xf = p.in[12][(l * 2 + 0) * 4 + h], xb = p.in[12][(l * 2 + 1) * 4 + h];
  lgf = -log2f(1.f + expf(-xf));
  lgb = -log2f(1.f + expf(-xb));
}

DEVI void ret1_item(const Params& p, int l, int it, unsigned char* sm) {
  const RetItem r = ret_decode(it);
  const int tid = TIDX, lane = tid & 63, w = tid >> 6, fr = lane & 15, fq = lane >> 4;
  u16* KTf = (u16*)sm;
  u16* KTb = (u16*)(sm + 9216);
  u16* VT = (u16*)(sm + 18432);
  const u16* Z = (const u16*)(p.ws + OFF_Z);
  const float* tab = (const float*)(p.ws + OFF_TAB);
  float lgf, lgb;
  ret_gammas(p, l, r.h, lgf, lgb);
  const int tok0 = r.seqbase + r.n * 64;
  {
    const int j = tid >> 2, part = tid & 3;
    float kv[16];
    load_qk16(Z + (size_t)(tok0 + j) * PIN + 1792 + r.h * 64, part, r.lat, r.n, j, tab, 0.125f, kv);
    const float df = exp2f(lgf * (float)(63 - j)), db = exp2f(lgb * (float)j);
#pragma unroll
    for (int i = 0; i < 16; ++i) {
      KTf[(part * 16 + i) * 72 + j] = f2bf(kv[i] * df);
      KTb[(part * 16 + i) * 72 + j] = f2bf(kv[i] * db);
    }
    const int jj = tid & 63, vp = (tid >> 6) * 32;
    const u16* vz = Z + (size_t)(tok0 + jj) * PIN + 2048 + r.h * 128 + vp;
#pragma unroll
    for (int c = 0; c < 4; ++c) {
      uint4 raw = *(const uint4*)(vz + c * 8);
      const u16* rv = (const u16*)&raw;
#pragma unroll
      for (int i = 0; i < 8; ++i) VT[(vp + c * 8 + i) * 72 + jj] = rv[i];
    }
  }
  __syncthreads();
  float* KV = (float*)(p.ws + OFF_KV) + (size_t)(r.kvbase + r.n) * 2 * 8192;
#pragma unroll
  for (int dir = 0; dir < 2; ++dir) {
    f32x4 acc[8];
#pragma unroll
    for (int n = 0; n < 8; ++n) acc[n] = f32x4{0.f, 0.f, 0.f, 0.f};
    wave_mma<8>((dir ? KTb : KTf) + w * 16 * 72, 72, VT, 72, 64, acc);
#pragma unroll
    for (int n = 0; n < 8; ++n)
#pragma unroll
      for (int j = 0; j < 4; ++j) KV[(size_t)dir * 8192 + (w * 16 + fq * 4 + j) * 128 + n * 16 + fr] = acc[n][j];
  }
}

DEVI void ret3_item(const Params& p, int l, int it, unsigned char* sm) {
  const RetItem r = ret_decode(it);
  const int tid = TIDX, lane = tid & 63, w = tid >> 6, fr = lane & 15, fq = lane >> 4;
  u16* Qs = (u16*)sm;
  u16* Ks = (u16*)(sm + 9216);
  u16* VT = (u16*)(sm + 18432);
  u16* ST = (u16*)(sm + 36864);
  const u16* Z = (const u16*)(p.ws + OFF_Z);
  const float* tab = (const float*)(p.ws + OFF_TAB);
  float lgf, lgb;
  ret_gammas(p, l, r.h, lgf, lgb);
  const int tok0 = r.seqbase + r.n * 64;
  {
    const int i = tid >> 2, part = tid & 3;
    float t[16];
    load_qk16(Z + (size_t)(tok0 + i) * PIN + 1536 + r.h * 64, part, r.lat, r.n, i, tab, 1.f, t);
    *(uint4*)(Qs + i * 72 + part * 16) = pack8(t);
    *(uint4*)(Qs + i * 72 + part * 16 + 8) = pack8(t + 8);
    load_qk16(Z + (size_t)(tok0 + i) * PIN + 1792 + r.h * 64, part, r.lat, r.n, i, tab, 0.125f, t);
    *(uint4*)(Ks + i * 72 + part * 16) = pack8(t);
    *(uint4*)(Ks + i * 72 + part * 16 + 8) = pack8(t + 8);
    const int jj = tid & 63, vp = (tid >> 6) * 32;
    const u16* vz = Z + (size_t)(tok0 + jj) * PIN + 2048 + r.h * 128 + vp;
#pragma unroll
    for (int c = 0; c < 4; ++c) {
      uint4 raw = *(const uint4*)(vz + c * 8);
      const u16* rv = (const u16*)&raw;
#pragma unroll
      for (int e = 0; e < 8; ++e) VT[(vp + c * 8 + e) * 72 + jj] = rv[e];
    }
  }
  __syncthreads();
  f32x4 at[4];
#pragma unroll
  for (int n = 0; n < 4; ++n) at[n] = f32x4{0.f, 0.f, 0.f, 0.f};
  wave_mma<4>(Qs + w * 16 * 72, 72, Ks, 72, 64, at);
  __syncthreads();
#pragma unroll
  for (int n = 0; n < 4; ++n)
#pragma unroll
    for (int j = 0; j < 4; ++j) {
      int i = w * 16 + fq * 4 + j, jc = n * 16 + fr;
      float mval = (i > jc) ? exp2f(lgf * (float)(i - jc)) : ((i < jc) ? exp2f(lgb * (float)(jc - i)) : 2.f);
      Ks[i * 72 + jc] = f2bf(at[n][j] * mval);
    }
  __syncthreads();
  f32x4 o[8];
#pragma unroll
  for (int n = 0; n < 8; ++n) o[n] = f32x4{0.f, 0.f, 0.f, 0.f};
  wave_mma<8>(Ks + w * 16 * 72, 72, VT, 72, 64, o);
  const float* KVb_ = (const float*)(p.ws + OFF_KV);
  for (int dir = 0; dir < 2; ++dir) {
    const float lg = dir ? lgb : lgf;
    const float cdec = exp2f(lg * 64.f);
    const int nprev = dir ? (r.N - 1 - r.n) : r.n;
    __syncthreads();
#pragma unroll 4
    for (int e8 = 0; e8 < 32; ++e8) {
      int e = e8 * 256 + tid, d = e >> 7, v = e & 127;
      float S = 0.f;
      if (r.lat) S = p.in[4][((((size_t)(r.b * 2 + l) * 2 + dir) * 4 + r.h) * 64 + d) * 128 + v];
      for (int m = 0; m < nprev; ++m) {
        int ch = dir ? (r.N - 1 - m) : m;
        S = S * cdec + KVb_[((size_t)(r.kvbase + ch) * 2 + dir) * 8192 + e];
      }
      ST[v * 72 + d] = f2bf(S);
      if (!r.lat && nprev == r.N - 1) {
        float sf = S * cdec + KVb_[((size_t)(r.kvbase + r.n) * 2 + dir) * 8192 + e];
        p.out[OUT_SRET + ((((size_t)(r.b * 2 + l) * 2 + dir) * 4 + r.h) * 64 + d) * 128 + v] = sf;
      }
    }
    __syncthreads();
    f32x4 t2[8];
#pragma unroll
    for (int n = 0; n < 8; ++n) t2[n] = f32x4{0.f, 0.f, 0.f, 0.f};
    wave_mma<8>(Qs + w * 16 * 72, 72, ST, 72, 64, t2);
#pragma unroll
    for (int j = 0; j < 4; ++j) {
      int i = w * 16 + fq * 4 + j;
      float dec = dir ? exp2f(lg * (float)(64 - i)) : exp2f(lg * (float)(i + 1));
#pragma unroll
      for (int n = 0; n < 8; ++n) o[n][j] += dec * t2[n][j];
    }
  }
  const float* gw = p.in[13] + l * 512 + r.h * 128;
  const float* gb = p.in[14] + l * 512 + r.h * 128;
  u16* ORT = (u16*)(p.ws + OFF_ORT);
#pragma unroll
  for (int j = 0; j < 4; ++j) {
    float s = 0.f;
#pragma unroll
    for (int n = 0; n < 8; ++n) s += o[n][j];
    float mu = row16_sum(s) * (1.f / 128.f);
    float q = 0.f;
#pragma unroll
    for (int n = 0; n < 8; ++n) { float d = o[n][j] - mu; q += d * d; }
    float rs = rsqrtf(row16_sum(q) * (1.f / 128.f) + 1e-5f);
    const int tok = tok0 + w * 16 + fq * 4 + j;
#pragma unroll
    for (int n = 0; n < 8; ++n) {
      int v = n * 16 + fr;
      float g = bf2f(Z[(size_t)tok * PIN + 2560 + r.h * 128 + v]);
      float y = ((o[n][j] - mu) * rs * gw[v] + gb[v]) * (g * sigmoidf_(g));
      ORT[(size_t)tok * 512 + r.h * 128 + v] = f2bf(y);
    }
  }
}

DEVI void shifted8(const u16* Z, int tok, bool hasp, bool hasn, int col, const float* mu, float* out) {
  float z[8], zp[8], zn[8];
  unpack8(*(const uint4*)(Z + (size_t)tok * PIN + col), z);
  if (hasp) unpack8(*(const uint4*)(Z + (size_t)(tok - 1) * PIN + col), zp);
  else {
#pragma unroll
    for (int i = 0; i < 8; ++i) zp[i] = 0.f;
  }
  if (hasn) unpack8(*(const uint4*)(Z + (size_t)(tok + 1) * PIN + col), zn);
  else {
#pragma unroll
    for (int i = 0; i < 8; ++i) zn[i] = 0.f;
  }
  float4 m0 = *(const float4*)(mu + col - 3072), m1 = *(const float4*)(mu + col - 3072 + 4);
  float mm[8] = {m0.x, m0.y, m0.z, m0.w, m1.x, m1.y, m1.z, m1.w};
#pragma unroll
  for (int i = 0; i < 8; ++i) out[i] = z[i] + mm[i] * (0.5f * (zp[i] + zn[i]) - z[i]);
}
DEVI void tok_neighbors(int tok, bool& hasp, bool& hasn) {
  if (tok < 4096) { int s = tok & 255; hasp = s > 0; hasn = s < 255; }
  else { int s = (tok - 4096) & 2047; hasp = s > 0; hasn = s < 2047; }
}

DEVI void rwprep_item(const Params& p, int l, int it) {
  const int tid = TIDX, lane = tid & 63, w = tid >> 6, fr = lane & 15, fq = lane >> 4;
  const u16* Z = (const u16*)(p.ws + OFF_Z);
  const float* mu = p.in[15] + l * 1920;
  const int tok0 = (it >> 2) * 64, hq = it & 3;
  u16* R = (u16*)(p.ws + OFF_RWR);
  u16* V = (u16*)(p.ws + OFF_RWV);
  u16* KC = (u16*)(p.ws + OFF_RWKC);
  for (int e = tid; e < 64 * 48; e += 256) {
    int ti = e / 48, u = e % 48, arr = u >> 4, c8 = hq * 128 + (u & 15) * 8;
    int tok = tok0 + ti;
    bool hp, hn;
    tok_neighbors(tok, hp, hn);
    float zs[8];
    shifted8(Z, tok, hp, hn, 3072 + arr * 512 + c8, mu, zs);
    u16* dst = (arr == 0) ? R : (arr == 1 ? KC : V);
    *(uint4*)(dst + (size_t)tok * 512 + c8) = pack8(zs);
  }
  __threadfence();
  __syncthreads();
  bf16x8 af[12];
  {
    const int tok = tok0 + w * 16 + fr;
    bool hp, hn;
    tok_neighbors(tok, hp, hn);
#pragma unroll
    for (int f = 0; f < 12; ++f) {
      int col = 4608 + f * 32 + fq * 8;
      float zs[8];
      shifted8(Z, tok, hp, hn, col, mu, zs);
      if (f < 4) {
#pragma unroll
        for (int i = 0; i < 8; ++i) zs[i] = tanhf(zs[i]);
      } else if (f >= 8) {
#pragma unroll
        for (int i = 0; i < 8; ++i) zs[i] = sigmoidf_(zs[i]);
      }
      uint4 pk = pack8(zs);
      af[f] = __builtin_bit_cast(bf16x8, pk);
    }
  }
  const u16* WUP = (const u16*)(p.ws + OFF_WUPT) + (size_t)l * 2 * 32768;
  const u16* AUP = (const u16*)(p.ws + OFF_AUPT) + (size_t)l * 2 * 32768;
  const u16* GUP = (const u16*)(p.ws + OFF_GUPT) + (size_t)l * 65536;
  float* Wd = (float*)(p.ws + OFF_RWW);
  u16* KK = (u16*)(p.ws + OFF_RWKK);
  u16* KD = (u16*)(p.ws + OFF_RWKD);
  u16* KKA = (u16*)(p.ws + OFF_RWKKA);
  u16* G = (u16*)(p.ws + OFF_RWG);
  u16* BON = (u16*)(p.ws + OFF_RWBON);
  const float* kkw = p.in[21] + l * 512;
  const float* kaw = p.in[22] + l * 512;
  const float* rkw = p.in[23] + l * 512;
  const float* w0 = p.in[16] + l * 1024;
  const float* a0 = p.in[18] + l * 1024;
  for (int h = hq * 2; h < hq * 2 + 2; ++h) {
    float inv[4], sbv[4];
#pragma unroll
    for (int j = 0; j < 4; ++j) {
      const int tok = tok0 + w * 16 + fq * 4 + j;
      float ssq = 0.f, sb = 0.f;
#pragma unroll
      for (int n = 0; n < 4; ++n) {
        int c = h * 64 + n * 16 + fr;
        float rr = bf2f(R[(size_t)tok * 512 + c]);
        float kc = bf2f(KC[(size_t)tok * 512 + c]);
        float kk = kc * kkw[c];
        ssq += kk * kk;
        sb += rr * kc * rkw[c];
      }
      ssq = row16_sum(ssq);
      sbv[j] = row16_sum(sb);
      inv[j] = rsqrtf(fmaxf(ssq, 1e-24f));
    }
#pragma unroll 1
    for (int n = 0; n < 4; ++n) {
      f32x4 acc[5];
#pragma unroll
      for (int m = 0; m < 5; ++m) acc[m] = f32x4{0.f, 0.f, 0.f, 0.f};
      const int c = h * 64 + n * 16 + fr;
#pragma unroll
      for (int ks = 0; ks < 2; ++ks) {
        acc[0] = mfma16(af[0 + ks], *(const bf16x8*)(WUP + (size_t)c * 64 + ks * 32 + fq * 8), acc[0]);
        acc[1] = mfma16(af[2 + ks], *(const bf16x8*)(WUP + 32768 + (size_t)c * 64 + ks * 32 + fq * 8), acc[1]);
        acc[2] = mfma16(af[4 + ks], *(const bf16x8*)(AUP + (size_t)c * 64 + ks * 32 + fq * 8), acc[2]);
        acc[3] = mfma16(af[6 + ks], *(const bf16x8*)(AUP + 32768 + (size_t)c * 64 + ks * 32 + fq * 8), acc[3]);
      }
#pragma unroll
      for (int ks = 0; ks < 4; ++ks)
        acc[4] = mfma16(af[8 + ks], *(const bf16x8*)(GUP + (size_t)c * 128 + ks * 32 + fq * 8), acc[4]);
      const float kkc = kkw[c], ka = kaw[c];
      const float w0f = w0[c], w0b = w0[512 + c], a0f = a0[c], a0b = a0[512 + c];
#pragma unroll
      for (int j = 0; j < 4; ++j) {
        const int tok = tok0 + w * 16 + fq * 4 + j;
        const size_t o = (size_t)tok * 512 + c;
        const float kc = bf2f(KC[o]), vv = bf2f(V[o]);
        const float kkn = kc * kkc * inv[j];
        KK[o] = f2bf(kkn);
        G[o] = f2bf(acc[4][j]);
        BON[o] = f2bf(sbv[j] * vv);
#pragma unroll
        for (int d = 0; d < 2; ++d) {
          float wv = __expf(-0.606531f * sigmoidf_((d ? w0b : w0f) + acc[d][j]));
          float a = sigmoidf_((d ? a0b : a0f) + acc[2 + d][j]);
          Wd[(size_t)d * NTOK * 512 + o] = wv;
          KD[(size_t)d * NTOK * 512 + o] = f2bf(kc * (1.f + (a - 1.f) * ka));
          KKA[(size_t)d * NTOK * 512 + o] = f2bf(kkn * a);
        }
      }
    }
  }
}

template <int KPT>
DEVI void scan_run(const Params& p, int l, bool lat, int b, int h, int dir, int rowbase, unsigned char* sm) {
  constexpr int LPR = 64 / KPT;
  const int tid = TIDX;
  const int row = rowbase + tid / LPR, ks = (tid % LPR) * KPT;
  const int T = lat ? 2048 : 256, seq0 = lat ? 4096 + b * 2048 : b * 256;
  float S[KPT];
  if (lat) {
    const float* s0 = p.in[5] + ((((size_t)(b * 2 + l) * 2 + dir) * 8 + h) * 64 + row) * 64 + ks;
#pragma unroll
    for (int i = 0; i < KPT; ++i) S[i] = s0[i];
  } else {
#pragma unroll
    for (int i = 0; i < KPT; ++i) S[i] = 0.f;
  }
  float* buf = (float*)sm;
  const float* Wd = (const float*)(p.ws + OFF_RWW) + (size_t)dir * NTOK * 512;
  const u16* R = (const u16*)(p.ws + OFF_RWR);
  const u16* V = (const u16*)(p.ws + OFF_RWV);
  const u16* KK = (const u16*)(p.ws + OFF_RWKK);
  const u16* KD = (const u16*)(p.ws + OFF_RWKD) + (size_t)dir * NTOK * 512;
  const u16* KKA = (const u16*)(p.ws + OFF_RWKKA) + (size_t)dir * NTOK * 512;
  float* O = (float*)(p.ws + OFF_OF) + (size_t)dir * NTOK * 512;
  const int pst = tid >> 4, c4 = (tid & 15) * 4;
  float4 pw; uint2 pr, pk, pv, pd, pa;
  auto issue = [&](int chunk) {
    int s = chunk * 16 + pst;
    int tok = dir ? (seq0 + T - 1 - s) : (seq0 + s);
    size_t o = (size_t)tok * 512 + h * 64 + c4;
    pw = *(const float4*)(Wd + o);
    pr = *(const uint2*)(R + o); pk = *(const uint2*)(KK + o); pv = *(const uint2*)(V + o);
    pd = *(const uint2*)(KD + o); pa = *(const uint2*)(KKA + o);
  };
  issue(0);
  const int nch = T / 16;
  for (int chunk = 0; chunk < nch; ++chunk) {
    __syncthreads();
    {
      float* bp = buf + pst * 384 + c4;
      float t[4];
      *(float4*)bp = pw;
      unpack4(pr, t); *(float4*)(bp + 64) = make_float4(t[0], t[1], t[2], t[3]);
      unpack4(pk, t); *(float4*)(bp + 128) = make_float4(t[0], t[1], t[2], t[3]);
      unpack4(pv, t); *(float4*)(bp + 192) = make_float4(t[0], t[1], t[2], t[3]);
      unpack4(pd, t); *(float4*)(bp + 256) = make_float4(t[0], t[1], t[2], t[3]);
      unpack4(pa, t); *(float4*)(bp + 320) = make_float4(t[0], t[1], t[2], t[3]);
    }
    __syncthreads();
    if (chunk + 1 < nch) issue(chunk + 1);
    float myo = 0.f;
    const int lir = tid % LPR;
    constexpr int UNR = (KPT == 4) ? 16 : 4;
#pragma unroll 1
    for (int sb = 0; sb < 16; sb += UNR)
#pragma unroll
    for (int si = 0; si < UNR; ++si) {
      const int s = sb + si;
      const float* bp = buf + s * 384;
      float wv[KPT], rv[KPT], kkv[KPT], kdv[KPT], kav[KPT];
#pragma unroll
      for (int i = 0; i < KPT; i += 4) {
        *(float4*)(wv + i) = *(const float4*)(bp + ks + i);
        *(float4*)(rv + i) = *(const float4*)(bp + 64 + ks + i);
        *(float4*)(kkv + i) = *(const float4*)(bp + 128 + ks + i);
        *(float4*)(kdv + i) = *(const float4*)(bp + 256 + ks + i);
        *(float4*)(kav + i) = *(const float4*)(bp + 320 + ks + i);
      }
      const float vr = bp[192 + row];
      float sk = 0.f;
#pragma unroll
      for (int i = 0; i < KPT; ++i) sk += S[i] * kkv[i];
      sk = (LPR == 16) ? row16_sum(sk) : quad_sum(sk);
      float o = 0.f;
#pragma unroll
      for (int i = 0; i < KPT; ++i) {
        S[i] = S[i] * wv[i] - sk * kav[i] + vr * kdv[i];
        o += S[i] * rv[i];
      }
      o = (LPR == 16) ? row16_sum(o) : quad_sum(o);
      myo = ((si % LPR) == lir) ? o : myo;
      if ((si % LPR) == LPR - 1) {
        int st = chunk * 16 + (s - (LPR - 1)) + lir;
        int tok = dir ? (seq0 + T - 1 - st) : (seq0 + st);
        O[(size_t)tok * 512 + h * 64 + row] = myo;
      }
    }
  }
  if (!lat) {
    float* so = p.out + OUT_SRW + ((((size_t)(b * 2 + l) * 2 + dir) * 8 + h) * 64 + row) * 64 + ks;
#pragma unroll
    for (int i = 0; i < KPT; ++i) so[i] = S[i];
  }
}

DEVI void attn_item(const Params& p, int l, int it, unsigned char* sm) {
  const int tid = TIDX, lane = tid & 63, w = tid >> 6, fr = lane & 15, fq = lane >> 4;
  u16* Ks = (u16*)sm;
  u16* VT = (u16*)(sm + 9216);
  float* rpbs = (float*)(sm + 18432);
  const u16* Z = (const u16*)(p.ws + OFF_Z);
  const bool lat = it < 512;
  int b, h, r = 0, seqbase, qtok0;
  if (lat) { b = it >> 8; h = (it >> 5) & 7; r = it & 31; seqbase = 4096 + b * 2048; qtok0 = seqbase + r * 64; }
  else { int j = it - 512; b = j >> 5; h = (j >> 2) & 7; int qb = j & 3; seqbase = b * 256; qtok0 = seqbase + qb * 64; }
  bf16x8 qf[2];
#pragma unroll
  for (int ks = 0; ks < 2; ++ks) qf[ks] = *(const bf16x8*)(Z + (size_t)(qtok0 + w * 16 + fr) * PIN + h * 64 + ks * 32 + fq * 8);
  if (lat)
    for (int i = tid; i < 465; i += 256) rpbs[i] = p.in[11][(size_t)(l * 8 + h) * 465 + i];
  float m_run = -3e38f, l_run = 0.f;
  f32x4 o[4];
#pragma unroll
  for (int d = 0; d < 4; ++d) o[d] = f32x4{0.f, 0.f, 0.f, 0.f};
  const int ntiles = lat ? 16 : 4;
  const int row_start = lat ? clampi(r - 4, 0, 24) : 0;
  const int cbs = lat ? clampi(w * 16 - 8, 0, 32) : 0;
  for (int ti = 0; ti < ntiles; ++ti) {
    __syncthreads();
    const bool ctxtile = lat && ti < 8;
    if (ctxtile) {
      const float* kc = p.in[2] + ((((size_t)b * 2 + l) * 8 + h) * 512 + ti * 64) * 64;
      const float* vc = p.in[3] + ((((size_t)b * 2 + l) * 8 + h) * 512 + ti * 64) * 64;
      {
        const int key = tid >> 2, dp = (tid & 3) * 16;
        float t[16];
#pragma unroll
        for (int c = 0; c < 4; ++c) *(float4*)(t + c * 4) = *(const float4*)(kc + key * 64 + dp + c * 4);
        *(uint4*)(Ks + key * 72 + dp) = pack8(t);
        *(uint4*)(Ks + key * 72 + dp + 8) = pack8(t + 8);
      }
      {
        const int key = tid & 63, dp = (tid >> 6) * 16;
        float t[16];
#pragma unroll
        for (int c = 0; c < 4; ++c) *(float4*)(t + c * 4) = *(const float4*)(vc + key * 64 + dp + c * 4);
#pragma unroll
        for (int i = 0; i < 16; ++i) VT[(dp + i) * 72 + key] = f2bf(t[i]);
      }
    } else {
      const int trow = lat ? (row_start + ti - 8) : ti;
      const u16* zr = Z + (size_t)(seqbase + trow * 64) * PIN;
      {
        const int key = tid >> 2, dp = (tid & 3) * 16;
        const u16* src = zr + (size_t)key * PIN + 512 + h * 64 + dp;
        *(uint4*)(Ks + key * 72 + dp) = *(const uint4*)src;
        *(uint4*)(Ks + key * 72 + dp + 8) = *(const uint4*)(src + 8);
      }
      {
        const int key = tid & 63, dp = (tid >> 6) * 16;
        const u16* src = zr + (size_t)key * PIN + 1024 + h * 64 + dp;
        uint4 r0 = *(const uint4*)src, r1 = *(const uint4*)(src + 8);
        const u16* a0 = (const u16*)&r0;
        const u16* a1 = (const u16*)&r1;
#pragma unroll
        for (int i = 0; i < 8; ++i) { VT[(dp + i) * 72 + key] = a0[i]; VT[(dp + 8 + i) * 72 + key] = a1[i]; }
      }
    }
    __syncthreads();
    const bool win = lat && !ctxtile;
    const int nsteps = win ? 1 : 2;
    for (int st = 0; st < nsteps; ++st) {
      const int ko = win ? cbs : st * 32;
      f32x4 s0 = f32x4{0.f, 0.f, 0.f, 0.f}, s1 = s0;
#pragma unroll
      for (int ks = 0; ks < 2; ++ks) {
        bf16x8 a0 = *(const bf16x8*)(Ks + (ko + fr) * 72 + ks * 32 + fq * 8);
        bf16x8 a1 = *(const bf16x8*)(Ks + (ko + 16 + fr) * 72 + ks * 32 + fq * 8);
        s0 = mfma16(a0, qf[ks], s0);
        s1 = mfma16(a1, qf[ks], s1);
      }
      float sv[8];
#pragma unroll
      for (int j = 0; j < 4; ++j) { sv[j] = s0[j] * 0.125f; sv[4 + j] = s1[j] * 0.125f; }
      if (win) {
        const int qc = w * 16 + fr;
        const int dr = (row_start + ti - 8) - r + 7;
        const int qs = clampi(qc - 8, 0, 48);
#pragma unroll
        for (int e = 0; e < 8; ++e) {
          int kc_ = ko + ((e < 4) ? (fq * 4 + e) : (16 + fq * 4 + e - 4));
          int dc = clampi(kc_ - qc, -15, 15) + 15;
          int rel = kc_ - qs;
          sv[e] = (rel >= 0 && rel < 16) ? (sv[e] + rpbs[dr * 31 + dc]) : -1e30f;
        }
      }
      float mx = sv[0];
#pragma unroll
      for (int e = 1; e < 8; ++e) mx = fmaxf(mx, sv[e]);
      mx = fmaxf(mx, __shfl_xor(mx, 16));
      mx = fmaxf(mx, __shfl_xor(mx, 32));
      const float m_new = fmaxf(m_run, mx);
      const float alpha = __expf(m_run - m_new);
      float pe[8], ps = 0.f;
#pragma unroll
      for (int e = 0; e < 8; ++e) { pe[e] = __expf(sv[e] - m_new); ps += pe[e]; }
      l_run = l_run * alpha + ps;
      m_run = m_new;
#pragma unroll
      for (int d = 0; d < 4; ++d) o[d] *= alpha;
      uint4 pk = pack8(pe);
      bf16x8 pb = __builtin_bit_cast(bf16x8, pk);
#pragma unroll
      for (int d = 0; d < 4; ++d) {
        uint2 lo = *(const uint2*)(VT + (d * 16 + fr) * 72 + ko + fq * 4);
        uint2 hi = *(const uint2*)(VT + (d * 16 + fr) * 72 + ko + 16 + fq * 4);
        uint4 vv; vv.x = lo.x; vv.y = lo.y; vv.z = hi.x; vv.w = hi.y;
        o[d] = mfma16(__builtin_bit_cast(bf16x8, vv), pb, o[d]);
      }
    }
  }
  float lt = l_run + __shfl_xor(l_run, 16);
  lt += __shfl_xor(lt, 32);
  const float inv = 1.f / lt;
  u16* ONA = (u16*)(p.ws + OFF_ONA);
  const int tok = qtok0 + w * 16 + fr;
#pragma unroll
  for (int d = 0; d < 4; ++d) {
    uint2 ov; ov.x = cvtpk(o[d][0] * inv, o[d][1] * inv); ov.y = cvtpk(o[d][2] * inv, o[d][3] * inv);
    *(uint2*)(ONA + (size_t)tok * 512 + h * 64 + d * 16 + fq * 4) = ov;
  }
}

constexpr int MIX_NSCAN_LAT = 128, MIX_NSCAN_CTX = 256, MIX_NATT = 1024, MIX_NRET = 512;
constexpr int MIX_TOTAL = MIX_NSCAN_LAT + MIX_NSCAN_CTX + MIX_NATT + MIX_NRET;
#ifndef ONLYP
#define ONLYP -1
#endif
#define PH_ON(x) (ONLYP < 0 || ONLYP == (x))
DEVI void mix_item(const Params& p, int l, int it, unsigned char* sm) {
  if (it < MIX_NSCAN_LAT) {
    int ch = it >> 2, rq = it & 3;
    if (PH_ON(12)) scan_run<4>(p, l, true, ch >> 4, ch & 7, (ch >> 3) & 1, rq * 16, sm);
    return;
  }
  it -= MIX_NSCAN_LAT;
  if (it < MIX_NSCAN_CTX) { if (PH_ON(13)) scan_run<16>(p, l, false, it >> 4, it & 7, (it >> 3) & 1, 0, sm); return; }
  it -= MIX_NSCAN_CTX;
  if (it < MIX_NATT) { if (PH_ON(14)) attn_item(p, l, it, sm); return; }
  it -= MIX_NATT;
  if (PH_ON(15)) ret3_item(p, l, it, sm);
}

DEVI void fin_item(const Params& p, int l, int it) {
  const int tid = TIDX;
  const int tok = it * 2 + (tid >> 7), c4 = (tid & 127) * 4;
  const size_t o = (size_t)tok * 512 + c4;
  float4 a = *(const float4*)((const float*)(p.ws + OFF_OF) + o);
  float4 b = *(const float4*)((const float*)(p.ws + OFF_OF) + (size_t)NTOK * 512 + o);
  float x[4] = {a.x + b.x, a.y + b.y, a.z + b.z, a.w + b.w};
  float mu = row16_sum(x[0] + x[1] + x[2] + x[3]) * (1.f / 64.f);
  float q = 0.f;
#pragma unroll
  for (int i = 0; i < 4; ++i) { float d = x[i] - mu; q += d * d; }
  float rs = rsqrtf(row16_sum(q) * (1.f / 64.f) + 64e-5f);
  float4 gw = *(const float4*)(p.in[24] + l * 512 + c4), gb = *(const float4*)(p.in[25] + l * 512 + c4);
  float gwv[4] = {gw.x, gw.y, gw.z, gw.w}, gbv[4] = {gb.x, gb.y, gb.z, gb.w};
  float bon[4], g[4];
  unpack4(*(const uint2*)((const u16*)(p.ws + OFF_RWBON) + o), bon);
  unpack4(*(const uint2*)((const u16*)(p.ws + OFF_RWG) + o), g);
  float y[4];
#pragma unroll
  for (int i = 0; i < 4; ++i) y[i] = ((x[i] - mu) * rs * gwv[i] + gbv[i] + bon[i]) * g[i];
  uint2 ov; ov.x = cvtpk(y[0], y[1]); ov.y = cvtpk(y[2], y[3]);
  *(uint2*)((u16*)(p.ws + OFF_ORW) + o) = ov;
}

DEVI void ln2_item(const Params& p, int l, int it) {
  const int lane = TIDX & 63, w = TIDX >> 6;
  const int tok = it * 4 + w;
  const float* y = (const float*)(p.ws + OFF_Y) + (size_t)tok * 1024;
  const float* mod = (const float*)(p.ws + OFF_MOD) + ((size_t)l * 3 + modrow(tok)) * 6144;
  float v[16];
  float s = 0.f;
#pragma unroll
  for (int i = 0; i < 4; ++i) { *(float4*)(v + i * 4) = *(const float4*)(y + lane * 4 + 256 * i); }
#pragma unroll
  for (int i = 0; i < 16; ++i) s += v[i];
  float mu = wave_sum(s) * (1.f / 1024.f);
  float q = 0.f;
#pragma unroll
  for (int i = 0; i < 16; ++i) { float d = v[i] - mu; q += d * d; }
  float rs = rsqrtf(wave_sum(q) * (1.f / 1024.f) + 1e-5f);
  float* X1 = (float*)(p.ws + OFF_X1) + (size_t)tok * 1024;
  s = 0.f;
#pragma unroll
  for (int i = 0; i < 4; ++i) {
    int c = lane * 4 + 256 * i;
    float4 g = *(const float4*)(p.in[28] + l * 1024 + c), bb = *(const float4*)(p.in[29] + l * 1024 + c);
    v[i * 4 + 0] = (v[i * 4 + 0] - mu) * rs * g.x + bb.x;
    v[i * 4 + 1] = (v[i * 4 + 1] - mu) * rs * g.y + bb.y;
    v[i * 4 + 2] = (v[i * 4 + 2] - mu) * rs * g.z + bb.z;
    v[i * 4 + 3] = (v[i * 4 + 3] - mu) * rs * g.w + bb.w;
    *(float4*)(X1 + c) = *(float4*)(v + i * 4);
    s += v[i * 4] + v[i * 4 + 1] + v[i * 4 + 2] + v[i * 4 + 3];
  }
  mu = wave_sum(s) * (1.f / 1024.f);
  q = 0.f;
#pragma unroll
  for (int i = 0; i < 16; ++i) { float d = v[i] - mu; q += d * d; }
  rs = rsqrtf(wave_sum(q) * (1.f / 1024.f) + 1e-5f);
  u16* H2 = (u16*)(p.ws + OFF_H2) + (size_t)tok * 1024;
#pragma unroll
  for (int i = 0; i < 4; ++i) {
    int c = lane * 4 + 256 * i;
    float4 sh = *(const float4*)(mod + 3072 + c), sc = *(const float4*)(mod + 4096 + c);
    uint2 o;
    o.x = cvtpk((v[i * 4] - mu) * rs * (1.f + sc.x) + sh.x, (v[i * 4 + 1] - mu) * rs * (1.f + sc.y) + sh.y);
    o.y = cvtpk((v[i * 4 + 2] - mu) * rs * (1.f + sc.z) + sh.z, (v[i * 4 + 3] - mu) * rs * (1.f + sc.w) + sh.w);
    *(uint2*)(H2 + c) = o;
  }
}

DEVI int f2ord(float f) { int i = __float_as_int(f); return i ^ ((i >> 31) & 0x7fffffff); }
DEVI float ord2f(int i) { return __int_as_float(i ^ ((i >> 31) & 0x7fffffff)); }
DEVI void insert16(int (&t)[16], int x) {
#pragma unroll
  for (int i = 0; i < 16; ++i) { int hi = max(t[i], x); x = min(t[i], x); t[i] = hi; }
}
DEVI void route_item(const Params& p, int l, int it, unsigned char* sm) {
  const int tid = TIDX, lane = tid & 63, w = tid >> 6;
  const int g = w >> 1, pp = w & 1;
  const int tb = it >> 3, h = it & 7;
  const int tok = tb * 128 + g * 64 + lane;
  float* kl = (float*)sm;
  const float* Q = (const float*)(p.ws + OFF_Q) + (size_t)tok * 1024 + h * 128 + pp * 64;
  float q[64];
#pragma unroll
  for (int i = 0; i < 16; ++i) *(float4*)(q + i * 4) = *(const float4*)(Q + i * 4);
  int T[16];
#pragma unroll
  for (int i = 0; i < 16; ++i) T[i] = (int)0x80000000;
  const float* keys = p.in[33] + (size_t)((l * 8 + h) * 2) * 8192;
  for (int half = 0; half < 2; ++half) {
    __syncthreads();
#pragma unroll
    for (int i = 0; i < 8; ++i) {
      int e = (i * 256 + tid) * 4;
      int ps = e >> 12, r = e & 4095;
      *(float4*)(kl + e) = *(const float4*)(keys + (size_t)ps * 8192 + half * 4096 + r);
    }
    __syncthreads();
    const float* kb = kl + pp * 4096;
#pragma unroll 2
    for (int k = 0; k < 64; ++k) {
      const float* kp = kb + k * 64;
      float s0 = 0.f, s1 = 0.f, s2 = 0.f, s3 = 0.f;
#pragma unroll
      for (int d = 0; d < 64; d += 4) {
        float4 kv = *(const float4*)(kp + d);
        s0 += q[d] * kv.x; s1 += q[d + 1] * kv.y; s2 += q[d + 2] * kv.z; s3 += q[d + 3] * kv.w;
      }
      float sc = (s0 + s1) + (s2 + s3);
      int bits = (f2ord(sc) & ~127) | (127 - (half * 64 + k));
      insert16(T, bits);
    }
  }
  __syncthreads();
  int* xb = (int*)sm;
  if (pp == 1) {
#pragma unroll
    for (int i = 0; i < 16; ++i) xb[(g * 16 + i) * 64 + lane] = T[i];
  }
  __syncthreads();
  if (pp == 0) {
    int T1[16];
#pragma unroll
    for (int i = 0; i < 16; ++i) T1[i] = xb[(g * 16 + i) * 64 + lane];
    int F[16];
#pragma unroll
    for (int i = 0; i < 16; ++i) F[i] = (int)0x80000000;
#pragma unroll
    for (int i = 0; i < 16; ++i) {
#pragma unroll
      for (int j = 0; j < 16; ++j) {
        if ((i + 1) * (j + 1) <= 16) {
          float c = ord2f(T[i] & ~127) + ord2f(T1[j] & ~127);
          int bits = (f2ord(c) & ~255) | (255 - (i * 16 + j));
          insert16(F, bits);
        }
      }
    }
    float fs[16], den = 0.f;
    const float f0 = ord2f(F[0] & ~255);
#pragma unroll
    for (int i = 0; i < 16; ++i) { fs[i] = __expf(ord2f(F[i] & ~255) - f0); den += fs[i]; }
    const float inv = 1.f / den;
    int* EIDX = (int*)(p.ws + OFF_EIDX) + (size_t)tok * 128 + h * 16;
    float* GATE = (float*)(p.ws + OFF_GATE) + (size_t)tok * 128 + h * 16;
    int eo[16]; float go[16];
#pragma unroll
    for (int i = 0; i < 16; ++i) {
      int pos = 255 - (F[i] & 255);
      int i0 = pos >> 4, j0 = pos & 15;
      int k0 = 0, k1 = 0;
#pragma unroll
      for (int c = 0; c < 16; ++c) {
        int a0 = 127 - (T[c] & 127), a1 = 127 - (T1[c] & 127);
        k0 = (i0 == c) ? a0 : k0;
        k1 = (j0 == c) ? a1 : k1;
      }
      eo[i] = k0 * 128 + k1;
      go[i] = fs[i] * inv;
    }
#pragma unroll
    for (int i = 0; i < 16; i += 4) {
      *(int4*)(EIDX + i) = make_int4(eo[i], eo[i + 1], eo[i + 2], eo[i + 3]);
      *(float4*)(GATE + i) = make_float4(go[i], go[i + 1], go[i + 2], go[i + 3]);
    }
  }
}

DEVI void expert_item(const Params& p, int l, int it) {
  const int lane = TIDX & 63;
  const int w = __builtin_amdgcn_readfirstlane(TIDX >> 6);
  const int tok = it * 4 + w;
  const u16* H2 = (const u16*)(p.ws + OFF_H2) + (size_t)tok * 1024;
  float hv[16];
  unpack8(*(const uint4*)(H2 + lane * 8), hv);
  unpack8(*(const uint4*)(H2 + 512 + lane * 8), hv + 8);
  const int* EIDX = (const int*)(p.ws + OFF_EIDX) + (size_t)tok * 128;
  const float* GATE = (const float*)(p.ws + OFF_GATE) + (size_t)tok * 128;
  const u16* UB = (const u16*)(p.ws + OFF_UB);
  const u16* VB = (const u16*)(p.ws + OFF_VB);
  float f[16];
#pragma unroll
  for (int i = 0; i < 16; ++i) f[i] = 0.f;
#pragma unroll 4
  for (int e = 0; e < 128; ++e) {
    const int idx = EIDX[e];
    const float gate = GATE[e];
    const u16* ur = UB + (size_t)idx * 1024;
    const u16* vr = VB + (size_t)idx * 1024;
    uint4 u0 = *(const uint4*)(ur + lane * 8), u1 = *(const uint4*)(ur + 512 + lane * 8);
    uint4 v0 = *(const uint4*)(vr + lane * 8), v1 = *(const uint4*)(vr + 512 + lane * 8);
    float uu[16];
    unpack8(u0, uu); unpack8(u1, uu + 8);
    float d = 0.f;
#pragma unroll
    for (int i = 0; i < 16; ++i) d += uu[i] * hv[i];
    d = wave_sum(d);
    const float act = 0.5f * d * (1.f + erff(d * 0.70710678118654752f)) * gate;
    float vv[16];
    unpack8(v0, vv); unpack8(v1, vv + 8);
#pragma unroll
    for (int i = 0; i < 16; ++i) f[i] += act * vv[i];
  }
  const float* X1 = (const float*)(p.ws + OFF_X1) + (size_t)tok * 1024;
  const float* mod = (const float*)(p.ws + OFF_MOD) + ((size_t)l * 3 + modrow(tok)) * 6144;
  float y[16];
  float s = 0.f;
#pragma unroll
  for (int hh = 0; hh < 2; ++hh)
#pragma unroll
    for (int c = 0; c < 2; ++c) {
      int col = hh * 512 + lane * 8 + c * 4;
      float4 x = *(const float4*)(X1 + col), gt = *(const float4*)(mod + 5120 + col);
      int o = hh * 8 + c * 4;
      y[o] = ALPHA * x.x + gt.x * f[o]; y[o + 1] = ALPHA * x.y + gt.y * f[o + 1];
      y[o + 2] = ALPHA * x.z + gt.z * f[o + 2]; y[o + 3] = ALPHA * x.w + gt.w * f[o + 3];
      s += y[o] + y[o + 1] + y[o + 2] + y[o + 3];
    }
  float mu = wave_sum(s) * (1.f / 1024.f);
  float q = 0.f;
#pragma unroll
  for (int i = 0; i < 16; ++i) { float d = y[i] - mu; q += d * d; }
  float rs = rsqrtf(wave_sum(q) * (1.f / 1024.f) + 1e-5f);
  float* xo = (l == 1) ? (p.out + OUT_Y + (size_t)tok * 1024) : ((float*)(p.ws + OFF_X) + (size_t)tok * 1024);
  s = 0.f;
#pragma unroll
  for (int hh = 0; hh < 2; ++hh)
#pragma unroll
    for (int c = 0; c < 2; ++c) {
      int col = hh * 512 + lane * 8 + c * 4;
      int o = hh * 8 + c * 4;
      float4 g = *(const float4*)(p.in[30] + l * 1024 + col), bb = *(const float4*)(p.in[31] + l * 1024 + col);
      y[o] = (y[o] - mu) * rs * g.x + bb.x; y[o + 1] = (y[o + 1] - mu) * rs * g.y + bb.y;
      y[o + 2] = (y[o + 2] - mu) * rs * g.z + bb.z; y[o + 3] = (y[o + 3] - mu) * rs * g.w + bb.w;
      *(float4*)(xo + col) = make_float4(y[o], y[o + 1], y[o + 2], y[o + 3]);
      s += y[o] + y[o + 1] + y[o + 2] + y[o + 3];
    }
  if (l == 0) {
    const float* mod1 = (const float*)(p.ws + OFF_MOD) + ((size_t)3 + modrow(tok)) * 6144;
    mu = wave_sum(s) * (1.f / 1024.f);
    q = 0.f;
#pragma unroll
    for (int i = 0; i < 16; ++i) { float d = y[i] - mu; q += d * d; }
    rs = rsqrtf(wave_sum(q) * (1.f / 1024.f) + 1e-5f);
    u16* H = (u16*)(p.ws + OFF_H) + (size_t)tok * 1024;
#pragma unroll
    for (int hh = 0; hh < 2; ++hh) {
      int col = hh * 512 + lane * 8;
      float t[8];
#pragma unroll
      for (int c = 0; c < 2; ++c) {
        float4 sh = *(const float4*)(mod1 + col + c * 4), sc = *(const float4*)(mod1 + 1024 + col + c * 4);
        int o = hh * 8 + c * 4;
        t[c * 4] = (y[o] - mu) * rs * (1.f + sc.x) + sh.x; t[c * 4 + 1] = (y[o + 1] - mu) * rs * (1.f + sc.y) + sh.y;
        t[c * 4 + 2] = (y[o + 2] - mu) * rs * (1.f + sc.z) + sh.z; t[c * 4 + 3] = (y[o + 3] - mu) * rs * (1.f + sc.w) + sh.w;
      }
      *(uint4*)(H + col) = pack8(t);
    }
  }
}

constexpr int NPHASES = 22;
DEVI int phase_total(int idx) {
  if (idx == 0) return P0_TOTAL;
  if (idx == 1) return 2048;
  const int l = (idx - 2) / 10, t = (idx - 2) % 10;
  switch (t) {
    case 0: return 4032 + (l == 1 ? P0_NUV : 0);
    case 1: return 512 + 512;
    case 2: return MIX_TOTAL;
    case 3: return 4096;
    case 4: return 512;
    case 5: return 512;
    case 6: return 2048;
    case 7: return 512;
    case 8: return 512;
    default: return 2048;
  }
}
DEVI void phase_item(const Params& p, int idx, int it, unsigned char* sm) {
  if (idx == 0) { if (PH_ON(0)) phase0_item(p, it, sm); return; }
  if (idx == 1) { if (PH_ON(1)) ln1_item(p, it); return; }
  const int l = (idx - 2) / 10, t = (idx - 2) % 10;
  switch (t) {
    case 0: if (PH_ON(2)) { if (it < 4032) g1_item(p, l, it, sm); else convert_uv_item(p, 1, it - 4032); } break;
    case 1: if (it < 512) { if (PH_ON(3)) rwprep_item(p, l, it); } else { if (PH_ON(4)) ret1_item(p, l, it - 512, sm); } break;
    case 2: mix_item(p, l, it, sm); break;
    case 3: if (PH_ON(5)) fin_item(p, l, it); break;
    case 4: if (PH_ON(6)) g2_item(p, l, it, sm); break;
    case 5: if (PH_ON(7)) g3_item(p, l, it, sm); break;
    case 6: if (PH_ON(8)) ln2_item(p, l, it); break;
    case 7: if (PH_ON(9)) g4_item(p, l, it, sm); break;
    case 8: if (PH_ON(10)) route_item(p, l, it, sm); break;
    default: if (PH_ON(11)) expert_item(p, l, it); break;
  }
}

__global__ void __launch_bounds__(256, 2) mega_kernel(KArgs ka, int ph_lo, int ph_hi) {
  __shared__ __attribute__((aligned(16))) unsigned char sm[56320];
  __shared__ int s_item;
  __shared__ const float* s_in[36];
  cg::grid_group grid = cg::this_grid();
  if (threadIdx.x < 36) {
    const float* const* kp = (const float* const*)__builtin_amdgcn_kernarg_segment_ptr();
    s_in[threadIdx.x] = kp[threadIdx.x];
  }
  __syncthreads();
  Params p;
  p.in = s_in; p.out = ka.out; p.ws = ka.ws;
  int* ctr = (int*)(p.ws + OFF_CTR);
  for (int idx = ph_lo; idx < ph_hi; ++idx) {
    const int total = phase_total(idx);
#ifdef PROBE_T
    const int ptype = idx < 2 ? idx : 2 + (idx - 2) % 10;
    const int reps = (ptype == PROBE_T) ? 2 : 1;
#else
    const int reps = 1;
#endif
    for (int rep = 0; rep < reps; ++rep) {
      while (true) {
        __syncthreads();
        if (TIDX == 0) s_item = atomicAdd(&ctr[idx + 32 * rep], 1);
        __syncthreads();
        const int it = s_item;
        if (it >= total) break;
        Params q = p;
        asm volatile("" : "+s"(q.ws));
        asm volatile("" : "+s"(q.out));
        asm volatile("" : "+s"(q.in));
        phase_item(q, idx, it, sm);
      }
      if (rep + 1 < reps) grid.sync();
    }
    if (idx + 1 < ph_hi) grid.sync();
  }
}

#ifndef MULTI_LAUNCH
#define MULTI_LAUNCH 0
#endif

extern "C" void kernel_launch(void* const* d_in, const int* in_sizes, int n_in, void* d_out, int out_size, void* d_ws,
                              size_t ws_size, hipStream_t stream) {
  static int grid_blocks = 0;
  if (!grid_blocks) {
    int dev = 0, cus = 0, per_cu = 0;
    hipGetDevice(&dev);
    hipDeviceGetAttribute(&cus, hipDeviceAttributeMultiprocessorCount, dev);
    hipOccupancyMaxActiveBlocksPerMultiprocessor(&per_cu, mega_kernel, 256, 0);
    if (per_cu > 2) per_cu = 2;
    if (per_cu < 1) per_cu = 1;
    grid_blocks = cus * per_cu;
  }
  KArgs p{};
  for (int i = 0; i < 36; ++i) p.in[i] = (const float*)d_in[i];
  p.out = (float*)d_out;
  p.ws = (unsigned char*)d_ws;
  if (ws_size < OFF_END) { fprintf(stderr, "workspace too small: %zu < %zu\n", ws_size, (size_t)OFF_END); return; }
  hipMemsetAsync(d_ws, 0, 1024, stream);
#if MULTI_LAUNCH
  for (int ph = 0; ph < NPHASES; ++ph) {
    hipLaunchKernelGGL(mega_kernel, dim3(grid_blocks), dim3(256), 0, stream, p, ph, ph + 1);
  }
#else
  int lo = 0, hi = NPHASES;
  void* args[] = {&p, &lo, &hi};
  hipError_t e = hipLaunchCooperativeKernel((void*)mega_kernel, dim3(grid_blocks), dim3(256), args, 0, stream);
  if (e != hipSuccess) fprintf(stderr, "cooperative launch failed: %s (grid %d)\n", hipGetErrorString(e), grid_blocks);
#endif
}
```

```cpp
#include <hip/hip_runtime.h>
#include <hip/hip_bf16.h>
#include <hip/hip_cooperative_groups.h>
#include <cstdio>
namespace cg = cooperative_groups;

typedef unsigned short u16;
using bf16x8 = __attribute__((ext_vector_type(8))) short;
using f32x4 = __attribute__((ext_vector_type(4))) float;
#define DEVI __device__ __forceinline__
__device__ __forceinline__ int ltid_() { int t = threadIdx.x; asm volatile("" : "+v"(t)); return t; }
#define TIDX ltid_()

constexpr int NTOK = 8192;
constexpr int PIN = 8064;
constexpr float ALPHA = 1.4142135623730951f;
constexpr size_t OUT_Y = 0;
constexpr size_t OUT_NAK = 8388608;
constexpr size_t OUT_NAV = 12582912;
constexpr size_t OUT_SRET = 16777216;
constexpr size_t OUT_SRW = 18874368;
constexpr size_t OFF_CTR = 0;
constexpr size_t OFF_TAB = 4096;
constexpr size_t OFF_MOD = 16384;
constexpr size_t OFF_WINT = 1048576;
constexpr size_t OFF_WBRT = OFF_WINT + 33030144;
constexpr size_t OFF_WOUTT = OFF_WBRT + 6291456;
constexpr size_t OFF_WQT = OFF_WOUTT + 4194304;
constexpr size_t OFF_WUPT = OFF_WQT + 4194304;
constexpr size_t OFF_AUPT = OFF_WUPT + 262144;
constexpr size_t OFF_GUPT = OFF_AUPT + 262144;
constexpr size_t OFF_UB = OFF_GUPT + 262144;
constexpr size_t OFF_VB = OFF_UB + 33554432;
constexpr size_t OFF_Z = OFF_VB + 33554432;
constexpr size_t OFF_X = OFF_Z + 132120576;
constexpr size_t OFF_H = OFF_X + 33554432;
constexpr size_t OFF_ONA = OFF_H + 16777216;
constexpr size_t OFF_ORT = OFF_ONA + 8388608;
constexpr size_t OFF_ORW = OFF_ORT + 8388608;
constexpr size_t OFF_GA = OFF_ORW + 8388608;
constexpr size_t SZB = 8388608;
constexpr size_t OFF_RWW = OFF_GA;
constexpr size_t OFF_RWR = OFF_RWW + 4 * SZB;
constexpr size_t OFF_RWV = OFF_RWR + SZB;
constexpr size_t OFF_RWKK = OFF_RWV + SZB;
constexpr size_t OFF_RWKC = OFF_RWKK + SZB;
constexpr size_t OFF_RWKD = OFF_RWKC + SZB;
constexpr size_t OFF_RWKKA = OFF_RWKD + 2 * SZB;
constexpr size_t OFF_RWG = OFF_RWKKA + 2 * SZB;
constexpr size_t OFF_RWBON = OFF_RWG + SZB;
constexpr size_t OFF_OF = OFF_RWBON + SZB;
constexpr size_t OFF_KV = OFF_OF + 4 * SZB;
constexpr size_t OFF_BAR = OFF_KV + 33554432;
constexpr size_t OFF_END = OFF_BAR + 16384;
constexpr size_t OFF_Y = OFF_GA;
constexpr size_t OFF_X1 = OFF_GA + 33554432;
constexpr size_t OFF_Q = OFF_GA + 2 * 33554432;
constexpr size_t OFF_H2 = OFF_GA + 3 * 33554432;
constexpr size_t OFF_EIDX = OFF_H2 + 16777216;
constexpr size_t OFF_GATE = OFF_EIDX + 4194304;

struct KArgs {
  const float* in[36];
  float* out;
  unsigned char* ws;
};
struct Params {
  const float* const* in;
  float* out;
  unsigned char* ws;
};
DEVI const float* uniform_ptr(const float* q) {
  unsigned long long v = (unsigned long long)q;
  unsigned lo = __builtin_amdgcn_readfirstlane((unsigned)v), hi = __builtin_amdgcn_readfirstlane((unsigned)(v >> 32));
  return (const float*)(((unsigned long long)hi << 32) | lo);
}

DEVI float bf2f(u16 h) { return __uint_as_float(((unsigned)h) << 16); }
DEVI unsigned cvtpk(float lo, float hi) {
  unsigned r;
  asm volatile("v_cvt_pk_bf16_f32 %0, %1, %2" : "=v"(r) : "v"(lo), "v"(hi));
  return r;
}
DEVI u16 f2bf(float f) { return (u16)(cvtpk(f, f) & 0xffffu); }
DEVI float sigmoidf_(float x) { return 1.f / (1.f + __expf(-x)); }
template <int CTRL> DEVI float dpp(float x) {
  return __builtin_bit_cast(float, __builtin_amdgcn_update_dpp(0, __builtin_bit_cast(int, x), CTRL, 0xf, 0xf, true));
}
DEVI float quad_sum(float x) { x += dpp<0xB1>(x); x += dpp<0x4E>(x); return x; }
DEVI float row16_sum(float x) { x = quad_sum(x); x += dpp<0x141>(x); x += dpp<0x140>(x); return x; }
DEVI float wave_sum(float x) { x = row16_sum(x); x += __shfl_xor(x, 16); x += __shfl_xor(x, 32); return x; }
DEVI void unpack8(uint4 v, float* f) {
  f[0] = __uint_as_float(v.x << 16); f[1] = __uint_as_float(v.x & 0xffff0000u);
  f[2] = __uint_as_float(v.y << 16); f[3] = __uint_as_float(v.y & 0xffff0000u);
  f[4] = __uint_as_float(v.z << 16); f[5] = __uint_as_float(v.z & 0xffff0000u);
  f[6] = __uint_as_float(v.w << 16); f[7] = __uint_as_float(v.w & 0xffff0000u);
}
DEVI void unpack4(uint2 v, float* f) {
  f[0] = __uint_as_float(v.x << 16); f[1] = __uint_as_float(v.x & 0xffff0000u);
  f[2] = __uint_as_float(v.y << 16); f[3] = __uint_as_float(v.y & 0xffff0000u);
}
DEVI uint4 pack8(const float* f) {
  uint4 r; r.x = cvtpk(f[0], f[1]); r.y = cvtpk(f[2], f[3]); r.z = cvtpk(f[4], f[5]); r.w = cvtpk(f[6], f[7]); return r;
}
DEVI f32x4 mfma16(bf16x8 a, bf16x8 b, f32x4 c) { return __builtin_amdgcn_mfma_f32_16x16x32_bf16(a, b, c, 0, 0, 0); }
DEVI int modrow(int tok) { return tok < 4096 ? 0 : 1 + ((tok - 4096) >> 11); }
DEVI const float* xin_row(const Params& p, int tok) {
  return tok < 4096 ? p.in[0] + (size_t)tok * 1024 : p.in[1] + (size_t)(tok - 4096) * 1024;
}
DEVI int clampi(int v, int lo, int hi) { return v < lo ? lo : (v > hi ? hi : v); }

template <int NT> DEVI void wave_mma(const u16* A, int lda, const u16* B, int ldb, int K, f32x4* acc) {
  const int lane = TIDX & 63, fr = lane & 15, fq = lane >> 4;
  for (int k0 = 0; k0 < K; k0 += 32) {
    bf16x8 a = *(const bf16x8*)(A + fr * lda + k0 + fq * 8);
#pragma unroll
    for (int n = 0; n < NT; ++n) {
      bf16x8 b = *(const bf16x8*)(B + (n * 16 + fr) * ldb + k0 + fq * 8);
      acc[n] = mfma16(a, b, acc[n]);
    }
  }
}

#define LDS_RD(dst, addr, off) asm volatile("ds_read_b128 %0, %1 offset:" #off : "=v"(dst) : "v"(addr))
DEVI void gemm_acc(const u16* __restrict__ A, int lda, const u16* __restrict__ Bt, int ldb, int K, int m0, int n0,
                   unsigned char* sm, f32x4 (&acc)[4][4]) {
  const int tid = TIDX, lane = tid & 63, wid = tid >> 6, wr = wid >> 1, wc = wid & 1, fr = lane & 15, fq = lane >> 4;
  const int nk = K >> 5;
  const int b0 = tid * 16, r0 = b0 >> 6, c0 = (b0 & 63) >> 1;
  const u16* Ap = A + (size_t)(m0 + r0) * lda + c0;
  const u16* Bp = Bt + (size_t)(n0 + r0) * ldb + c0;
  const unsigned lbase = (unsigned)(size_t)(__attribute__((address_space(3))) unsigned char*)sm;
  const unsigned aoff = lbase + (wr * 64 + fr) * 64 + fq * 16;
  const unsigned boff = lbase + 8192 + (wc * 64 + fr) * 64 + fq * 16;
  auto issue = [&](int kt, int st) {
    unsigned char* SA = sm + st * 16384;
    unsigned char* SB = SA + 8192;
    __builtin_amdgcn_global_load_lds((const unsigned*)(Ap + kt * 32), (__attribute__((address_space(3))) unsigned*)(SA + b0), 16, 0, 0);
    __builtin_amdgcn_global_load_lds((const unsigned*)(Ap + (size_t)64 * lda + kt * 32), (__attribute__((address_space(3))) unsigned*)(SA + b0 + 4096), 16, 0, 0);
    __builtin_amdgcn_global_load_lds((const unsigned*)(Bp + kt * 32), (__attribute__((address_space(3))) unsigned*)(SB + b0), 16, 0, 0);
    __builtin_amdgcn_global_load_lds((const unsigned*)(Bp + (size_t)64 * ldb + kt * 32), (__attribute__((address_space(3))) unsigned*)(SB + b0 + 4096), 16, 0, 0);
  };
  issue(0, 0);
  if (nk > 1) issue(1, 1);
  int st = 0;
  for (int kt = 0; kt < nk; ++kt) {
    if (kt + 1 < nk) asm volatile("s_waitcnt vmcnt(4)\n\ts_barrier" ::: "memory");
    else asm volatile("s_waitcnt vmcnt(0)\n\ts_barrier" ::: "memory");
    if (kt + 2 < nk) { int s2 = st + 2; if (s2 >= 3) s2 -= 3; issue(kt + 2, s2); }
    const unsigned aa = aoff + st * 16384, bb = boff + st * 16384;
    bf16x8 a0, a1, a2, a3, b0_, b1_, b2_, b3_;
    LDS_RD(a0, aa, 0); LDS_RD(b0_, bb, 0); LDS_RD(b1_, bb, 1024); LDS_RD(b2_, bb, 2048); LDS_RD(b3_, bb, 3072);
    LDS_RD(a1, aa, 1024); LDS_RD(a2, aa, 2048); LDS_RD(a3, aa, 3072);
    asm volatile("s_waitcnt lgkmcnt(0)" : "+v"(a0), "+v"(a1), "+v"(a2), "+v"(a3), "+v"(b0_), "+v"(b1_), "+v"(b2_), "+v"(b3_));
    acc[0][0] = mfma16(a0, b0_, acc[0][0]); acc[0][1] = mfma16(a0, b1_, acc[0][1]);
    acc[0][2] = mfma16(a0, b2_, acc[0][2]); acc[0][3] = mfma16(a0, b3_, acc[0][3]);
    acc[1][0] = mfma16(a1, b0_, acc[1][0]); acc[1][1] = mfma16(a1, b1_, acc[1][1]);
    acc[1][2] = mfma16(a1, b2_, acc[1][2]); acc[1][3] = mfma16(a1, b3_, acc[1][3]);
    acc[2][0] = mfma16(a2, b0_, acc[2][0]); acc[2][1] = mfma16(a2, b1_, acc[2][1]);
    acc[2][2] = mfma16(a2, b2_, acc[2][2]); acc[2][3] = mfma16(a2, b3_, acc[2][3]);
    acc[3][0] = mfma16(a3, b0_, acc[3][0]); acc[3][1] = mfma16(a3, b1_, acc[3][1]);
    acc[3][2] = mfma16(a3, b2_, acc[3][2]); acc[3][3] = mfma16(a3, b3_, acc[3][3]);
    st = (st == 2) ? 0 : st + 1;
  }
  __syncthreads();
}
#define EPI_LOOP                                                                                         \
  const int _lane = TIDX & 63, _wid = TIDX >> 6, _wr = _wid >> 1, _wc = _wid & 1, _fr = _lane & 15, \
            _fq = _lane >> 4;                                                                            \
  _Pragma("unroll") for (int m = 0; m < 4; ++m) _Pragma("unroll") for (int n = 0; n < 4; ++n)            \
      _Pragma("unroll") for (int j = 0; j < 4; ++j)
#define EPI_ROW (m0 + _wr * 64 + m * 16 + _fq * 4 + j)
#define EPI_COL (n0 + _wc * 64 + n * 16 + _fr)

DEVI void zero_acc(f32x4 (&acc)[4][4]) {
#pragma unroll
  for (int m = 0; m < 4; ++m)
#pragma unroll
    for (int n = 0; n < 4; ++n) acc[m][n] = f32x4{0.f, 0.f, 0.f, 0.f};
}

__constant__ double ROPE_FREQ[16] = {1.0, 0.5623413251903491, 0.31622776601683794, 0.1778279410038923, 0.1,
                                     0.05623413251903491, 0.03162277660168379, 0.01778279410038923, 0.01,
                                     0.005623413251903491, 0.0031622776601683794, 0.0017782794100389228, 0.001,
                                     0.0005623413251903491, 0.00031622776601683794, 0.00017782794100389227};

DEVI void transpose_tile(const float* __restrict__ src, int K, int N, u16* __restrict__ dst, int kt, int nt, unsigned char* sm) {
  float* tile = (float*)sm;
  const int tid = TIDX;
  const int k0 = kt * 64, n0 = nt * 64;
#pragma unroll
  for (int i = 0; i < 16; ++i) {
    int kk = i * 4 + (tid >> 6), nn = tid & 63;
    tile[kk * 65 + nn] = src[(size_t)(k0 + kk) * N + n0 + nn];
  }
  __syncthreads();
#pragma unroll
  for (int i = 0; i < 16; ++i) {
    int nn = i * 4 + (tid >> 6), kk = tid & 63;
    dst[(size_t)(n0 + nn) * K + k0 + kk] = f2bf(tile[kk * 65 + nn]);
  }
}

DEVI void convert_uv_item(const Params& p, int l, int it) {
  const int which = it >> 12, chunk = it & 4095;
  const float* src = p.in[34 + which] + (size_t)l * 16777216 + (size_t)chunk * 4096;
  u16* dst = (u16*)(p.ws + (which ? OFF_VB : OFF_UB)) + (size_t)chunk * 4096;
#pragma unroll
  for (int i = 0; i < 4; ++i) {
    int e = i * 1024 + TIDX * 4;
    float4 v = *(const float4*)(src + e);
    uint2 o; o.x = cvtpk(v.x, v.y); o.y = cvtpk(v.z, v.w);
    *(uint2*)(dst + e) = o;
  }
}

constexpr int P0_NT = 5920;
constexpr int P0_NUV = 8192;
constexpr int P0_NMOD = 192;
constexpr int P0_TOTAL = P0_NMOD + P0_NT + P0_NUV + 1;

DEVI void phase0_item(const Params& p, int it, unsigned char* sm) {
  const int tid = TIDX;
  if (it < P0_NMOD) {
    const int l = it / 96, n0 = (it % 96) * 64;
    const int kg = tid >> 4, c4 = (tid & 15) * 4;
    float acc[3][4];
#pragma unroll
    for (int r = 0; r < 3; ++r)
#pragma unroll
      for (int i = 0; i < 4; ++i) acc[r][i] = 0.f;
    const float* wm = p.in[8] + (size_t)l * 1024 * 6144;
    for (int k = kg * 64; k < kg * 64 + 64; ++k) {
      float4 w = *(const float4*)(wm + (size_t)k * 6144 + n0 + c4);
      float c0 = p.in[7][k], c1 = p.in[6][k], c2 = p.in[6][1024 + k];
      float s0 = c0 * sigmoidf_(c0), s1 = c1 * sigmoidf_(c1), s2 = c2 * sigmoidf_(c2);
      acc[0][0] += s0 * w.x; acc[0][1] += s0 * w.y; acc[0][2] += s0 * w.z; acc[0][3] += s0 * w.w;
      acc[1][0] += s1 * w.x; acc[1][1] += s1 * w.y; acc[1][2] += s1 * w.z; acc[1][3] += s1 * w.w;
      acc[2][0] += s2 * w.x; acc[2][1] += s2 * w.y; acc[2][2] += s2 * w.z; acc[2][3] += s2 * w.w;
    }
    float* red = (float*)sm;
#pragma unroll
    for (int r = 0; r < 3; ++r)
#pragma unroll
      for (int i = 0; i < 4; ++i) red[(kg * 3 + r) * 64 + c4 + i] = acc[r][i];
    __syncthreads();
    if (tid < 192) {
      int r = tid >> 6, col = tid & 63;
      float s = p.in[9][(size_t)l * 6144 + n0 + col];
      for (int g = 0; g < 16; ++g) s += red[(g * 3 + r) * 64 + col];
      ((float*)(p.ws + OFF_MOD))[((size_t)l * 3 + r) * 6144 + n0 + col] = s;
    }
    return;
  }
  it -= P0_NMOD;
  if (it < P0_NT) {
    int t = it;
    const float* src; u16* dst; int K, N, kt, nt;
    if (t < 4032) { int l = t / 2016, r = t % 2016; kt = r / 126; nt = r % 126; K = 1024; N = 8064;
      src = p.in[10] + (size_t)l * 1024 * 8064; dst = (u16*)(p.ws + OFF_WINT) + (size_t)l * 8064 * 1024; }
    else if ((t -= 4032) < 768) { int j = t / 128, r = t % 128; kt = r / 16; nt = r % 16; K = 512; N = 1024;
      src = p.in[26] + (size_t)j * 512 * 1024; dst = (u16*)(p.ws + OFF_WBRT) + (size_t)j * 1024 * 512; }
    else if ((t -= 768) < 512) { int l = t / 256, r = t % 256; kt = r / 16; nt = r % 16; K = 1024; N = 1024;
      src = p.in[27] + (size_t)l * 1048576; dst = (u16*)(p.ws + OFF_WOUTT) + (size_t)l * 1048576; }
    else if ((t -= 512) < 512) { int l = t / 256, r = t % 256; kt = r / 16; nt = r % 16; K = 1024; N = 1024;
      src = p.in[32] + (size_t)l * 1048576; dst = (u16*)(p.ws + OFF_WQT) + (size_t)l * 1048576; }
    else if ((t -= 512) < 32) { int j = t / 8; kt = 0; nt = t % 8; K = 64; N = 512;
      src = p.in[17] + (size_t)j * 32768; dst = (u16*)(p.ws + OFF_WUPT) + (size_t)j * 32768; }
    else if ((t -= 32) < 32) { int j = t / 8; kt = 0; nt = t % 8; K = 64; N = 512;
      src = p.in[19] + (size_t)j * 32768; dst = (u16*)(p.ws + OFF_AUPT) + (size_t)j * 32768; }
    else { t -= 32; int l = t / 16, r = t % 16; kt = r / 8; nt = r % 8; K = 128; N = 512;
      src = p.in[20] + (size_t)l * 65536; dst = (u16*)(p.ws + OFF_GUPT) + (size_t)l * 65536; }
    transpose_tile(src, K, N, dst, kt, nt, sm);
    return;
  }
  it -= P0_NT;
  if (it < P0_NUV) { convert_uv_item(p, 0, it); return; }
  float* tab = (float*)(p.ws + OFF_TAB);
  for (int e = tid; e < 1024; e += 256) {
    int pos = e >> 4, f = e & 15;
    double rev = (double)pos * ROPE_FREQ[f] * 0.15915494309189535;
    rev -= floor(rev);
    float rf = (float)rev;
    tab[e] = __builtin_amdgcn_cosf(rf);
    tab[1024 + e] = __builtin_amdgcn_sinf(rf);
  }
}

DEVI void ln1_item(const Params& p, int it) {
  const int lane = TIDX & 63, w = TIDX >> 6;
  const int tok = it * 4 + w;
  const float* x = xin_row(p, tok);
  const float* mod = (const float*)(p.ws + OFF_MOD) + (size_t)modrow(tok) * 6144;
  float4 v[4];
  float s = 0.f;
#pragma unroll
  for (int i = 0; i < 4; ++i) { v[i] = *(const float4*)(x + lane * 4 + 256 * i); s += v[i].x + v[i].y + v[i].z + v[i].w; }
  float mu = wave_sum(s) * (1.f / 1024.f);
  float q = 0.f;
#pragma unroll
  for (int i = 0; i < 4; ++i) { float a = v[i].x - mu, b = v[i].y - mu, c = v[i].z - mu, d = v[i].w - mu; q += a * a + b * b + c * c + d * d; }
  float rs = rsqrtf(wave_sum(q) * (1.f / 1024.f) + 1e-5f);
  u16* H = (u16*)(p.ws + OFF_H) + (size_t)tok * 1024;
#pragma unroll
  for (int i = 0; i < 4; ++i) {
    int c = lane * 4 + 256 * i;
    float4 sh = *(const float4*)(mod + c), sc = *(const float4*)(mod + 1024 + c);
    uint2 o;
    o.x = cvtpk((v[i].x - mu) * rs * (1.f + sc.x) + sh.x, (v[i].y - mu) * rs * (1.f + sc.y) + sh.y);
    o.y = cvtpk((v[i].z - mu) * rs * (1.f + sc.z) + sh.z, (v[i].w - mu) * rs * (1.f + sc.w) + sh.w);
    *(uint2*)(H + c) = o;
  }
}

DEVI void g1_item(const Params& p, int l, int it, unsigned char* sm) {
  const int nt = it >> 6, mt = it & 63;
  const int m0 = mt * 128, n0 = nt * 128;
  f32x4 acc[4][4];
  zero_acc(acc);
  gemm_acc((const u16*)(p.ws + OFF_H), 1024, (const u16*)(p.ws + OFF_WINT) + (size_t)l * 8064 * 1024, 1024, 1024, m0, n0, sm, acc);
  u16* Z = (u16*)(p.ws + OFF_Z);
  EPI_LOOP {
    int row = EPI_ROW, col = EPI_COL;
    float v = acc[m][n][j];
    Z[(size_t)row * PIN + col] = f2bf(v);
    if (row < 4096 && col >= 512 && col < 1536) {
      int which = (col - 512) >> 9, cc = (col - 512) & 511, h = cc >> 6, d = cc & 63, b = row >> 8, s = row & 255;
      p.out[OUT_NAK + (size_t)which * 4194304 + ((((size_t)(b * 2 + l) * 8 + h) * 256 + s) * 64 + d)] = v;
    }
  }
}
DEVI void g2_item(const Params& p, int l, int it, unsigned char* sm) {
  const int nt = it >> 6, mt = it & 63;
  const int m0 = mt * 128, n0 = nt * 128;
  f32x4 tot[4][4];
  zero_acc(tot);
  const u16* Z = (const u16*)(p.ws + OFF_Z);
  for (int i = 0; i < 3; ++i) {
    f32x4 acc[4][4];
    zero_acc(acc);
    const u16* A = (const u16*)(p.ws + (i == 0 ? OFF_ONA : (i == 1 ? OFF_ORT : OFF_ORW)));
    gemm_acc(A, 512, (const u16*)(p.ws + OFF_WBRT) + (size_t)(l * 3 + i) * 1024 * 512, 512, 512, m0, n0, sm, acc);
    EPI_LOOP {
      int row = EPI_ROW, col = EPI_COL;
      float g = bf2f(Z[(size_t)row * PIN + 4992 + i * 1024 + col]);
      tot[m][n][j] += sigmoidf_(g) * acc[m][n][j];
    }
  }
  u16* MG = (u16*)(p.ws + OFF_H);
  EPI_LOOP { MG[(size_t)EPI_ROW * 1024 + EPI_COL] = f2bf(tot[m][n][j]); }
}
DEVI void g3_item(const Params& p, int l, int it, unsigned char* sm) {
  const int nt = it >> 6, mt = it & 63;
  const int m0 = mt * 128, n0 = nt * 128;
  f32x4 acc[4][4];
  zero_acc(acc);
  gemm_acc((const u16*)(p.ws + OFF_H), 1024, (const u16*)(p.ws + OFF_WOUTT) + (size_t)l * 1048576, 1024, 1024, m0, n0, sm, acc);
  float* Y = (float*)(p.ws + OFF_Y);
  const float* mod = (const float*)(p.ws + OFF_MOD) + (size_t)l * 3 * 6144;
  const float* X = (const float*)(p.ws + OFF_X);
  EPI_LOOP {
    int row = EPI_ROW, col = EPI_COL;
    float xr = (l == 0) ? xin_row(p, row)[col] : X[(size_t)row * 1024 + col];
    float gt = mod[(size_t)modrow(row) * 6144 + 2048 + col];
    Y[(size_t)row * 1024 + col] = ALPHA * xr + gt * acc[m][n][j];
  }
}
DEVI void g4_item(const Params& p, int l, int it, unsigned char* sm) {
  const int nt = it >> 6, mt = it & 63;
  const int m0 = mt * 128, n0 = nt * 128;
  f32x4 acc[4][4];
  zero_acc(acc);
  gemm_acc((const u16*)(p.ws + OFF_H2), 1024, (const u16*)(p.ws + OFF_WQT) + (size_t)l * 1048576, 1024, 1024, m0, n0, sm, acc);
  float* Q = (float*)(p.ws + OFF_Q);
  EPI_LOOP { Q[(size_t)EPI_ROW * 1024 + EPI_COL] = acc[m][n][j]; }
}

DEVI void load_qk16(const u16* zp  , int part, bool lat, int prow, int pcol, const float* tab,
                    float scale, float* out) {
  if (!lat) {
    float t[16];
    unpack8(*(const uint4*)(zp + part * 16), t);
    unpack8(*(const uint4*)(zp + part * 16 + 8), t + 8);
#pragma unroll
    for (int i = 0; i < 16; ++i) out[i] = t[i] * scale;
    return;
  }
  const int half = part >> 1, isp2 = part & 1;
  float p1[16], p2[16];
  unpack8(*(const uint4*)(zp + half * 32), p1);
  unpack8(*(const uint4*)(zp + half * 32 + 8), p1 + 8);
  unpack8(*(const uint4*)(zp + half * 32 + 16), p2);
  unpack8(*(const uint4*)(zp + half * 32 + 24), p2 + 8);
  const int pos = half ? pcol : prow;
  const float* ct = tab + pos * 16;
  const float* st = tab + 1024 + pos * 16;
#pragma unroll
  for (int f = 0; f < 16; ++f) {
    float c = ct[f], s = st[f];
    out[f] = (isp2 ? (p1[f] * s + p2[f] * c) : (p1[f] * c - p2[f] * s)) * scale;
  }
}
struct RetItem { int lat, b, h, n, N, seqbase, kvbase; };
DEVI RetItem ret_decode(int it) {
  RetItem r;
  if (it < 256) { r.lat = 1; r.b = it >> 7; r.h = (it >> 5) & 3; r.n = it & 31; r.N = 32; r.seqbase = 4096 + r.b * 2048; r.kvbase = 256 + (r.b * 4 + r.h) * 32; }
  else { int j = it - 256; r.lat = 0; r.b = j >> 4; r.h = (j >> 2) & 3; r.n = j & 3; r.N = 4; r.seqbase = r.b * 256; r.kvbase = (r.b * 4 + r.h) * 4; }
  return r;
}
DEVI void ret_gammas(const Params& p, int l, int h, float& lgf, float& lgb) {
  float xf = p.in[12][(l * 2 + 0) * 4 + h], xb = p.in[12][(l * 2 + 1) * 4 + h];
  lgf = -log2f(1.f + expf(-xf));
  lgb = -log2f(1.f + expf(-xb));
}

DEVI void ret1_item(const Params& p, int l, int it, unsigned char* sm) {
  const RetItem r = ret_decode(it);
  const int tid = TIDX, lane = tid & 63, w = tid >> 6, fr = lane & 15, fq = lane >> 4;
  u16* KTf = (u16*)sm;
  u16* KTb = (u16*)(sm + 9216);
  u16* VT = (u16*)(sm + 18432);
  const u16* Z = (const u16*)(p.ws + OFF_Z);
  const float* tab = (const float*)(p.ws + OFF_TAB);
  float lgf, lgb;
  ret_gammas(p, l, r.h, lgf, lgb);
  const int tok0 = r.seqbase + r.n * 64;
  {
    const int j = tid >> 2, part = tid & 3;
    float kv[16];
    load_qk16(Z + (size_t)(tok0 + j) * PIN + 1792 + r.h * 64, part, r.lat, r.n, j, tab, 0.125f, kv);
    const float df = exp2f(lgf * (float)(63 - j)), db = exp2f(lgb * (float)j);
#pragma unroll
    for (int i = 0; i < 16; ++i) {
      KTf[(part * 16 + i) * 72 + j] = f2bf(kv[i] * df);
      KTb[(part * 16 + i) * 72 + j] = f2bf(kv[i] * db);
    }
    const int jj = tid & 63, vp = (tid >> 6) * 32;
    const u16* vz = Z + (size_t)(tok0 + jj) * PIN + 2048 + r.h * 128 + vp;
#pragma unroll
    for (int c = 0; c < 4; ++c) {
      uint4 raw = *(const uint4*)(vz + c * 8);
      const u16* rv = (const u16*)&raw;
#pragma unroll
      for (int i = 0; i < 8; ++i) VT[(vp + c * 8 + i) * 72 + jj] = rv[i];
    }
  }
  __syncthreads();
  float* KV = (float*)(p.ws + OFF_KV) + (size_t)(r.kvbase + r.n) * 2 * 8192;
#pragma unroll
  for (int dir = 0; dir < 2; ++dir) {
    f32x4 acc[8];
#pragma unroll
    for (int n = 0; n < 8; ++n) acc[n] = f32x4{0.f, 0.f, 0.f, 0.f};
    wave_mma<8>((dir ? KTb : KTf) + w * 16 * 72, 72, VT, 72, 64, acc);
#pragma unroll
    for (int n = 0; n < 8; ++n)
#pragma unroll
      for (int j = 0; j < 4; ++j) KV[(size_t)dir * 8192 + (w * 16 + fq * 4 + j) * 128 + n * 16 + fr] = acc[n][j];
  }
}

DEVI void ret3_item(const Params& p, int l, int it, unsigned char* sm) {
  const RetItem r = ret_decode(it);
  const int tid = TIDX, lane = tid & 63, w = tid >> 6, fr = lane & 15, fq = lane >> 4;
  u16* Qs = (u16*)sm;
  u16* Ks = (u16*)(sm + 9216);
  u16* VT = (u16*)(sm + 18432);
  u16* ST = (u16*)(sm + 36864);
  const u16* Z = (const u16*)(p.ws + OFF_Z);
  const float* tab = (const float*)(p.ws + OFF_TAB);
  float lgf, lgb;
  ret_gammas(p, l, r.h, lgf, lgb);
  const int tok0 = r.seqbase + r.n * 64;
  {
    const int i = tid >> 2, part = tid & 3;
    float t[16];
    load_qk16(Z + (size_t)(tok0 + i) * PIN + 1536 + r.h * 64, part, r.lat, r.n, i, tab, 1.f, t);
    *(uint4*)(Qs + i * 72 + part * 16) = pack8(t);
    *(uint4*)(Qs + i * 72 + part * 16 + 8) = pack8(t + 8);
    load_qk16(Z + (size_t)(tok0 + i) * PIN + 1792 + r.h * 64, part, r.lat, r.n, i, tab, 0.125f, t);
    *(uint4*)(Ks + i * 72 + part * 16) = pack8(t);
    *(uint4*)(Ks + i * 72 + part * 16 + 8) = pack8(t + 8);
    const int jj = tid & 63, vp = (tid >> 6) * 32;
    const u16* vz = Z + (size_t)(tok0 + jj) * PIN + 2048 + r.h * 128 + vp;
#pragma unroll
    for (int c = 0; c < 4; ++c) {
      uint4 raw = *(const uint4*)(vz + c * 8);
      const u16* rv = (const u16*)&raw;
#pragma unroll
      for (int e = 0; e < 8; ++e) VT[(vp + c * 8 + e) * 72 + jj] = rv[e];
    }
  }
  __syncthreads();
  f32x4 at[4];
#pragma unroll
  for (int n = 0; n < 4; ++n) at[n] = f32x4{0.f, 0.f, 0.f, 0.f};
  wave_mma<4>(Qs + w * 16 * 72, 72, Ks, 72, 64, at);
  __syncthreads();
#pragma unroll
  for (int n = 0; n < 4; ++n)
#pragma unroll
    for (int j = 0; j < 4; ++j) {
      int i = w * 16 + fq * 4 + j, jc = n * 16 + fr;
      float mval = (i > jc) ? exp2f(lgf * (float)(i - jc)) : ((i < jc) ? exp2f(lgb * (float)(jc - i)) : 2.f);
      Ks[i * 72 + jc] = f2bf(at[n][j] * mval);
    }
  __syncthreads();
  f32x4 o[8];
#pragma unroll
  for (int n = 0; n < 8; ++n) o[n] = f32x4{0.f, 0.f, 0.f, 0.f};
  wave_mma<8>(Ks + w * 16 * 72, 72, VT, 72, 64, o);
  const float* KVb_ = (const float*)(p.ws + OFF_KV);
  for (int dir = 0; dir < 2; ++dir) {
    const float lg = dir ? lgb : lgf;
    const float cdec = exp2f(lg * 64.f);
    const int nprev = dir ? (r.N - 1 - r.n) : r.n;
    __syncthreads();
    {
      float S[32];
#pragma unroll
      for (int e8 = 0; e8 < 32; ++e8) {
        int e = e8 * 256 + tid;
        S[e8] = r.lat ? p.in[4][((((size_t)(r.b * 2 + l) * 2 + dir) * 4 + r.h) * 64) * 128 + e] : 0.f;
      }
      for (int m = 0; m < nprev; ++m) {
        const int ch = dir ? (r.N - 1 - m) : m;
        const float* kvp = KVb_ + ((size_t)(r.kvbase + ch) * 2 + dir) * 8192 + tid;
#pragma unroll
        for (int e8 = 0; e8 < 32; ++e8) S[e8] = S[e8] * cdec + kvp[e8 * 256];
      }
      const bool fin = (!r.lat) && (nprev == r.N - 1);
      const float* kvn = KVb_ + ((size_t)(r.kvbase + r.n) * 2 + dir) * 8192 + tid;
      float* so = p.out + OUT_SRET + ((((size_t)(r.b * 2 + l) * 2 + dir) * 4 + r.h) * 64) * 128 + tid;
#pragma unroll
      for (int e8 = 0; e8 < 32; ++e8) {
        int e = e8 * 256 + tid, d = e >> 7, v = e & 127;
        ST[v * 72 + d] = f2bf(S[e8]);
        if (fin) so[e8 * 256] = S[e8] * cdec + kvn[e8 * 256];
      }
    }
    __syncthreads();
    f32x4 t2[8];
#pragma unroll
    for (int n = 0; n < 8; ++n) t2[n] = f32x4{0.f, 0.f, 0.f, 0.f};
    wave_mma<8>(Qs + w * 16 * 72, 72, ST, 72, 64, t2);
#pragma unroll
    for (int j = 0; j < 4; ++j) {
      int i = w * 16 + fq * 4 + j;
      float dec = dir ? exp2f(lg * (float)(64 - i)) : exp2f(lg * (float)(i + 1));
#pragma unroll
      for (int n = 0; n < 8; ++n) o[n][j] += dec * t2[n][j];
    }
  }
  const float* gw = p.in[13] + l * 512 + r.h * 128;
  const float* gb = p.in[14] + l * 512 + r.h * 128;
  u16* ORT = (u16*)(p.ws + OFF_ORT);
#pragma unroll
  for (int j = 0; j < 4; ++j) {
    float s = 0.f;
#pragma unroll
    for (int n = 0; n < 8; ++n) s += o[n][j];
    float mu = row16_sum(s) * (1.f / 128.f);
    float q = 0.f;
#pragma unroll
    for (int n = 0; n < 8; ++n) { float d = o[n][j] - mu; q += d * d; }
    float rs = rsqrtf(row16_sum(q) * (1.f / 128.f) + 1e-5f);
    const int tok = tok0 + w * 16 + fq * 4 + j;
#pragma unroll
    for (int n = 0; n < 8; ++n) {
      int v = n * 16 + fr;
      float g = bf2f(Z[(size_t)tok * PIN + 2560 + r.h * 128 + v]);
      float y = ((o[n][j] - mu) * rs * gw[v] + gb[v]) * (g * sigmoidf_(g));
      ORT[(size_t)tok * 512 + r.h * 128 + v] = f2bf(y);
    }
  }
}

DEVI void shifted8(const u16* Z, int tok, bool hasp, bool hasn, int col, const float* mu, float* out) {
  float z[8], zp[8], zn[8];
  unpack8(*(const uint4*)(Z + (size_t)tok * PIN + col), z);
  if (hasp) unpack8(*(const uint4*)(Z + (size_t)(tok - 1) * PIN + col), zp);
  else {
#pragma unroll
    for (int i = 0; i < 8; ++i) zp[i] = 0.f;
  }
  if (hasn) unpack8(*(const uint4*)(Z + (size_t)(tok + 1) * PIN + col), zn);
  else {
#pragma unroll
    for (int i = 0; i < 8; ++i) zn[i] = 0.f;
  }
  float4 m0 = *(const float4*)(mu + col - 3072), m1 = *(const float4*)(mu + col - 3072 + 4);
  float mm[8] = {m0.x, m0.y, m0.z, m0.w, m1.x, m1.y, m1.z, m1.w};
#pragma unroll
  for (int i = 0; i < 8; ++i) out[i] = z[i] + mm[i] * (0.5f * (zp[i] + zn[i]) - z[i]);
}
DEVI void tok_neighbors(int tok, bool& hasp, bool& hasn) {
  if (tok < 4096) { int s = tok & 255; hasp = s > 0; hasn = s < 255; }
  else { int s = (tok - 4096) & 2047; hasp = s > 0; hasn = s < 2047; }
}

DEVI void rwprep_item(const Params& p, int l, int it) {
  const int tid = TIDX, lane = tid & 63, w = tid >> 6, fr = lane & 15, fq = lane >> 4;
  const u16* Z = (const u16*)(p.ws + OFF_Z);
  const float* mu = p.in[15] + l * 1920;
  const int tok0 = (it >> 2) * 64, hq = it & 3;
  u16* R = (u16*)(p.ws + OFF_RWR);
  u16* V = (u16*)(p.ws + OFF_RWV);
  u16* KC = (u16*)(p.ws + OFF_RWKC);
  for (int e = tid; e < 64 * 48; e += 256) {
    int ti = e / 48, u = e % 48, arr = u >> 4, c8 = hq * 128 + (u & 15) * 8;
    int tok = tok0 + ti;
    bool hp, hn;
    tok_neighbors(tok, hp, hn);
    float zs[8];
    shifted8(Z, tok, hp, hn, 3072 + arr * 512 + c8, mu, zs);
    u16* dst = (arr == 0) ? R : (arr == 1 ? KC : V);
    *(uint4*)(dst + (size_t)tok * 512 + c8) = pack8(zs);
  }
  __threadfence();
  __syncthreads();
  bf16x8 af[12];
  {
    const int tok = tok0 + w * 16 + fr;
    bool hp, hn;
    tok_neighbors(tok, hp, hn);
#pragma unroll
    for (int f = 0; f < 12; ++f) {
      int col = 4608 + f * 32 + fq * 8;
      float zs[8];
      shifted8(Z, tok, hp, hn, col, mu, zs);
      if (f < 4) {
#pragma unroll
        for (int i = 0; i < 8; ++i) zs[i] = tanhf(zs[i]);
      } else if (f >= 8) {
#pragma unroll
        for (int i = 0; i < 8; ++i) zs[i] = sigmoidf_(zs[i]);
      }
      uint4 pk = pack8(zs);
      af[f] = __builtin_bit_cast(bf16x8, pk);
    }
  }
  const u16* WUP = (const u16*)(p.ws + OFF_WUPT) + (size_t)l * 2 * 32768;
  const u16* AUP = (const u16*)(p.ws + OFF_AUPT) + (size_t)l * 2 * 32768;
  const u16* GUP = (const u16*)(p.ws + OFF_GUPT) + (size_t)l * 65536;
  float* Wd = (float*)(p.ws + OFF_RWW);
  u16* KK = (u16*)(p.ws + OFF_RWKK);
  u16* KD = (u16*)(p.ws + OFF_RWKD);
  u16* KKA = (u16*)(p.ws + OFF_RWKKA);
  u16* G = (u16*)(p.ws + OFF_RWG);
  u16* BON = (u16*)(p.ws + OFF_RWBON);
  const float* kkw = p.in[21] + l * 512;
  const float* kaw = p.in[22] + l * 512;
  const float* rkw = p.in[23] + l * 512;
  const float* w0 = p.in[16] + l * 1024;
  const float* a0 = p.in[18] + l * 1024;
  for (int h = hq * 2; h < hq * 2 + 2; ++h) {
    float inv[4], sbv[4];
#pragma unroll
    for (int j = 0; j < 4; ++j) {
      const int tok = tok0 + w * 16 + fq * 4 + j;
      float ssq = 0.f, sb = 0.f;
#pragma unroll
      for (int n = 0; n < 4; ++n) {
        int c = h * 64 + n * 16 + fr;
        float rr = bf2f(R[(size_t)tok * 512 + c]);
        float kc = bf2f(KC[(size_t)tok * 512 + c]);
        float kk = kc * kkw[c];
        ssq += kk * kk;
        sb += rr * kc * rkw[c];
      }
      ssq = row16_sum(ssq);
      sbv[j] = row16_sum(sb);
      inv[j] = rsqrtf(fmaxf(ssq, 1e-24f));
    }
#pragma unroll 1
    for (int n = 0; n < 4; ++n) {
      f32x4 acc[5];
#pragma unroll
      for (int m = 0; m < 5; ++m) acc[m] = f32x4{0.f, 0.f, 0.f, 0.f};
      const int c = h * 64 + n * 16 + fr;
#pragma unroll
      for (int ks = 0; ks < 2; ++ks) {
        acc[0] = mfma16(af[0 + ks], *(const bf16x8*)(WUP + (size_t)c * 64 + ks * 32 + fq * 8), acc[0]);
        acc[1] = mfma16(af[2 + ks], *(const bf16x8*)(WUP + 32768 + (size_t)c * 64 + ks * 32 + fq * 8), acc[1]);
        acc[2] = mfma16(af[4 + ks], *(const bf16x8*)(AUP + (size_t)c * 64 + ks * 32 + fq * 8), acc[2]);
        acc[3] = mfma16(af[6 + ks], *(const bf16x8*)(AUP + 32768 + (size_t)c * 64 + ks * 32 + fq * 8), acc[3]);
      }
#pragma unroll
      for (int ks = 0; ks < 4; ++ks)
        acc[4] = mfma16(af[8 + ks], *(const bf16x8*)(GUP + (size_t)c * 128 + ks * 32 + fq * 8), acc[4]);
      const float kkc = kkw[c], ka = kaw[c];
      const float w0f = w0[c], w0b = w0[512 + c], a0f = a0[c], a0b = a0[512 + c];
#pragma unroll
      for (int j = 0; j < 4; ++j) {
        const int tok = tok0 + w * 16 + fq * 4 + j;
        const size_t o = (size_t)tok * 512 + c;
        const float kc = bf2f(KC[o]), vv = bf2f(V[o]);
        const float kkn = kc * kkc * inv[j];
        KK[o] = f2bf(kkn);
        G[o] = f2bf(acc[4][j]);
        BON[o] = f2bf(sbv[j] * vv);
#pragma unroll
        for (int d = 0; d < 2; ++d) {
          float wv = __expf(-0.606531f * sigmoidf_((d ? w0b : w0f) + acc[d][j]));
          float a = sigmoidf_((d ? a0b : a0f) + acc[2 + d][j]);
          Wd[(size_t)d * NTOK * 512 + o] = wv;
          KD[(size_t)d * NTOK * 512 + o] = f2bf(kc * (1.f + (a - 1.f) * ka));
          KKA[(size_t)d * NTOK * 512 + o] = f2bf(kkn * a);
        }
      }
    }
  }
}

template <int KPT>
DEVI void scan_run(const Params& p, int l, bool lat, int b, int h, int dir, int rowbase, unsigned char* sm) {
  constexpr int LPR = 64 / KPT;
  const int tid = TIDX;
  const int row = rowbase + tid / LPR, ks = (tid % LPR) * KPT;
  const int T = lat ? 2048 : 256, seq0 = lat ? 4096 + b * 2048 : b * 256;
  float S[KPT];
  if (lat) {
    const float* s0 = p.in[5] + ((((size_t)(b * 2 + l) * 2 + dir) * 8 + h) * 64 + row) * 64 + ks;
#pragma unroll
    for (int i = 0; i < KPT; ++i) S[i] = s0[i];
  } else {
#pragma unroll
    for (int i = 0; i < KPT; ++i) S[i] = 0.f;
  }
  float* buf = (float*)sm;
  const float* Wd = (const float*)(p.ws + OFF_RWW) + (size_t)dir * NTOK * 512;
  const u16* R = (const u16*)(p.ws + OFF_RWR);
  const u16* V = (const u16*)(p.ws + OFF_RWV);
  const u16* KK = (const u16*)(p.ws + OFF_RWKK);
  const u16* KD = (const u16*)(p.ws + OFF_RWKD) + (size_t)dir * NTOK * 512;
  const u16* KKA = (const u16*)(p.ws + OFF_RWKKA) + (size_t)dir * NTOK * 512;
  float* O = (float*)(p.ws + OFF_OF) + (size_t)dir * NTOK * 512;
  const int pst = tid >> 4, c4 = (tid & 15) * 4;
  float4 pw; uint2 pr, pk, pv, pd, pa;
  auto issue = [&](int chunk) {
    int s = chunk * 16 + pst;
    int tok = dir ? (seq0 + T - 1 - s) : (seq0 + s);
    size_t o = (size_t)tok * 512 + h * 64 + c4;
    pw = *(const float4*)(Wd + o);
    pr = *(const uint2*)(R + o); pk = *(const uint2*)(KK + o); pv = *(const uint2*)(V + o);
    pd = *(const uint2*)(KD + o); pa = *(const uint2*)(KKA + o);
  };
  issue(0);
  const int nch = T / 16;
  for (int chunk = 0; chunk < nch; ++chunk) {
    __syncthreads();
    {
      float* bp = buf + pst * 384 + c4;
      float t[4];
      *(float4*)bp = pw;
      unpack4(pr, t); *(float4*)(bp + 64) = make_float4(t[0], t[1], t[2], t[3]);
      unpack4(pk, t); *(float4*)(bp + 128) = make_float4(t[0], t[1], t[2], t[3]);
      unpack4(pv, t); *(float4*)(bp + 192) = make_float4(t[0], t[1], t[2], t[3]);
      unpack4(pd, t); *(float4*)(bp + 256) = make_float4(t[0], t[1], t[2], t[3]);
      unpack4(pa, t); *(float4*)(bp + 320) = make_float4(t[0], t[1], t[2], t[3]);
    }
    __syncthreads();
    if (chunk + 1 < nch) issue(chunk + 1);
    float myo = 0.f;
    const int lir = tid % LPR;
    constexpr int UNR = (KPT == 4) ? 16 : 4;
#pragma unroll 1
    for (int sb = 0; sb < 16; sb += UNR)
#pragma unroll
    for (int si = 0; si < UNR; ++si) {
      const int s = sb + si;
      const float* bp = buf + s * 384;
      float wv[KPT], rv[KPT], kkv[KPT], kdv[KPT], kav[KPT];
#pragma unroll
      for (int i = 0; i < KPT; i += 4) {
        *(float4*)(wv + i) = *(const float4*)(bp + ks + i);
        *(float4*)(rv + i) = *(const float4*)(bp + 64 + ks + i);
        *(float4*)(kkv + i) = *(const float4*)(bp + 128 + ks + i);
        *(float4*)(kdv + i) = *(const float4*)(bp + 256 + ks + i);
        *(float4*)(kav + i) = *(const float4*)(bp + 320 + ks + i);
      }
      const float vr = bp[192 + row];
      float sk = 0.f;
#pragma unroll
      for (int i = 0; i < KPT; ++i) sk += S[i] * kkv[i];
      sk = (LPR == 16) ? row16_sum(sk) : quad_sum(sk);
      float o = 0.f;
#pragma unroll
      for (int i = 0; i < KPT; ++i) {
        S[i] = S[i] * wv[i] - sk * kav[i] + vr * kdv[i];
        o += S[i] * rv[i];
      }
      o = (LPR == 16) ? row16_sum(o) : quad_sum(o);
      myo = ((si % LPR) == lir) ? o : myo;
      if ((si % LPR) == LPR - 1) {
        int st = chunk * 16 + (s - (LPR - 1)) + lir;
        int tok = dir ? (seq0 + T - 1 - st) : (seq0 + st);
        O[(size_t)tok * 512 + h * 64 + row] = myo;
      }
    }
  }
  if (!lat) {
    float* so = p.out + OUT_SRW + ((((size_t)(b * 2 + l) * 2 + dir) * 8 + h) * 64 + row) * 64 + ks;
#pragma unroll
    for (int i = 0; i < KPT; ++i) so[i] = S[i];
  }
}

DEVI void attn_item(const Params& p, int l, int it, unsigned char* sm) {
  const int tid = TIDX, lane = tid & 63, w = tid >> 6, fr = lane & 15, fq = lane >> 4;
  u16* Ks = (u16*)sm;
  u16* VT = (u16*)(sm + 9216);
  float* rpbs = (float*)(sm + 18432);
  const u16* Z = (const u16*)(p.ws + OFF_Z);
  const bool lat = it < 512;
  int b, h, r = 0, seqbase, qtok0;
  if (lat) { b = it >> 8; h = (it >> 5) & 7; r = it & 31; seqbase = 4096 + b * 2048; qtok0 = seqbase + r * 64; }
  else { int j = it - 512; b = j >> 5; h = (j >> 2) & 7; int qb = j & 3; seqbase = b * 256; qtok0 = seqbase + qb * 64; }
  bf16x8 qf[2];
#pragma unroll
  for (int ks = 0; ks < 2; ++ks) qf[ks] = *(const bf16x8*)(Z + (size_t)(qtok0 + w * 16 + fr) * PIN + h * 64 + ks * 32 + fq * 8);
  if (lat)
    for (int i = tid; i < 465; i += 256) rpbs[i] = p.in[11][(size_t)(l * 8 + h) * 465 + i];
  float m_run = -3e38f, l_run = 0.f;
  f32x4 o[4];
#pragma unroll
  for (int d = 0; d < 4; ++d) o[d] = f32x4{0.f, 0.f, 0.f, 0.f};
  const int ntiles = lat ? 16 : 4;
  const int row_start = lat ? clampi(r - 4, 0, 24) : 0;
  const int cbs = lat ? clampi(w * 16 - 8, 0, 32) : 0;
  for (int ti = 0; ti < ntiles; ++ti) {
    __syncthreads();
    const bool ctxtile = lat && ti < 8;
    if (ctxtile) {
      const float* kc = p.in[2] + ((((size_t)b * 2 + l) * 8 + h) * 512 + ti * 64) * 64;
      const float* vc = p.in[3] + ((((size_t)b * 2 + l) * 8 + h) * 512 + ti * 64) * 64;
      {
        const int key = tid >> 2, dp = (tid & 3) * 16;
        float t[16];
#pragma unroll
        for (int c = 0; c < 4; ++c) *(float4*)(t + c * 4) = *(const float4*)(kc + key * 64 + dp + c * 4);
        *(uint4*)(Ks + key * 72 + dp) = pack8(t);
        *(uint4*)(Ks + key * 72 + dp + 8) = pack8(t + 8);
      }
      {
        const int key = tid & 63, dp = (tid >> 6) * 16;
        float t[16];
#pragma unroll
        for (int c = 0; c < 4; ++c) *(float4*)(t + c * 4) = *(const float4*)(vc + key * 64 + dp + c * 4);
#pragma unroll
        for (int i = 0; i < 16; ++i) VT[(dp + i) * 72 + key] = f2bf(t[i]);
      }
    } else {
      const int trow = lat ? (row_start + ti - 8) : ti;
      const u16* zr = Z + (size_t)(seqbase + trow * 64) * PIN;
      {
        const int key = tid >> 2, dp = (tid & 3) * 16;
        const u16* src = zr + (size_t)key * PIN + 512 + h * 64 + dp;
        *(uint4*)(Ks + key * 72 + dp) = *(const uint4*)src;
        *(uint4*)(Ks + key * 72 + dp + 8) = *(const uint4*)(src + 8);
      }
      {
        const int key = tid & 63, dp = (tid >> 6) * 16;
        const u16* src = zr + (size_t)key * PIN + 1024 + h * 64 + dp;
        uint4 r0 = *(const uint4*)src, r1 = *(const uint4*)(src + 8);
        const u16* a0 = (const u16*)&r0;
        const u16* a1 = (const u16*)&r1;
#pragma unroll
        for (int i = 0; i < 8; ++i) { VT[(dp + i) * 72 + key] = a0[i]; VT[(dp + 8 + i) * 72 + key] = a1[i]; }
      }
    }
    __syncthreads();
    const bool win = lat && !ctxtile;
    const int nsteps = win ? 1 : 2;
    for (int st = 0; st < nsteps; ++st) {
      const int ko = win ? cbs : st * 32;
      f32x4 s0 = f32x4{0.f, 0.f, 0.f, 0.f}, s1 = s0;
#pragma unroll
      for (int ks = 0; ks < 2; ++ks) {
        bf16x8 a0 = *(const bf16x8*)(Ks + (ko + fr) * 72 + ks * 32 + fq * 8);
        bf16x8 a1 = *(const bf16x8*)(Ks + (ko + 16 + fr) * 72 + ks * 32 + fq * 8);
        s0 = mfma16(a0, qf[ks], s0);
        s1 = mfma16(a1, qf[ks], s1);
      }
      float sv[8];
#pragma unroll
      for (int j = 0; j < 4; ++j) { sv[j] = s0[j] * 0.125f; sv[4 + j] = s1[j] * 0.125f; }
      if (win) {
        const int qc = w * 16 + fr;
        const int dr = (row_start + ti - 8) - r + 7;
        const int qs = clampi(qc - 8, 0, 48);
#pragma unroll
        for (int e = 0; e < 8; ++e) {
          int kc_ = ko + ((e < 4) ? (fq * 4 + e) : (16 + fq * 4 + e - 4));
          int dc = clampi(kc_ - qc, -15, 15) + 15;
          int rel = kc_ - qs;
          sv[e] = (rel >= 0 && rel < 16) ? (sv[e] + rpbs[dr * 31 + dc]) : -1e30f;
        }
      }
      float mx = sv[0];
#pragma unroll
      for (int e = 1; e < 8; ++e) mx = fmaxf(mx, sv[e]);
      mx = fmaxf(mx, __shfl_xor(mx, 16));
      mx = fmaxf(mx, __shfl_xor(mx, 32));
      const float m_new = fmaxf(m_run, mx);
      const float alpha = __expf(m_run - m_new);
      float pe[8], ps = 0.f;
#pragma unroll
      for (int e = 0; e < 8; ++e) { pe[e] = __expf(sv[e] - m_new); ps += pe[e]; }
      l_run = l_run * alpha + ps;
      m_run = m_new;
#pragma unroll
      for (int d = 0; d < 4; ++d) o[d] *= alpha;
      uint4 pk = pack8(pe);
      bf16x8 pb = __builtin_bit_cast(bf16x8, pk);
#pragma unroll
      for (int d = 0; d < 4; ++d) {
        uint2 lo = *(const uint2*)(VT + (d * 16 + fr) * 72 + ko + fq * 4);
        uint2 hi = *(const uint2*)(VT + (d * 16 + fr) * 72 + ko + 16 + fq * 4);
        uint4 vv; vv.x = lo.x; vv.y = lo.y; vv.z = hi.x; vv.w = hi.y;
        o[d] = mfma16(__builtin_bit_cast(bf16x8, vv), pb, o[d]);
      }
    }
  }
  float lt = l_run + __shfl_xor(l_run, 16);
  lt += __shfl_xor(lt, 32);
  const float inv = 1.f / lt;
  u16* ONA = (u16*)(p.ws + OFF_ONA);
  const int tok = qtok0 + w * 16 + fr;
#pragma unroll
  for (int d = 0; d < 4; ++d) {
    uint2 ov; ov.x = cvtpk(o[d][0] * inv, o[d][1] * inv); ov.y = cvtpk(o[d][2] * inv, o[d][3] * inv);
    *(uint2*)(ONA + (size_t)tok * 512 + h * 64 + d * 16 + fq * 4) = ov;
  }
}

constexpr int MIX_NSCAN_LAT = 128, MIX_NSCAN_CTX = 256, MIX_NATT = 1024, MIX_NRET = 512;
constexpr int MIX_TOTAL = MIX_NSCAN_LAT + MIX_NSCAN_CTX + MIX_NATT + MIX_NRET;
#ifndef ONLYP
#define ONLYP -1
#endif
#define PH_ON(x) (ONLYP < 0 || ONLYP == (x))
DEVI void mix_item(const Params& p, int l, int it, unsigned char* sm) {
  if (it < MIX_NSCAN_LAT) {
    int ch = it >> 2, rq = it & 3;
    if (PH_ON(12)) scan_run<4>(p, l, true, ch >> 4, ch & 7, (ch >> 3) & 1, rq * 16, sm);
    return;
  }
  it -= MIX_NSCAN_LAT;
  if (it < MIX_NSCAN_CTX) { if (PH_ON(13)) scan_run<16>(p, l, false, it >> 4, it & 7, (it >> 3) & 1, 0, sm); return; }
  it -= MIX_NSCAN_CTX;
  if (it < MIX_NATT) { if (PH_ON(14)) attn_item(p, l, it, sm); return; }
  it -= MIX_NATT;
  if (PH_ON(15)) ret3_item(p, l, it, sm);
}

DEVI void fin_item(const Params& p, int l, int it) {
  const int tid = TIDX;
  const int tok = it * 2 + (tid >> 7), c4 = (tid & 127) * 4;
  const size_t o = (size_t)tok * 512 + c4;
  float4 a = *(const float4*)((const float*)(p.ws + OFF_OF) + o);
  float4 b = *(const float4*)((const float*)(p.ws + OFF_OF) + (size_t)NTOK * 512 + o);
  float x[4] = {a.x + b.x, a.y + b.y, a.z + b.z, a.w + b.w};
  float mu = row16_sum(x[0] + x[1] + x[2] + x[3]) * (1.f / 64.f);
  float q = 0.f;
#pragma unroll
  for (int i = 0; i < 4; ++i) { float d = x[i] - mu; q += d * d; }
  float rs = rsqrtf(row16_sum(q) * (1.f / 64.f) + 64e-5f);
  float4 gw = *(const float4*)(p.in[24] + l * 512 + c4), gb = *(const float4*)(p.in[25] + l * 512 + c4);
  float gwv[4] = {gw.x, gw.y, gw.z, gw.w}, gbv[4] = {gb.x, gb.y, gb.z, gb.w};
  float bon[4], g[4];
  unpack4(*(const uint2*)((const u16*)(p.ws + OFF_RWBON) + o), bon);
  unpack4(*(const uint2*)((const u16*)(p.ws + OFF_RWG) + o), g);
  float y[4];
#pragma unroll
  for (int i = 0; i < 4; ++i) y[i] = ((x[i] - mu) * rs * gwv[i] + gbv[i] + bon[i]) * g[i];
  uint2 ov; ov.x = cvtpk(y[0], y[1]); ov.y = cvtpk(y[2], y[3]);
  *(uint2*)((u16*)(p.ws + OFF_ORW) + o) = ov;
}

DEVI void ln2_item(const Params& p, int l, int it) {
  const int lane = TIDX & 63, w = TIDX >> 6;
  const int tok = it * 4 + w;
  const float* y = (const float*)(p.ws + OFF_Y) + (size_t)tok * 1024;
  const float* mod = (const float*)(p.ws + OFF_MOD) + ((size_t)l * 3 + modrow(tok)) * 6144;
  float v[16];
  float s = 0.f;
#pragma unroll
  for (int i = 0; i < 4; ++i) { *(float4*)(v + i * 4) = *(const float4*)(y + lane * 4 + 256 * i); }
#pragma unroll
  for (int i = 0; i < 16; ++i) s += v[i];
  float mu = wave_sum(s) * (1.f / 1024.f);
  float q = 0.f;
#pragma unroll
  for (int i = 0; i < 16; ++i) { float d = v[i] - mu; q += d * d; }
  float rs = rsqrtf(wave_sum(q) * (1.f / 1024.f) + 1e-5f);
  float* X1 = (float*)(p.ws + OFF_X1) + (size_t)tok * 1024;
  s = 0.f;
#pragma unroll
  for (int i = 0; i < 4; ++i) {
    int c = lane * 4 + 256 * i;
    float4 g = *(const float4*)(p.in[28] + l * 1024 + c), bb = *(const float4*)(p.in[29] + l * 1024 + c);
    v[i * 4 + 0] = (v[i * 4 + 0] - mu) * rs * g.x + bb.x;
    v[i * 4 + 1] = (v[i * 4 + 1] - mu) * rs * g.y + bb.y;
    v[i * 4 + 2] = (v[i * 4 + 2] - mu) * rs * g.z + bb.z;
    v[i * 4 + 3] = (v[i * 4 + 3] - mu) * rs * g.w + bb.w;
    *(float4*)(X1 + c) = *(float4*)(v + i * 4);
    s += v[i * 4] + v[i * 4 + 1] + v[i * 4 + 2] + v[i * 4 + 3];
  }
  mu = wave_sum(s) * (1.f / 1024.f);
  q = 0.f;
#pragma unroll
  for (int i = 0; i < 16; ++i) { float d = v[i] - mu; q += d * d; }
  rs = rsqrtf(wave_sum(q) * (1.f / 1024.f) + 1e-5f);
  u16* H2 = (u16*)(p.ws + OFF_H2) + (size_t)tok * 1024;
#pragma unroll
  for (int i = 0; i < 4; ++i) {
    int c = lane * 4 + 256 * i;
    float4 sh = *(const float4*)(mod + 3072 + c), sc = *(const float4*)(mod + 4096 + c);
    uint2 o;
    o.x = cvtpk((v[i * 4] - mu) * rs * (1.f + sc.x) + sh.x, (v[i * 4 + 1] - mu) * rs * (1.f + sc.y) + sh.y);
    o.y = cvtpk((v[i * 4 + 2] - mu) * rs * (1.f + sc.z) + sh.z, (v[i * 4 + 3] - mu) * rs * (1.f + sc.w) + sh.w);
    *(uint2*)(H2 + c) = o;
  }
}

DEVI int f2ord(float f) { int i = __float_as_int(f); return i ^ ((i >> 31) & 0x7fffffff); }
DEVI float ord2f(int i) { return __int_as_float(i ^ ((i >> 31) & 0x7fffffff)); }
DEVI void insert16(int (&t)[16], int x) {
#pragma unroll
  for (int i = 0; i < 16; ++i) { int hi = max(t[i], x); x = min(t[i], x); t[i] = hi; }
}
DEVI void route_item(const Params& p, int l, int it, unsigned char* sm) {
  const int tid = TIDX, lane = tid & 63, w = tid >> 6;
  const int g = w >> 1, pp = w & 1;
  const int tb = it >> 3, h = it & 7;
  const int tok = tb * 128 + g * 64 + lane;
  float* kl = (float*)sm;
  const float* Q = (const float*)(p.ws + OFF_Q) + (size_t)tok * 1024 + h * 128 + pp * 64;
  float q[64];
#pragma unroll
  for (int i = 0; i < 16; ++i) *(float4*)(q + i * 4) = *(const float4*)(Q + i * 4);
  int T[16];
#pragma unroll
  for (int i = 0; i < 16; ++i) T[i] = (int)0x80000000;
  const float* keys = p.in[33] + (size_t)((l * 8 + h) * 2) * 8192;
  for (int half = 0; half < 2; ++half) {
    __syncthreads();
#pragma unroll
    for (int i = 0; i < 8; ++i) {
      int e = (i * 256 + tid) * 4;
      int ps = e >> 12, r = e & 4095;
      *(float4*)(kl + e) = *(const float4*)(keys + (size_t)ps * 8192 + half * 4096 + r);
    }
    __syncthreads();
    const float* kb = kl + pp * 4096;
#pragma unroll 2
    for (int k = 0; k < 64; ++k) {
      const float* kp = kb + k * 64;
      float s0 = 0.f, s1 = 0.f, s2 = 0.f, s3 = 0.f;
#pragma unroll
      for (int d = 0; d < 64; d += 4) {
        float4 kv = *(const float4*)(kp + d);
        s0 += q[d] * kv.x; s1 += q[d + 1] * kv.y; s2 += q[d + 2] * kv.z; s3 += q[d + 3] * kv.w;
      }
      float sc = (s0 + s1) + (s2 + s3);
      int bits = (f2ord(sc) & ~127) | (127 - (half * 64 + k));
      insert16(T, bits);
    }
  }
  __syncthreads();
  int* xb = (int*)sm;
  if (pp == 1) {
#pragma unroll
    for (int i = 0; i < 16; ++i) xb[(g * 16 + i) * 64 + lane] = T[i];
  }
  __syncthreads();
  if (pp == 0) {
    int T1[16];
#pragma unroll
    for (int i = 0; i < 16; ++i) T1[i] = xb[(g * 16 + i) * 64 + lane];
    int F[16];
#pragma unroll
    for (int i = 0; i < 16; ++i) F[i] = (int)0x80000000;
#pragma unroll
    for (int i = 0; i < 16; ++i) {
#pragma unroll
      for (int j = 0; j < 16; ++j) {
        if ((i + 1) * (j + 1) <= 16) {
          float c = ord2f(T[i] & ~127) + ord2f(T1[j] & ~127);
          int bits = (f2ord(c) & ~255) | (255 - (i * 16 + j));
          insert16(F, bits);
        }
      }
    }
    float fs[16], den = 0.f;
    const float f0 = ord2f(F[0] & ~255);
#pragma unroll
    for (int i = 0; i < 16; ++i) { fs[i] = __expf(ord2f(F[i] & ~255) - f0); den += fs[i]; }
    const float inv = 1.f / den;
    int* EIDX = (int*)(p.ws + OFF_EIDX) + (size_t)tok * 128 + h * 16;
    float* GATE = (float*)(p.ws + OFF_GATE) + (size_t)tok * 128 + h * 16;
    int eo[16]; float go[16];
#pragma unroll
    for (int i = 0; i < 16; ++i) {
      int pos = 255 - (F[i] & 255);
      int i0 = pos >> 4, j0 = pos & 15;
      int k0 = 0, k1 = 0;
#pragma unroll
      for (int c = 0; c < 16; ++c) {
        int a0 = 127 - (T[c] & 127), a1 = 127 - (T1[c] & 127);
        k0 = (i0 == c) ? a0 : k0;
        k1 = (j0 == c) ? a1 : k1;
      }
      eo[i] = k0 * 128 + k1;
      go[i] = fs[i] * inv;
    }
#pragma unroll
    for (int i = 0; i < 16; i += 4) {
      *(int4*)(EIDX + i) = make_int4(eo[i], eo[i + 1], eo[i + 2], eo[i + 3]);
      *(float4*)(GATE + i) = make_float4(go[i], go[i + 1], go[i + 2], go[i + 3]);
    }
  }
}

DEVI void expert_item(const Params& p, int l, int it) {
  const int lane = TIDX & 63;
  const int w = __builtin_amdgcn_readfirstlane(TIDX >> 6);
  const int tok = it * 4 + w;
  const u16* H2 = (const u16*)(p.ws + OFF_H2) + (size_t)tok * 1024;
  float hv[16];
  unpack8(*(const uint4*)(H2 + lane * 8), hv);
  unpack8(*(const uint4*)(H2 + 512 + lane * 8), hv + 8);
  const int* EIDX = (const int*)(p.ws + OFF_EIDX) + (size_t)tok * 128;
  const float* GATE = (const float*)(p.ws + OFF_GATE) + (size_t)tok * 128;
  const u16* UB = (const u16*)(p.ws + OFF_UB);
  const u16* VB = (const u16*)(p.ws + OFF_VB);
  float f[16];
#pragma unroll
  for (int i = 0; i < 16; ++i) f[i] = 0.f;
#pragma unroll 4
  for (int e = 0; e < 128; ++e) {
    const int idx = EIDX[e];
    const float gate = GATE[e];
    const u16* ur = UB + (size_t)idx * 1024;
    const u16* vr = VB + (size_t)idx * 1024;
    uint4 u0 = *(const uint4*)(ur + lane * 8), u1 = *(const uint4*)(ur + 512 + lane * 8);
    uint4 v0 = *(const uint4*)(vr + lane * 8), v1 = *(const uint4*)(vr + 512 + lane * 8);
    float uu[16];
    unpack8(u0, uu); unpack8(u1, uu + 8);
    float d = 0.f;
#pragma unroll
    for (int i = 0; i < 16; ++i) d += uu[i] * hv[i];
    d = wave_sum(d);
    const float act = 0.5f * d * (1.f + erff(d * 0.70710678118654752f)) * gate;
    float vv[16];
    unpack8(v0, vv); unpack8(v1, vv + 8);
#pragma unroll
    for (int i = 0; i < 16; ++i) f[i] += act * vv[i];
  }
  const float* X1 = (const float*)(p.ws + OFF_X1) + (size_t)tok * 1024;
  const float* mod = (const float*)(p.ws + OFF_MOD) + ((size_t)l * 3 + modrow(tok)) * 6144;
  float y[16];
  float s = 0.f;
#pragma unroll
  for (int hh = 0; hh < 2; ++hh)
#pragma unroll
    for (int c = 0; c < 2; ++c) {
      int col = hh * 512 + lane * 8 + c * 4;
      float4 x = *(const float4*)(X1 + col), gt = *(const float4*)(mod + 5120 + col);
      int o = hh * 8 + c * 4;
      y[o] = ALPHA * x.x + gt.x * f[o]; y[o + 1] = ALPHA * x.y + gt.y * f[o + 1];
      y[o + 2] = ALPHA * x.z + gt.z * f[o + 2]; y[o + 3] = ALPHA * x.w + gt.w * f[o + 3];
      s += y[o] + y[o + 1] + y[o + 2] + y[o + 3];
    }
  float mu = wave_sum(s) * (1.f / 1024.f);
  float q = 0.f;
#pragma unroll
  for (int i = 0; i < 16; ++i) { float d = y[i] - mu; q += d * d; }
  float rs = rsqrtf(wave_sum(q) * (1.f / 1024.f) + 1e-5f);
  float* xo = (l == 1) ? (p.out + OUT_Y + (size_t)tok * 1024) : ((float*)(p.ws + OFF_X) + (size_t)tok * 1024);
  s = 0.f;
#pragma unroll
  for (int hh = 0; hh < 2; ++hh)
#pragma unroll
    for (int c = 0; c < 2; ++c) {
      int col = hh * 512 + lane * 8 + c * 4;
      int o = hh * 8 + c * 4;
      float4 g = *(const float4*)(p.in[30] + l * 1024 + col), bb = *(const float4*)(p.in[31] + l * 1024 + col);
      y[o] = (y[o] - mu) * rs * g.x + bb.x; y[o + 1] = (y[o + 1] - mu) * rs * g.y + bb.y;
      y[o + 2] = (y[o + 2] - mu) * rs * g.z + bb.z; y[o + 3] = (y[o + 3] - mu) * rs * g.w + bb.w;
      *(float4*)(xo + col) = make_float4(y[o], y[o + 1], y[o + 2], y[o + 3]);
      s += y[o] + y[o + 1] + y[o + 2] + y[o + 3];
    }
  if (l == 0) {
    const float* mod1 = (const float*)(p.ws + OFF_MOD) + ((size_t)3 + modrow(tok)) * 6144;
    mu = wave_sum(s) * (1.f / 1024.f);
    q = 0.f;
#pragma unroll
    for (int i = 0; i < 16; ++i) { float d = y[i] - mu; q += d * d; }
    rs = rsqrtf(wave_sum(q) * (1.f / 1024.f) + 1e-5f);
    u16* H = (u16*)(p.ws + OFF_H) + (size_t)tok * 1024;
#pragma unroll
    for (int hh = 0; hh < 2; ++hh) {
      int col = hh * 512 + lane * 8;
      float t[8];
#pragma unroll
      for (int c = 0; c < 2; ++c) {
        float4 sh = *(const float4*)(mod1 + col + c * 4), sc = *(const float4*)(mod1 + 1024 + col + c * 4);
        int o = hh * 8 + c * 4;
        t[c * 4] = (y[o] - mu) * rs * (1.f + sc.x) + sh.x; t[c * 4 + 1] = (y[o + 1] - mu) * rs * (1.f + sc.y) + sh.y;
        t[c * 4 + 2] = (y[o + 2] - mu) * rs * (1.f + sc.z) + sh.z; t[c * 4 + 3] = (y[o + 3] - mu) * rs * (1.f + sc.w) + sh.w;
      }
      *(uint4*)(H + col) = pack8(t);
    }
  }
}

constexpr int NPHASES = 22;
DEVI int phase_total(int idx) {
  if (idx == 0) return P0_TOTAL;
  if (idx == 1) return 2048;
  const int l = (idx - 2) / 10, t = (idx - 2) % 10;
  switch (t) {
    case 0: return (l == 1 ? P0_NUV : 0);
    case 1: return 512 + 512;
    case 2: return MIX_TOTAL;
    case 3: return 4096;
    case 4: return 0;
    case 5: return 0;
    case 6: return 2048;
    case 7: return 0;
    case 8: return 512;
    default: return 2048;
  }
}
DEVI int phase_xcd_total(int idx) {
  if (idx < 2) return 0;
  const int t = (idx - 2) % 10;
  if (t == 0) return 504;
  if (t == 4 || t == 5 || t == 7) return 64;
  return 0;
}
DEVI void phase_item_x(const Params& p, int idx, int xcd, int q, unsigned char* sm) {
  const int l = (idx - 2) / 10, t = (idx - 2) % 10;
  const int it = (q >> 3) * 64 + xcd * 8 + (q & 7);
  if (t == 0) { if (PH_ON(2)) g1_item(p, l, it, sm); }
  else if (t == 4) { if (PH_ON(6)) g2_item(p, l, it, sm); }
  else if (t == 5) { if (PH_ON(7)) g3_item(p, l, it, sm); }
  else { if (PH_ON(9)) g4_item(p, l, it, sm); }
}
DEVI void phase_item(const Params& p, int idx, int it, unsigned char* sm) {
  if (idx == 0) { if (PH_ON(0)) phase0_item(p, it, sm); return; }
  if (idx == 1) { if (PH_ON(1)) ln1_item(p, it); return; }
  const int l = (idx - 2) / 10, t = (idx - 2) % 10;
  switch (t) {
    case 0: if (PH_ON(2)) convert_uv_item(p, 1, it); break;
    case 1: if (it < 512) { if (PH_ON(3)) rwprep_item(p, l, it); } else { if (PH_ON(4)) ret1_item(p, l, it - 512, sm); } break;
    case 2: mix_item(p, l, it, sm); break;
    case 3: if (PH_ON(5)) fin_item(p, l, it); break;
    case 4: break;
    case 5: break;
    case 6: if (PH_ON(8)) ln2_item(p, l, it); break;
    case 7: break;
    case 8: if (PH_ON(10)) route_item(p, l, it, sm); break;
    default: if (PH_ON(11)) expert_item(p, l, it); break;
  }
}

#define XB_TMO      128
#define XB_XCNT(j)  (256  + 64 * (j))
#define XB_XSUB(j)  (1280 + 64 * (j))
#define XB_XGEN(j)  (2304 + 64 * (j))
#define XB_TOP      3328
#define XB_TOPGEN   3392
#define XCD_BAR_WORDS 3456
#define XB_SPIN_CAP (1u << 18)
#define LAS __attribute__((address_space(3)))
DEVI unsigned xb_ld(unsigned* p) { return __hip_atomic_load(p, __ATOMIC_RELAXED, __HIP_MEMORY_SCOPE_AGENT); }
DEVI unsigned xb_add(unsigned* p, unsigned v) { return __hip_atomic_fetch_add(p, v, __ATOMIC_RELAXED, __HIP_MEMORY_SCOPE_AGENT); }
DEVI unsigned xb_xcc_id() { return (unsigned)__builtin_amdgcn_s_getreg((3 << 11) | 20) & 0xFu; }
#define XB_SPIN(cond, bar) do { unsigned _sp = 0; while (cond) { __builtin_amdgcn_s_sleep(1); \
    if ((++_sp & 255u) == 0u) { if (xb_ld(&(bar)[XB_TMO])) break; if (_sp > XB_SPIN_CAP) { atomicAdd(&(bar)[XB_TMO], 1u); break; } } } } while (0)
struct XcdBarrier { unsigned* bar; unsigned x; volatile LAS unsigned* st; };
DEVI XcdBarrier xcd_barrier_post(unsigned* bar, volatile LAS unsigned* st) {
  XcdBarrier b; b.bar = bar; b.x = xb_xcc_id(); b.st = st;
  if (threadIdx.x == 0) (void)xb_add(&bar[XB_XCNT(b.x)], 1u);
  return b;
}
DEVI void xcd_barrier_complete(unsigned* bar, unsigned x, unsigned& nloc, unsigned& nx) {
  const unsigned G = gridDim.x * gridDim.y * gridDim.z;
  unsigned sum, cnt, mine, sp = 0u;
  for (;;) {
    sum = 0u; cnt = 0u; mine = 0u;
#pragma unroll
    for (unsigned j = 0; j < 16; ++j) { const unsigned c = xb_ld(&bar[XB_XCNT(j)]); sum += c; cnt += (c > 0u) ? 1u : 0u; mine = (j == x) ? c : mine; }
    if (sum == G) break;
    __builtin_amdgcn_s_sleep(1);
    if ((++sp & 255u) == 0u) { if (xb_ld(&bar[XB_TMO])) break; if (sp > XB_SPIN_CAP) { atomicAdd(&bar[XB_TMO], 1u); break; } }
  }
  nloc = mine > 0u ? mine : 1u; nx = cnt > 0u ? cnt : 1u;
}
DEVI void xcd_barrier(const XcdBarrier& b) {
  asm volatile("s_waitcnt vmcnt(0)" ::: "memory");
  __syncthreads();
  if (threadIdx.x == 0) {
    unsigned* bar = b.bar;
    __builtin_amdgcn_s_waitcnt(0);
    unsigned nloc = b.st[0], nx = b.st[1];
    if (nloc == 0u) { xcd_barrier_complete(bar, b.x, nloc, nx); b.st[0] = nloc; b.st[1] = nx; }
    const unsigned old = xb_add(&bar[XB_XSUB(b.x)], 1u);
    const unsigned gen = old / nloc;
    if (old + 1u == (gen + 1u) * nloc) {
      __builtin_amdgcn_fence(__ATOMIC_RELEASE, "agent");
      asm volatile("s_waitcnt vmcnt(0)" ::: "memory");
      const unsigned og = xb_add(&bar[XB_TOP], 1u);
      const unsigned tg = og / nx;
      if (og + 1u == (tg + 1u) * nx) xb_add(&bar[XB_TOPGEN], 1u);
      else XB_SPIN(xb_ld(&bar[XB_TOPGEN]) == tg, bar);
      __builtin_amdgcn_fence(__ATOMIC_ACQUIRE, "agent");
      xb_add(&bar[XB_XGEN(b.x)], 1u);
      asm volatile("s_waitcnt vmcnt(0)" ::: "memory");
    } else {
      XB_SPIN(xb_ld(&bar[XB_XGEN(b.x)]) == gen, bar);
      __builtin_amdgcn_fence(__ATOMIC_ACQUIRE, "agent");
      asm volatile("s_waitcnt vmcnt(0)" ::: "memory");
    }
  }
  __syncthreads();
}

__global__ void __launch_bounds__(256, 2) mega_kernel(KArgs ka, int ph_lo, int ph_hi) {
  __shared__ __attribute__((aligned(16))) unsigned char sm[56320];
  __shared__ int s_item;
  __shared__ const float* s_in[36];
  __shared__ __attribute__((aligned(16))) unsigned s_xb[4];
  cg::grid_group grid = cg::this_grid();
  if (threadIdx.x < 4) s_xb[threadIdx.x] = 0u;
  if (threadIdx.x < 36) {
    const float* const* kp = (const float* const*)__builtin_amdgcn_kernarg_segment_ptr();
    s_in[threadIdx.x] = kp[threadIdx.x];
  }
  __syncthreads();
  Params p;
  p.in = s_in; p.out = ka.out; p.ws = ka.ws;
  int* ctr = (int*)(p.ws + OFF_CTR);
  const XcdBarrier xb = xcd_barrier_post((unsigned*)(p.ws + OFF_BAR), (volatile LAS unsigned*)s_xb);
  for (int idx = ph_lo; idx < ph_hi; ++idx) {
    const int total = phase_total(idx);
#ifdef PROBE_T
    const int ptype = idx < 2 ? idx : 2 + (idx - 2) % 10;
    const int reps = (ptype == PROBE_T) ? 2 : 1;
#else
    const int reps = 1;
#endif
    for (int rep = 0; rep < reps; ++rep) {
      const int nx = phase_xcd_total(idx);
      if (nx) {
        const int xcd = blockIdx.x & 7;
        while (true) {
          __syncthreads();
          if (TIDX == 0) s_item = atomicAdd(&ctr[64 + (idx + 32 * rep) * 8 + xcd], 1);
          __syncthreads();
          const int q_ = s_item;
          if (q_ >= nx) break;
          Params q = p;
          asm volatile("" : "+s"(q.ws));
          asm volatile("" : "+s"(q.out));
          asm volatile("" : "+s"(q.in));
          phase_item_x(q, idx, xcd, q_, sm);
        }
      }
      while (true) {
        __syncthreads();
        if (TIDX == 0) s_item = atomicAdd(&ctr[idx + 32 * rep], 1);
        __syncthreads();
        const int it = s_item;
        if (it >= total) break;
        Params q = p;
        asm volatile("" : "+s"(q.ws));
        asm volatile("" : "+s"(q.out));
        asm volatile("" : "+s"(q.in));
        phase_item(q, idx, it, sm);
      }
      if (rep + 1 < reps) xcd_barrier(xb);
    }
    if (idx + 1 < ph_hi) {
      if (idx == ph_lo) grid.sync();
      else xcd_barrier(xb);
    }
  }
}

#ifndef MULTI_LAUNCH
#define MULTI_LAUNCH 0
#endif

extern "C" void kernel_launch(void* const* d_in, const int* in_sizes, int n_in, void* d_out, int out_size, void* d_ws,
                              size_t ws_size, hipStream_t stream) {
  static int grid_blocks = 0;
  if (!grid_blocks) {
    int dev = 0, cus = 0, per_cu = 0;
    hipGetDevice(&dev);
    hipDeviceGetAttribute(&cus, hipDeviceAttributeMultiprocessorCount, dev);
    hipOccupancyMaxActiveBlocksPerMultiprocessor(&per_cu, mega_kernel, 256, 0);
    if (per_cu > 2) per_cu = 2;
    if (per_cu < 1) per_cu = 1;
    grid_blocks = cus * per_cu;
  }
  KArgs p{};
  for (int i = 0; i < 36; ++i) p.in[i] = (const float*)d_in[i];
  p.out = (float*)d_out;
  p.ws = (unsigned char*)d_ws;
  if (ws_size < OFF_END) { fprintf(stderr, "workspace too small: %zu < %zu\n", ws_size, (size_t)OFF_END); return; }
  hipMemsetAsync(d_ws, 0, 4096, stream);
  hipMemsetAsync((unsigned char*)d_ws + OFF_BAR, 0, 16384, stream);
#if MULTI_LAUNCH
  for (int ph = 0; ph < NPHASES; ++ph) {
    hipLaunchKernelGGL(mega_kernel, dim3(grid_blocks), dim3(256), 0, stream, p, ph, ph + 1);
  }
#else
  int lo = 0, hi = NPHASES;
  void* args[] = {&p, &lo, &hi};
  hipError_t e = hipLaunchCooperativeKernel((void*)mega_kernel, dim3(grid_blocks), dim3(256), args, 0, stream);
  if (e != hipSuccess) fprintf(stderr, "cooperative launch failed: %s (grid %d)\n", hipGetErrorString(e), grid_blocks);
#endif
}
```

```cpp
#include <hip/hip_runtime.h>
#include <hip/hip_bf16.h>
#include <hip/hip_cooperative_groups.h>
#include <cstdio>
namespace cg = cooperative_groups;

typedef unsigned short u16;
using bf16x8 = __attribute__((ext_vector_type(8))) short;
using f32x4 = __attribute__((ext_vector_type(4))) float;
#define DEVI __device__ __forceinline__
__device__ __forceinline__ int ltid_() { int t = threadIdx.x; asm volatile("" : "+v"(t)); return t; }
#define TIDX ltid_()

constexpr int NTOK = 8192;
constexpr int PIN = 8064;
constexpr float ALPHA = 1.4142135623730951f;
constexpr size_t OUT_Y = 0;
constexpr size_t OUT_NAK = 8388608;
constexpr size_t OUT_NAV = 12582912;
constexpr size_t OUT_SRET = 16777216;
constexpr size_t OUT_SRW = 18874368;
constexpr size_t OFF_CTR = 0;
constexpr size_t OFF_TAB = 4096;
constexpr size_t OFF_MOD = 16384;
constexpr size_t OFF_WINT = 1048576;
constexpr size_t OFF_WBRT = OFF_WINT + 33030144;
constexpr size_t OFF_WOUTT = OFF_WBRT + 6291456;
constexpr size_t OFF_WQT = OFF_WOUTT + 4194304;
constexpr size_t OFF_WUPT = OFF_WQT + 4194304;
constexpr size_t OFF_AUPT = OFF_WUPT + 262144;
constexpr size_t OFF_GUPT = OFF_AUPT + 262144;
constexpr size_t OFF_UB = OFF_GUPT + 262144;
constexpr size_t OFF_VB = OFF_UB + 33554432;
constexpr size_t OFF_Z = OFF_VB + 33554432;
constexpr size_t OFF_X = OFF_Z + 132120576;
constexpr size_t OFF_H = OFF_X + 33554432;
constexpr size_t OFF_ONA = OFF_H + 16777216;
constexpr size_t OFF_ORT = OFF_ONA + 8388608;
constexpr size_t OFF_ORW = OFF_ORT + 8388608;
constexpr size_t OFF_GA = OFF_ORW + 8388608;
constexpr size_t SZB = 8388608;
constexpr size_t OFF_RWW = OFF_GA;
constexpr size_t OFF_RWR = OFF_RWW + 4 * SZB;
constexpr size_t OFF_RWV = OFF_RWR + SZB;
constexpr size_t OFF_RWKK = OFF_RWV + SZB;
constexpr size_t OFF_RWKC = OFF_RWKK + SZB;
constexpr size_t OFF_RWKD = OFF_RWKC + SZB;
constexpr size_t OFF_RWKKA = OFF_RWKD + 2 * SZB;
constexpr size_t OFF_RWG = OFF_RWKKA + 2 * SZB;
constexpr size_t OFF_RWBON = OFF_RWG + SZB;
constexpr size_t OFF_OF = OFF_RWBON + SZB;
constexpr size_t OFF_KV = OFF_OF + 4 * SZB;
constexpr size_t OFF_BAR = OFF_KV + 33554432;
constexpr size_t OFF_SC = OFF_BAR + 16384;
constexpr size_t OFF_END = OFF_SC + 4 * 65536;
constexpr size_t OFF_Y = OFF_GA;
constexpr size_t OFF_X1 = OFF_GA + 33554432;
constexpr size_t OFF_Q = OFF_GA + 2 * 33554432;
constexpr size_t OFF_H2 = OFF_GA + 3 * 33554432;
constexpr size_t OFF_EIDX = OFF_H2 + 16777216;
constexpr size_t OFF_GATE = OFF_EIDX + 4194304;

constexpr size_t UV_LSTRIDE = 16777216;
struct KArgs {
  const float* in[36];
  float* out;
  unsigned char* ws;
};
typedef __attribute__((address_space(1))) unsigned char g_u8;
typedef __attribute__((address_space(1))) float g_f32;
typedef const __attribute__((address_space(1))) float g_cf32;
struct InTab {
  g_cf32* const* t;
  DEVI const float* operator[](int k) const { return (const float*)t[k]; }
};
struct Params {
  InTab in;
  g_f32* out;
  g_u8* ws;
};
DEVI const float* uniform_ptr(const float* q) {
  unsigned long long v = (unsigned long long)q;
  unsigned lo = __builtin_amdgcn_readfirstlane((unsigned)v), hi = __builtin_amdgcn_readfirstlane((unsigned)(v >> 32));
  return (const float*)(((unsigned long long)hi << 32) | lo);
}

DEVI float bf2f(u16 h) { return __uint_as_float(((unsigned)h) << 16); }
DEVI unsigned cvtpk(float lo, float hi) {
  unsigned r;
  asm volatile("v_cvt_pk_bf16_f32 %0, %1, %2" : "=v"(r) : "v"(lo), "v"(hi));
  return r;
}
DEVI u16 f2bf(float f) { return (u16)(cvtpk(f, f) & 0xffffu); }
DEVI float sigmoidf_(float x) { return 1.f / (1.f + __expf(-x)); }
template <int CTRL> DEVI float dpp(float x) {
  return __builtin_bit_cast(float, __builtin_amdgcn_update_dpp(0, __builtin_bit_cast(int, x), CTRL, 0xf, 0xf, true));
}
DEVI float quad_sum(float x) { x += dpp<0xB1>(x); x += dpp<0x4E>(x); return x; }
DEVI float row16_sum(float x) { x = quad_sum(x); x += dpp<0x141>(x); x += dpp<0x140>(x); return x; }
DEVI float wave_sum(float x) { x = row16_sum(x); x += __shfl_xor(x, 16); x += __shfl_xor(x, 32); return x; }
DEVI void unpack8(uint4 v, float* f) {
  f[0] = __uint_as_float(v.x << 16); f[1] = __uint_as_float(v.x & 0xffff0000u);
  f[2] = __uint_as_float(v.y << 16); f[3] = __uint_as_float(v.y & 0xffff0000u);
  f[4] = __uint_as_float(v.z << 16); f[5] = __uint_as_float(v.z & 0xffff0000u);
  f[6] = __uint_as_float(v.w << 16); f[7] = __uint_as_float(v.w & 0xffff0000u);
}
DEVI void unpack4(uint2 v, float* f) {
  f[0] = __uint_as_float(v.x << 16); f[1] = __uint_as_float(v.x & 0xffff0000u);
  f[2] = __uint_as_float(v.y << 16); f[3] = __uint_as_float(v.y & 0xffff0000u);
}
DEVI uint4 pack8(const float* f) {
  uint4 r; r.x = cvtpk(f[0], f[1]); r.y = cvtpk(f[2], f[3]); r.z = cvtpk(f[4], f[5]); r.w = cvtpk(f[6], f[7]); return r;
}
DEVI f32x4 mfma16(bf16x8 a, bf16x8 b, f32x4 c) { return __builtin_amdgcn_mfma_f32_16x16x32_bf16(a, b, c, 0, 0, 0); }
DEVI int modrow(int tok) { return tok < 4096 ? 0 : 1 + ((tok - 4096) >> 11); }
DEVI const float* xin_row(const Params& p, int tok) {
  return tok < 4096 ? p.in[0] + (size_t)tok * 1024 : p.in[1] + (size_t)(tok - 4096) * 1024;
}
DEVI int clampi(int v, int lo, int hi) { return v < lo ? lo : (v > hi ? hi : v); }

template <int NT> DEVI void wave_mma(const u16* A, int lda, const u16* B, int ldb, int K, f32x4* acc) {
  const int lane = TIDX & 63, fr = lane & 15, fq = lane >> 4;
  for (int k0 = 0; k0 < K; k0 += 32) {
    bf16x8 a = *(const bf16x8*)(A + fr * lda + k0 + fq * 8);
#pragma unroll
    for (int n = 0; n < NT; ++n) {
      bf16x8 b = *(const bf16x8*)(B + (n * 16 + fr) * ldb + k0 + fq * 8);
      acc[n] = mfma16(a, b, acc[n]);
    }
  }
}

#define LDS_RD(dst, addr, off) asm volatile("ds_read_b128 %0, %1 offset:" #off : "=v"(dst) : "v"(addr))
DEVI void gemm_acc(const u16* __restrict__ A, int lda, const u16* __restrict__ Bt, int ldb, int K, int m0, int n0,
                   unsigned char* sm, f32x4 (&acc)[4][4]) {
  const int tid = TIDX, lane = tid & 63, wid = tid >> 6, wr = wid >> 1, wc = wid & 1, fr = lane & 15, fq = lane >> 4;
  const int nk = K >> 5;
  const int b0 = tid * 16, r0 = b0 >> 6, c0 = (b0 & 63) >> 1;
  const u16* Ap = A + (size_t)(m0 + r0) * lda + c0;
  const u16* Bp = Bt + (size_t)(n0 + r0) * ldb + c0;
  const unsigned lbase = (unsigned)(size_t)(__attribute__((address_space(3))) unsigned char*)sm;
  const unsigned aoff = lbase + (wr * 64 + fr) * 64 + fq * 16;
  const unsigned boff = lbase + 8192 + (wc * 64 + fr) * 64 + fq * 16;
  auto issue = [&](int kt, int st) {
    unsigned char* SA = sm + st * 16384;
    unsigned char* SB = SA + 8192;
    __builtin_amdgcn_global_load_lds((const unsigned*)(Ap + kt * 32), (__attribute__((address_space(3))) unsigned*)(SA + b0), 16, 0, 0);
    __builtin_amdgcn_global_load_lds((const unsigned*)(Ap + (size_t)64 * lda + kt * 32), (__attribute__((address_space(3))) unsigned*)(SA + b0 + 4096), 16, 0, 0);
    __builtin_amdgcn_global_load_lds((const unsigned*)(Bp + kt * 32), (__attribute__((address_space(3))) unsigned*)(SB + b0), 16, 0, 0);
    __builtin_amdgcn_global_load_lds((const unsigned*)(Bp + (size_t)64 * ldb + kt * 32), (__attribute__((address_space(3))) unsigned*)(SB + b0 + 4096), 16, 0, 0);
  };
  issue(0, 0);
  if (nk > 1) issue(1, 1);
  int st = 0;
  for (int kt = 0; kt < nk; ++kt) {
    if (kt + 1 < nk) asm volatile("s_waitcnt vmcnt(4)\n\ts_barrier" ::: "memory");
    else asm volatile("s_waitcnt vmcnt(0)\n\ts_barrier" ::: "memory");
    if (kt + 2 < nk) { int s2 = st + 2; if (s2 >= 3) s2 -= 3; issue(kt + 2, s2); }
    const unsigned aa = aoff + st * 16384, bb = boff + st * 16384;
    bf16x8 a0, a1, a2, a3, b0_, b1_, b2_, b3_;
    LDS_RD(a0, aa, 0); LDS_RD(b0_, bb, 0); LDS_RD(b1_, bb, 1024); LDS_RD(b2_, bb, 2048); LDS_RD(b3_, bb, 3072);
    LDS_RD(a1, aa, 1024); LDS_RD(a2, aa, 2048); LDS_RD(a3, aa, 3072);
    asm volatile("s_waitcnt lgkmcnt(0)" : "+v"(a0), "+v"(a1), "+v"(a2), "+v"(a3), "+v"(b0_), "+v"(b1_), "+v"(b2_), "+v"(b3_));
    acc[0][0] = mfma16(a0, b0_, acc[0][0]); acc[0][1] = mfma16(a0, b1_, acc[0][1]);
    acc[0][2] = mfma16(a0, b2_, acc[0][2]); acc[0][3] = mfma16(a0, b3_, acc[0][3]);
    acc[1][0] = mfma16(a1, b0_, acc[1][0]); acc[1][1] = mfma16(a1, b1_, acc[1][1]);
    acc[1][2] = mfma16(a1, b2_, acc[1][2]); acc[1][3] = mfma16(a1, b3_, acc[1][3]);
    acc[2][0] = mfma16(a2, b0_, acc[2][0]); acc[2][1] = mfma16(a2, b1_, acc[2][1]);
    acc[2][2] = mfma16(a2, b2_, acc[2][2]); acc[2][3] = mfma16(a2, b3_, acc[2][3]);
    acc[3][0] = mfma16(a3, b0_, acc[3][0]); acc[3][1] = mfma16(a3, b1_, acc[3][1]);
    acc[3][2] = mfma16(a3, b2_, acc[3][2]); acc[3][3] = mfma16(a3, b3_, acc[3][3]);
    st = (st == 2) ? 0 : st + 1;
  }
  __syncthreads();
}
#define EPI_LOOP                                                                                         \
  const int _lane = TIDX & 63, _wid = TIDX >> 6, _wr = _wid >> 1, _wc = _wid & 1, _fr = _lane & 15, \
            _fq = _lane >> 4;                                                                            \
  _Pragma("unroll") for (int m = 0; m < 4; ++m) _Pragma("unroll") for (int n = 0; n < 4; ++n)            \
      _Pragma("unroll") for (int j = 0; j < 4; ++j)
#define EPI_ROW (m0 + _wr * 64 + m * 16 + _fq * 4 + j)
#define EPI_COL (n0 + _wc * 64 + n * 16 + _fr)

DEVI void zero_acc(f32x4 (&acc)[4][4]) {
#pragma unroll
  for (int m = 0; m < 4; ++m)
#pragma unroll
    for (int n = 0; n < 4; ++n) acc[m][n] = f32x4{0.f, 0.f, 0.f, 0.f};
}

__constant__ double ROPE_FREQ[16] = {1.0, 0.5623413251903491, 0.31622776601683794, 0.1778279410038923, 0.1,
                                     0.05623413251903491, 0.03162277660168379, 0.01778279410038923, 0.01,
                                     0.005623413251903491, 0.0031622776601683794, 0.0017782794100389228, 0.001,
                                     0.0005623413251903491, 0.00031622776601683794, 0.00017782794100389227};

DEVI void transpose_tile(const float* __restrict__ src, int K, int N, u16* __restrict__ dst, int kt, int nt, unsigned char* sm) {
  float* tile = (float*)sm;
  const int tid = TIDX;
  const int k0 = kt * 64, n0 = nt * 64;
#pragma unroll
  for (int i = 0; i < 16; ++i) {
    int kk = i * 4 + (tid >> 6), nn = tid & 63;
    tile[kk * 65 + nn] = src[(size_t)(k0 + kk) * N + n0 + nn];
  }
  __syncthreads();
#pragma unroll
  for (int i = 0; i < 16; ++i) {
    int nn = i * 4 + (tid >> 6), kk = tid & 63;
    dst[(size_t)(n0 + nn) * K + k0 + kk] = f2bf(tile[kk * 65 + nn]);
  }
}

typedef float f32x2_ __attribute__((ext_vector_type(2)));
DEVI void convert_uv_item(const Params& p, int l, int it) {
  const int which = it >> 12, chunk = it & 4095;
  const int lane = TIDX & 63, w = TIDX >> 6;
  const int row = chunk * 4 + w;
  const float* src = p.in[34 + which] + (size_t)l * 16777216 + (size_t)row * 1024 + lane * 16;
  unsigned char* base = (unsigned char*)(p.ws + (which ? OFF_VB : OFF_UB)) + (size_t)l * UV_LSTRIDE;
  float v[16];
#pragma unroll
  for (int i = 0; i < 4; ++i) *(float4*)(v + i * 4) = *(const float4*)(src + i * 4);
  float am = 0.f;
#pragma unroll
  for (int i = 0; i < 16; ++i) am = fmaxf(am, fabsf(v[i]));
  am = fmaxf(am, dpp<0xB1>(am)); am = fmaxf(am, dpp<0x4E>(am)); am = fmaxf(am, dpp<0x141>(am)); am = fmaxf(am, dpp<0x140>(am));
  am = fmaxf(am, __shfl_xor(am, 16)); am = fmaxf(am, __shfl_xor(am, 32));
  const float sc = (am > 0.f) ? (240.f / am) : 1.f;
  int o[4];
#pragma unroll
  for (int i = 0; i < 4; ++i) {
    int wv = 0;
    wv = __builtin_amdgcn_cvt_pk_fp8_f32(v[i * 4] * sc, v[i * 4 + 1] * sc, wv, false);
    wv = __builtin_amdgcn_cvt_pk_fp8_f32(v[i * 4 + 2] * sc, v[i * 4 + 3] * sc, wv, true);
    o[i] = wv;
  }
  *(int4*)(base + (size_t)row * 1024 + lane * 16) = make_int4(o[0], o[1], o[2], o[3]);
  if (lane == 0) ((float*)(p.ws + OFF_SC))[(which * 2 + l) * 16384 + row] = am * (1.f / 240.f);
}

constexpr int P0_NT = 5920;
constexpr int P0_NUV = 8192;
constexpr int P0_NMOD = 192;
constexpr int P0_TOTAL = P0_NMOD + P0_NT + P0_NUV + 1;

DEVI bool p0_tile(const Params& p, int t, int want_l, unsigned char* sm) {
  const float* src; u16* dst; int K, N, kt, nt, l;
  if (t < 4032) { l = t / 2016; int r = t % 2016; kt = r / 126; nt = r % 126; K = 1024; N = 8064;
    src = p.in[10] + (size_t)l * 1024 * 8064; dst = (u16*)(p.ws + OFF_WINT) + (size_t)l * 8064 * 1024; }
  else if ((t -= 4032) < 768) { int j = t / 128, r = t % 128; l = j / 3; kt = r / 16; nt = r % 16; K = 512; N = 1024;
    src = p.in[26] + (size_t)j * 512 * 1024; dst = (u16*)(p.ws + OFF_WBRT) + (size_t)j * 1024 * 512; }
  else if ((t -= 768) < 512) { l = t / 256; int r = t % 256; kt = r / 16; nt = r % 16; K = 1024; N = 1024;
    src = p.in[27] + (size_t)l * 1048576; dst = (u16*)(p.ws + OFF_WOUTT) + (size_t)l * 1048576; }
  else if ((t -= 512) < 512) { l = t / 256; int r = t % 256; kt = r / 16; nt = r % 16; K = 1024; N = 1024;
    src = p.in[32] + (size_t)l * 1048576; dst = (u16*)(p.ws + OFF_WQT) + (size_t)l * 1048576; }
  else if ((t -= 512) < 32) { int j = t / 8; l = j / 2; kt = 0; nt = t % 8; K = 64; N = 512;
    src = p.in[17] + (size_t)j * 32768; dst = (u16*)(p.ws + OFF_WUPT) + (size_t)j * 32768; }
  else if ((t -= 32) < 32) { int j = t / 8; l = j / 2; kt = 0; nt = t % 8; K = 64; N = 512;
    src = p.in[19] + (size_t)j * 32768; dst = (u16*)(p.ws + OFF_AUPT) + (size_t)j * 32768; }
  else { t -= 32; l = t / 16; int r = t % 16; kt = r / 8; nt = r % 8; K = 128; N = 512;
    src = p.in[20] + (size_t)l * 65536; dst = (u16*)(p.ws + OFF_GUPT) + (size_t)l * 65536; }
  if (l != want_l) return false;
  transpose_tile(src, K, N, dst, kt, nt, sm);
  return true;
}
DEVI void phase0_item(const Params& p, int it, unsigned char* sm) {
  const int tid = TIDX;
  if (it < P0_NMOD) {
    const int l = it / 96, n0 = (it % 96) * 64;
    const int kg = tid >> 4, c4 = (tid & 15) * 4;
    float acc[3][4];
#pragma unroll
    for (int r = 0; r < 3; ++r)
#pragma unroll
      for (int i = 0; i < 4; ++i) acc[r][i] = 0.f;
    const float* wm = p.in[8] + (size_t)l * 1024 * 6144;
    for (int k = kg * 64; k < kg * 64 + 64; ++k) {
      float4 w = *(const float4*)(wm + (size_t)k * 6144 + n0 + c4);
      float c0 = p.in[7][k], c1 = p.in[6][k], c2 = p.in[6][1024 + k];
      float s0 = c0 * sigmoidf_(c0), s1 = c1 * sigmoidf_(c1), s2 = c2 * sigmoidf_(c2);
      acc[0][0] += s0 * w.x; acc[0][1] += s0 * w.y; acc[0][2] += s0 * w.z; acc[0][3] += s0 * w.w;
      acc[1][0] += s1 * w.x; acc[1][1] += s1 * w.y; acc[1][2] += s1 * w.z; acc[1][3] += s1 * w.w;
      acc[2][0] += s2 * w.x; acc[2][1] += s2 * w.y; acc[2][2] += s2 * w.z; acc[2][3] += s2 * w.w;
    }
    float* red = (float*)sm;
#pragma unroll
    for (int r = 0; r < 3; ++r)
#pragma unroll
      for (int i = 0; i < 4; ++i) red[(kg * 3 + r) * 64 + c4 + i] = acc[r][i];
    __syncthreads();
    if (tid < 192) {
      int r = tid >> 6, col = tid & 63;
      float s = p.in[9][(size_t)l * 6144 + n0 + col];
      for (int g = 0; g < 16; ++g) s += red[(g * 3 + r) * 64 + col];
      ((float*)(p.ws + OFF_MOD))[((size_t)l * 3 + r) * 6144 + n0 + col] = s;
    }
    return;
  }
  it -= P0_NMOD;
  if (it < P0_NT) {
    if (!p0_tile(p, it, 0, sm)) {}
    return;
  }
  if (0) {
    int t = it;
    const float* src; u16* dst; int K, N, kt, nt;
    if (t < 4032) { int l = t / 2016, r = t % 2016; kt = r / 126; nt = r % 126; K = 1024; N = 8064;
      src = p.in[10] + (size_t)l * 1024 * 8064; dst = (u16*)(p.ws + OFF_WINT) + (size_t)l * 8064 * 1024; }
    else if ((t -= 4032) < 768) { int j = t / 128, r = t % 128; kt = r / 16; nt = r % 16; K = 512; N = 1024;
      src = p.in[26] + (size_t)j * 512 * 1024; dst = (u16*)(p.ws + OFF_WBRT) + (size_t)j * 1024 * 512; }
    else if ((t -= 768) < 512) { int l = t / 256, r = t % 256; kt = r / 16; nt = r % 16; K = 1024; N = 1024;
      src = p.in[27] + (size_t)l * 1048576; dst = (u16*)(p.ws + OFF_WOUTT) + (size_t)l * 1048576; }
    else if ((t -= 512) < 512) { int l = t / 256, r = t % 256; kt = r / 16; nt = r % 16; K = 1024; N = 1024;
      src = p.in[32] + (size_t)l * 1048576; dst = (u16*)(p.ws + OFF_WQT) + (size_t)l * 1048576; }
    else if ((t -= 512) < 32) { int j = t / 8; kt = 0; nt = t % 8; K = 64; N = 512;
      src = p.in[17] + (size_t)j * 32768; dst = (u16*)(p.ws + OFF_WUPT) + (size_t)j * 32768; }
    else if ((t -= 32) < 32) { int j = t / 8; kt = 0; nt = t % 8; K = 64; N = 512;
      src = p.in[19] + (size_t)j * 32768; dst = (u16*)(p.ws + OFF_AUPT) + (size_t)j * 32768; }
    else { t -= 32; int l = t / 16, r = t % 16; kt = r / 8; nt = r % 8; K = 128; N = 512;
      src = p.in[20] + (size_t)l * 65536; dst = (u16*)(p.ws + OFF_GUPT) + (size_t)l * 65536; }
    transpose_tile(src, K, N, dst, kt, nt, sm);
    return;
  }
  it -= P0_NT;
  if (it < P0_NUV) { convert_uv_item(p, 0, it); return; }
  float* tab = (float*)(p.ws + OFF_TAB);
  for (int e = tid; e < 1024; e += 256) {
    int pos = e >> 4, f = e & 15;
    double rev = (double)pos * ROPE_FREQ[f] * 0.15915494309189535;
    rev -= floor(rev);
    float rf = (float)rev;
    tab[e] = __builtin_amdgcn_cosf(rf);
    tab[1024 + e] = __builtin_amdgcn_sinf(rf);
  }
}

DEVI void ln1_item(const Params& p, int it) {
  const int lane = TIDX & 63, w = TIDX >> 6;
  const int tok = it * 4 + w;
  const float* x = xin_row(p, tok);
  const float* mod = (const float*)(p.ws + OFF_MOD) + (size_t)modrow(tok) * 6144;
  float4 v[4];
  float s = 0.f;
#pragma unroll
  for (int i = 0; i < 4; ++i) { v[i] = *(const float4*)(x + lane * 4 + 256 * i); s += v[i].x + v[i].y + v[i].z + v[i].w; }
  float mu = wave_sum(s) * (1.f / 1024.f);
  float q = 0.f;
#pragma unroll
  for (int i = 0; i < 4; ++i) { float a = v[i].x - mu, b = v[i].y - mu, c = v[i].z - mu, d = v[i].w - mu; q += a * a + b * b + c * c + d * d; }
  float rs = rsqrtf(wave_sum(q) * (1.f / 1024.f) + 1e-5f);
  u16* H = (u16*)(p.ws + OFF_H) + (size_t)tok * 1024;
#pragma unroll
  for (int i = 0; i < 4; ++i) {
    int c = lane * 4 + 256 * i;
    float4 sh = *(const float4*)(mod + c), sc = *(const float4*)(mod + 1024 + c);
    uint2 o;
    o.x = cvtpk((v[i].x - mu) * rs * (1.f + sc.x) + sh.x, (v[i].y - mu) * rs * (1.f + sc.y) + sh.y);
    o.y = cvtpk((v[i].z - mu) * rs * (1.f + sc.z) + sh.z, (v[i].w - mu) * rs * (1.f + sc.w) + sh.w);
    *(uint2*)(H + c) = o;
  }
}

DEVI void g1_item(const Params& p, int l, int it, unsigned char* sm) {
  const int nt = it >> 6, mt = it & 63;
  const int m0 = mt * 128, n0 = nt * 128;
  f32x4 acc[4][4];
  zero_acc(acc);
  gemm_acc((const u16*)(p.ws + OFF_H), 1024, (const u16*)(p.ws + OFF_WINT) + (size_t)l * 8064 * 1024, 1024, 1024, m0, n0, sm, acc);
  u16* Z = (u16*)(p.ws + OFF_Z);
  EPI_LOOP {
    int row = EPI_ROW, col = EPI_COL;
    float v = acc[m][n][j];
    Z[(size_t)row * PIN + col] = f2bf(v);
    if (row < 4096 && col >= 512 && col < 1536) {
      int which = (col - 512) >> 9, cc = (col - 512) & 511, h = cc >> 6, d = cc & 63, b = row >> 8, s = row & 255;
      p.out[OUT_NAK + (size_t)which * 4194304 + ((((size_t)(b * 2 + l) * 8 + h) * 256 + s) * 64 + d)] = v;
    }
  }
}
DEVI void g2_item(const Params& p, int l, int it, unsigned char* sm) {
  const int nt = it >> 6, mt = it & 63;
  const int m0 = mt * 128, n0 = nt * 128;
  f32x4 tot[4][4];
  zero_acc(tot);
  const u16* Z = (const u16*)(p.ws + OFF_Z);
  for (int i = 0; i < 3; ++i) {
    f32x4 acc[4][4];
    zero_acc(acc);
    const u16* A = (const u16*)(p.ws + (i == 0 ? OFF_ONA : (i == 1 ? OFF_ORT : OFF_ORW)));
    gemm_acc(A, 512, (const u16*)(p.ws + OFF_WBRT) + (size_t)(l * 3 + i) * 1024 * 512, 512, 512, m0, n0, sm, acc);
    EPI_LOOP {
      int row = EPI_ROW, col = EPI_COL;
      float g = bf2f(Z[(size_t)row * PIN + 4992 + i * 1024 + col]);
      tot[m][n][j] += sigmoidf_(g) * acc[m][n][j];
    }
  }
  u16* MG = (u16*)(p.ws + OFF_H);
  EPI_LOOP { MG[(size_t)EPI_ROW * 1024 + EPI_COL] = f2bf(tot[m][n][j]); }
}
DEVI void g3_item(const Params& p, int l, int it, unsigned char* sm) {
  const int nt = it >> 6, mt = it & 63;
  const int m0 = mt * 128, n0 = nt * 128;
  f32x4 acc[4][4];
  zero_acc(acc);
  gemm_acc((const u16*)(p.ws + OFF_H), 1024, (const u16*)(p.ws + OFF_WOUTT) + (size_t)l * 1048576, 1024, 1024, m0, n0, sm, acc);
  float* Y = (float*)(p.ws + OFF_Y);
  const float* mod = (const float*)(p.ws + OFF_MOD) + (size_t)l * 3 * 6144;
  const float* X = (const float*)(p.ws + OFF_X);
  EPI_LOOP {
    int row = EPI_ROW, col = EPI_COL;
    float xr = (l == 0) ? xin_row(p, row)[col] : X[(size_t)row * 1024 + col];
    float gt = mod[(size_t)modrow(row) * 6144 + 2048 + col];
    Y[(size_t)row * 1024 + col] = ALPHA * xr + gt * acc[m][n][j];
  }
}
DEVI void g4_item(const Params& p, int l, int it, unsigned char* sm) {
  const int nt = it >> 6, mt = it & 63;
  const int m0 = mt * 128, n0 = nt * 128;
  f32x4 acc[4][4];
  zero_acc(acc);
  gemm_acc((const u16*)(p.ws + OFF_H2), 1024, (const u16*)(p.ws + OFF_WQT) + (size_t)l * 1048576, 1024, 1024, m0, n0, sm, acc);
  float* Q = (float*)(p.ws + OFF_Q);
  EPI_LOOP { Q[(size_t)EPI_ROW * 1024 + EPI_COL] = acc[m][n][j]; }
}

DEVI void load_qk16(const u16* zp  , int part, bool lat, int prow, int pcol, const float* tab,
                    float scale, float* out) {
  if (!lat) {
    float t[16];
    unpack8(*(const uint4*)(zp + part * 16), t);
    unpack8(*(const uint4*)(zp + part * 16 + 8), t + 8);
#pragma unroll
    for (int i = 0; i < 16; ++i) out[i] = t[i] * scale;
    return;
  }
  const int half = part >> 1, isp2 = part & 1;
  float p1[16], p2[16];
  unpack8(*(const uint4*)(zp + half * 32), p1);
  unpack8(*(const uint4*)(zp + half * 32 + 8), p1 + 8);
  unpack8(*(const uint4*)(zp + half * 32 + 16), p2);
  unpack8(*(const uint4*)(zp + half * 32 + 24), p2 + 8);
  const int pos = half ? pcol : prow;
  const float* ct = tab + pos * 16;
  const float* st = tab + 1024 + pos * 16;
#pragma unroll
  for (int f = 0; f < 16; ++f) {
    float c = ct[f], s = st[f];
    out[f] = (isp2 ? (p1[f] * s + p2[f] * c) : (p1[f] * c - p2[f] * s)) * scale;
  }
}
struct RetItem { int lat, b, h, n, N, seqbase, kvbase; };
DEVI RetItem ret_decode(int it) {
  RetItem r;
  if (it < 256) { r.lat = 1; r.b = it >> 7; r.h = (it >> 5) & 3; r.n = it & 31; r.N = 32; r.seqbase = 4096 + r.b * 2048; r.kvbase = 256 + (r.b * 4 + r.h) * 32; }
  else { int j = it - 256; r.lat = 0; r.b = j >> 4; r.h = (j >> 2) & 3; r.n = j & 3; r.N = 4; r.seqbase = r.b * 256; r.kvbase = (r.b * 4 + r.h) * 4; }
  return r;
}
DEVI void ret_gammas(const Params& p, int l, int h, float& lgf, float& lgb) {
  float xf = p.in[12][(l * 2 + 0) * 4 + h], xb = p.in[12][(l * 2 + 1) * 4 + h];
  lgf = -log2f(1.f + expf(-xf));
  lgb = -log2f(1.f + expf(-xb));
}

DEVI void ret1_item(const Params& p, int l, int it, unsigned char* sm) {
  const RetItem r = ret_decode(it);
  const int tid = TIDX, lane = tid & 63, w = tid >> 6, fr = lane & 15, fq = lane >> 4;
  u16* KTf = (u16*)sm;
  u16* KTb = (u16*)(sm + 9216);
  u16* VT = (u16*)(sm + 18432);
  const u16* Z = (const u16*)(p.ws + OFF_Z);
  const float* tab = (const float*)(p.ws + OFF_TAB);
  float lgf, lgb;
  ret_gammas(p, l, r.h, lgf, lgb);
  const int tok0 = r.seqbase + r.n * 64;
  {
    const int j = tid >> 2, part = tid & 3;
    float kv[16];
    load_qk16(Z + (size_t)(tok0 + j) * PIN + 1792 + r.h * 64, part, r.lat, r.n, j, tab, 0.125f, kv);
    const float df = exp2f(lgf * (float)(63 - j)), db = exp2f(lgb * (float)j);
#pragma unroll
    for (int i = 0; i < 16; ++i) {
      KTf[(part * 16 + i) * 72 + j] = f2bf(kv[i] * df);
      KTb[(part * 16 + i) * 72 + j] = f2bf(kv[i] * db);
    }
    const int jj = tid & 63, vp = (tid >> 6) * 32;
    const u16* vz = Z + (size_t)(tok0 + jj) * PIN + 2048 + r.h * 128 + vp;
#pragma unroll
    for (int c = 0; c < 4; ++c) {
      uint4 raw = *(const uint4*)(vz + c * 8);
      const u16* rv = (const u16*)&raw;
#pragma unroll
      for (int i = 0; i < 8; ++i) VT[(vp + c * 8 + i) * 72 + jj] = rv[i];
    }
  }
  __syncthreads();
  float* KV = (float*)(p.ws + OFF_KV) + (size_t)(r.kvbase + r.n) * 2 * 8192;
#pragma unroll
  for (int dir = 0; dir < 2; ++dir) {
    f32x4 acc[8];
#pragma unroll
    for (int n = 0; n < 8; ++n) acc[n] = f32x4{0.f, 0.f, 0.f, 0.f};
    wave_mma<8>((dir ? KTb : KTf) + w * 16 * 72, 72, VT, 72, 64, acc);
#pragma unroll
    for (int n = 0; n < 8; ++n)
#pragma unroll
      for (int j = 0; j < 4; ++j) KV[(size_t)dir * 8192 + (w * 16 + fq * 4 + j) * 128 + n * 16 + fr] = acc[n][j];
  }
}

DEVI void ret3_item(const Params& p, int l, int it, unsigned char* sm) {
  const RetItem r = ret_decode(it);
  const int tid = TIDX, lane = tid & 63, w = tid >> 6, fr = lane & 15, fq = lane >> 4;
  u16* Qs = (u16*)sm;
  u16* Ks = (u16*)(sm + 9216);
  u16* VT = (u16*)(sm + 18432);
  u16* ST = (u16*)(sm + 36864);
  const u16* Z = (const u16*)(p.ws + OFF_Z);
  const float* tab = (const float*)(p.ws + OFF_TAB);
  float lgf, lgb;
  ret_gammas(p, l, r.h, lgf, lgb);
  const int tok0 = r.seqbase + r.n * 64;
  {
    const int i = tid >> 2, part = tid & 3;
    float t[16];
    load_qk16(Z + (size_t)(tok0 + i) * PIN + 1536 + r.h * 64, part, r.lat, r.n, i, tab, 1.f, t);
    *(uint4*)(Qs + i * 72 + part * 16) = pack8(t);
    *(uint4*)(Qs + i * 72 + part * 16 + 8) = pack8(t + 8);
    load_qk16(Z + (size_t)(tok0 + i) * PIN + 1792 + r.h * 64, part, r.lat, r.n, i, tab, 0.125f, t);
    *(uint4*)(Ks + i * 72 + part * 16) = pack8(t);
    *(uint4*)(Ks + i * 72 + part * 16 + 8) = pack8(t + 8);
    const int jj = tid & 63, vp = (tid >> 6) * 32;
    const u16* vz = Z + (size_t)(tok0 + jj) * PIN + 2048 + r.h * 128 + vp;
#pragma unroll
    for (int c = 0; c < 4; ++c) {
      uint4 raw = *(const uint4*)(vz + c * 8);
      const u16* rv = (const u16*)&raw;
#pragma unroll
      for (int e = 0; e < 8; ++e) VT[(vp + c * 8 + e) * 72 + jj] = rv[e];
    }
  }
  __syncthreads();
  f32x4 at[4];
#pragma unroll
  for (int n = 0; n < 4; ++n) at[n] = f32x4{0.f, 0.f, 0.f, 0.f};
  wave_mma<4>(Qs + w * 16 * 72, 72, Ks, 72, 64, at);
  __syncthreads();
#pragma unroll
  for (int n = 0; n < 4; ++n)
#pragma unroll
    for (int j = 0; j < 4; ++j) {
      int i = w * 16 + fq * 4 + j, jc = n * 16 + fr;
      float mval = (i > jc) ? exp2f(lgf * (float)(i - jc)) : ((i < jc) ? exp2f(lgb * (float)(jc - i)) : 2.f);
      Ks[i * 72 + jc] = f2bf(at[n][j] * mval);
    }
  __syncthreads();
  f32x4 o[8];
#pragma unroll
  for (int n = 0; n < 8; ++n) o[n] = f32x4{0.f, 0.f, 0.f, 0.f};
  wave_mma<8>(Ks + w * 16 * 72, 72, VT, 72, 64, o);
  const float* KVb_ = (const float*)(p.ws + OFF_KV);
  for (int dir = 0; dir < 2; ++dir) {
    const float lg = dir ? lgb : lgf;
    const float cdec = exp2f(lg * 64.f);
    const int nprev = dir ? (r.N - 1 - r.n) : r.n;
    __syncthreads();
    {
      float S[32];
#pragma unroll
      for (int e8 = 0; e8 < 32; ++e8) {
        int e = e8 * 256 + tid;
        S[e8] = r.lat ? p.in[4][((((size_t)(r.b * 2 + l) * 2 + dir) * 4 + r.h) * 64) * 128 + e] : 0.f;
      }
      for (int m = 0; m < nprev; ++m) {
        const int ch = dir ? (r.N - 1 - m) : m;
        const float* kvp = KVb_ + ((size_t)(r.kvbase + ch) * 2 + dir) * 8192 + tid;
#pragma unroll
        for (int e8 = 0; e8 < 32; ++e8) S[e8] = S[e8] * cdec + kvp[e8 * 256];
      }
      const bool fin = (!r.lat) && (nprev == r.N - 1);
      const float* kvn = KVb_ + ((size_t)(r.kvbase + r.n) * 2 + dir) * 8192 + tid;
      float* so = (float*)p.out + OUT_SRET + ((((size_t)(r.b * 2 + l) * 2 + dir) * 4 + r.h) * 64) * 128 + tid;
#pragma unroll
      for (int e8 = 0; e8 < 32; ++e8) {
        int e = e8 * 256 + tid, d = e >> 7, v = e & 127;
        ST[v * 72 + d] = f2bf(S[e8]);
        if (fin) so[e8 * 256] = S[e8] * cdec + kvn[e8 * 256];
      }
    }
    __syncthreads();
    f32x4 t2[8];
#pragma unroll
    for (int n = 0; n < 8; ++n) t2[n] = f32x4{0.f, 0.f, 0.f, 0.f};
    wave_mma<8>(Qs + w * 16 * 72, 72, ST, 72, 64, t2);
#pragma unroll
    for (int j = 0; j < 4; ++j) {
      int i = w * 16 + fq * 4 + j;
      float dec = dir ? exp2f(lg * (float)(64 - i)) : exp2f(lg * (float)(i + 1));
#pragma unroll
      for (int n = 0; n < 8; ++n) o[n][j] += dec * t2[n][j];
    }
  }
  const float* gw = p.in[13] + l * 512 + r.h * 128;
  const float* gb = p.in[14] + l * 512 + r.h * 128;
  u16* ORT = (u16*)(p.ws + OFF_ORT);
#pragma unroll
  for (int j = 0; j < 4; ++j) {
    float s = 0.f;
#pragma unroll
    for (int n = 0; n < 8; ++n) s += o[n][j];
    float mu = row16_sum(s) * (1.f / 128.f);
    float q = 0.f;
#pragma unroll
    for (int n = 0; n < 8; ++n) { float d = o[n][j] - mu; q += d * d; }
    float rs = rsqrtf(row16_sum(q) * (1.f / 128.f) + 1e-5f);
    const int tok = tok0 + w * 16 + fq * 4 + j;
#pragma unroll
    for (int n = 0; n < 8; ++n) {
      int v = n * 16 + fr;
      float g = bf2f(Z[(size_t)tok * PIN + 2560 + r.h * 128 + v]);
      float y = ((o[n][j] - mu) * rs * gw[v] + gb[v]) * (g * sigmoidf_(g));
      ORT[(size_t)tok * 512 + r.h * 128 + v] = f2bf(y);
    }
  }
}

DEVI void shifted8(const u16* Z, int tok, bool hasp, bool hasn, int col, const float* mu, float* out) {
  float z[8], zp[8], zn[8];
  unpack8(*(const uint4*)(Z + (size_t)tok * PIN + col), z);
  if (hasp) unpack8(*(const uint4*)(Z + (size_t)(tok - 1) * PIN + col), zp);
  else {
#pragma unroll
    for (int i = 0; i < 8; ++i) zp[i] = 0.f;
  }
  if (hasn) unpack8(*(const uint4*)(Z + (size_t)(tok + 1) * PIN + col), zn);
  else {
#pragma unroll
    for (int i = 0; i < 8; ++i) zn[i] = 0.f;
  }
  float4 m0 = *(const float4*)(mu + col - 3072), m1 = *(const float4*)(mu + col - 3072 + 4);
  float mm[8] = {m0.x, m0.y, m0.z, m0.w, m1.x, m1.y, m1.z, m1.w};
#pragma unroll
  for (int i = 0; i < 8; ++i) out[i] = z[i] + mm[i] * (0.5f * (zp[i] + zn[i]) - z[i]);
}
DEVI void tok_neighbors(int tok, bool& hasp, bool& hasn) {
  if (tok < 4096) { int s = tok & 255; hasp = s > 0; hasn = s < 255; }
  else { int s = (tok - 4096) & 2047; hasp = s > 0; hasn = s < 2047; }
}

DEVI void rwprep_item(const Params& p, int l, int it) {
  const int tid = TIDX, lane = tid & 63, w = tid >> 6, fr = lane & 15, fq = lane >> 4;
  const u16* Z = (const u16*)(p.ws + OFF_Z);
  const float* mu = p.in[15] + l * 1920;
  const int tok0 = (it >> 2) * 64, hq = it & 3;
  u16* R = (u16*)(p.ws + OFF_RWR);
  u16* V = (u16*)(p.ws + OFF_RWV);
  u16* KC = (u16*)(p.ws + OFF_RWKC);
  for (int e = tid; e < 64 * 48; e += 256) {
    int ti = e / 48, u = e % 48, arr = u >> 4, c8 = hq * 128 + (u & 15) * 8;
    int tok = tok0 + ti;
    bool hp, hn;
    tok_neighbors(tok, hp, hn);
    float zs[8];
    shifted8(Z, tok, hp, hn, 3072 + arr * 512 + c8, mu, zs);
    u16* dst = (arr == 0) ? R : (arr == 1 ? KC : V);
    *(uint4*)(dst + (size_t)tok * 512 + c8) = pack8(zs);
  }
  __threadfence();
  __syncthreads();
  bf16x8 af[12];
  {
    const int tok = tok0 + w * 16 + fr;
    bool hp, hn;
    tok_neighbors(tok, hp, hn);
#pragma unroll
    for (int f = 0; f < 12; ++f) {
      int col = 4608 + f * 32 + fq * 8;
      float zs[8];
      shifted8(Z, tok, hp, hn, col, mu, zs);
      if (f < 4) {
#pragma unroll
        for (int i = 0; i < 8; ++i) zs[i] = tanhf(zs[i]);
      } else if (f >= 8) {
#pragma unroll
        for (int i = 0; i < 8; ++i) zs[i] = sigmoidf_(zs[i]);
      }
      uint4 pk = pack8(zs);
      af[f] = __builtin_bit_cast(bf16x8, pk);
    }
  }
  const u16* WUP = (const u16*)(p.ws + OFF_WUPT) + (size_t)l * 2 * 32768;
  const u16* AUP = (const u16*)(p.ws + OFF_AUPT) + (size_t)l * 2 * 32768;
  const u16* GUP = (const u16*)(p.ws + OFF_GUPT) + (size_t)l * 65536;
  float* Wd = (float*)(p.ws + OFF_RWW);
  u16* KK = (u16*)(p.ws + OFF_RWKK);
  u16* KD = (u16*)(p.ws + OFF_RWKD);
  u16* KKA = (u16*)(p.ws + OFF_RWKKA);
  u16* G = (u16*)(p.ws + OFF_RWG);
  u16* BON = (u16*)(p.ws + OFF_RWBON);
  const float* kkw = p.in[21] + l * 512;
  const float* kaw = p.in[22] + l * 512;
  const float* rkw = p.in[23] + l * 512;
  const float* w0 = p.in[16] + l * 1024;
  const float* a0 = p.in[18] + l * 1024;
  for (int h = hq * 2; h < hq * 2 + 2; ++h) {
    float inv[4], sbv[4];
#pragma unroll
    for (int j = 0; j < 4; ++j) {
      const int tok = tok0 + w * 16 + fq * 4 + j;
      float ssq = 0.f, sb = 0.f;
#pragma unroll
      for (int n = 0; n < 4; ++n) {
        int c = h * 64 + n * 16 + fr;
        float rr = bf2f(R[(size_t)tok * 512 + c]);
        float kc = bf2f(KC[(size_t)tok * 512 + c]);
        float kk = kc * kkw[c];
        ssq += kk * kk;
        sb += rr * kc * rkw[c];
      }
      ssq = row16_sum(ssq);
      sbv[j] = row16_sum(sb);
      inv[j] = rsqrtf(fmaxf(ssq, 1e-24f));
    }
#pragma unroll 1
    for (int n = 0; n < 4; ++n) {
      f32x4 acc[5];
#pragma unroll
      for (int m = 0; m < 5; ++m) acc[m] = f32x4{0.f, 0.f, 0.f, 0.f};
      const int c = h * 64 + n * 16 + fr;
#pragma unroll
      for (int ks = 0; ks < 2; ++ks) {
        acc[0] = mfma16(af[0 + ks], *(const bf16x8*)(WUP + (size_t)c * 64 + ks * 32 + fq * 8), acc[0]);
        acc[1] = mfma16(af[2 + ks], *(const bf16x8*)(WUP + 32768 + (size_t)c * 64 + ks * 32 + fq * 8), acc[1]);
        acc[2] = mfma16(af[4 + ks], *(const bf16x8*)(AUP + (size_t)c * 64 + ks * 32 + fq * 8), acc[2]);
        acc[3] = mfma16(af[6 + ks], *(const bf16x8*)(AUP + 32768 + (size_t)c * 64 + ks * 32 + fq * 8), acc[3]);
      }
#pragma unroll
      for (int ks = 0; ks < 4; ++ks)
        acc[4] = mfma16(af[8 + ks], *(const bf16x8*)(GUP + (size_t)c * 128 + ks * 32 + fq * 8), acc[4]);
      const float kkc = kkw[c], ka = kaw[c];
      const float w0f = w0[c], w0b = w0[512 + c], a0f = a0[c], a0b = a0[512 + c];
#pragma unroll
      for (int j = 0; j < 4; ++j) {
        const int tok = tok0 + w * 16 + fq * 4 + j;
        const size_t o = (size_t)tok * 512 + c;
        const float kc = bf2f(KC[o]), vv = bf2f(V[o]);
        const float kkn = kc * kkc * inv[j];
        KK[o] = f2bf(kkn);
        G[o] = f2bf(acc[4][j]);
        BON[o] = f2bf(sbv[j] * vv);
#pragma unroll
        for (int d = 0; d < 2; ++d) {
          float wv = __expf(-0.606531f * sigmoidf_((d ? w0b : w0f) + acc[d][j]));
          float a = sigmoidf_((d ? a0b : a0f) + acc[2 + d][j]);
          Wd[(size_t)d * NTOK * 512 + o] = wv;
          KD[(size_t)d * NTOK * 512 + o] = f2bf(kc * (1.f + (a - 1.f) * ka));
          KKA[(size_t)d * NTOK * 512 + o] = f2bf(kkn * a);
        }
      }
    }
  }
}

template <int KPT>
DEVI void scan_run(const Params& p, int l, bool lat, int b, int h, int dir, int rowbase, unsigned char* sm) {
  constexpr int LPR = 64 / KPT;
  constexpr int CH = 32;
  const int tid = TIDX;
  const int row = rowbase + tid / LPR, ks = (tid % LPR) * KPT;
  const int lir = tid % LPR;
  const int T = lat ? 2048 : 256, seq0 = lat ? 4096 + b * 2048 : b * 256;
  float S[KPT];
  if (lat) {
    const float* s0 = p.in[5] + ((((size_t)(b * 2 + l) * 2 + dir) * 8 + h) * 64 + row) * 64 + ks;
#pragma unroll
    for (int i = 0; i < KPT; ++i) S[i] = s0[i];
  } else {
#pragma unroll
    for (int i = 0; i < KPT; ++i) S[i] = 0.f;
  }
  float* buf = (float*)sm;
  float* obuf = buf + CH * 384;
  const float* Wd = (const float*)(p.ws + OFF_RWW) + (size_t)dir * NTOK * 512;
  const u16* R = (const u16*)(p.ws + OFF_RWR);
  const u16* V = (const u16*)(p.ws + OFF_RWV);
  const u16* KK = (const u16*)(p.ws + OFF_RWKK);
  const u16* KD = (const u16*)(p.ws + OFF_RWKD) + (size_t)dir * NTOK * 512;
  const u16* KKA = (const u16*)(p.ws + OFF_RWKKA) + (size_t)dir * NTOK * 512;
  float* O = (float*)(p.ws + OFF_OF) + (size_t)dir * NTOK * 512;
  const int pst = tid >> 3, c8 = (tid & 7) * 8;
  const int nch = T / CH;
  float4 qw0, qw1; uint4 qr, qk, qv, qd, qa;
  auto issue = [&](int chunk) {
    int s_ = chunk * CH + pst;
    int tok_ = dir ? (seq0 + T - 1 - s_) : (seq0 + s_);
    size_t o_ = (size_t)tok_ * 512 + h * 64 + c8;
    qw0 = *(const float4*)(Wd + o_); qw1 = *(const float4*)(Wd + o_ + 4);
    qr = *(const uint4*)(R + o_); qk = *(const uint4*)(KK + o_); qv = *(const uint4*)(V + o_);
    qd = *(const uint4*)(KD + o_); qa = *(const uint4*)(KKA + o_);
  };
  auto commit = [&]() {
    float* bp = buf + pst * 384 + c8;
    float t[8];
    *(float4*)bp = qw0; *(float4*)(bp + 4) = qw1;
    unpack8(qr, t); *(float4*)(bp + 64) = *(float4*)t; *(float4*)(bp + 68) = *(float4*)(t + 4);
    unpack8(qk, t); *(float4*)(bp + 128) = *(float4*)t; *(float4*)(bp + 132) = *(float4*)(t + 4);
    unpack8(qv, t); *(float4*)(bp + 192) = *(float4*)t; *(float4*)(bp + 196) = *(float4*)(t + 4);
    unpack8(qd, t); *(float4*)(bp + 256) = *(float4*)t; *(float4*)(bp + 260) = *(float4*)(t + 4);
    unpack8(qa, t); *(float4*)(bp + 320) = *(float4*)t; *(float4*)(bp + 324) = *(float4*)(t + 4);
  };
  auto compute = [&](int chunk) {
    if constexpr (KPT == 4) {
      typedef float f2 __attribute__((ext_vector_type(2)));
      f2 S01 = {S[0], S[1]}, S23 = {S[2], S[3]};
      float4 w4 = *(const float4*)(buf + ks), r4 = *(const float4*)(buf + 64 + ks), k4 = *(const float4*)(buf + 128 + ks),
             d4 = *(const float4*)(buf + 256 + ks), a4 = *(const float4*)(buf + 320 + ks);
      float vr = buf[192 + row];
#pragma unroll 1
      for (int sb = 0; sb < CH; sb += 16)
#pragma unroll
      for (int si = 0; si < 16; ++si) {
        const int s = sb + si;
        float4 nw = w4, nr = r4, nk = k4, nd = d4, na = a4;
        float nv = vr;
        if (s + 1 < CH) {
          const float* bp = buf + (s + 1) * 384;
          nw = *(const float4*)(bp + ks); nr = *(const float4*)(bp + 64 + ks); nk = *(const float4*)(bp + 128 + ks);
          nd = *(const float4*)(bp + 256 + ks); na = *(const float4*)(bp + 320 + ks);
          nv = bp[192 + row];
        }
        const f2 w01 = {w4.x, w4.y}, w23 = {w4.z, w4.w}, k01 = {k4.x, k4.y}, k23 = {k4.z, k4.w};
        const f2 d01 = {d4.x, d4.y}, d23 = {d4.z, d4.w}, a01 = {a4.x, a4.y}, a23 = {a4.z, a4.w};
        const f2 r01 = {r4.x, r4.y}, r23 = {r4.z, r4.w};
        f2 m = S01 * k01 + S23 * k23;
        const f2 pre01 = S01 * w01 + d01 * vr, pre23 = S23 * w23 + d23 * vr;
        float sk = row16_sum(m.x + m.y);
        S01 = pre01 - a01 * sk;
        S23 = pre23 - a23 * sk;
        const f2 q = S01 * r01 + S23 * r23;
        const float qq = quad_sum(q.x + q.y);
        obuf[s * 64 + (tid >> 2)] = qq;
        w4 = nw; r4 = nr; k4 = nk; d4 = nd; a4 = na; vr = nv;
      }
      S[0] = S01.x; S[1] = S01.y; S[2] = S23.x; S[3] = S23.y;
#pragma unroll
      for (int hh = 0; hh < 2; ++hh) {
        const int s = hh * 16 + lir;
        const float4 o4 = *(const float4*)(obuf + s * 64 + ((tid >> 4) << 2));
        const float o = (o4.x + o4.y) + (o4.z + o4.w);
        int st = chunk * CH + s;
        int tok = dir ? (seq0 + T - 1 - st) : (seq0 + st);
        O[(size_t)tok * 512 + h * 64 + row] = o;
      }
      return;
    } else {
      float myo = 0.f;
#pragma unroll 1
      for (int sb = 0; sb < CH; sb += 4)
#pragma unroll
        for (int si = 0; si < 4; ++si) {
          const int s = sb + si;
          const float* bp = buf + s * 384;
          float wv[KPT], rv[KPT], kkv[KPT], kdv[KPT], kav[KPT];
#pragma unroll
          for (int i = 0; i < KPT; i += 4) {
            *(float4*)(wv + i) = *(const float4*)(bp + ks + i);
            *(float4*)(rv + i) = *(const float4*)(bp + 64 + ks + i);
            *(float4*)(kkv + i) = *(const float4*)(bp + 128 + ks + i);
            *(float4*)(kdv + i) = *(const float4*)(bp + 256 + ks + i);
            *(float4*)(kav + i) = *(const float4*)(bp + 320 + ks + i);
          }
          const float vr = bp[192 + row];
          float sk = 0.f;
#pragma unroll
          for (int i = 0; i < KPT; ++i) sk += S[i] * kkv[i];
          sk = quad_sum(sk);
          float o = 0.f;
#pragma unroll
          for (int i = 0; i < KPT; ++i) {
            S[i] = S[i] * wv[i] - sk * kav[i] + vr * kdv[i];
            o += S[i] * rv[i];
          }
          o = quad_sum(o);
          myo = (si == lir) ? o : myo;
          if (si == 3) {
            int st = chunk * CH + sb + lir;
            int tok = dir ? (seq0 + T - 1 - st) : (seq0 + st);
            O[(size_t)tok * 512 + h * 64 + row] = myo;
          }
        }
    }
  };
  issue(0);
  for (int c0 = 0; c0 < nch; ++c0) {
    asm volatile("s_waitcnt lgkmcnt(0)\n\ts_barrier" ::: "memory");
    commit();
    asm volatile("s_waitcnt lgkmcnt(0)\n\ts_barrier" ::: "memory");
    if (c0 + 1 < nch) issue(c0 + 1);
    compute(c0);
  }
  if (!lat) {
    float* so = (float*)p.out + OUT_SRW + ((((size_t)(b * 2 + l) * 2 + dir) * 8 + h) * 64 + row) * 64 + ks;
#pragma unroll
    for (int i = 0; i < KPT; ++i) so[i] = S[i];
  }
}

DEVI void attn_item(const Params& p, int l, int it, unsigned char* sm) {
  const int tid = TIDX, lane = tid & 63, w = tid >> 6, fr = lane & 15, fq = lane >> 4;
  u16* Ks = (u16*)sm;
  u16* VT = (u16*)(sm + 9216);
  float* rpbs = (float*)(sm + 18432);
  const u16* Z = (const u16*)(p.ws + OFF_Z);
  const bool lat = it < 512;
  int b, h, r = 0, seqbase, qtok0;
  if (lat) { b = it >> 8; h = (it >> 5) & 7; r = it & 31; seqbase = 4096 + b * 2048; qtok0 = seqbase + r * 64; }
  else { int j = it - 512; b = j >> 5; h = (j >> 2) & 7; int qb = j & 3; seqbase = b * 256; qtok0 = seqbase + qb * 64; }
  bf16x8 qf[2];
#pragma unroll
  for (int ks = 0; ks < 2; ++ks) qf[ks] = *(const bf16x8*)(Z + (size_t)(qtok0 + w * 16 + fr) * PIN + h * 64 + ks * 32 + fq * 8);
  if (lat)
    for (int i = tid; i < 465; i += 256) rpbs[i] = p.in[11][(size_t)(l * 8 + h) * 465 + i];
  float m_run = -3e38f, l_run = 0.f;
  f32x4 o[4];
#pragma unroll
  for (int d = 0; d < 4; ++d) o[d] = f32x4{0.f, 0.f, 0.f, 0.f};
  const int ntiles = lat ? 16 : 4;
  const int row_start = lat ? clampi(r - 4, 0, 24) : 0;
  const int cbs = lat ? clampi(w * 16 - 8, 0, 32) : 0;
  for (int ti = 0; ti < ntiles; ++ti) {
    __syncthreads();
    const bool ctxtile = lat && ti < 8;
    if (ctxtile) {
      const float* kc = p.in[2] + ((((size_t)b * 2 + l) * 8 + h) * 512 + ti * 64) * 64;
      const float* vc = p.in[3] + ((((size_t)b * 2 + l) * 8 + h) * 512 + ti * 64) * 64;
      {
        const int key = tid >> 2, dp = (tid & 3) * 16;
        float t[16];
#pragma unroll
        for (int c = 0; c < 4; ++c) *(float4*)(t + c * 4) = *(const float4*)(kc + key * 64 + dp + c * 4);
        *(uint4*)(Ks + key * 72 + dp) = pack8(t);
        *(uint4*)(Ks + key * 72 + dp + 8) = pack8(t + 8);
      }
      {
        const int key = tid & 63, dp = (tid >> 6) * 16;
        float t[16];
#pragma unroll
        for (int c = 0; c < 4; ++c) *(float4*)(t + c * 4) = *(const float4*)(vc + key * 64 + dp + c * 4);
#pragma unroll
        for (int i = 0; i < 16; ++i) VT[(dp + i) * 72 + key] = f2bf(t[i]);
      }
    } else {
      const int trow = lat ? (row_start + ti - 8) : ti;
      const u16* zr = Z + (size_t)(seqbase + trow * 64) * PIN;
      {
        const int key = tid >> 2, dp = (tid & 3) * 16;
        const u16* src = zr + (size_t)key * PIN + 512 + h * 64 + dp;
        *(uint4*)(Ks + key * 72 + dp) = *(const uint4*)src;
        *(uint4*)(Ks + key * 72 + dp + 8) = *(const uint4*)(src + 8);
      }
      {
        const int key = tid & 63, dp = (tid >> 6) * 16;
        const u16* src = zr + (size_t)key * PIN + 1024 + h * 64 + dp;
        uint4 r0 = *(const uint4*)src, r1 = *(const uint4*)(src + 8);
        const u16* a0 = (const u16*)&r0;
        const u16* a1 = (const u16*)&r1;
#pragma unroll
        for (int i = 0; i < 8; ++i) { VT[(dp + i) * 72 + key] = a0[i]; VT[(dp + 8 + i) * 72 + key] = a1[i]; }
      }
    }
    __syncthreads();
    const bool win = lat && !ctxtile;
    const int nsteps = win ? 1 : 2;
    for (int st = 0; st < nsteps; ++st) {
      const int ko = win ? cbs : st * 32;
      f32x4 s0 = f32x4{0.f, 0.f, 0.f, 0.f}, s1 = s0;
#pragma unroll
      for (int ks = 0; ks < 2; ++ks) {
        bf16x8 a0 = *(const bf16x8*)(Ks + (ko + fr) * 72 + ks * 32 + fq * 8);
        bf16x8 a1 = *(const bf16x8*)(Ks + (ko + 16 + fr) * 72 + ks * 32 + fq * 8);
        s0 = mfma16(a0, qf[ks], s0);
        s1 = mfma16(a1, qf[ks], s1);
      }
      float sv[8];
#pragma unroll
      for (int j = 0; j < 4; ++j) { sv[j] = s0[j] * 0.125f; sv[4 + j] = s1[j] * 0.125f; }
      if (win) {
        const int qc = w * 16 + fr;
        const int dr = (row_start + ti - 8) - r + 7;
        const int qs = clampi(qc - 8, 0, 48);
#pragma unroll
        for (int e = 0; e < 8; ++e) {
          int kc_ = ko + ((e < 4) ? (fq * 4 + e) : (16 + fq * 4 + e - 4));
          int dc = clampi(kc_ - qc, -15, 15) + 15;
          int rel = kc_ - qs;
          sv[e] = (rel >= 0 && rel < 16) ? (sv[e] + rpbs[dr * 31 + dc]) : -1e30f;
        }
      }
      float mx = sv[0];
#pragma unroll
      for (int e = 1; e < 8; ++e) mx = fmaxf(mx, sv[e]);
      mx = fmaxf(mx, __shfl_xor(mx, 16));
      mx = fmaxf(mx, __shfl_xor(mx, 32));
      const float m_new = fmaxf(m_run, mx);
      const float alpha = __expf(m_run - m_new);
      float pe[8], ps = 0.f;
#pragma unroll
      for (int e = 0; e < 8; ++e) { pe[e] = __expf(sv[e] - m_new); ps += pe[e]; }
      l_run = l_run * alpha + ps;
      m_run = m_new;
#pragma unroll
      for (int d = 0; d < 4; ++d) o[d] *= alpha;
      uint4 pk = pack8(pe);
      bf16x8 pb = __builtin_bit_cast(bf16x8, pk);
#pragma unroll
      for (int d = 0; d < 4; ++d) {
        uint2 lo = *(const uint2*)(VT + (d * 16 + fr) * 72 + ko + fq * 4);
        uint2 hi = *(const uint2*)(VT + (d * 16 + fr) * 72 + ko + 16 + fq * 4);
        uint4 vv; vv.x = lo.x; vv.y = lo.y; vv.z = hi.x; vv.w = hi.y;
        o[d] = mfma16(__builtin_bit_cast(bf16x8, vv), pb, o[d]);
      }
    }
  }
  float lt = l_run + __shfl_xor(l_run, 16);
  lt += __shfl_xor(lt, 32);
  const float inv = 1.f / lt;
  u16* ONA = (u16*)(p.ws + OFF_ONA);
  const int tok = qtok0 + w * 16 + fr;
#pragma unroll
  for (int d = 0; d < 4; ++d) {
    uint2 ov; ov.x = cvtpk(o[d][0] * inv, o[d][1] * inv); ov.y = cvtpk(o[d][2] * inv, o[d][3] * inv);
    *(uint2*)(ONA + (size_t)tok * 512 + h * 64 + d * 16 + fq * 4) = ov;
  }
}

constexpr int MIX_NSCAN_LAT = 128, MIX_NSCAN_CTX = 256, MIX_NATT = 1024, MIX_NRET = 512;
constexpr int MIX_TOTAL = MIX_NSCAN_LAT + MIX_NSCAN_CTX + MIX_NATT + MIX_NRET;
#ifndef ONLYP
#define ONLYP -1
#endif
#define PH_ON(x) (ONLYP < 0 || ONLYP == (x))
DEVI void mix_item(const Params& p, int l, int it, unsigned char* sm) {
  if (it < MIX_NSCAN_LAT) {
    int ch = it >> 2, rq = it & 3;
    if (PH_ON(12)) scan_run<4>(p, l, true, ch >> 4, ch & 7, (ch >> 3) & 1, rq * 16, sm);
    return;
  }
  it -= MIX_NSCAN_LAT;
  if (it < MIX_NSCAN_CTX) { if (PH_ON(13)) scan_run<16>(p, l, false, it >> 4, it & 7, (it >> 3) & 1, 0, sm); return; }
  it -= MIX_NSCAN_CTX;
  if (it < MIX_NATT) { if (PH_ON(14)) attn_item(p, l, it, sm); return; }
  it -= MIX_NATT;
  if (PH_ON(15)) ret3_item(p, l, it, sm);
}

DEVI void fin_item(const Params& p, int l, int it) {
  const int tid = TIDX;
  const int tok = it * 2 + (tid >> 7), c4 = (tid & 127) * 4;
  const size_t o = (size_t)tok * 512 + c4;
  float4 a = *(const float4*)((const float*)(p.ws + OFF_OF) + o);
  float4 b = *(const float4*)((const float*)(p.ws + OFF_OF) + (size_t)NTOK * 512 + o);
  float x[4] = {a.x + b.x, a.y + b.y, a.z + b.z, a.w + b.w};
  float mu = row16_sum(x[0] + x[1] + x[2] + x[3]) * (1.f / 64.f);
  float q = 0.f;
#pragma unroll
  for (int i = 0; i < 4; ++i) { float d = x[i] - mu; q += d * d; }
  float rs = rsqrtf(row16_sum(q) * (1.f / 64.f) + 64e-5f);
  float4 gw = *(const float4*)(p.in[24] + l * 512 + c4), gb = *(const float4*)(p.in[25] + l * 512 + c4);
  float gwv[4] = {gw.x, gw.y, gw.z, gw.w}, gbv[4] = {gb.x, gb.y, gb.z, gb.w};
  float bon[4], g[4];
  unpack4(*(const uint2*)((const u16*)(p.ws + OFF_RWBON) + o), bon);
  unpack4(*(const uint2*)((const u16*)(p.ws + OFF_RWG) + o), g);
  float y[4];
#pragma unroll
  for (int i = 0; i < 4; ++i) y[i] = ((x[i] - mu) * rs * gwv[i] + gbv[i] + bon[i]) * g[i];
  uint2 ov; ov.x = cvtpk(y[0], y[1]); ov.y = cvtpk(y[2], y[3]);
  *(uint2*)((u16*)(p.ws + OFF_ORW) + o) = ov;
}

DEVI void ln2_item(const Params& p, int l, int it) {
  const int lane = TIDX & 63, w = TIDX >> 6;
  const int tok = it * 4 + w;
  const float* y = (const float*)(p.ws + OFF_Y) + (size_t)tok * 1024;
  const float* mod = (const float*)(p.ws + OFF_MOD) + ((size_t)l * 3 + modrow(tok)) * 6144;
  float v[16];
  float s = 0.f;
#pragma unroll
  for (int i = 0; i < 4; ++i) { *(float4*)(v + i * 4) = *(const float4*)(y + lane * 4 + 256 * i); }
#pragma unroll
  for (int i = 0; i < 16; ++i) s += v[i];
  float mu = wave_sum(s) * (1.f / 1024.f);
  float q = 0.f;
#pragma unroll
  for (int i = 0; i < 16; ++i) { float d = v[i] - mu; q += d * d; }
  float rs = rsqrtf(wave_sum(q) * (1.f / 1024.f) + 1e-5f);
  float* X1 = (float*)(p.ws + OFF_X1) + (size_t)tok * 1024;
  s = 0.f;
#pragma unroll
  for (int i = 0; i < 4; ++i) {
    int c = lane * 4 + 256 * i;
    float4 g = *(const float4*)(p.in[28] + l * 1024 + c), bb = *(const float4*)(p.in[29] + l * 1024 + c);
    v[i * 4 + 0] = (v[i * 4 + 0] - mu) * rs * g.x + bb.x;
    v[i * 4 + 1] = (v[i * 4 + 1] - mu) * rs * g.y + bb.y;
    v[i * 4 + 2] = (v[i * 4 + 2] - mu) * rs * g.z + bb.z;
    v[i * 4 + 3] = (v[i * 4 + 3] - mu) * rs * g.w + bb.w;
    *(float4*)(X1 + c) = *(float4*)(v + i * 4);
    s += v[i * 4] + v[i * 4 + 1] + v[i * 4 + 2] + v[i * 4 + 3];
  }
  mu = wave_sum(s) * (1.f / 1024.f);
  q = 0.f;
#pragma unroll
  for (int i = 0; i < 16; ++i) { float d = v[i] - mu; q += d * d; }
  rs = rsqrtf(wave_sum(q) * (1.f / 1024.f) + 1e-5f);
  u16* H2 = (u16*)(p.ws + OFF_H2) + (size_t)tok * 1024;
#pragma unroll
  for (int i = 0; i < 4; ++i) {
    int c = lane * 4 + 256 * i;
    float4 sh = *(const float4*)(mod + 3072 + c), sc = *(const float4*)(mod + 4096 + c);
    uint2 o;
    o.x = cvtpk((v[i * 4] - mu) * rs * (1.f + sc.x) + sh.x, (v[i * 4 + 1] - mu) * rs * (1.f + sc.y) + sh.y);
    o.y = cvtpk((v[i * 4 + 2] - mu) * rs * (1.f + sc.z) + sh.z, (v[i * 4 + 3] - mu) * rs * (1.f + sc.w) + sh.w);
    *(uint2*)(H2 + c) = o;
  }
}

DEVI int f2ord(float f) { int i = __float_as_int(f); return i ^ ((i >> 31) & 0x7fffffff); }
DEVI float ord2f(int i) { return __int_as_float(i ^ ((i >> 31) & 0x7fffffff)); }
DEVI void insert16(int (&t)[16], int x) {
#pragma unroll
  for (int i = 0; i < 16; ++i) { int hi = max(t[i], x); x = min(t[i], x); t[i] = hi; }
}
DEVI void route_item(const Params& p, int l, int it, unsigned char* sm) {
  const int tid = TIDX, lane = tid & 63, w = tid >> 6;
  const int g = w >> 1, pp = w & 1;
  const int tb = it >> 3, h = it & 7;
  const int tok = tb * 128 + g * 64 + lane;
  float* kl = (float*)sm;
  const float* Q = (const float*)(p.ws + OFF_Q) + (size_t)tok * 1024 + h * 128 + pp * 64;
  float q[64];
#pragma unroll
  for (int i = 0; i < 16; ++i) *(float4*)(q + i * 4) = *(const float4*)(Q + i * 4);
  int T[16];
#pragma unroll
  for (int i = 0; i < 16; ++i) T[i] = (int)0x80000000;
  const float* keys = p.in[33] + (size_t)((l * 8 + h) * 2) * 8192;
  for (int half = 0; half < 2; ++half) {
    __syncthreads();
#pragma unroll
    for (int i = 0; i < 8; ++i) {
      int e = (i * 256 + tid) * 4;
      int ps = e >> 12, r = e & 4095;
      *(float4*)(kl + e) = *(const float4*)(keys + (size_t)ps * 8192 + half * 4096 + r);
    }
    __syncthreads();
    const float* kb = kl + pp * 4096;
#pragma unroll 2
    for (int k = 0; k < 64; ++k) {
      const float* kp = kb + k * 64;
      float s0 = 0.f, s1 = 0.f, s2 = 0.f, s3 = 0.f;
#pragma unroll
      for (int d = 0; d < 64; d += 4) {
        float4 kv = *(const float4*)(kp + d);
        s0 += q[d] * kv.x; s1 += q[d + 1] * kv.y; s2 += q[d + 2] * kv.z; s3 += q[d + 3] * kv.w;
      }
      float sc = (s0 + s1) + (s2 + s3);
      int bits = (f2ord(sc) & ~127) | (127 - (half * 64 + k));
      insert16(T, bits);
    }
  }
  __syncthreads();
  int* xb = (int*)sm;
  if (pp == 1) {
#pragma unroll
    for (int i = 0; i < 16; ++i) xb[(g * 16 + i) * 64 + lane] = T[i];
  }
  __syncthreads();
  if (pp == 0) {
    int T1[16];
#pragma unroll
    for (int i = 0; i < 16; ++i) T1[i] = xb[(g * 16 + i) * 64 + lane];
    int F[16];
#pragma unroll
    for (int i = 0; i < 16; ++i) F[i] = (int)0x80000000;
#pragma unroll
    for (int i = 0; i < 16; ++i) {
#pragma unroll
      for (int j = 0; j < 16; ++j) {
        if ((i + 1) * (j + 1) <= 16) {
          float c = ord2f(T[i] & ~127) + ord2f(T1[j] & ~127);
          int bits = (f2ord(c) & ~255) | (255 - (i * 16 + j));
          insert16(F, bits);
        }
      }
    }
    float fs[16], den = 0.f;
    const float f0 = ord2f(F[0] & ~255);
#pragma unroll
    for (int i = 0; i < 16; ++i) { fs[i] = __expf(ord2f(F[i] & ~255) - f0); den += fs[i]; }
    const float inv = 1.f / den;
    int* EIDX = (int*)(p.ws + OFF_EIDX) + (size_t)tok * 128 + h * 16;
    float* GATE = (float*)(p.ws + OFF_GATE) + (size_t)tok * 128 + h * 16;
    int eo[16]; float go[16];
#pragma unroll
    for (int i = 0; i < 16; ++i) {
      int pos = 255 - (F[i] & 255);
      int i0 = pos >> 4, j0 = pos & 15;
      int k0 = 0, k1 = 0;
#pragma unroll
      for (int c = 0; c < 16; ++c) {
        int a0 = 127 - (T[c] & 127), a1 = 127 - (T1[c] & 127);
        k0 = (i0 == c) ? a0 : k0;
        k1 = (j0 == c) ? a1 : k1;
      }
      eo[i] = k0 * 128 + k1;
      go[i] = fs[i] * inv;
    }
#pragma unroll
    for (int i = 0; i < 16; i += 4) {
      *(int4*)(EIDX + i) = make_int4(eo[i], eo[i + 1], eo[i + 2], eo[i + 3]);
      *(float4*)(GATE + i) = make_float4(go[i], go[i + 1], go[i + 2], go[i + 3]);
    }
  }
}

DEVI void fp8x16_to_f32(int4 r, float* f) {
  const int w[4] = {r.x, r.y, r.z, r.w};
#pragma unroll
  for (int i = 0; i < 4; ++i) {
    f32x2_ lo = __builtin_amdgcn_cvt_pk_f32_fp8(w[i], false);
    f32x2_ hi = __builtin_amdgcn_cvt_pk_f32_fp8(w[i], true);
    f[i * 4] = lo.x; f[i * 4 + 1] = lo.y; f[i * 4 + 2] = hi.x; f[i * 4 + 3] = hi.y;
  }
}
DEVI void expert_item(const Params& p, int l, int it) {
  const int lane = TIDX & 63;
  const int w = __builtin_amdgcn_readfirstlane(TIDX >> 6);
  const int tok = it * 4 + w;
  const u16* H2 = (const u16*)(p.ws + OFF_H2) + (size_t)tok * 1024;
  float hv[16];
  unpack8(*(const uint4*)(H2 + lane * 16), hv);
  unpack8(*(const uint4*)(H2 + lane * 16 + 8), hv + 8);
  const int* EIDX = (const int*)(p.ws + OFF_EIDX) + (size_t)tok * 128;
  const float* GATE = (const float*)(p.ws + OFF_GATE) + (size_t)tok * 128;
  const unsigned char* UB = (const unsigned char*)(p.ws + OFF_UB) + (size_t)l * UV_LSTRIDE;
  const unsigned char* VB = (const unsigned char*)(p.ws + OFF_VB) + (size_t)l * UV_LSTRIDE;
  const float* USC = (const float*)(p.ws + OFF_SC) + (0 * 2 + l) * 16384;
  const float* VSC = (const float*)(p.ws + OFF_SC) + (1 * 2 + l) * 16384;
  float f[16];
#pragma unroll
  for (int i = 0; i < 16; ++i) f[i] = 0.f;
  const int ei0 = EIDX[lane], ei1 = EIDX[64 + lane];
  const float ga0 = GATE[lane] * VSC[ei0], ga1 = GATE[64 + lane] * VSC[ei1];
  const float us0 = USC[ei0], us1 = USC[ei1];
  int4 ua[8], va[8], ub[8], vb[8];
#define EXP_LOAD(UBUF, VBUF, G)                                                                      \
  {                                                                                                  \
    const int src_ = ((G) < 8) ? ei0 : ei1;                                                          \
    _Pragma("unroll") for (int j = 0; j < 8; ++j) {                                                  \
      const int idx = __builtin_amdgcn_readlane(src_, (((G) & 7) << 3) + j);                         \
      UBUF[j] = *(const int4*)(UB + (size_t)idx * 1024 + lane * 16);                                 \
      VBUF[j] = *(const int4*)(VB + (size_t)idx * 1024 + lane * 16);                                 \
    }                                                                                                \
  }
#define EXP_COMP(UBUF, VBUF, G)                                                                      \
  {                                                                                                  \
    const float gsrc_ = ((G) < 8) ? ga0 : ga1;                                                       \
    const float usrc_ = ((G) < 8) ? us0 : us1;                                                       \
    _Pragma("unroll") for (int j = 0; j < 8; ++j) {                                                  \
      const int ln_ = (((G) & 7) << 3) + j;                                                          \
      const float gate = __int_as_float(__builtin_amdgcn_readlane(__float_as_int(gsrc_), ln_));     \
      const float us = __int_as_float(__builtin_amdgcn_readlane(__float_as_int(usrc_), ln_));       \
      float uu[16];                                                                                  \
      fp8x16_to_f32(UBUF[j], uu);                                                                    \
      float d0 = 0.f, d1 = 0.f;                                                                      \
      _Pragma("unroll") for (int i = 0; i < 16; i += 2) { d0 += uu[i] * hv[i]; d1 += uu[i + 1] * hv[i + 1]; } \
      float dd = row16_sum(d0 + d1);                                                                 \
      const float r0 = __int_as_float(__builtin_amdgcn_readlane(__float_as_int(dd), 0));            \
      const float r1 = __int_as_float(__builtin_amdgcn_readlane(__float_as_int(dd), 16));           \
      const float r2 = __int_as_float(__builtin_amdgcn_readlane(__float_as_int(dd), 32));           \
      const float r3 = __int_as_float(__builtin_amdgcn_readlane(__float_as_int(dd), 48));           \
      const float d = ((r0 + r1) + (r2 + r3)) * us;                                                  \
      const float act = 0.5f * d * (1.f + erff(d * 0.70710678118654752f)) * gate;                    \
      float vv[16];                                                                                  \
      fp8x16_to_f32(VBUF[j], vv);                                                                    \
      _Pragma("unroll") for (int i = 0; i < 16; ++i) f[i] += act * vv[i];                            \
    }                                                                                                \
  }
  EXP_LOAD(ua, va, 0);
#pragma unroll 1
  for (int g = 0; g < 16; g += 2) {
    EXP_LOAD(ub, vb, g + 1);
    EXP_COMP(ua, va, g);
    if (g + 2 < 16) EXP_LOAD(ua, va, g + 2);
    EXP_COMP(ub, vb, g + 1);
  }
#undef EXP_LOAD
#undef EXP_COMP
  const float* X1 = (const float*)(p.ws + OFF_X1) + (size_t)tok * 1024 + lane * 16;
  const float* mod = (const float*)(p.ws + OFF_MOD) + ((size_t)l * 3 + modrow(tok)) * 6144 + lane * 16;
  float y[16];
  float s = 0.f;
#pragma unroll
  for (int c = 0; c < 4; ++c) {
    float4 x = *(const float4*)(X1 + c * 4), gt = *(const float4*)(mod + 5120 + c * 4);
    int o = c * 4;
    y[o] = ALPHA * x.x + gt.x * f[o]; y[o + 1] = ALPHA * x.y + gt.y * f[o + 1];
    y[o + 2] = ALPHA * x.z + gt.z * f[o + 2]; y[o + 3] = ALPHA * x.w + gt.w * f[o + 3];
    s += y[o] + y[o + 1] + y[o + 2] + y[o + 3];
  }
  float mu = wave_sum(s) * (1.f / 1024.f);
  float q = 0.f;
#pragma unroll
  for (int i = 0; i < 16; ++i) { float d = y[i] - mu; q += d * d; }
  float rs = rsqrtf(wave_sum(q) * (1.f / 1024.f) + 1e-5f);
  float* xo = ((l == 1) ? ((float*)p.out + OUT_Y + (size_t)tok * 1024) : ((float*)(p.ws + OFF_X) + (size_t)tok * 1024)) + lane * 16;
  s = 0.f;
#pragma unroll
  for (int c = 0; c < 4; ++c) {
    int o = c * 4;
    float4 g = *(const float4*)(p.in[30] + l * 1024 + lane * 16 + o), bb = *(const float4*)(p.in[31] + l * 1024 + lane * 16 + o);
    y[o] = (y[o] - mu) * rs * g.x + bb.x; y[o + 1] = (y[o + 1] - mu) * rs * g.y + bb.y;
    y[o + 2] = (y[o + 2] - mu) * rs * g.z + bb.z; y[o + 3] = (y[o + 3] - mu) * rs * g.w + bb.w;
    *(float4*)(xo + o) = make_float4(y[o], y[o + 1], y[o + 2], y[o + 3]);
    s += y[o] + y[o + 1] + y[o + 2] + y[o + 3];
  }
  if (l == 0) {
    const float* mod1 = (const float*)(p.ws + OFF_MOD) + ((size_t)3 + modrow(tok)) * 6144 + lane * 16;
    mu = wave_sum(s) * (1.f / 1024.f);
    q = 0.f;
#pragma unroll
    for (int i = 0; i < 16; ++i) { float d = y[i] - mu; q += d * d; }
    rs = rsqrtf(wave_sum(q) * (1.f / 1024.f) + 1e-5f);
    u16* H = (u16*)(p.ws + OFF_H) + (size_t)tok * 1024 + lane * 16;
    float t[16];
#pragma unroll
    for (int c = 0; c < 4; ++c) {
      float4 sh = *(const float4*)(mod1 + c * 4), sc = *(const float4*)(mod1 + 1024 + c * 4);
      int o = c * 4;
      t[o] = (y[o] - mu) * rs * (1.f + sc.x) + sh.x; t[o + 1] = (y[o + 1] - mu) * rs * (1.f + sc.y) + sh.y;
      t[o + 2] = (y[o + 2] - mu) * rs * (1.f + sc.z) + sh.z; t[o + 3] = (y[o + 3] - mu) * rs * (1.f + sc.w) + sh.w;
    }
    *(uint4*)(H) = pack8(t);
    *(uint4*)(H + 8) = pack8(t + 8);
  }
}

constexpr int NPHASES = 22;
DEVI int phase_total(int idx) {
  if (idx == 0) return P0_TOTAL;
  if (idx == 1) return 2048;
  const int l = (idx - 2) / 10, t = (idx - 2) % 10;
  switch (t) {
    case 0: return 0;
    case 1: return 512 + 512;
    case 2: return MIX_TOTAL + (l == 0 ? (P0_NT + P0_NUV) : 0);
    case 3: return 4096;
    case 4: return 0;
    case 5: return 0;
    case 6: return 2048;
    case 7: return 0;
    case 8: return 512;
    default: return 2048;
  }
}
DEVI int phase_xcd_total(int idx) {
  if (idx < 2) return 0;
  const int t = (idx - 2) % 10;
  if (t == 0) return 504;
  if (t == 4 || t == 5 || t == 7) return 64;
  return 0;
}
DEVI void phase_item_x(const Params& p, int idx, int xcd, int q, unsigned char* sm) {
  const int l = (idx - 2) / 10, t = (idx - 2) % 10;
  const int it = (q >> 3) * 64 + xcd * 8 + (q & 7);
  if (t == 0) { if (PH_ON(2)) g1_item(p, l, it, sm); }
  else if (t == 4) { if (PH_ON(6)) g2_item(p, l, it, sm); }
  else if (t == 5) { if (PH_ON(7)) g3_item(p, l, it, sm); }
  else { if (PH_ON(9)) g4_item(p, l, it, sm); }
}
DEVI void phase_item(const Params& p, int idx, int it, unsigned char* sm) {
  if (idx == 0) { if (PH_ON(0)) phase0_item(p, it, sm); return; }
  if (idx == 1) { if (PH_ON(1)) ln1_item(p, it); return; }
  const int l = (idx - 2) / 10, t = (idx - 2) % 10;
  switch (t) {
    case 0: break;
    case 1: if (it < 512) { if (PH_ON(3)) rwprep_item(p, l, it); } else { if (PH_ON(4)) ret1_item(p, l, it - 512, sm); } break;
    case 2:
      if (it < MIX_TOTAL) mix_item(p, l, it, sm);
      else if (it < MIX_TOTAL + P0_NT) p0_tile(p, it - MIX_TOTAL, 1, sm);
      else convert_uv_item(p, 1, it - MIX_TOTAL - P0_NT);
      break;
    case 3: if (PH_ON(5)) fin_item(p, l, it); break;
    case 4: break;
    case 5: break;
    case 6: if (PH_ON(8)) ln2_item(p, l, it); break;
    case 7: break;
    case 8: if (PH_ON(10)) route_item(p, l, it, sm); break;
    default: if (PH_ON(11)) expert_item(p, l, it); break;
  }
}

#define XB_TMO      128
#define XB_XCNT(j)  (256  + 64 * (j))
#define XB_XSUB(j)  (1280 + 64 * (j))
#define XB_XGEN(j)  (2304 + 64 * (j))
#define XB_TOP      3328
#define XB_TOPGEN   3392
#define XCD_BAR_WORDS 3456
#define XB_SPIN_CAP (1u << 18)
#define LAS __attribute__((address_space(3)))
DEVI unsigned xb_ld(unsigned* p) { return __hip_atomic_load(p, __ATOMIC_RELAXED, __HIP_MEMORY_SCOPE_AGENT); }
DEVI unsigned xb_add(unsigned* p, unsigned v) { return __hip_atomic_fetch_add(p, v, __ATOMIC_RELAXED, __HIP_MEMORY_SCOPE_AGENT); }
DEVI unsigned xb_xcc_id() { return (unsigned)__builtin_amdgcn_s_getreg((3 << 11) | 20) & 0xFu; }
#define XB_SPIN(cond, bar) do { unsigned _sp = 0; while (cond) { __builtin_amdgcn_s_sleep(1); \
    if ((++_sp & 255u) == 0u) { if (xb_ld(&(bar)[XB_TMO])) break; if (_sp > XB_SPIN_CAP) { atomicAdd(&(bar)[XB_TMO], 1u); break; } } } } while (0)
struct XcdBarrier { unsigned* bar; unsigned x; volatile LAS unsigned* st; };
DEVI XcdBarrier xcd_barrier_post(unsigned* bar, volatile LAS unsigned* st) {
  XcdBarrier b; b.bar = bar; b.x = xb_xcc_id(); b.st = st;
  if (threadIdx.x == 0) (void)xb_add(&bar[XB_XCNT(b.x)], 1u);
  return b;
}
DEVI void xcd_barrier_complete(unsigned* bar, unsigned x, unsigned& nloc, unsigned& nx) {
  const unsigned G = gridDim.x * gridDim.y * gridDim.z;
  unsigned sum, cnt, mine, sp = 0u;
  for (;;) {
    sum = 0u; cnt = 0u; mine = 0u;
#pragma unroll
    for (unsigned j = 0; j < 16; ++j) { const unsigned c = xb_ld(&bar[XB_XCNT(j)]); sum += c; cnt += (c > 0u) ? 1u : 0u; mine = (j == x) ? c : mine; }
    if (sum == G) break;
    __builtin_amdgcn_s_sleep(1);
    if ((++sp & 255u) == 0u) { if (xb_ld(&bar[XB_TMO])) break; if (sp > XB_SPIN_CAP) { atomicAdd(&bar[XB_TMO], 1u); break; } }
  }
  nloc = mine > 0u ? mine : 1u; nx = cnt > 0u ? cnt : 1u;
}
DEVI void xcd_barrier(const XcdBarrier& b) {
  asm volatile("s_waitcnt vmcnt(0)" ::: "memory");
  __syncthreads();
  if (threadIdx.x == 0) {
    unsigned* bar = b.bar;
    __builtin_amdgcn_s_waitcnt(0);
    unsigned nloc = b.st[0], nx = b.st[1];
    if (nloc == 0u) { xcd_barrier_complete(bar, b.x, nloc, nx); b.st[0] = nloc; b.st[1] = nx; }
    const unsigned old = xb_add(&bar[XB_XSUB(b.x)], 1u);
    const unsigned gen = old / nloc;
    if (old + 1u == (gen + 1u) * nloc) {
      __builtin_amdgcn_fence(__ATOMIC_RELEASE, "agent");
      asm volatile("s_waitcnt vmcnt(0)" ::: "memory");
      const unsigned og = xb_add(&bar[XB_TOP], 1u);
      const unsigned tg = og / nx;
      if (og + 1u == (tg + 1u) * nx) xb_add(&bar[XB_TOPGEN], 1u);
      else XB_SPIN(xb_ld(&bar[XB_TOPGEN]) == tg, bar);
      __builtin_amdgcn_fence(__ATOMIC_ACQUIRE, "agent");
      xb_add(&bar[XB_XGEN(b.x)], 1u);
      asm volatile("s_waitcnt vmcnt(0)" ::: "memory");
    } else {
      XB_SPIN(xb_ld(&bar[XB_XGEN(b.x)]) == gen, bar);
      __builtin_amdgcn_fence(__ATOMIC_ACQUIRE, "agent");
      asm volatile("s_waitcnt vmcnt(0)" ::: "memory");
    }
  }
  __syncthreads();
}

__global__ void __launch_bounds__(256, 2) mega_kernel(KArgs ka, int ph_lo, int ph_hi) {
  __shared__ __attribute__((aligned(16))) unsigned char sm[57344];
  __shared__ int s_item;
  __shared__ g_cf32* s_in[36];
  __shared__ __attribute__((aligned(16))) unsigned s_xb[4];
  cg::grid_group grid = cg::this_grid();
  if (threadIdx.x < 4) s_xb[threadIdx.x] = 0u;
  if (threadIdx.x < 36) {
    const float* const* kp = (const float* const*)__builtin_amdgcn_kernarg_segment_ptr();
    s_in[threadIdx.x] = (g_cf32*)kp[threadIdx.x];
  }
  __syncthreads();
  Params p;
  p.in.t = s_in; p.out = (g_f32*)ka.out; p.ws = (g_u8*)ka.ws;
  int* ctr = (int*)(p.ws + OFF_CTR);
  const XcdBarrier xb = xcd_barrier_post((unsigned*)(p.ws + OFF_BAR), (volatile LAS unsigned*)s_xb);
  for (int idx = ph_lo; idx < ph_hi; ++idx) {
    const int total = phase_total(idx);
#ifdef PROBE_T
    const int ptype = idx < 2 ? idx : 2 + (idx - 2) % 10;
    const int reps = (ptype == PROBE_T) ? 2 : 1;
#else
    const int reps = 1;
#endif
    for (int rep = 0; rep < reps; ++rep) {
      const int nx = phase_xcd_total(idx);
      if (nx) {
        const int xcd = blockIdx.x & 7;
        while (true) {
          __syncthreads();
          if (TIDX == 0) s_item = atomicAdd(&ctr[64 + (idx + 32 * rep) * 8 + xcd], 1);
          __syncthreads();
          const int q_ = s_item;
          if (q_ >= nx) break;
          Params q = p;
          asm volatile("" : "+s"(q.ws));
          asm volatile("" : "+s"(q.out));
          asm volatile("" : "+s"(q.in.t));
          phase_item_x(q, idx, xcd, q_, sm);
        }
      }
      while (true) {
        __syncthreads();
        if (TIDX == 0) s_item = atomicAdd(&ctr[idx + 32 * rep], 1);
        __syncthreads();
        const int it = s_item;
        if (it >= total) break;
        Params q = p;
        asm volatile("" : "+s"(q.ws));
        asm volatile("" : "+s"(q.out));
        asm volatile("" : "+s"(q.in.t));
        phase_item(q, idx, it, sm);
      }
      if (rep + 1 < reps) xcd_barrier(xb);
    }
    if (idx + 1 < ph_hi) {
      if (idx == ph_lo) grid.sync();
      else xcd_barrier(xb);
    }
  }
}

#ifndef MULTI_LAUNCH
#define MULTI_LAUNCH 0
#endif

extern "C" void kernel_launch(void* const* d_in, const int* in_sizes, int n_in, void* d_out, int out_size, void* d_ws,
                              size_t ws_size, hipStream_t stream) {
  static int grid_blocks = 0;
  if (!grid_blocks) {
    int dev = 0, cus = 0, per_cu = 0;
    hipGetDevice(&dev);
    hipDeviceGetAttribute(&cus, hipDeviceAttributeMultiprocessorCount, dev);
    hipOccupancyMaxActiveBlocksPerMultiprocessor(&per_cu, mega_kernel, 256, 0);
    if (per_cu > 2) per_cu = 2;
    if (per_cu < 1) per_cu = 1;
    grid_blocks = cus * per_cu;
  }
  KArgs p{};
  for (int i = 0; i < 36; ++i) p.in[i] = (const float*)d_in[i];
  p.out = (float*)d_out;
  p.ws = (unsigned char*)d_ws;
  if (ws_size < OFF_END) { fprintf(stderr, "workspace too small: %zu < %zu\n", ws_size, (size_t)OFF_END); return; }
  hipMemsetAsync(d_ws, 0, 4096, stream);
  hipMemsetAsync((unsigned char*)d_ws + OFF_BAR, 0, 16384, stream);
#if MULTI_LAUNCH
  for (int ph = 0; ph < NPHASES; ++ph) {
    hipLaunchKernelGGL(mega_kernel, dim3(grid_blocks), dim3(256), 0, stream, p, ph, ph + 1);
  }
#else
  int lo = 0, hi = NPHASES;
  void* args[] = {&p, &lo, &hi};
  hipError_t e = hipLaunchCooperativeKernel((void*)mega_kernel, dim3(grid_blocks), dim3(256), args, 0, stream);
  if (e != hipSuccess) fprintf(stderr, "cooperative launch failed: %s (grid %d)\n", hipGetErrorString(e), grid_blocks);
#endif
}
```

```cpp
#include <hip/hip_runtime.h>
#include <hip/hip_bf16.h>
#include <hip/hip_cooperative_groups.h>
#include <cstdio>
namespace cg = cooperative_groups;

typedef unsigned short u16;
using bf16x8 = __attribute__((ext_vector_type(8))) short;
using f32x4 = __attribute__((ext_vector_type(4))) float;
#define DEVI __device__ __forceinline__
__device__ __forceinline__ int ltid_() { int t = threadIdx.x; asm volatile("" : "+v"(t)); return t; }
#define TIDX ltid_()

constexpr int NTOK = 8192;
constexpr int PIN = 8064;
constexpr float ALPHA = 1.4142135623730951f;
constexpr size_t OUT_Y = 0;
constexpr size_t OUT_NAK = 8388608;
constexpr size_t OUT_NAV = 12582912;
constexpr size_t OUT_SRET = 16777216;
constexpr size_t OUT_SRW = 18874368;
constexpr size_t OFF_CTR = 0;
constexpr size_t OFF_TAB = 4096;
constexpr size_t OFF_MOD = 16384;
constexpr size_t OFF_WINT = 1048576;
constexpr size_t OFF_WBRT = OFF_WINT + 33030144;
constexpr size_t OFF_WOUTT = OFF_WBRT + 6291456;
constexpr size_t OFF_WQT = OFF_WOUTT + 4194304;
constexpr size_t OFF_WUPT = OFF_WQT + 4194304;
constexpr size_t OFF_AUPT = OFF_WUPT + 262144;
constexpr size_t OFF_GUPT = OFF_AUPT + 262144;
constexpr size_t OFF_UB = OFF_GUPT + 262144;
constexpr size_t OFF_VB = OFF_UB + 33554432;
constexpr size_t OFF_Z = OFF_VB + 33554432;
constexpr size_t OFF_X = OFF_Z + 132120576;
constexpr size_t OFF_H = OFF_X + 33554432;
constexpr size_t OFF_ONA = OFF_H + 16777216;
constexpr size_t OFF_ORT = OFF_ONA + 8388608;
constexpr size_t OFF_ORW = OFF_ORT + 8388608;
constexpr size_t OFF_GA = OFF_ORW + 8388608;
constexpr size_t SZB = 8388608;
constexpr size_t OFF_RWW = OFF_GA;
constexpr size_t OFF_RWR = OFF_RWW + 4 * SZB;
constexpr size_t OFF_RWV = OFF_RWR + SZB;
constexpr size_t OFF_RWKK = OFF_RWV + SZB;
constexpr size_t OFF_RWKC = OFF_RWKK + SZB;
constexpr size_t OFF_RWKD = OFF_RWKC + SZB;
constexpr size_t OFF_RWKKA = OFF_RWKD + 2 * SZB;
constexpr size_t OFF_RWG = OFF_RWKKA + 2 * SZB;
constexpr size_t OFF_RWBON = OFF_RWG + SZB;
constexpr size_t OFF_OF = OFF_RWBON + SZB;
constexpr size_t OFF_KV = OFF_OF + 4 * SZB;
constexpr size_t OFF_BAR = OFF_KV + 33554432;
constexpr size_t OFF_SC = OFF_BAR + 16384;
constexpr size_t OFF_END = OFF_SC + 4 * 65536;
constexpr size_t OFF_Y = OFF_GA;
constexpr size_t OFF_X1 = OFF_GA + 33554432;
constexpr size_t OFF_Q = OFF_GA + 2 * 33554432;
constexpr size_t OFF_H2 = OFF_GA + 3 * 33554432;
constexpr size_t OFF_EIDX = OFF_H2 + 16777216;
constexpr size_t OFF_GATE = OFF_EIDX + 4194304;

constexpr size_t UV_LSTRIDE = 16777216;
struct KArgs {
  const float* in[36];
  float* out;
  unsigned char* ws;
};
typedef __attribute__((address_space(1))) unsigned char g_u8;
typedef __attribute__((address_space(1))) float g_f32;
typedef const __attribute__((address_space(1))) float g_cf32;
struct InTab {
  g_cf32* const* t;
  DEVI const float* operator[](int k) const { return (const float*)t[k]; }
};
struct Params {
  InTab in;
  g_f32* out;
  g_u8* ws;
};
DEVI const float* uniform_ptr(const float* q) {
  unsigned long long v = (unsigned long long)q;
  unsigned lo = __builtin_amdgcn_readfirstlane((unsigned)v), hi = __builtin_amdgcn_readfirstlane((unsigned)(v >> 32));
  return (const float*)(((unsigned long long)hi << 32) | lo);
}

DEVI float bf2f(u16 h) { return __uint_as_float(((unsigned)h) << 16); }
DEVI unsigned cvtpk(float lo, float hi) {
  unsigned r;
  asm volatile("v_cvt_pk_bf16_f32 %0, %1, %2" : "=v"(r) : "v"(lo), "v"(hi));
  return r;
}
DEVI u16 f2bf(float f) { return (u16)(cvtpk(f, f) & 0xffffu); }
DEVI float sigmoidf_(float x) { return 1.f / (1.f + __expf(-x)); }
template <int CTRL> DEVI float dpp(float x) {
  return __builtin_bit_cast(float, __builtin_amdgcn_update_dpp(0, __builtin_bit_cast(int, x), CTRL, 0xf, 0xf, true));
}
DEVI float quad_sum(float x) { x += dpp<0xB1>(x); x += dpp<0x4E>(x); return x; }
DEVI float row16_sum(float x) { x = quad_sum(x); x += dpp<0x141>(x); x += dpp<0x140>(x); return x; }
DEVI float wave_sum(float x) { x = row16_sum(x); x += __shfl_xor(x, 16); x += __shfl_xor(x, 32); return x; }
DEVI void unpack8(uint4 v, float* f) {
  f[0] = __uint_as_float(v.x << 16); f[1] = __uint_as_float(v.x & 0xffff0000u);
  f[2] = __uint_as_float(v.y << 16); f[3] = __uint_as_float(v.y & 0xffff0000u);
  f[4] = __uint_as_float(v.z << 16); f[5] = __uint_as_float(v.z & 0xffff0000u);
  f[6] = __uint_as_float(v.w << 16); f[7] = __uint_as_float(v.w & 0xffff0000u);
}
DEVI void unpack4(uint2 v, float* f) {
  f[0] = __uint_as_float(v.x << 16); f[1] = __uint_as_float(v.x & 0xffff0000u);
  f[2] = __uint_as_float(v.y << 16); f[3] = __uint_as_float(v.y & 0xffff0000u);
}
DEVI uint4 pack8(const float* f) {
  uint4 r; r.x = cvtpk(f[0], f[1]); r.y = cvtpk(f[2], f[3]); r.z = cvtpk(f[4], f[5]); r.w = cvtpk(f[6], f[7]); return r;
}
DEVI f32x4 mfma16(bf16x8 a, bf16x8 b, f32x4 c) { return __builtin_amdgcn_mfma_f32_16x16x32_bf16(a, b, c, 0, 0, 0); }
DEVI int modrow(int tok) { return tok < 4096 ? 0 : 1 + ((tok - 4096) >> 11); }
DEVI const float* xin_row(const Params& p, int tok) {
  return tok < 4096 ? p.in[0] + (size_t)tok * 1024 : p.in[1] + (size_t)(tok - 4096) * 1024;
}
DEVI int clampi(int v, int lo, int hi) { return v < lo ? lo : (v > hi ? hi : v); }

template <int NT> DEVI void wave_mma(const u16* A, int lda, const u16* B, int ldb, int K, f32x4* acc) {
  const int lane = TIDX & 63, fr = lane & 15, fq = lane >> 4;
  for (int k0 = 0; k0 < K; k0 += 32) {
    bf16x8 a = *(const bf16x8*)(A + fr * lda + k0 + fq * 8);
#pragma unroll
    for (int n = 0; n < NT; ++n) {
      bf16x8 b = *(const bf16x8*)(B + (n * 16 + fr) * ldb + k0 + fq * 8);
      acc[n] = mfma16(a, b, acc[n]);
    }
  }
}

#define LDS_RD(dst, addr, off) asm volatile("ds_read_b128 %0, %1 offset:" #off : "=v"(dst) : "v"(addr))
DEVI void gemm_acc(const u16* __restrict__ A, int lda, const u16* __restrict__ Bt, int ldb, int K, int m0, int n0,
                   unsigned char* sm, f32x4 (&acc)[4][4]) {
  const int tid = TIDX, lane = tid & 63, wid = tid >> 6, wr = wid >> 1, wc = wid & 1, fr = lane & 15, fq = lane >> 4;
  const int nk = K >> 5;
  const int b0 = tid * 16, r0 = b0 >> 6, c0 = (b0 & 63) >> 1;
  const u16* Ap = A + (size_t)(m0 + r0) * lda + c0;
  const u16* Bp = Bt + (size_t)(n0 + r0) * ldb + c0;
  const unsigned lbase = (unsigned)(size_t)(__attribute__((address_space(3))) unsigned char*)sm;
  const unsigned aoff = lbase + (wr * 64 + fr) * 64 + fq * 16;
  const unsigned boff = lbase + 8192 + (wc * 64 + fr) * 64 + fq * 16;
  auto issue = [&](int kt, int st) {
    unsigned char* SA = sm + st * 16384;
    unsigned char* SB = SA + 8192;
    __builtin_amdgcn_global_load_lds((const unsigned*)(Ap + kt * 32), (__attribute__((address_space(3))) unsigned*)(SA + b0), 16, 0, 0);
    __builtin_amdgcn_global_load_lds((const unsigned*)(Ap + (size_t)64 * lda + kt * 32), (__attribute__((address_space(3))) unsigned*)(SA + b0 + 4096), 16, 0, 0);
    __builtin_amdgcn_global_load_lds((const unsigned*)(Bp + kt * 32), (__attribute__((address_space(3))) unsigned*)(SB + b0), 16, 0, 0);
    __builtin_amdgcn_global_load_lds((const unsigned*)(Bp + (size_t)64 * ldb + kt * 32), (__attribute__((address_space(3))) unsigned*)(SB + b0 + 4096), 16, 0, 0);
  };
  issue(0, 0);
  if (nk > 1) issue(1, 1);
  int st = 0;
  for (int kt = 0; kt < nk; ++kt) {
    if (kt + 1 < nk) asm volatile("s_waitcnt vmcnt(4)\n\ts_barrier" ::: "memory");
    else asm volatile("s_waitcnt vmcnt(0)\n\ts_barrier" ::: "memory");
    if (kt + 2 < nk) { int s2 = st + 2; if (s2 >= 3) s2 -= 3; issue(kt + 2, s2); }
    const unsigned aa = aoff + st * 16384, bb = boff + st * 16384;
    bf16x8 a0, a1, a2, a3, b0_, b1_, b2_, b3_;
    LDS_RD(a0, aa, 0); LDS_RD(b0_, bb, 0); LDS_RD(b1_, bb, 1024); LDS_RD(b2_, bb, 2048); LDS_RD(b3_, bb, 3072);
    LDS_RD(a1, aa, 1024); LDS_RD(a2, aa, 2048); LDS_RD(a3, aa, 3072);
    asm volatile("s_waitcnt lgkmcnt(0)" : "+v"(a0), "+v"(a1), "+v"(a2), "+v"(a3), "+v"(b0_), "+v"(b1_), "+v"(b2_), "+v"(b3_));
    acc[0][0] = mfma16(a0, b0_, acc[0][0]); acc[0][1] = mfma16(a0, b1_, acc[0][1]);
    acc[0][2] = mfma16(a0, b2_, acc[0][2]); acc[0][3] = mfma16(a0, b3_, acc[0][3]);
    acc[1][0] = mfma16(a1, b0_, acc[1][0]); acc[1][1] = mfma16(a1, b1_, acc[1][1]);
    acc[1][2] = mfma16(a1, b2_, acc[1][2]); acc[1][3] = mfma16(a1, b3_, acc[1][3]);
    acc[2][0] = mfma16(a2, b0_, acc[2][0]); acc[2][1] = mfma16(a2, b1_, acc[2][1]);
    acc[2][2] = mfma16(a2, b2_, acc[2][2]); acc[2][3] = mfma16(a2, b3_, acc[2][3]);
    acc[3][0] = mfma16(a3, b0_, acc[3][0]); acc[3][1] = mfma16(a3, b1_, acc[3][1]);
    acc[3][2] = mfma16(a3, b2_, acc[3][2]); acc[3][3] = mfma16(a3, b3_, acc[3][3]);
    st = (st == 2) ? 0 : st + 1;
  }
  __syncthreads();
}
#define EPI_LOOP                                                                                         \
  const int _lane = TIDX & 63, _wid = TIDX >> 6, _wr = _wid >> 1, _wc = _wid & 1, _fr = _lane & 15, \
            _fq = _lane >> 4;                                                                            \
  _Pragma("unroll") for (int m = 0; m < 4; ++m) _Pragma("unroll") for (int n = 0; n < 4; ++n)            \
      _Pragma("unroll") for (int j = 0; j < 4; ++j)
#define EPI_ROW (m0 + _wr * 64 + m * 16 + _fq * 4 + j)
#define EPI_COL (n0 + _wc * 64 + n * 16 + _fr)

DEVI void zero_acc(f32x4 (&acc)[4][4]) {
#pragma unroll
  for (int m = 0; m < 4; ++m)
#pragma unroll
    for (int n = 0; n < 4; ++n) acc[m][n] = f32x4{0.f, 0.f, 0.f, 0.f};
}

__constant__ double ROPE_FREQ[16] = {1.0, 0.5623413251903491, 0.31622776601683794, 0.1778279410038923, 0.1,
                                     0.05623413251903491, 0.03162277660168379, 0.01778279410038923, 0.01,
                                     0.005623413251903491, 0.0031622776601683794, 0.0017782794100389228, 0.001,
                                     0.0005623413251903491, 0.00031622776601683794, 0.00017782794100389227};

DEVI void transpose_tile(const float* __restrict__ src, int K, int N, u16* __restrict__ dst, int kt, int nt, unsigned char* sm) {
  float* tile = (float*)sm;
  const int tid = TIDX;
  const int k0 = kt * 64, n0 = nt * 64;
#pragma unroll
  for (int i = 0; i < 16; ++i) {
    int kk = i * 4 + (tid >> 6), nn = tid & 63;
    tile[kk * 65 + nn] = src[(size_t)(k0 + kk) * N + n0 + nn];
  }
  __syncthreads();
#pragma unroll
  for (int i = 0; i < 16; ++i) {
    int nn = i * 4 + (tid >> 6), kk = tid & 63;
    dst[(size_t)(n0 + nn) * K + k0 + kk] = f2bf(tile[kk * 65 + nn]);
  }
}

typedef float f32x2_ __attribute__((ext_vector_type(2)));
DEVI void convert_uv_item(const Params& p, int l, int it) {
  const int which = it >> 9, chunk = it & 511;
  const int lane = TIDX & 63, w = TIDX >> 6;
#pragma unroll 2
  for (int sub = 0; sub < 8; ++sub) {
  const int row = chunk * 32 + sub * 4 + w;
  const float* src = p.in[34 + which] + (size_t)l * 16777216 + (size_t)row * 1024 + lane * 16;
  unsigned char* base = (unsigned char*)(p.ws + (which ? OFF_VB : OFF_UB)) + (size_t)l * UV_LSTRIDE;
  float v[16];
#pragma unroll
  for (int i = 0; i < 4; ++i) *(float4*)(v + i * 4) = *(const float4*)(src + i * 4);
  float am = 0.f;
#pragma unroll
  for (int i = 0; i < 16; ++i) am = fmaxf(am, fabsf(v[i]));
  am = fmaxf(am, dpp<0xB1>(am)); am = fmaxf(am, dpp<0x4E>(am)); am = fmaxf(am, dpp<0x141>(am)); am = fmaxf(am, dpp<0x140>(am));
  am = fmaxf(am, __shfl_xor(am, 16)); am = fmaxf(am, __shfl_xor(am, 32));
  const float sc = (am > 0.f) ? (240.f / am) : 1.f;
  int o[4];
#pragma unroll
  for (int i = 0; i < 4; ++i) {
    int wv = 0;
    wv = __builtin_amdgcn_cvt_pk_fp8_f32(v[i * 4] * sc, v[i * 4 + 1] * sc, wv, false);
    wv = __builtin_amdgcn_cvt_pk_fp8_f32(v[i * 4 + 2] * sc, v[i * 4 + 3] * sc, wv, true);
    o[i] = wv;
  }
  *(int4*)(base + (size_t)row * 1024 + lane * 16) = make_int4(o[0], o[1], o[2], o[3]);
  if (lane == 0) ((float*)(p.ws + OFF_SC))[(which * 2 + l) * 16384 + row] = am * (1.f / 240.f);
  }
}

constexpr int P0_NT = 740;
constexpr int P0_NUV = 1024;
constexpr int P0_NMOD = 192;
constexpr int P0_TOTAL = P0_NMOD + P0_NT + P0_NUV + 1;

constexpr int P0_TILES_L = 2960;
constexpr int P0_NT_ITEMS = P0_TILES_L / 4;
DEVI void p0_tile1(const Params& p, int l, int u, unsigned char* sm) {
  const float* src; u16* dst; int K, N, kt, nt;
  if (u < 2016) { kt = u / 126; nt = u % 126; K = 1024; N = 8064;
    src = p.in[10] + (size_t)l * 1024 * 8064; dst = (u16*)(p.ws + OFF_WINT) + (size_t)l * 8064 * 1024; }
  else if ((u -= 2016) < 384) { int j = l * 3 + u / 128, r = u % 128; kt = r / 16; nt = r % 16; K = 512; N = 1024;
    src = p.in[26] + (size_t)j * 512 * 1024; dst = (u16*)(p.ws + OFF_WBRT) + (size_t)j * 1024 * 512; }
  else if ((u -= 384) < 256) { kt = u / 16; nt = u % 16; K = 1024; N = 1024;
    src = p.in[27] + (size_t)l * 1048576; dst = (u16*)(p.ws + OFF_WOUTT) + (size_t)l * 1048576; }
  else if ((u -= 256) < 256) { kt = u / 16; nt = u % 16; K = 1024; N = 1024;
    src = p.in[32] + (size_t)l * 1048576; dst = (u16*)(p.ws + OFF_WQT) + (size_t)l * 1048576; }
  else if ((u -= 256) < 16) { int j = l * 2 + u / 8; kt = 0; nt = u % 8; K = 64; N = 512;
    src = p.in[17] + (size_t)j * 32768; dst = (u16*)(p.ws + OFF_WUPT) + (size_t)j * 32768; }
  else if ((u -= 16) < 16) { int j = l * 2 + u / 8; kt = 0; nt = u % 8; K = 64; N = 512;
    src = p.in[19] + (size_t)j * 32768; dst = (u16*)(p.ws + OFF_AUPT) + (size_t)j * 32768; }
  else { u -= 16; kt = u / 8; nt = u % 8; K = 128; N = 512;
    src = p.in[20] + (size_t)l * 65536; dst = (u16*)(p.ws + OFF_GUPT) + (size_t)l * 65536; }
  transpose_tile(src, K, N, dst, kt, nt, sm);
}
DEVI void p0_tiles(const Params& p, int l, int item, unsigned char* sm) {
  for (int i = 0; i < 4; ++i) {
    if (i) __syncthreads();
    p0_tile1(p, l, item * 4 + i, sm);
  }
}
DEVI void phase0_item(const Params& p, int it, unsigned char* sm) {
  const int tid = TIDX;
  if (it < P0_NMOD) {
    const int l = it / 96, n0 = (it % 96) * 64;
    const int kg = tid >> 4, c4 = (tid & 15) * 4;
    float acc[3][4];
#pragma unroll
    for (int r = 0; r < 3; ++r)
#pragma unroll
      for (int i = 0; i < 4; ++i) acc[r][i] = 0.f;
    const float* wm = p.in[8] + (size_t)l * 1024 * 6144;
#pragma unroll 8
    for (int k = kg * 64; k < kg * 64 + 64; ++k) {
      float4 w = *(const float4*)(wm + (size_t)k * 6144 + n0 + c4);
      float c0 = p.in[7][k], c1 = p.in[6][k], c2 = p.in[6][1024 + k];
      float s0 = c0 * sigmoidf_(c0), s1 = c1 * sigmoidf_(c1), s2 = c2 * sigmoidf_(c2);
      acc[0][0] += s0 * w.x; acc[0][1] += s0 * w.y; acc[0][2] += s0 * w.z; acc[0][3] += s0 * w.w;
      acc[1][0] += s1 * w.x; acc[1][1] += s1 * w.y; acc[1][2] += s1 * w.z; acc[1][3] += s1 * w.w;
      acc[2][0] += s2 * w.x; acc[2][1] += s2 * w.y; acc[2][2] += s2 * w.z; acc[2][3] += s2 * w.w;
    }
    float* red = (float*)sm;
#pragma unroll
    for (int r = 0; r < 3; ++r)
#pragma unroll
      for (int i = 0; i < 4; ++i) red[(kg * 3 + r) * 64 + c4 + i] = acc[r][i];
    __syncthreads();
    if (tid < 192) {
      int r = tid >> 6, col = tid & 63;
      float s = p.in[9][(size_t)l * 6144 + n0 + col];
      for (int g = 0; g < 16; ++g) s += red[(g * 3 + r) * 64 + col];
      ((float*)(p.ws + OFF_MOD))[((size_t)l * 3 + r) * 6144 + n0 + col] = s;
    }
    return;
  }
  it -= P0_NMOD;
  if (it < P0_NT) {
    p0_tiles(p, 0, it, sm);
    return;
  }
  if (0) {
    int t = it;
    const float* src; u16* dst; int K, N, kt, nt;
    if (t < 4032) { int l = t / 2016, r = t % 2016; kt = r / 126; nt = r % 126; K = 1024; N = 8064;
      src = p.in[10] + (size_t)l * 1024 * 8064; dst = (u16*)(p.ws + OFF_WINT) + (size_t)l * 8064 * 1024; }
    else if ((t -= 4032) < 768) { int j = t / 128, r = t % 128; kt = r / 16; nt = r % 16; K = 512; N = 1024;
      src = p.in[26] + (size_t)j * 512 * 1024; dst = (u16*)(p.ws + OFF_WBRT) + (size_t)j * 1024 * 512; }
    else if ((t -= 768) < 512) { int l = t / 256, r = t % 256; kt = r / 16; nt = r % 16; K = 1024; N = 1024;
      src = p.in[27] + (size_t)l * 1048576; dst = (u16*)(p.ws + OFF_WOUTT) + (size_t)l * 1048576; }
    else if ((t -= 512) < 512) { int l = t / 256, r = t % 256; kt = r / 16; nt = r % 16; K = 1024; N = 1024;
      src = p.in[32] + (size_t)l * 1048576; dst = (u16*)(p.ws + OFF_WQT) + (size_t)l * 1048576; }
    else if ((t -= 512) < 32) { int j = t / 8; kt = 0; nt = t % 8; K = 64; N = 512;
      src = p.in[17] + (size_t)j * 32768; dst = (u16*)(p.ws + OFF_WUPT) + (size_t)j * 32768; }
    else if ((t -= 32) < 32) { int j = t / 8; kt = 0; nt = t % 8; K = 64; N = 512;
      src = p.in[19] + (size_t)j * 32768; dst = (u16*)(p.ws + OFF_AUPT) + (size_t)j * 32768; }
    else { t -= 32; int l = t / 16, r = t % 16; kt = r / 8; nt = r % 8; K = 128; N = 512;
      src = p.in[20] + (size_t)l * 65536; dst = (u16*)(p.ws + OFF_GUPT) + (size_t)l * 65536; }
    transpose_tile(src, K, N, dst, kt, nt, sm);
    return;
  }
  it -= P0_NT;
  if (it < P0_NUV) { convert_uv_item(p, 0, it); return; }
  float* tab = (float*)(p.ws + OFF_TAB);
  for (int e = tid; e < 1024; e += 256) {
    int pos = e >> 4, f = e & 15;
    double rev = (double)pos * ROPE_FREQ[f] * 0.15915494309189535;
    rev -= floor(rev);
    float rf = (float)rev;
    tab[e] = __builtin_amdgcn_cosf(rf);
    tab[1024 + e] = __builtin_amdgcn_sinf(rf);
  }
}

DEVI void ln1_item(const Params& p, int it) {
  const int lane = TIDX & 63, w = TIDX >> 6;
  const int tok = it * 4 + w;
  const float* x = xin_row(p, tok);
  const float* mod = (const float*)(p.ws + OFF_MOD) + (size_t)modrow(tok) * 6144;
  float4 v[4];
  float s = 0.f;
#pragma unroll
  for (int i = 0; i < 4; ++i) { v[i] = *(const float4*)(x + lane * 4 + 256 * i); s += v[i].x + v[i].y + v[i].z + v[i].w; }
  float mu = wave_sum(s) * (1.f / 1024.f);
  float q = 0.f;
#pragma unroll
  for (int i = 0; i < 4; ++i) { float a = v[i].x - mu, b = v[i].y - mu, c = v[i].z - mu, d = v[i].w - mu; q += a * a + b * b + c * c + d * d; }
  float rs = rsqrtf(wave_sum(q) * (1.f / 1024.f) + 1e-5f);
  u16* H = (u16*)(p.ws + OFF_H) + (size_t)tok * 1024;
#pragma unroll
  for (int i = 0; i < 4; ++i) {
    int c = lane * 4 + 256 * i;
    float4 sh = *(const float4*)(mod + c), sc = *(const float4*)(mod + 1024 + c);
    uint2 o;
    o.x = cvtpk((v[i].x - mu) * rs * (1.f + sc.x) + sh.x, (v[i].y - mu) * rs * (1.f + sc.y) + sh.y);
    o.y = cvtpk((v[i].z - mu) * rs * (1.f + sc.z) + sh.z, (v[i].w - mu) * rs * (1.f + sc.w) + sh.w);
    *(uint2*)(H + c) = o;
  }
}

DEVI void g1_item(const Params& p, int l, int it, unsigned char* sm) {
  const int nt = it >> 6, mt = it & 63;
  const int m0 = mt * 128, n0 = nt * 128;
  f32x4 acc[4][4];
  zero_acc(acc);
  gemm_acc((const u16*)(p.ws + OFF_H), 1024, (const u16*)(p.ws + OFF_WINT) + (size_t)l * 8064 * 1024, 1024, 1024, m0, n0, sm, acc);
  u16* Z = (u16*)(p.ws + OFF_Z);
  EPI_LOOP {
    int row = EPI_ROW, col = EPI_COL;
    float v = acc[m][n][j];
    Z[(size_t)row * PIN + col] = f2bf(v);
    if (row < 4096 && col >= 512 && col < 1536) {
      int which = (col - 512) >> 9, cc = (col - 512) & 511, h = cc >> 6, d = cc & 63, b = row >> 8, s = row & 255;
      p.out[OUT_NAK + (size_t)which * 4194304 + ((((size_t)(b * 2 + l) * 8 + h) * 256 + s) * 64 + d)] = v;
    }
  }
}
DEVI void g2_item(const Params& p, int l, int it, unsigned char* sm) {
  const int nt = it >> 6, mt = it & 63;
  const int m0 = mt * 128, n0 = nt * 128;
  f32x4 tot[4][4];
  zero_acc(tot);
  const u16* Z = (const u16*)(p.ws + OFF_Z);
  for (int i = 0; i < 3; ++i) {
    f32x4 acc[4][4];
    zero_acc(acc);
    const u16* A = (const u16*)(p.ws + (i == 0 ? OFF_ONA : (i == 1 ? OFF_ORT : OFF_ORW)));
    gemm_acc(A, 512, (const u16*)(p.ws + OFF_WBRT) + (size_t)(l * 3 + i) * 1024 * 512, 512, 512, m0, n0, sm, acc);
    EPI_LOOP {
      int row = EPI_ROW, col = EPI_COL;
      float g = bf2f(Z[(size_t)row * PIN + 4992 + i * 1024 + col]);
      tot[m][n][j] += sigmoidf_(g) * acc[m][n][j];
    }
  }
  u16* MG = (u16*)(p.ws + OFF_H);
  EPI_LOOP { MG[(size_t)EPI_ROW * 1024 + EPI_COL] = f2bf(tot[m][n][j]); }
}
DEVI void g3_item(const Params& p, int l, int it, unsigned char* sm) {
  const int nt = it >> 6, mt = it & 63;
  const int m0 = mt * 128, n0 = nt * 128;
  f32x4 acc[4][4];
  zero_acc(acc);
  gemm_acc((const u16*)(p.ws + OFF_H), 1024, (const u16*)(p.ws + OFF_WOUTT) + (size_t)l * 1048576, 1024, 1024, m0, n0, sm, acc);
  float* Y = (float*)(p.ws + OFF_Y);
  const float* mod = (const float*)(p.ws + OFF_MOD) + (size_t)l * 3 * 6144;
  const float* X = (const float*)(p.ws + OFF_X);
  EPI_LOOP {
    int row = EPI_ROW, col = EPI_COL;
    float xr = (l == 0) ? xin_row(p, row)[col] : X[(size_t)row * 1024 + col];
    float gt = mod[(size_t)modrow(row) * 6144 + 2048 + col];
    Y[(size_t)row * 1024 + col] = ALPHA * xr + gt * acc[m][n][j];
  }
}
DEVI void g4_item(const Params& p, int l, int it, unsigned char* sm) {
  const int nt = it >> 6, mt = it & 63;
  const int m0 = mt * 128, n0 = nt * 128;
  f32x4 acc[4][4];
  zero_acc(acc);
  gemm_acc((const u16*)(p.ws + OFF_H2), 1024, (const u16*)(p.ws + OFF_WQT) + (size_t)l * 1048576, 1024, 1024, m0, n0, sm, acc);
  float* Q = (float*)(p.ws + OFF_Q);
  EPI_LOOP { Q[(size_t)EPI_ROW * 1024 + EPI_COL] = acc[m][n][j]; }
}

DEVI void load_qk16(const u16* zp  , int part, bool lat, int prow, int pcol, const float* tab,
                    float scale, float* out) {
  if (!lat) {
    float t[16];
    unpack8(*(const uint4*)(zp + part * 16), t);
    unpack8(*(const uint4*)(zp + part * 16 + 8), t + 8);
#pragma unroll
    for (int i = 0; i < 16; ++i) out[i] = t[i] * scale;
    return;
  }
  const int half = part >> 1, isp2 = part & 1;
  float p1[16], p2[16];
  unpack8(*(const uint4*)(zp + half * 32), p1);
  unpack8(*(const uint4*)(zp + half * 32 + 8), p1 + 8);
  unpack8(*(const uint4*)(zp + half * 32 + 16), p2);
  unpack8(*(const uint4*)(zp + half * 32 + 24), p2 + 8);
  const int pos = half ? pcol : prow;
  const float* ct = tab + pos * 16;
  const float* st = tab + 1024 + pos * 16;
#pragma unroll
  for (int f = 0; f < 16; ++f) {
    float c = ct[f], s = st[f];
    out[f] = (isp2 ? (p1[f] * s + p2[f] * c) : (p1[f] * c - p2[f] * s)) * scale;
  }
}
struct RetItem { int lat, b, h, n, N, seqbase, kvbase; };
DEVI RetItem ret_decode(int it) {
  RetItem r;
  if (it < 256) { r.lat = 1; r.b = it >> 7; r.h = (it >> 5) & 3; r.n = it & 31; r.N = 32; r.seqbase = 4096 + r.b * 2048; r.kvbase = 256 + (r.b * 4 + r.h) * 32; }
  else { int j = it - 256; r.lat = 0; r.b = j >> 4; r.h = (j >> 2) & 3; r.n = j & 3; r.N = 4; r.seqbase = r.b * 256; r.kvbase = (r.b * 4 + r.h) * 4; }
  return r;
}
DEVI void ret_gammas(const Params& p, int l, int h, float& lgf, float& lgb) {
  float xf = p.in[12][(l * 2 + 0) * 4 + h], xb = p.in[12][(l * 2 + 1) * 4 + h];
  lgf = -log2f(1.f + expf(-xf));
  lgb = -log2f(1.f + expf(-xb));
}

DEVI void ret1_item(const Params& p, int l, int it, unsigned char* sm) {
  const RetItem r = ret_decode(it);
  const int tid = TIDX, lane = tid & 63, w = tid >> 6, fr = lane & 15, fq = lane >> 4;
  u16* KTf = (u16*)sm;
  u16* KTb = (u16*)(sm + 9216);
  u16* VT = (u16*)(sm + 18432);
  const u16* Z = (const u16*)(p.ws + OFF_Z);
  const float* tab = (const float*)(p.ws + OFF_TAB);
  float lgf, lgb;
  ret_gammas(p, l, r.h, lgf, lgb);
  const int tok0 = r.seqbase + r.n * 64;
  {
    const int j = tid >> 2, part = tid & 3;
    float kv[16];
    load_qk16(Z + (size_t)(tok0 + j) * PIN + 1792 + r.h * 64, part, r.lat, r.n, j, tab, 0.125f, kv);
    const float df = exp2f(lgf * (float)(63 - j)), db = exp2f(lgb * (float)j);
#pragma unroll
    for (int i = 0; i < 16; ++i) {
      KTf[(part * 16 + i) * 72 + j] = f2bf(kv[i] * df);
      KTb[(part * 16 + i) * 72 + j] = f2bf(kv[i] * db);
    }
    const int jj = tid & 63, vp = (tid >> 6) * 32;
    const u16* vz = Z + (size_t)(tok0 + jj) * PIN + 2048 + r.h * 128 + vp;
#pragma unroll
    for (int c = 0; c < 4; ++c) {
      uint4 raw = *(const uint4*)(vz + c * 8);
      const u16* rv = (const u16*)&raw;
#pragma unroll
      for (int i = 0; i < 8; ++i) VT[(vp + c * 8 + i) * 72 + jj] = rv[i];
    }
  }
  __syncthreads();
  float* KV = (float*)(p.ws + OFF_KV) + (size_t)(r.kvbase + r.n) * 2 * 8192;
#pragma unroll
  for (int dir = 0; dir < 2; ++dir) {
    f32x4 acc[8];
#pragma unroll
    for (int n = 0; n < 8; ++n) acc[n] = f32x4{0.f, 0.f, 0.f, 0.f};
    wave_mma<8>((dir ? KTb : KTf) + w * 16 * 72, 72, VT, 72, 64, acc);
#pragma unroll
    for (int n = 0; n < 8; ++n)
#pragma unroll
      for (int j = 0; j < 4; ++j) KV[(size_t)dir * 8192 + (w * 16 + fq * 4 + j) * 128 + n * 16 + fr] = acc[n][j];
  }
}

DEVI void ret3_item(const Params& p, int l, int it, unsigned char* sm) {
  const RetItem r = ret_decode(it);
  const int tid = TIDX, lane = tid & 63, w = tid >> 6, fr = lane & 15, fq = lane >> 4;
  u16* Qs = (u16*)sm;
  u16* Ks = (u16*)(sm + 9216);
  u16* VT = (u16*)(sm + 18432);
  u16* ST = (u16*)(sm + 36864);
  const u16* Z = (const u16*)(p.ws + OFF_Z);
  const float* tab = (const float*)(p.ws + OFF_TAB);
  float lgf, lgb;
  ret_gammas(p, l, r.h, lgf, lgb);
  const int tok0 = r.seqbase + r.n * 64;
  {
    const int i = tid >> 2, part = tid & 3;
    float t[16];
    load_qk16(Z + (size_t)(tok0 + i) * PIN + 1536 + r.h * 64, part, r.lat, r.n, i, tab, 1.f, t);
    *(uint4*)(Qs + i * 72 + part * 16) = pack8(t);
    *(uint4*)(Qs + i * 72 + part * 16 + 8) = pack8(t + 8);
    load_qk16(Z + (size_t)(tok0 + i) * PIN + 1792 + r.h * 64, part, r.lat, r.n, i, tab, 0.125f, t);
    *(uint4*)(Ks + i * 72 + part * 16) = pack8(t);
    *(uint4*)(Ks + i * 72 + part * 16 + 8) = pack8(t + 8);
    const int jj = tid & 63, vp = (tid >> 6) * 32;
    const u16* vz = Z + (size_t)(tok0 + jj) * PIN + 2048 + r.h * 128 + vp;
#pragma unroll
    for (int c = 0; c < 4; ++c) {
      uint4 raw = *(const uint4*)(vz + c * 8);
      const u16* rv = (const u16*)&raw;
#pragma unroll
      for (int e = 0; e < 8; ++e) VT[(vp + c * 8 + e) * 72 + jj] = rv[e];
    }
  }
  __syncthreads();
  f32x4 at[4];
#pragma unroll
  for (int n = 0; n < 4; ++n) at[n] = f32x4{0.f, 0.f, 0.f, 0.f};
  wave_mma<4>(Qs + w * 16 * 72, 72, Ks, 72, 64, at);
  __syncthreads();
#pragma unroll
  for (int n = 0; n < 4; ++n)
#pragma unroll
    for (int j = 0; j < 4; ++j) {
      int i = w * 16 + fq * 4 + j, jc = n * 16 + fr;
      float mval = (i > jc) ? exp2f(lgf * (float)(i - jc)) : ((i < jc) ? exp2f(lgb * (float)(jc - i)) : 2.f);
      Ks[i * 72 + jc] = f2bf(at[n][j] * mval);
    }
  __syncthreads();
  f32x4 o[8];
#pragma unroll
  for (int n = 0; n < 8; ++n) o[n] = f32x4{0.f, 0.f, 0.f, 0.f};
  wave_mma<8>(Ks + w * 16 * 72, 72, VT, 72, 64, o);
  const float* KVb_ = (const float*)(p.ws + OFF_KV);
  for (int dir = 0; dir < 2; ++dir) {
    const float lg = dir ? lgb : lgf;
    const float cdec = exp2f(lg * 64.f);
    const int nprev = dir ? (r.N - 1 - r.n) : r.n;
    __syncthreads();
    {
      float S[32];
#pragma unroll
      for (int e8 = 0; e8 < 32; ++e8) {
        int e = e8 * 256 + tid;
        S[e8] = r.lat ? p.in[4][((((size_t)(r.b * 2 + l) * 2 + dir) * 4 + r.h) * 64) * 128 + e] : 0.f;
      }
      for (int m = 0; m < nprev; ++m) {
        const int ch = dir ? (r.N - 1 - m) : m;
        const float* kvp = KVb_ + ((size_t)(r.kvbase + ch) * 2 + dir) * 8192 + tid;
#pragma unroll
        for (int e8 = 0; e8 < 32; ++e8) S[e8] = S[e8] * cdec + kvp[e8 * 256];
      }
      const bool fin = (!r.lat) && (nprev == r.N - 1);
      const float* kvn = KVb_ + ((size_t)(r.kvbase + r.n) * 2 + dir) * 8192 + tid;
      float* so = (float*)p.out + OUT_SRET + ((((size_t)(r.b * 2 + l) * 2 + dir) * 4 + r.h) * 64) * 128 + tid;
#pragma unroll
      for (int e8 = 0; e8 < 32; ++e8) {
        int e = e8 * 256 + tid, d = e >> 7, v = e & 127;
        ST[v * 72 + d] = f2bf(S[e8]);
        if (fin) so[e8 * 256] = S[e8] * cdec + kvn[e8 * 256];
      }
    }
    __syncthreads();
    f32x4 t2[8];
#pragma unroll
    for (int n = 0; n < 8; ++n) t2[n] = f32x4{0.f, 0.f, 0.f, 0.f};
    wave_mma<8>(Qs + w * 16 * 72, 72, ST, 72, 64, t2);
#pragma unroll
    for (int j = 0; j < 4; ++j) {
      int i = w * 16 + fq * 4 + j;
      float dec = dir ? exp2f(lg * (float)(64 - i)) : exp2f(lg * (float)(i + 1));
#pragma unroll
      for (int n = 0; n < 8; ++n) o[n][j] += dec * t2[n][j];
    }
  }
  const float* gw = p.in[13] + l * 512 + r.h * 128;
  const float* gb = p.in[14] + l * 512 + r.h * 128;
  u16* ORT = (u16*)(p.ws + OFF_ORT);
#pragma unroll
  for (int j = 0; j < 4; ++j) {
    float s = 0.f;
#pragma unroll
    for (int n = 0; n < 8; ++n) s += o[n][j];
    float mu = row16_sum(s) * (1.f / 128.f);
    float q = 0.f;
#pragma unroll
    for (int n = 0; n < 8; ++n) { float d = o[n][j] - mu; q += d * d; }
    float rs = rsqrtf(row16_sum(q) * (1.f / 128.f) + 1e-5f);
    const int tok = tok0 + w * 16 + fq * 4 + j;
#pragma unroll
    for (int n = 0; n < 8; ++n) {
      int v = n * 16 + fr;
      float g = bf2f(Z[(size_t)tok * PIN + 2560 + r.h * 128 + v]);
      float y = ((o[n][j] - mu) * rs * gw[v] + gb[v]) * (g * sigmoidf_(g));
      ORT[(size_t)tok * 512 + r.h * 128 + v] = f2bf(y);
    }
  }
}

DEVI void shifted8(const u16* Z, int tok, bool hasp, bool hasn, int col, const float* mu, float* out) {
  float z[8], zp[8], zn[8];
  unpack8(*(const uint4*)(Z + (size_t)tok * PIN + col), z);
  if (hasp) unpack8(*(const uint4*)(Z + (size_t)(tok - 1) * PIN + col), zp);
  else {
#pragma unroll
    for (int i = 0; i < 8; ++i) zp[i] = 0.f;
  }
  if (hasn) unpack8(*(const uint4*)(Z + (size_t)(tok + 1) * PIN + col), zn);
  else {
#pragma unroll
    for (int i = 0; i < 8; ++i) zn[i] = 0.f;
  }
  float4 m0 = *(const float4*)(mu + col - 3072), m1 = *(const float4*)(mu + col - 3072 + 4);
  float mm[8] = {m0.x, m0.y, m0.z, m0.w, m1.x, m1.y, m1.z, m1.w};
#pragma unroll
  for (int i = 0; i < 8; ++i) out[i] = z[i] + mm[i] * (0.5f * (zp[i] + zn[i]) - z[i]);
}
DEVI void tok_neighbors(int tok, bool& hasp, bool& hasn) {
  if (tok < 4096) { int s = tok & 255; hasp = s > 0; hasn = s < 255; }
  else { int s = (tok - 4096) & 2047; hasp = s > 0; hasn = s < 2047; }
}

DEVI void rwprep_item(const Params& p, int l, int it) {
  const int tid = TIDX, lane = tid & 63, w = tid >> 6, fr = lane & 15, fq = lane >> 4;
  const u16* Z = (const u16*)(p.ws + OFF_Z);
  const float* mu = p.in[15] + l * 1920;
  const int tok0 = (it >> 2) * 64, hq = it & 3;
  u16* R = (u16*)(p.ws + OFF_RWR);
  u16* V = (u16*)(p.ws + OFF_RWV);
  u16* KC = (u16*)(p.ws + OFF_RWKC);
  for (int e = tid; e < 64 * 48; e += 256) {
    int ti = e / 48, u = e % 48, arr = u >> 4, c8 = hq * 128 + (u & 15) * 8;
    int tok = tok0 + ti;
    bool hp, hn;
    tok_neighbors(tok, hp, hn);
    float zs[8];
    shifted8(Z, tok, hp, hn, 3072 + arr * 512 + c8, mu, zs);
    u16* dst = (arr == 0) ? R : (arr == 1 ? KC : V);
    *(uint4*)(dst + (size_t)tok * 512 + c8) = pack8(zs);
  }
  __threadfence();
  __syncthreads();
  bf16x8 af[12];
  {
    const int tok = tok0 + w * 16 + fr;
    bool hp, hn;
    tok_neighbors(tok, hp, hn);
#pragma unroll
    for (int f = 0; f < 12; ++f) {
      int col = 4608 + f * 32 + fq * 8;
      float zs[8];
      shifted8(Z, tok, hp, hn, col, mu, zs);
      if (f < 4) {
#pragma unroll
        for (int i = 0; i < 8; ++i) zs[i] = tanhf(zs[i]);
      } else if (f >= 8) {
#pragma unroll
        for (int i = 0; i < 8; ++i) zs[i] = sigmoidf_(zs[i]);
      }
      uint4 pk = pack8(zs);
      af[f] = __builtin_bit_cast(bf16x8, pk);
    }
  }
  const u16* WUP = (const u16*)(p.ws + OFF_WUPT) + (size_t)l * 2 * 32768;
  const u16* AUP = (const u16*)(p.ws + OFF_AUPT) + (size_t)l * 2 * 32768;
  const u16* GUP = (const u16*)(p.ws + OFF_GUPT) + (size_t)l * 65536;
  float* Wd = (float*)(p.ws + OFF_RWW);
  u16* KK = (u16*)(p.ws + OFF_RWKK);
  u16* KD = (u16*)(p.ws + OFF_RWKD);
  u16* KKA = (u16*)(p.ws + OFF_RWKKA);
  u16* G = (u16*)(p.ws + OFF_RWG);
  u16* BON = (u16*)(p.ws + OFF_RWBON);
  const float* kkw = p.in[21] + l * 512;
  const float* kaw = p.in[22] + l * 512;
  const float* rkw = p.in[23] + l * 512;
  const float* w0 = p.in[16] + l * 1024;
  const float* a0 = p.in[18] + l * 1024;
  for (int h = hq * 2; h < hq * 2 + 2; ++h) {
    float inv[4], sbv[4];
#pragma unroll
    for (int j = 0; j < 4; ++j) {
      const int tok = tok0 + w * 16 + fq * 4 + j;
      float ssq = 0.f, sb = 0.f;
#pragma unroll
      for (int n = 0; n < 4; ++n) {
        int c = h * 64 + n * 16 + fr;
        float rr = bf2f(R[(size_t)tok * 512 + c]);
        float kc = bf2f(KC[(size_t)tok * 512 + c]);
        float kk = kc * kkw[c];
        ssq += kk * kk;
        sb += rr * kc * rkw[c];
      }
      ssq = row16_sum(ssq);
      sbv[j] = row16_sum(sb);
      inv[j] = rsqrtf(fmaxf(ssq, 1e-24f));
    }
#pragma unroll 1
    for (int n = 0; n < 4; ++n) {
      f32x4 acc[5];
#pragma unroll
      for (int m = 0; m < 5; ++m) acc[m] = f32x4{0.f, 0.f, 0.f, 0.f};
      const int c = h * 64 + n * 16 + fr;
#pragma unroll
      for (int ks = 0; ks < 2; ++ks) {
        acc[0] = mfma16(af[0 + ks], *(const bf16x8*)(WUP + (size_t)c * 64 + ks * 32 + fq * 8), acc[0]);
        acc[1] = mfma16(af[2 + ks], *(const bf16x8*)(WUP + 32768 + (size_t)c * 64 + ks * 32 + fq * 8), acc[1]);
        acc[2] = mfma16(af[4 + ks], *(const bf16x8*)(AUP + (size_t)c * 64 + ks * 32 + fq * 8), acc[2]);
        acc[3] = mfma16(af[6 + ks], *(const bf16x8*)(AUP + 32768 + (size_t)c * 64 + ks * 32 + fq * 8), acc[3]);
      }
#pragma unroll
      for (int ks = 0; ks < 4; ++ks)
        acc[4] = mfma16(af[8 + ks], *(const bf16x8*)(GUP + (size_t)c * 128 + ks * 32 + fq * 8), acc[4]);
      const float kkc = kkw[c], ka = kaw[c];
      const float w0f = w0[c], w0b = w0[512 + c], a0f = a0[c], a0b = a0[512 + c];
#pragma unroll
      for (int j = 0; j < 4; ++j) {
        const int tok = tok0 + w * 16 + fq * 4 + j;
        const size_t o = (size_t)tok * 512 + c;
        const float kc = bf2f(KC[o]), vv = bf2f(V[o]);
        const float kkn = kc * kkc * inv[j];
        KK[o] = f2bf(kkn);
        G[o] = f2bf(acc[4][j]);
        BON[o] = f2bf(sbv[j] * vv);
#pragma unroll
        for (int d = 0; d < 2; ++d) {
          float wv = __expf(-0.606531f * sigmoidf_((d ? w0b : w0f) + acc[d][j]));
          float a = sigmoidf_((d ? a0b : a0f) + acc[2 + d][j]);
          Wd[(size_t)d * NTOK * 512 + o] = wv;
          KD[(size_t)d * NTOK * 512 + o] = f2bf(kc * (1.f + (a - 1.f) * ka));
          KKA[(size_t)d * NTOK * 512 + o] = f2bf(kkn * a);
        }
      }
    }
  }
}

template <int KPT>
DEVI void scan_run(const Params& p, int l, bool lat, int b, int h, int dir, int rowbase, unsigned char* sm) {
  constexpr int LPR = 64 / KPT;
  constexpr int CH = 32;
  const int tid = TIDX;
  const int row = rowbase + tid / LPR, ks = (tid % LPR) * KPT;
  const int lir = tid % LPR;
  const int T = lat ? 2048 : 256, seq0 = lat ? 4096 + b * 2048 : b * 256;
  float S[KPT];
  if (lat) {
    const float* s0 = p.in[5] + ((((size_t)(b * 2 + l) * 2 + dir) * 8 + h) * 64 + row) * 64 + ks;
#pragma unroll
    for (int i = 0; i < KPT; ++i) S[i] = s0[i];
  } else {
#pragma unroll
    for (int i = 0; i < KPT; ++i) S[i] = 0.f;
  }
  float* buf = (float*)sm;
  float* obuf = buf + CH * 384;
  const float* Wd = (const float*)(p.ws + OFF_RWW) + (size_t)dir * NTOK * 512;
  const u16* R = (const u16*)(p.ws + OFF_RWR);
  const u16* V = (const u16*)(p.ws + OFF_RWV);
  const u16* KK = (const u16*)(p.ws + OFF_RWKK);
  const u16* KD = (const u16*)(p.ws + OFF_RWKD) + (size_t)dir * NTOK * 512;
  const u16* KKA = (const u16*)(p.ws + OFF_RWKKA) + (size_t)dir * NTOK * 512;
  float* O = (float*)(p.ws + OFF_OF) + (size_t)dir * NTOK * 512;
  const int pst = tid >> 3, c8 = (tid & 7) * 8;
  const int nch = T / CH;
  float4 qw0, qw1; uint4 qr, qk, qv, qd, qa;
  auto issue = [&](int chunk) {
    int s_ = chunk * CH + pst;
    int tok_ = dir ? (seq0 + T - 1 - s_) : (seq0 + s_);
    size_t o_ = (size_t)tok_ * 512 + h * 64 + c8;
    qw0 = *(const float4*)(Wd + o_); qw1 = *(const float4*)(Wd + o_ + 4);
    qr = *(const uint4*)(R + o_); qk = *(const uint4*)(KK + o_); qv = *(const uint4*)(V + o_);
    qd = *(const uint4*)(KD + o_); qa = *(const uint4*)(KKA + o_);
  };
  auto commit = [&]() {
    float* bp = buf + pst * 384 + c8;
    float t[8];
    *(float4*)bp = qw0; *(float4*)(bp + 4) = qw1;
    unpack8(qr, t); *(float4*)(bp + 64) = *(float4*)t; *(float4*)(bp + 68) = *(float4*)(t + 4);
    unpack8(qk, t); *(float4*)(bp + 128) = *(float4*)t; *(float4*)(bp + 132) = *(float4*)(t + 4);
    unpack8(qv, t); *(float4*)(bp + 192) = *(float4*)t; *(float4*)(bp + 196) = *(float4*)(t + 4);
    unpack8(qd, t); *(float4*)(bp + 256) = *(float4*)t; *(float4*)(bp + 260) = *(float4*)(t + 4);
    unpack8(qa, t); *(float4*)(bp + 320) = *(float4*)t; *(float4*)(bp + 324) = *(float4*)(t + 4);
  };
  auto compute = [&](int chunk) {
    if constexpr (KPT == 4) {
      typedef float f2 __attribute__((ext_vector_type(2)));
      f2 S01 = {S[0], S[1]}, S23 = {S[2], S[3]};
      float4 w4 = *(const float4*)(buf + ks), r4 = *(const float4*)(buf + 64 + ks), k4 = *(const float4*)(buf + 128 + ks),
             d4 = *(const float4*)(buf + 256 + ks), a4 = *(const float4*)(buf + 320 + ks);
      float vr = buf[192 + row];
#pragma unroll 1
      for (int sb = 0; sb < CH; sb += 16)
#pragma unroll
      for (int si = 0; si < 16; ++si) {
        const int s = sb + si;
        float4 nw = w4, nr = r4, nk = k4, nd = d4, na = a4;
        float nv = vr;
        if (s + 1 < CH) {
          const float* bp = buf + (s + 1) * 384;
          nw = *(const float4*)(bp + ks); nr = *(const float4*)(bp + 64 + ks); nk = *(const float4*)(bp + 128 + ks);
          nd = *(const float4*)(bp + 256 + ks); na = *(const float4*)(bp + 320 + ks);
          nv = bp[192 + row];
        }
        const f2 w01 = {w4.x, w4.y}, w23 = {w4.z, w4.w}, k01 = {k4.x, k4.y}, k23 = {k4.z, k4.w};
        const f2 d01 = {d4.x, d4.y}, d23 = {d4.z, d4.w}, a01 = {a4.x, a4.y}, a23 = {a4.z, a4.w};
        const f2 r01 = {r4.x, r4.y}, r23 = {r4.z, r4.w};
        f2 m = S01 * k01 + S23 * k23;
        const f2 pre01 = S01 * w01 + d01 * vr, pre23 = S23 * w23 + d23 * vr;
        float sk = row16_sum(m.x + m.y);
        S01 = pre01 - a01 * sk;
        S23 = pre23 - a23 * sk;
        const f2 q = S01 * r01 + S23 * r23;
        const float qq = quad_sum(q.x + q.y);
        obuf[s * 64 + (tid >> 2)] = qq;
        w4 = nw; r4 = nr; k4 = nk; d4 = nd; a4 = na; vr = nv;
      }
      S[0] = S01.x; S[1] = S01.y; S[2] = S23.x; S[3] = S23.y;
#pragma unroll
      for (int hh = 0; hh < 2; ++hh) {
        const int s = hh * 16 + lir;
        const float4 o4 = *(const float4*)(obuf + s * 64 + ((tid >> 4) << 2));
        const float o = (o4.x + o4.y) + (o4.z + o4.w);
        int st = chunk * CH + s;
        int tok = dir ? (seq0 + T - 1 - st) : (seq0 + st);
        O[(size_t)tok * 512 + h * 64 + row] = o;
      }
      return;
    } else {
      float myo = 0.f;
#pragma unroll 1
      for (int sb = 0; sb < CH; sb += 4)
#pragma unroll
        for (int si = 0; si < 4; ++si) {
          const int s = sb + si;
          const float* bp = buf + s * 384;
          float wv[KPT], rv[KPT], kkv[KPT], kdv[KPT], kav[KPT];
#pragma unroll
          for (int i = 0; i < KPT; i += 4) {
            *(float4*)(wv + i) = *(const float4*)(bp + ks + i);
            *(float4*)(rv + i) = *(const float4*)(bp + 64 + ks + i);
            *(float4*)(kkv + i) = *(const float4*)(bp + 128 + ks + i);
            *(float4*)(kdv + i) = *(const float4*)(bp + 256 + ks + i);
            *(float4*)(kav + i) = *(const float4*)(bp + 320 + ks + i);
          }
          const float vr = bp[192 + row];
          float sk = 0.f;
#pragma unroll
          for (int i = 0; i < KPT; ++i) sk += S[i] * kkv[i];
          sk = quad_sum(sk);
          float o = 0.f;
#pragma unroll
          for (int i = 0; i < KPT; ++i) {
            S[i] = S[i] * wv[i] - sk * kav[i] + vr * kdv[i];
            o += S[i] * rv[i];
          }
          o = quad_sum(o);
          myo = (si == lir) ? o : myo;
          if (si == 3) {
            int st = chunk * CH + sb + lir;
            int tok = dir ? (seq0 + T - 1 - st) : (seq0 + st);
            O[(size_t)tok * 512 + h * 64 + row] = myo;
          }
        }
    }
  };
  if (KPT == 4) __builtin_amdgcn_s_setprio(3);
  issue(0);
  for (int c0 = 0; c0 < nch; ++c0) {
    asm volatile("s_waitcnt lgkmcnt(0)\n\ts_barrier" ::: "memory");
    commit();
    asm volatile("s_waitcnt lgkmcnt(0)\n\ts_barrier" ::: "memory");
    if (c0 + 1 < nch) issue(c0 + 1);
    compute(c0);
  }
  if (KPT == 4) __builtin_amdgcn_s_setprio(0);
  if (!lat) {
    float* so = (float*)p.out + OUT_SRW + ((((size_t)(b * 2 + l) * 2 + dir) * 8 + h) * 64 + row) * 64 + ks;
#pragma unroll
    for (int i = 0; i < KPT; ++i) so[i] = S[i];
  }
}

DEVI void attn_item(const Params& p, int l, int it, unsigned char* sm) {
  const int tid = TIDX, lane = tid & 63, w = tid >> 6, fr = lane & 15, fq = lane >> 4;
  u16* Ks = (u16*)sm;
  u16* VT = (u16*)(sm + 9216);
  float* rpbs = (float*)(sm + 18432);
  const u16* Z = (const u16*)(p.ws + OFF_Z);
  const bool lat = it < 512;
  int b, h, r = 0, seqbase, qtok0;
  if (lat) { b = it >> 8; h = (it >> 5) & 7; r = it & 31; seqbase = 4096 + b * 2048; qtok0 = seqbase + r * 64; }
  else { int j = it - 512; b = j >> 5; h = (j >> 2) & 7; int qb = j & 3; seqbase = b * 256; qtok0 = seqbase + qb * 64; }
  bf16x8 qf[2];
#pragma unroll
  for (int ks = 0; ks < 2; ++ks) qf[ks] = *(const bf16x8*)(Z + (size_t)(qtok0 + w * 16 + fr) * PIN + h * 64 + ks * 32 + fq * 8);
  if (lat)
    for (int i = tid; i < 465; i += 256) rpbs[i] = p.in[11][(size_t)(l * 8 + h) * 465 + i];
  float m_run = -3e38f, l_run = 0.f;
  f32x4 o[4];
#pragma unroll
  for (int d = 0; d < 4; ++d) o[d] = f32x4{0.f, 0.f, 0.f, 0.f};
  const int ntiles = lat ? 16 : 4;
  const int row_start = lat ? clampi(r - 4, 0, 24) : 0;
  const int cbs = lat ? clampi(w * 16 - 8, 0, 32) : 0;
  for (int ti = 0; ti < ntiles; ++ti) {
    __syncthreads();
    const bool ctxtile = lat && ti < 8;
    if (ctxtile) {
      const float* kc = p.in[2] + ((((size_t)b * 2 + l) * 8 + h) * 512 + ti * 64) * 64;
      const float* vc = p.in[3] + ((((size_t)b * 2 + l) * 8 + h) * 512 + ti * 64) * 64;
      {
        const int key = tid >> 2, dp = (tid & 3) * 16;
        float t[16];
#pragma unroll
        for (int c = 0; c < 4; ++c) *(float4*)(t + c * 4) = *(const float4*)(kc + key * 64 + dp + c * 4);
        *(uint4*)(Ks + key * 72 + dp) = pack8(t);
        *(uint4*)(Ks + key * 72 + dp + 8) = pack8(t + 8);
      }
      {
        const int key = tid & 63, dp = (tid >> 6) * 16;
        float t[16];
#pragma unroll
        for (int c = 0; c < 4; ++c) *(float4*)(t + c * 4) = *(const float4*)(vc + key * 64 + dp + c * 4);
#pragma unroll
        for (int i = 0; i < 16; ++i) VT[(dp + i) * 72 + key] = f2bf(t[i]);
      }
    } else {
      const int trow = lat ? (row_start + ti - 8) : ti;
      const u16* zr = Z + (size_t)(seqbase + trow * 64) * PIN;
      {
        const int key = tid >> 2, dp = (tid & 3) * 16;
        const u16* src = zr + (size_t)key * PIN + 512 + h * 64 + dp;
        *(uint4*)(Ks + key * 72 + dp) = *(const uint4*)src;
        *(uint4*)(Ks + key * 72 + dp + 8) = *(const uint4*)(src + 8);
      }
      {
        const int key = tid & 63, dp = (tid >> 6) * 16;
        const u16* src = zr + (size_t)key * PIN + 1024 + h * 64 + dp;
        uint4 r0 = *(const uint4*)src, r1 = *(const uint4*)(src + 8);
        const u16* a0 = (const u16*)&r0;
        const u16* a1 = (const u16*)&r1;
#pragma unroll
        for (int i = 0; i < 8; ++i) { VT[(dp + i) * 72 + key] = a0[i]; VT[(dp + 8 + i) * 72 + key] = a1[i]; }
      }
    }
    __syncthreads();
    const bool win = lat && !ctxtile;
    const int nsteps = win ? 1 : 2;
    for (int st = 0; st < nsteps; ++st) {
      const int ko = win ? cbs : st * 32;
      f32x4 s0 = f32x4{0.f, 0.f, 0.f, 0.f}, s1 = s0;
#pragma unroll
      for (int ks = 0; ks < 2; ++ks) {
        bf16x8 a0 = *(const bf16x8*)(Ks + (ko + fr) * 72 + ks * 32 + fq * 8);
        bf16x8 a1 = *(const bf16x8*)(Ks + (ko + 16 + fr) * 72 + ks * 32 + fq * 8);
        s0 = mfma16(a0, qf[ks], s0);
        s1 = mfma16(a1, qf[ks], s1);
      }
      float sv[8];
#pragma unroll
      for (int j = 0; j < 4; ++j) { sv[j] = s0[j] * 0.125f; sv[4 + j] = s1[j] * 0.125f; }
      if (win) {
        const int qc = w * 16 + fr;
        const int dr = (row_start + ti - 8) - r + 7;
        const int qs = clampi(qc - 8, 0, 48);
#pragma unroll
        for (int e = 0; e < 8; ++e) {
          int kc_ = ko + ((e < 4) ? (fq * 4 + e) : (16 + fq * 4 + e - 4));
          int dc = clampi(kc_ - qc, -15, 15) + 15;
          int rel = kc_ - qs;
          sv[e] = (rel >= 0 && rel < 16) ? (sv[e] + rpbs[dr * 31 + dc]) : -1e30f;
        }
      }
      float mx = sv[0];
#pragma unroll
      for (int e = 1; e < 8; ++e) mx = fmaxf(mx, sv[e]);
      mx = fmaxf(mx, __shfl_xor(mx, 16));
      mx = fmaxf(mx, __shfl_xor(mx, 32));
      const float m_new = fmaxf(m_run, mx);
      const float alpha = __expf(m_run - m_new);
      float pe[8], ps = 0.f;
#pragma unroll
      for (int e = 0; e < 8; ++e) { pe[e] = __expf(sv[e] - m_new); ps += pe[e]; }
      l_run = l_run * alpha + ps;
      m_run = m_new;
#pragma unroll
      for (int d = 0; d < 4; ++d) o[d] *= alpha;
      uint4 pk = pack8(pe);
      bf16x8 pb = __builtin_bit_cast(bf16x8, pk);
#pragma unroll
      for (int d = 0; d < 4; ++d) {
        uint2 lo = *(const uint2*)(VT + (d * 16 + fr) * 72 + ko + fq * 4);
        uint2 hi = *(const uint2*)(VT + (d * 16 + fr) * 72 + ko + 16 + fq * 4);
        uint4 vv; vv.x = lo.x; vv.y = lo.y; vv.z = hi.x; vv.w = hi.y;
        o[d] = mfma16(__builtin_bit_cast(bf16x8, vv), pb, o[d]);
      }
    }
  }
  float lt = l_run + __shfl_xor(l_run, 16);
  lt += __shfl_xor(lt, 32);
  const float inv = 1.f / lt;
  u16* ONA = (u16*)(p.ws + OFF_ONA);
  const int tok = qtok0 + w * 16 + fr;
#pragma unroll
  for (int d = 0; d < 4; ++d) {
    uint2 ov; ov.x = cvtpk(o[d][0] * inv, o[d][1] * inv); ov.y = cvtpk(o[d][2] * inv, o[d][3] * inv);
    *(uint2*)(ONA + (size_t)tok * 512 + h * 64 + d * 16 + fq * 4) = ov;
  }
}

constexpr int MIX_NSCAN_LAT = 128, MIX_NSCAN_CTX = 256, MIX_NATT = 1024, MIX_NRET = 512;
constexpr int MIX_TOTAL = MIX_NSCAN_LAT + MIX_NSCAN_CTX + MIX_NATT + MIX_NRET;
#ifndef ONLYP
#define ONLYP -1
#endif
#define PH_ON(x) (ONLYP < 0 || ONLYP == (x))
DEVI void mix_item(const Params& p, int l, int it, unsigned char* sm) {
  if (it < MIX_NSCAN_LAT) {
    int ch = it >> 2, rq = it & 3;
    if (PH_ON(12)) scan_run<4>(p, l, true, ch >> 4, ch & 7, (ch >> 3) & 1, rq * 16, sm);
    return;
  }
  it -= MIX_NSCAN_LAT;
  if (it < MIX_NSCAN_CTX) { if (PH_ON(13)) scan_run<16>(p, l, false, it >> 4, it & 7, (it >> 3) & 1, 0, sm); return; }
  it -= MIX_NSCAN_CTX;
  if (it < MIX_NATT) { if (PH_ON(14)) attn_item(p, l, it, sm); return; }
  it -= MIX_NATT;
  if (PH_ON(15)) ret3_item(p, l, it, sm);
}

DEVI void fin_item(const Params& p, int l, int it0) {
  const int tid = TIDX;
#pragma unroll 2
  for (int sub = 0; sub < 8; ++sub) {
  const int it = it0 * 8 + sub;
  const int tok = it * 2 + (tid >> 7), c4 = (tid & 127) * 4;
  const size_t o = (size_t)tok * 512 + c4;
  float4 a = *(const float4*)((const float*)(p.ws + OFF_OF) + o);
  float4 b = *(const float4*)((const float*)(p.ws + OFF_OF) + (size_t)NTOK * 512 + o);
  float x[4] = {a.x + b.x, a.y + b.y, a.z + b.z, a.w + b.w};
  float mu = row16_sum(x[0] + x[1] + x[2] + x[3]) * (1.f / 64.f);
  float q = 0.f;
#pragma unroll
  for (int i = 0; i < 4; ++i) { float d = x[i] - mu; q += d * d; }
  float rs = rsqrtf(row16_sum(q) * (1.f / 64.f) + 64e-5f);
  float4 gw = *(const float4*)(p.in[24] + l * 512 + c4), gb = *(const float4*)(p.in[25] + l * 512 + c4);
  float gwv[4] = {gw.x, gw.y, gw.z, gw.w}, gbv[4] = {gb.x, gb.y, gb.z, gb.w};
  float bon[4], g[4];
  unpack4(*(const uint2*)((const u16*)(p.ws + OFF_RWBON) + o), bon);
  unpack4(*(const uint2*)((const u16*)(p.ws + OFF_RWG) + o), g);
  float y[4];
#pragma unroll
  for (int i = 0; i < 4; ++i) y[i] = ((x[i] - mu) * rs * gwv[i] + gbv[i] + bon[i]) * g[i];
  uint2 ov; ov.x = cvtpk(y[0], y[1]); ov.y = cvtpk(y[2], y[3]);
  *(uint2*)((u16*)(p.ws + OFF_ORW) + o) = ov;
  }
}

DEVI void ln2_item(const Params& p, int l, int it0) {
  const int lane = TIDX & 63, w = TIDX >> 6;
#pragma unroll 1
  for (int sub = 0; sub < 4; ++sub) {
  const int it = it0 * 4 + sub;
  const int tok = it * 4 + w;
  const float* y = (const float*)(p.ws + OFF_Y) + (size_t)tok * 1024;
  const float* mod = (const float*)(p.ws + OFF_MOD) + ((size_t)l * 3 + modrow(tok)) * 6144;
  float v[16];
  float s = 0.f;
#pragma unroll
  for (int i = 0; i < 4; ++i) { *(float4*)(v + i * 4) = *(const float4*)(y + lane * 4 + 256 * i); }
#pragma unroll
  for (int i = 0; i < 16; ++i) s += v[i];
  float mu = wave_sum(s) * (1.f / 1024.f);
  float q = 0.f;
#pragma unroll
  for (int i = 0; i < 16; ++i) { float d = v[i] - mu; q += d * d; }
  float rs = rsqrtf(wave_sum(q) * (1.f / 1024.f) + 1e-5f);
  float* X1 = (float*)(p.ws + OFF_X1) + (size_t)tok * 1024;
  s = 0.f;
#pragma unroll
  for (int i = 0; i < 4; ++i) {
    int c = lane * 4 + 256 * i;
    float4 g = *(const float4*)(p.in[28] + l * 1024 + c), bb = *(const float4*)(p.in[29] + l * 1024 + c);
    v[i * 4 + 0] = (v[i * 4 + 0] - mu) * rs * g.x + bb.x;
    v[i * 4 + 1] = (v[i * 4 + 1] - mu) * rs * g.y + bb.y;
    v[i * 4 + 2] = (v[i * 4 + 2] - mu) * rs * g.z + bb.z;
    v[i * 4 + 3] = (v[i * 4 + 3] - mu) * rs * g.w + bb.w;
    *(float4*)(X1 + c) = *(float4*)(v + i * 4);
    s += v[i * 4] + v[i * 4 + 1] + v[i * 4 + 2] + v[i * 4 + 3];
  }
  mu = wave_sum(s) * (1.f / 1024.f);
  q = 0.f;
#pragma unroll
  for (int i = 0; i < 16; ++i) { float d = v[i] - mu; q += d * d; }
  rs = rsqrtf(wave_sum(q) * (1.f / 1024.f) + 1e-5f);
  u16* H2 = (u16*)(p.ws + OFF_H2) + (size_t)tok * 1024;
#pragma unroll
  for (int i = 0; i < 4; ++i) {
    int c = lane * 4 + 256 * i;
    float4 sh = *(const float4*)(mod + 3072 + c), sc = *(const float4*)(mod + 4096 + c);
    uint2 o;
    o.x = cvtpk((v[i * 4] - mu) * rs * (1.f + sc.x) + sh.x, (v[i * 4 + 1] - mu) * rs * (1.f + sc.y) + sh.y);
    o.y = cvtpk((v[i * 4 + 2] - mu) * rs * (1.f + sc.z) + sh.z, (v[i * 4 + 3] - mu) * rs * (1.f + sc.w) + sh.w);
    *(uint2*)(H2 + c) = o;
  }
  }
}

DEVI int f2ord(float f) { int i = __float_as_int(f); return i ^ ((i >> 31) & 0x7fffffff); }
DEVI float ord2f(int i) { return __int_as_float(i ^ ((i >> 31) & 0x7fffffff)); }
DEVI void insert16(int (&t)[16], int x) {
#pragma unroll
  for (int i = 0; i < 16; ++i) { int hi = max(t[i], x); x = min(t[i], x); t[i] = hi; }
}
DEVI void route_item(const Params& p, int l, int it, unsigned char* sm) {
  const int tid = TIDX, lane = tid & 63, w = tid >> 6;
  const int g = w >> 1, pp = w & 1;
  const int tb = it >> 3, h = it & 7;
  const int tok = tb * 128 + g * 64 + lane;
  float* kl = (float*)sm;
  const float* Q = (const float*)(p.ws + OFF_Q) + (size_t)tok * 1024 + h * 128 + pp * 64;
  float q[64];
#pragma unroll
  for (int i = 0; i < 16; ++i) *(float4*)(q + i * 4) = *(const float4*)(Q + i * 4);
  int T[16];
#pragma unroll
  for (int i = 0; i < 16; ++i) T[i] = (int)0x80000000;
  const float* keys = p.in[33] + (size_t)((l * 8 + h) * 2) * 8192;
  for (int half = 0; half < 2; ++half) {
    __syncthreads();
#pragma unroll
    for (int i = 0; i < 8; ++i) {
      int e = (i * 256 + tid) * 4;
      int ps = e >> 12, r = e & 4095;
      *(float4*)(kl + e) = *(const float4*)(keys + (size_t)ps * 8192 + half * 4096 + r);
    }
    __syncthreads();
    const float* kb = kl + pp * 4096;
#pragma unroll 2
    for (int k = 0; k < 64; ++k) {
      const float* kp = kb + k * 64;
      float s0 = 0.f, s1 = 0.f, s2 = 0.f, s3 = 0.f;
#pragma unroll
      for (int d = 0; d < 64; d += 4) {
        float4 kv = *(const float4*)(kp + d);
        s0 += q[d] * kv.x; s1 += q[d + 1] * kv.y; s2 += q[d + 2] * kv.z; s3 += q[d + 3] * kv.w;
      }
      float sc = (s0 + s1) + (s2 + s3);
      int bits = (f2ord(sc) & ~127) | (127 - (half * 64 + k));
      insert16(T, bits);
    }
  }
  __syncthreads();
  int* xb = (int*)sm;
  if (pp == 1) {
#pragma unroll
    for (int i = 0; i < 16; ++i) xb[(g * 16 + i) * 64 + lane] = T[i];
  }
  __syncthreads();
  if (pp == 0) {
    int T1[16];
#pragma unroll
    for (int i = 0; i < 16; ++i) T1[i] = xb[(g * 16 + i) * 64 + lane];
    int F[16];
#pragma unroll
    for (int i = 0; i < 16; ++i) F[i] = (int)0x80000000;
#pragma unroll
    for (int i = 0; i < 16; ++i) {
#pragma unroll
      for (int j = 0; j < 16; ++j) {
        if ((i + 1) * (j + 1) <= 16) {
          float c = ord2f(T[i] & ~127) + ord2f(T1[j] & ~127);
          int bits = (f2ord(c) & ~255) | (255 - (i * 16 + j));
          insert16(F, bits);
        }
      }
    }
    float fs[16], den = 0.f;
    const float f0 = ord2f(F[0] & ~255);
#pragma unroll
    for (int i = 0; i < 16; ++i) { fs[i] = __expf(ord2f(F[i] & ~255) - f0); den += fs[i]; }
    const float inv = 1.f / den;
    int* EIDX = (int*)(p.ws + OFF_EIDX) + (size_t)tok * 128 + h * 16;
    float* GATE = (float*)(p.ws + OFF_GATE) + (size_t)tok * 128 + h * 16;
    int eo[16]; float go[16];
#pragma unroll
    for (int i = 0; i < 16; ++i) {
      int pos = 255 - (F[i] & 255);
      int i0 = pos >> 4, j0 = pos & 15;
      int k0 = 0, k1 = 0;
#pragma unroll
      for (int c = 0; c < 16; ++c) {
        int a0 = 127 - (T[c] & 127), a1 = 127 - (T1[c] & 127);
        k0 = (i0 == c) ? a0 : k0;
        k1 = (j0 == c) ? a1 : k1;
      }
      eo[i] = k0 * 128 + k1;
      go[i] = fs[i] * inv;
    }
#pragma unroll
    for (int i = 0; i < 16; i += 4) {
      *(int4*)(EIDX + i) = make_int4(eo[i], eo[i + 1], eo[i + 2], eo[i + 3]);
      *(float4*)(GATE + i) = make_float4(go[i], go[i + 1], go[i + 2], go[i + 3]);
    }
  }
}

DEVI void fp8x16_to_f32(int4 r, float* f) {
  const int w[4] = {r.x, r.y, r.z, r.w};
#pragma unroll
  for (int i = 0; i < 4; ++i) {
    f32x2_ lo = __builtin_amdgcn_cvt_pk_f32_fp8(w[i], false);
    f32x2_ hi = __builtin_amdgcn_cvt_pk_f32_fp8(w[i], true);
    f[i * 4] = lo.x; f[i * 4 + 1] = lo.y; f[i * 4 + 2] = hi.x; f[i * 4 + 3] = hi.y;
  }
}
DEVI void expert_item(const Params& p, int l, int it) {
  const int lane = TIDX & 63;
  const int w = __builtin_amdgcn_readfirstlane(TIDX >> 6);
  const int tok = it * 4 + w;
  const u16* H2 = (const u16*)(p.ws + OFF_H2) + (size_t)tok * 1024;
  float hv[16];
  unpack8(*(const uint4*)(H2 + lane * 16), hv);
  unpack8(*(const uint4*)(H2 + lane * 16 + 8), hv + 8);
  const int* EIDX = (const int*)(p.ws + OFF_EIDX) + (size_t)tok * 128;
  const float* GATE = (const float*)(p.ws + OFF_GATE) + (size_t)tok * 128;
  const unsigned char* UB = (const unsigned char*)(p.ws + OFF_UB) + (size_t)l * UV_LSTRIDE;
  const unsigned char* VB = (const unsigned char*)(p.ws + OFF_VB) + (size_t)l * UV_LSTRIDE;
  const float* USC = (const float*)(p.ws + OFF_SC) + (0 * 2 + l) * 16384;
  const float* VSC = (const float*)(p.ws + OFF_SC) + (1 * 2 + l) * 16384;
  float f[16];
#pragma unroll
  for (int i = 0; i < 16; ++i) f[i] = 0.f;
  const int ei0 = EIDX[lane], ei1 = EIDX[64 + lane];
  const float ga0 = GATE[lane] * VSC[ei0], ga1 = GATE[64 + lane] * VSC[ei1];
  const float us0 = USC[ei0], us1 = USC[ei1];
  float dl0 = 0.f, dl1 = 0.f;
  int4 ba[8], bb[8];
#define ROW_LOAD(BUF, BASE, G)                                                                       \
  {                                                                                                  \
    const int src_ = ((G) < 8) ? ei0 : ei1;                                                          \
    _Pragma("unroll") for (int j = 0; j < 8; ++j) {                                                  \
      const int idx = __builtin_amdgcn_readlane(src_, (((G) & 7) << 3) + j);                         \
      BUF[j] = *(const int4*)(BASE + (size_t)idx * 1024 + lane * 16);                                \
    }                                                                                                \
  }
#define U_COMP(BUF, G)                                                                               \
  {                                                                                                  \
    const bool lo_ = (G) < 8;                                                                        \
    _Pragma("unroll") for (int j = 0; j < 8; ++j) {                                                  \
      const int ln_ = (((G) & 7) << 3) + j;                                                          \
      float uu[16];                                                                                  \
      fp8x16_to_f32(BUF[j], uu);                                                                     \
      float d0 = 0.f, d1 = 0.f;                                                                      \
      _Pragma("unroll") for (int i = 0; i < 16; i += 2) { d0 += uu[i] * hv[i]; d1 += uu[i + 1] * hv[i + 1]; } \
      float dd = row16_sum(d0 + d1);                                                                 \
      const float r0 = __int_as_float(__builtin_amdgcn_readlane(__float_as_int(dd), 0));            \
      const float r1 = __int_as_float(__builtin_amdgcn_readlane(__float_as_int(dd), 16));           \
      const float r2 = __int_as_float(__builtin_amdgcn_readlane(__float_as_int(dd), 32));           \
      const float r3 = __int_as_float(__builtin_amdgcn_readlane(__float_as_int(dd), 48));           \
      const float d = (r0 + r1) + (r2 + r3);                                                         \
      dl0 = (lo_ && lane == ln_) ? d : dl0;                                                          \
      dl1 = (!lo_ && lane == ln_) ? d : dl1;                                                         \
    }                                                                                                \
  }
#define V_COMP(BUF, G)                                                                               \
  {                                                                                                  \
    const float asrc_ = ((G) < 8) ? act0 : act1;                                                     \
    _Pragma("unroll") for (int j = 0; j < 8; ++j) {                                                  \
      const int ln_ = (((G) & 7) << 3) + j;                                                          \
      const float act = __int_as_float(__builtin_amdgcn_readlane(__float_as_int(asrc_), ln_));      \
      float vv[16];                                                                                  \
      fp8x16_to_f32(BUF[j], vv);                                                                     \
      _Pragma("unroll") for (int i = 0; i < 16; ++i) f[i] += act * vv[i];                            \
    }                                                                                                \
  }
  ROW_LOAD(ba, UB, 0);
#pragma unroll 1
  for (int g = 0; g < 16; g += 2) {
    ROW_LOAD(bb, UB, g + 1);
    U_COMP(ba, g);
    if (g + 2 < 16) { ROW_LOAD(ba, UB, g + 2); } else { ROW_LOAD(ba, VB, 0); }
    U_COMP(bb, g + 1);
  }
  const float x0 = dl0 * us0, x1 = dl1 * us1;
  const float act0 = 0.5f * x0 * (1.f + erff(x0 * 0.70710678118654752f)) * ga0;
  const float act1 = 0.5f * x1 * (1.f + erff(x1 * 0.70710678118654752f)) * ga1;
#pragma unroll 1
  for (int g = 0; g < 16; g += 2) {
    ROW_LOAD(bb, VB, g + 1);
    V_COMP(ba, g);
    if (g + 2 < 16) ROW_LOAD(ba, VB, g + 2);
    V_COMP(bb, g + 1);
  }
#undef ROW_LOAD
#undef U_COMP
#undef V_COMP
  const float* X1 = (const float*)(p.ws + OFF_X1) + (size_t)tok * 1024 + lane * 16;
  const float* mod = (const float*)(p.ws + OFF_MOD) + ((size_t)l * 3 + modrow(tok)) * 6144 + lane * 16;
  float y[16];
  float s = 0.f;
#pragma unroll
  for (int c = 0; c < 4; ++c) {
    float4 x = *(const float4*)(X1 + c * 4), gt = *(const float4*)(mod + 5120 + c * 4);
    int o = c * 4;
    y[o] = ALPHA * x.x + gt.x * f[o]; y[o + 1] = ALPHA * x.y + gt.y * f[o + 1];
    y[o + 2] = ALPHA * x.z + gt.z * f[o + 2]; y[o + 3] = ALPHA * x.w + gt.w * f[o + 3];
    s += y[o] + y[o + 1] + y[o + 2] + y[o + 3];
  }
  float mu = wave_sum(s) * (1.f / 1024.f);
  float q = 0.f;
#pragma unroll
  for (int i = 0; i < 16; ++i) { float d = y[i] - mu; q += d * d; }
  float rs = rsqrtf(wave_sum(q) * (1.f / 1024.f) + 1e-5f);
  float* xo = ((l == 1) ? ((float*)p.out + OUT_Y + (size_t)tok * 1024) : ((float*)(p.ws + OFF_X) + (size_t)tok * 1024)) + lane * 16;
  s = 0.f;
#pragma unroll
  for (int c = 0; c < 4; ++c) {
    int o = c * 4;
    float4 g = *(const float4*)(p.in[30] + l * 1024 + lane * 16 + o), bb = *(const float4*)(p.in[31] + l * 1024 + lane * 16 + o);
    y[o] = (y[o] - mu) * rs * g.x + bb.x; y[o + 1] = (y[o + 1] - mu) * rs * g.y + bb.y;
    y[o + 2] = (y[o + 2] - mu) * rs * g.z + bb.z; y[o + 3] = (y[o + 3] - mu) * rs * g.w + bb.w;
    *(float4*)(xo + o) = make_float4(y[o], y[o + 1], y[o + 2], y[o + 3]);
    s += y[o] + y[o + 1] + y[o + 2] + y[o + 3];
  }
  if (l == 0) {
    const float* mod1 = (const float*)(p.ws + OFF_MOD) + ((size_t)3 + modrow(tok)) * 6144 + lane * 16;
    mu = wave_sum(s) * (1.f / 1024.f);
    q = 0.f;
#pragma unroll
    for (int i = 0; i < 16; ++i) { float d = y[i] - mu; q += d * d; }
    rs = rsqrtf(wave_sum(q) * (1.f / 1024.f) + 1e-5f);
    u16* H = (u16*)(p.ws + OFF_H) + (size_t)tok * 1024 + lane * 16;
    float t[16];
#pragma unroll
    for (int c = 0; c < 4; ++c) {
      float4 sh = *(const float4*)(mod1 + c * 4), sc = *(const float4*)(mod1 + 1024 + c * 4);
      int o = c * 4;
      t[o] = (y[o] - mu) * rs * (1.f + sc.x) + sh.x; t[o + 1] = (y[o + 1] - mu) * rs * (1.f + sc.y) + sh.y;
      t[o + 2] = (y[o + 2] - mu) * rs * (1.f + sc.z) + sh.z; t[o + 3] = (y[o + 3] - mu) * rs * (1.f + sc.w) + sh.w;
    }
    *(uint4*)(H) = pack8(t);
    *(uint4*)(H + 8) = pack8(t + 8);
  }
}

constexpr int NPHASES = 22;
DEVI int phase_total(int idx) {
  if (idx == 0) return P0_TOTAL;
  if (idx == 1) return 2048;
  const int l = (idx - 2) / 10, t = (idx - 2) % 10;
  switch (t) {
    case 0: return 0;
    case 1: return 512 + 512;
    case 2: return MIX_TOTAL + (l == 0 ? (P0_NT + P0_NUV) : 0);
    case 3: return 512;
    case 4: return 0;
    case 5: return 0;
    case 6: return 512;
    case 7: return 0;
    case 8: return 512;
    default: return 2048;
  }
}
DEVI int phase_xcd_total(int idx) {
  if (idx < 2) return 0;
  const int t = (idx - 2) % 10;
  if (t == 0) return 504;
  if (t == 4 || t == 5 || t == 7) return 64;
  return 0;
}
DEVI void phase_item_x(const Params& p, int idx, int xcd, int q, unsigned char* sm) {
  const int l = (idx - 2) / 10, t = (idx - 2) % 10;
  const int it = (q >> 3) * 64 + xcd * 8 + (q & 7);
  if (t == 0) { if (PH_ON(2)) g1_item(p, l, it, sm); }
  else if (t == 4) { if (PH_ON(6)) g2_item(p, l, it, sm); }
  else if (t == 5) { if (PH_ON(7)) g3_item(p, l, it, sm); }
  else { if (PH_ON(9)) g4_item(p, l, it, sm); }
}
DEVI void phase_item(const Params& p, int idx, int it, unsigned char* sm) {
  if (idx == 0) { if (PH_ON(0)) phase0_item(p, it, sm); return; }
  if (idx == 1) { if (PH_ON(1)) ln1_item(p, it); return; }
  const int l = (idx - 2) / 10, t = (idx - 2) % 10;
  switch (t) {
    case 0: break;
    case 1: if (it < 512) { if (PH_ON(3)) rwprep_item(p, l, it); } else { if (PH_ON(4)) ret1_item(p, l, it - 512, sm); } break;
    case 2:
      if (it < MIX_TOTAL) mix_item(p, l, it, sm);
      else if (it < MIX_TOTAL + P0_NT) p0_tiles(p, 1, it - MIX_TOTAL, sm);
      else convert_uv_item(p, 1, it - MIX_TOTAL - P0_NT);
      break;
    case 3: if (PH_ON(5)) fin_item(p, l, it); break;
    case 4: break;
    case 5: break;
    case 6: if (PH_ON(8)) ln2_item(p, l, it); break;
    case 7: break;
    case 8: if (PH_ON(10)) route_item(p, l, it, sm); break;
    default: if (PH_ON(11)) expert_item(p, l, it); break;
  }
}

#define XB_TMO      128
#define XB_XCNT(j)  (256  + 64 * (j))
#define XB_XSUB(j)  (1280 + 64 * (j))
#define XB_XGEN(j)  (2304 + 64 * (j))
#define XB_TOP      3328
#define XB_TOPGEN   3392
#define XCD_BAR_WORDS 3456
#define XB_SPIN_CAP (1u << 18)
#define LAS __attribute__((address_space(3)))
DEVI unsigned xb_ld(unsigned* p) { return __hip_atomic_load(p, __ATOMIC_RELAXED, __HIP_MEMORY_SCOPE_AGENT); }
DEVI unsigned xb_add(unsigned* p, unsigned v) { return __hip_atomic_fetch_add(p, v, __ATOMIC_RELAXED, __HIP_MEMORY_SCOPE_AGENT); }
DEVI unsigned xb_xcc_id() { return (unsigned)__builtin_amdgcn_s_getreg((3 << 11) | 20) & 0xFu; }
#define XB_SPIN(cond, bar) do { unsigned _sp = 0; while (cond) { __builtin_amdgcn_s_sleep(1); \
    if ((++_sp & 255u) == 0u) { if (xb_ld(&(bar)[XB_TMO])) break; if (_sp > XB_SPIN_CAP) { atomicAdd(&(bar)[XB_TMO], 1u); break; } } } } while (0)
struct XcdBarrier { unsigned* bar; unsigned x; volatile LAS unsigned* st; };
DEVI XcdBarrier xcd_barrier_post(unsigned* bar, volatile LAS unsigned* st) {
  XcdBarrier b; b.bar = bar; b.x = xb_xcc_id(); b.st = st;
  if (threadIdx.x == 0) (void)xb_add(&bar[XB_XCNT(b.x)], 1u);
  return b;
}
DEVI void xcd_barrier_complete(unsigned* bar, unsigned x, unsigned& nloc, unsigned& nx) {
  const unsigned G = gridDim.x * gridDim.y * gridDim.z;
  unsigned sum, cnt, mine, sp = 0u;
  for (;;) {
    sum = 0u; cnt = 0u; mine = 0u;
#pragma unroll
    for (unsigned j = 0; j < 16; ++j) { const unsigned c = xb_ld(&bar[XB_XCNT(j)]); sum += c; cnt += (c > 0u) ? 1u : 0u; mine = (j == x) ? c : mine; }
    if (sum == G) break;
    __builtin_amdgcn_s_sleep(1);
    if ((++sp & 255u) == 0u) { if (xb_ld(&bar[XB_TMO])) break; if (sp > XB_SPIN_CAP) { atomicAdd(&bar[XB_TMO], 1u); break; } }
  }
  nloc = mine > 0u ? mine : 1u; nx = cnt > 0u ? cnt : 1u;
}
DEVI void xcd_barrier(const XcdBarrier& b) {
  asm volatile("s_waitcnt vmcnt(0)" ::: "memory");
  __syncthreads();
  if (threadIdx.x == 0) {
    unsigned* bar = b.bar;
    __builtin_amdgcn_s_waitcnt(0);
    unsigned nloc = b.st[0], nx = b.st[1];
    if (nloc == 0u) { xcd_barrier_complete(bar, b.x, nloc, nx); b.st[0] = nloc; b.st[1] = nx; }
    const unsigned old = xb_add(&bar[XB_XSUB(b.x)], 1u);
    const unsigned gen = old / nloc;
    if (old + 1u == (gen + 1u) * nloc) {
      __builtin_amdgcn_fence(__ATOMIC_RELEASE, "agent");
      asm volatile("s_waitcnt vmcnt(0)" ::: "memory");
      const unsigned og = xb_add(&bar[XB_TOP], 1u);
      const unsigned tg = og / nx;
      if (og + 1u == (tg + 1u) * nx) xb_add(&bar[XB_TOPGEN], 1u);
      else XB_SPIN(xb_ld(&bar[XB_TOPGEN]) == tg, bar);
      __builtin_amdgcn_fence(__ATOMIC_ACQUIRE, "agent");
      xb_add(&bar[XB_XGEN(b.x)], 1u);
      asm volatile("s_waitcnt vmcnt(0)" ::: "memory");
    } else {
      XB_SPIN(xb_ld(&bar[XB_XGEN(b.x)]) == gen, bar);
      __builtin_amdgcn_fence(__ATOMIC_ACQUIRE, "agent");
      asm volatile("s_waitcnt vmcnt(0)" ::: "memory");
    }
  }
  __syncthreads();
}

__global__ void __launch_bounds__(256, 2) mega_kernel(KArgs ka, int ph_lo, int ph_hi) {
  __shared__ __attribute__((aligned(16))) unsigned char sm[57344];
  __shared__ int s_item;
  __shared__ g_cf32* s_in[36];
  __shared__ __attribute__((aligned(16))) unsigned s_xb[4];
  cg::grid_group grid = cg::this_grid();
  if (threadIdx.x < 4) s_xb[threadIdx.x] = 0u;
  if (threadIdx.x < 36) {
    const float* const* kp = (const float* const*)__builtin_amdgcn_kernarg_segment_ptr();
    s_in[threadIdx.x] = (g_cf32*)kp[threadIdx.x];
  }
  __syncthreads();
  Params p;
  p.in.t = s_in; p.out = (g_f32*)ka.out; p.ws = (g_u8*)ka.ws;
  int* ctr = (int*)(p.ws + OFF_CTR);
  const XcdBarrier xb = xcd_barrier_post((unsigned*)(p.ws + OFF_BAR), (volatile LAS unsigned*)s_xb);
  for (int idx = ph_lo; idx < ph_hi; ++idx) {
    const int total = phase_total(idx);
#ifdef PROBE_T
    const int ptype = idx < 2 ? idx : 2 + (idx - 2) % 10;
    const int reps = (ptype == PROBE_T) ? 2 : 1;
#else
    const int reps = 1;
#endif
    for (int rep = 0; rep < reps; ++rep) {
      const int nx = phase_xcd_total(idx);
      if (nx) {
        const int xcd = blockIdx.x & 7;
        while (true) {
          __syncthreads();
          if (TIDX == 0) s_item = atomicAdd(&ctr[64 + (idx + 32 * rep) * 8 + xcd], 1);
          __syncthreads();
          const int q_ = s_item;
          if (q_ >= nx) break;
          Params q = p;
          asm volatile("" : "+s"(q.ws));
          asm volatile("" : "+s"(q.out));
          asm volatile("" : "+s"(q.in.t));
          phase_item_x(q, idx, xcd, q_, sm);
        }
      }
      while (true) {
        __syncthreads();
        if (TIDX == 0) s_item = atomicAdd(&ctr[512 + (idx + 32 * rep) * 8 + (blockIdx.x & 7)], 1);
        __syncthreads();
        const int it = s_item * 8 + (blockIdx.x & 7);
        if (it >= total) break;
        Params q = p;
        asm volatile("" : "+s"(q.ws));
        asm volatile("" : "+s"(q.out));
        asm volatile("" : "+s"(q.in.t));
        phase_item(q, idx, it, sm);
      }
      if (rep + 1 < reps) xcd_barrier(xb);
    }
    if (idx + 1 < ph_hi) {
      if (ph_lo < 0) grid.sync();
      xcd_barrier(xb);
    }
  }
}

#ifndef MULTI_LAUNCH
#define MULTI_LAUNCH 0
#endif

extern "C" void kernel_launch(void* const* d_in, const int* in_sizes, int n_in, void* d_out, int out_size, void* d_ws,
                              size_t ws_size, hipStream_t stream) {
  static int grid_blocks = 0;
  if (!grid_blocks) {
    int dev = 0, cus = 0, per_cu = 0;
    hipGetDevice(&dev);
    hipDeviceGetAttribute(&cus, hipDeviceAttributeMultiprocessorCount, dev);
    hipOccupancyMaxActiveBlocksPerMultiprocessor(&per_cu, mega_kernel, 256, 0);
    if (per_cu > 2) per_cu = 2;
    if (per_cu < 1) per_cu = 1;
    grid_blocks = cus * per_cu;
  }
  KArgs p{};
  for (int i = 0; i < 36; ++i) p.in[i] = (const float*)d_in[i];
  p.out = (float*)d_out;
  p.ws = (unsigned char*)d_ws;
  if (ws_size < OFF_END) { fprintf(stderr, "workspace too small: %zu < %zu\n", ws_size, (size_t)OFF_END); return; }
  hipMemsetAsync(d_ws, 0, 4096, stream);
  hipMemsetAsync((unsigned char*)d_ws + OFF_BAR, 0, 16384, stream);
#if MULTI_LAUNCH
  for (int ph = 0; ph < NPHASES; ++ph) {
    hipLaunchKernelGGL(mega_kernel, dim3(grid_blocks), dim3(256), 0, stream, p, ph, ph + 1);
  }
#else
  int lo = 0, hi = NPHASES;
  void* args[] = {&p, &lo, &hi};
  hipError_t e = hipLaunchCooperativeKernel((void*)mega_kernel, dim3(grid_blocks), dim3(256), args, 0, stream);
  if (e != hipSuccess) fprintf(stderr, "cooperative launch failed: %s (grid %d)\n", hipGetErrorString(e), grid_blocks);
#endif
}
```

```cpp
#include <hip/hip_runtime.h>
#include <hip/hip_bf16.h>
#include <hip/hip_cooperative_groups.h>
#include <cstdio>
namespace cg = cooperative_groups;

typedef unsigned short u16;
using bf16x8 = __attribute__((ext_vector_type(8))) short;
using f32x4 = __attribute__((ext_vector_type(4))) float;
#define DEVI __device__ __forceinline__
__device__ __forceinline__ int ltid_() { int t = threadIdx.x; asm volatile("" : "+v"(t)); return t; }
#define TIDX ltid_()

constexpr int NTOK = 8192;
constexpr int PIN = 8064;
constexpr float ALPHA = 1.4142135623730951f;
constexpr size_t OUT_Y = 0;
constexpr size_t OUT_NAK = 8388608;
constexpr size_t OUT_NAV = 12582912;
constexpr size_t OUT_SRET = 16777216;
constexpr size_t OUT_SRW = 18874368;
constexpr size_t OFF_CTR = 0;
constexpr size_t OFF_TAB = 4096;
constexpr size_t OFF_MOD = 16384;
constexpr size_t OFF_WINT = 1048576;
constexpr size_t OFF_WBRT = OFF_WINT + 33030144;
constexpr size_t OFF_WOUTT = OFF_WBRT + 6291456;
constexpr size_t OFF_WQT = OFF_WOUTT + 4194304;
constexpr size_t OFF_WUPT = OFF_WQT + 4194304;
constexpr size_t OFF_AUPT = OFF_WUPT + 262144;
constexpr size_t OFF_GUPT = OFF_AUPT + 262144;
constexpr size_t OFF_UB = OFF_GUPT + 262144;
constexpr size_t OFF_VB = OFF_UB + 33554432;
constexpr size_t OFF_Z = OFF_VB + 33554432;
constexpr size_t OFF_X = OFF_Z + 132120576;
constexpr size_t OFF_H = OFF_X + 33554432;
constexpr size_t OFF_ONA = OFF_H + 16777216;
constexpr size_t OFF_ORT = OFF_ONA + 8388608;
constexpr size_t OFF_ORW = OFF_ORT + 8388608;
constexpr size_t OFF_GA = OFF_ORW + 8388608;
constexpr size_t SZB = 8388608;
constexpr size_t OFF_RWW = OFF_GA;
constexpr size_t OFF_RWR = OFF_RWW + 4 * SZB;
constexpr size_t OFF_RWV = OFF_RWR + SZB;
constexpr size_t OFF_RWKK = OFF_RWV + SZB;
constexpr size_t OFF_RWKC = OFF_RWKK + SZB;
constexpr size_t OFF_RWKD = OFF_RWKC + SZB;
constexpr size_t OFF_RWKKA = OFF_RWKD + 2 * SZB;
constexpr size_t OFF_RWG = OFF_RWKKA + 2 * SZB;
constexpr size_t OFF_RWBON = OFF_RWG + SZB;
constexpr size_t OFF_OF = OFF_RWBON + SZB;
constexpr size_t OFF_KV = OFF_OF + 4 * SZB;
constexpr size_t OFF_BAR = OFF_KV + 33554432;
constexpr size_t OFF_SC = OFF_BAR + 16384;
constexpr size_t OFF_END = OFF_SC + 4 * 65536;
constexpr size_t OFF_Y = OFF_GA;
constexpr size_t OFF_X1 = OFF_GA + 33554432;
constexpr size_t OFF_Q = OFF_GA + 2 * 33554432;
constexpr size_t OFF_H2 = OFF_GA + 3 * 33554432;
constexpr size_t OFF_EIDX = OFF_H2 + 16777216;
constexpr size_t OFF_GATE = OFF_EIDX + 4194304;

constexpr size_t UV_LSTRIDE = 16777216;
struct KArgs {
  const float* in[36];
  float* out;
  unsigned char* ws;
};
typedef __attribute__((address_space(1))) unsigned char g_u8;
typedef __attribute__((address_space(1))) float g_f32;
typedef const __attribute__((address_space(1))) float g_cf32;
struct InTab {
  g_cf32* const* t;
  DEVI const float* operator[](int k) const { return (const float*)t[k]; }
};
struct Params {
  InTab in;
  g_f32* out;
  g_u8* ws;
};
DEVI const float* uniform_ptr(const float* q) {
  unsigned long long v = (unsigned long long)q;
  unsigned lo = __builtin_amdgcn_readfirstlane((unsigned)v), hi = __builtin_amdgcn_readfirstlane((unsigned)(v >> 32));
  return (const float*)(((unsigned long long)hi << 32) | lo);
}

DEVI float bf2f(u16 h) { return __uint_as_float(((unsigned)h) << 16); }
DEVI unsigned cvtpk(float lo, float hi) {
  unsigned r;
  asm volatile("v_cvt_pk_bf16_f32 %0, %1, %2" : "=v"(r) : "v"(lo), "v"(hi));
  return r;
}
DEVI u16 f2bf(float f) { return (u16)(cvtpk(f, f) & 0xffffu); }
DEVI float sigmoidf_(float x) { return 1.f / (1.f + __expf(-x)); }
template <int CTRL> DEVI float dpp(float x) {
  return __builtin_bit_cast(float, __builtin_amdgcn_update_dpp(0, __builtin_bit_cast(int, x), CTRL, 0xf, 0xf, true));
}
DEVI float quad_sum(float x) { x += dpp<0xB1>(x); x += dpp<0x4E>(x); return x; }
DEVI float row16_sum(float x) { x = quad_sum(x); x += dpp<0x141>(x); x += dpp<0x140>(x); return x; }
DEVI float wave_sum(float x) { x = row16_sum(x); x += __shfl_xor(x, 16); x += __shfl_xor(x, 32); return x; }
DEVI void unpack8(uint4 v, float* f) {
  f[0] = __uint_as_float(v.x << 16); f[1] = __uint_as_float(v.x & 0xffff0000u);
  f[2] = __uint_as_float(v.y << 16); f[3] = __uint_as_float(v.y & 0xffff0000u);
  f[4] = __uint_as_float(v.z << 16); f[5] = __uint_as_float(v.z & 0xffff0000u);
  f[6] = __uint_as_float(v.w << 16); f[7] = __uint_as_float(v.w & 0xffff0000u);
}
DEVI void unpack4(uint2 v, float* f) {
  f[0] = __uint_as_float(v.x << 16); f[1] = __uint_as_float(v.x & 0xffff0000u);
  f[2] = __uint_as_float(v.y << 16); f[3] = __uint_as_float(v.y & 0xffff0000u);
}
DEVI uint4 pack8(const float* f) {
  uint4 r; r.x = cvtpk(f[0], f[1]); r.y = cvtpk(f[2], f[3]); r.z = cvtpk(f[4], f[5]); r.w = cvtpk(f[6], f[7]); return r;
}
DEVI f32x4 mfma16(bf16x8 a, bf16x8 b, f32x4 c) { return __builtin_amdgcn_mfma_f32_16x16x32_bf16(a, b, c, 0, 0, 0); }
DEVI int modrow(int tok) { return tok < 4096 ? 0 : 1 + ((tok - 4096) >> 11); }
DEVI const float* xin_row(const Params& p, int tok) {
  return tok < 4096 ? p.in[0] + (size_t)tok * 1024 : p.in[1] + (size_t)(tok - 4096) * 1024;
}
DEVI int clampi(int v, int lo, int hi) { return v < lo ? lo : (v > hi ? hi : v); }

template <int NT> DEVI void wave_mma(const u16* A, int lda, const u16* B, int ldb, int K, f32x4* acc) {
  const int lane = TIDX & 63, fr = lane & 15, fq = lane >> 4;
  for (int k0 = 0; k0 < K; k0 += 32) {
    bf16x8 a = *(const bf16x8*)(A + fr * lda + k0 + fq * 8);
#pragma unroll
    for (int n = 0; n < NT; ++n) {
      bf16x8 b = *(const bf16x8*)(B + (n * 16 + fr) * ldb + k0 + fq * 8);
      acc[n] = mfma16(a, b, acc[n]);
    }
  }
}

#define LDS_RD(dst, addr, off) asm volatile("ds_read_b128 %0, %1 offset:" #off : "=v"(dst) : "v"(addr))
DEVI void gemm_acc(const u16* __restrict__ A, int lda, const u16* __restrict__ Bt, int ldb, int K, int m0, int n0,
                   unsigned char* sm, f32x4 (&acc)[4][4]) {
  const int tid = TIDX, lane = tid & 63, wid = tid >> 6, wr = wid >> 1, wc = wid & 1, fr = lane & 15, fq = lane >> 4;
  const int nk = K >> 5;
  const int b0 = tid * 16, r0 = b0 >> 6, c0 = (b0 & 63) >> 1;
  const u16* Ap = A + (size_t)(m0 + r0) * lda + c0;
  const u16* Bp = Bt + (size_t)(n0 + r0) * ldb + c0;
  const unsigned lbase = (unsigned)(size_t)(__attribute__((address_space(3))) unsigned char*)sm;
  const unsigned aoff = lbase + (wr * 64 + fr) * 64 + fq * 16;
  const unsigned boff = lbase + 8192 + (wc * 64 + fr) * 64 + fq * 16;
  auto issue = [&](int kt, int st) {
    unsigned char* SA = sm + st * 16384;
    unsigned char* SB = SA + 8192;
    __builtin_amdgcn_global_load_lds((const unsigned*)(Ap + kt * 32), (__attribute__((address_space(3))) unsigned*)(SA + b0), 16, 0, 0);
    __builtin_amdgcn_global_load_lds((const unsigned*)(Ap + (size_t)64 * lda + kt * 32), (__attribute__((address_space(3))) unsigned*)(SA + b0 + 4096), 16, 0, 0);
    __builtin_amdgcn_global_load_lds((const unsigned*)(Bp + kt * 32), (__attribute__((address_space(3))) unsigned*)(SB + b0), 16, 0, 0);
    __builtin_amdgcn_global_load_lds((const unsigned*)(Bp + (size_t)64 * ldb + kt * 32), (__attribute__((address_space(3))) unsigned*)(SB + b0 + 4096), 16, 0, 0);
  };
  issue(0, 0);
  if (nk > 1) issue(1, 1);
  int st = 0;
  for (int kt = 0; kt < nk; ++kt) {
    if (kt + 1 < nk) asm volatile("s_waitcnt vmcnt(4)\n\ts_barrier" ::: "memory");
    else asm volatile("s_waitcnt vmcnt(0)\n\ts_barrier" ::: "memory");
    if (kt + 2 < nk) { int s2 = st + 2; if (s2 >= 3) s2 -= 3; issue(kt + 2, s2); }
    const unsigned aa = aoff + st * 16384, bb = boff + st * 16384;
    bf16x8 a0, a1, a2, a3, b0_, b1_, b2_, b3_;
    LDS_RD(a0, aa, 0); LDS_RD(b0_, bb, 0); LDS_RD(b1_, bb, 1024); LDS_RD(b2_, bb, 2048); LDS_RD(b3_, bb, 3072);
    LDS_RD(a1, aa, 1024); LDS_RD(a2, aa, 2048); LDS_RD(a3, aa, 3072);
    asm volatile("s_waitcnt lgkmcnt(0)" : "+v"(a0), "+v"(a1), "+v"(a2), "+v"(a3), "+v"(b0_), "+v"(b1_), "+v"(b2_), "+v"(b3_));
    acc[0][0] = mfma16(a0, b0_, acc[0][0]); acc[0][1] = mfma16(a0, b1_, acc[0][1]);
    acc[0][2] = mfma16(a0, b2_, acc[0][2]); acc[0][3] = mfma16(a0, b3_, acc[0][3]);
    acc[1][0] = mfma16(a1, b0_, acc[1][0]); acc[1][1] = mfma16(a1, b1_, acc[1][1]);
    acc[1][2] = mfma16(a1, b2_, acc[1][2]); acc[1][3] = mfma16(a1, b3_, acc[1][3]);
    acc[2][0] = mfma16(a2, b0_, acc[2][0]); acc[2][1] = mfma16(a2, b1_, acc[2][1]);
    acc[2][2] = mfma16(a2, b2_, acc[2][2]); acc[2][3] = mfma16(a2, b3_, acc[2][3]);
    acc[3][0] = mfma16(a3, b0_, acc[3][0]); acc[3][1] = mfma16(a3, b1_, acc[3][1]);
    acc[3][2] = mfma16(a3, b2_, acc[3][2]); acc[3][3] = mfma16(a3, b3_, acc[3][3]);
    st = (st == 2) ? 0 : st + 1;
  }
  __syncthreads();
}
#define EPI_LOOP                                                                                         \
  const int _lane = TIDX & 63, _wid = TIDX >> 6, _wr = _wid >> 1, _wc = _wid & 1, _fr = _lane & 15, \
            _fq = _lane >> 4;                                                                            \
  _Pragma("unroll") for (int m = 0; m < 4; ++m) _Pragma("unroll") for (int n = 0; n < 4; ++n)            \
      _Pragma("unroll") for (int j = 0; j < 4; ++j)
#define EPI_ROW (m0 + _wr * 64 + m * 16 + _fq * 4 + j)
#define EPI_COL (n0 + _wc * 64 + n * 16 + _fr)

DEVI void zero_acc(f32x4 (&acc)[4][4]) {
#pragma unroll
  for (int m = 0; m < 4; ++m)
#pragma unroll
    for (int n = 0; n < 4; ++n) acc[m][n] = f32x4{0.f, 0.f, 0.f, 0.f};
}

__constant__ double ROPE_FREQ[16] = {1.0, 0.5623413251903491, 0.31622776601683794, 0.1778279410038923, 0.1,
                                     0.05623413251903491, 0.03162277660168379, 0.01778279410038923, 0.01,
                                     0.005623413251903491, 0.0031622776601683794, 0.0017782794100389228, 0.001,
                                     0.0005623413251903491, 0.00031622776601683794, 0.00017782794100389227};

DEVI void transpose_tile(const float* __restrict__ src, int K, int N, u16* __restrict__ dst, int kt, int nt, unsigned char* sm) {
  float* tile = (float*)sm;
  const int tid = TIDX;
  const int k0 = kt * 64, n0 = nt * 64;
#pragma unroll
  for (int i = 0; i < 16; ++i) {
    int kk = i * 4 + (tid >> 6), nn = tid & 63;
    tile[kk * 65 + nn] = src[(size_t)(k0 + kk) * N + n0 + nn];
  }
  __syncthreads();
#pragma unroll
  for (int i = 0; i < 16; ++i) {
    int nn = i * 4 + (tid >> 6), kk = tid & 63;
    dst[(size_t)(n0 + nn) * K + k0 + kk] = f2bf(tile[kk * 65 + nn]);
  }
}

typedef float f32x2_ __attribute__((ext_vector_type(2)));
DEVI void convert_uv_item(const Params& p, int l, int it) {
  const int which = it >> 9, chunk = it & 511;
  const int lane = TIDX & 63, w = TIDX >> 6;
#pragma unroll 2
  for (int sub = 0; sub < 8; ++sub) {
  const int row = chunk * 32 + sub * 4 + w;
  const float* src = p.in[34 + which] + (size_t)l * 16777216 + (size_t)row * 1024 + lane * 16;
  unsigned char* base = (unsigned char*)(p.ws + (which ? OFF_VB : OFF_UB)) + (size_t)l * UV_LSTRIDE;
  float v[16];
#pragma unroll
  for (int i = 0; i < 4; ++i) *(float4*)(v + i * 4) = *(const float4*)(src + i * 4);
  float am = 0.f;
#pragma unroll
  for (int i = 0; i < 16; ++i) am = fmaxf(am, fabsf(v[i]));
  am = fmaxf(am, dpp<0xB1>(am)); am = fmaxf(am, dpp<0x4E>(am)); am = fmaxf(am, dpp<0x141>(am)); am = fmaxf(am, dpp<0x140>(am));
  am = fmaxf(am, __shfl_xor(am, 16)); am = fmaxf(am, __shfl_xor(am, 32));
  const float sc = (am > 0.f) ? (240.f / am) : 1.f;
  int o[4];
#pragma unroll
  for (int i = 0; i < 4; ++i) {
    int wv = 0;
    wv = __builtin_amdgcn_cvt_pk_fp8_f32(v[i * 4] * sc, v[i * 4 + 1] * sc, wv, false);
    wv = __builtin_amdgcn_cvt_pk_fp8_f32(v[i * 4 + 2] * sc, v[i * 4 + 3] * sc, wv, true);
    o[i] = wv;
  }
  *(int4*)(base + (size_t)row * 1024 + lane * 16) = make_int4(o[0], o[1], o[2], o[3]);
  if (lane == 0) ((float*)(p.ws + OFF_SC))[(which * 2 + l) * 16384 + row] = am * (1.f / 240.f);
  }
}

constexpr int P0_NT = 740;
constexpr int P0_NUV = 1024;
constexpr int P0_NMOD = 192;
constexpr int P0_TOTAL = P0_NMOD + P0_NT + P0_NUV + 1;

constexpr int P0_TILES_L = 2960;
constexpr int P0_NT_ITEMS = P0_TILES_L / 4;
DEVI void p0_tile1(const Params& p, int l, int u, unsigned char* sm) {
  const float* src; u16* dst; int K, N, kt, nt;
  if (u < 2016) { kt = u / 126; nt = u % 126; K = 1024; N = 8064;
    src = p.in[10] + (size_t)l * 1024 * 8064; dst = (u16*)(p.ws + OFF_WINT) + (size_t)l * 8064 * 1024; }
  else if ((u -= 2016) < 384) { int j = l * 3 + u / 128, r = u % 128; kt = r / 16; nt = r % 16; K = 512; N = 1024;
    src = p.in[26] + (size_t)j * 512 * 1024; dst = (u16*)(p.ws + OFF_WBRT) + (size_t)j * 1024 * 512; }
  else if ((u -= 384) < 256) { kt = u / 16; nt = u % 16; K = 1024; N = 1024;
    src = p.in[27] + (size_t)l * 1048576; dst = (u16*)(p.ws + OFF_WOUTT) + (size_t)l * 1048576; }
  else if ((u -= 256) < 256) { kt = u / 16; nt = u % 16; K = 1024; N = 1024;
    src = p.in[32] + (size_t)l * 1048576; dst = (u16*)(p.ws + OFF_WQT) + (size_t)l * 1048576; }
  else if ((u -= 256) < 16) { int j = l * 2 + u / 8; kt = 0; nt = u % 8; K = 64; N = 512;
    src = p.in[17] + (size_t)j * 32768; dst = (u16*)(p.ws + OFF_WUPT) + (size_t)j * 32768; }
  else if ((u -= 16) < 16) { int j = l * 2 + u / 8; kt = 0; nt = u % 8; K = 64; N = 512;
    src = p.in[19] + (size_t)j * 32768; dst = (u16*)(p.ws + OFF_AUPT) + (size_t)j * 32768; }
  else { u -= 16; kt = u / 8; nt = u % 8; K = 128; N = 512;
    src = p.in[20] + (size_t)l * 65536; dst = (u16*)(p.ws + OFF_GUPT) + (size_t)l * 65536; }
  transpose_tile(src, K, N, dst, kt, nt, sm);
}
DEVI void p0_tiles(const Params& p, int l, int item, unsigned char* sm) {
  for (int i = 0; i < 4; ++i) {
    if (i) __syncthreads();
    p0_tile1(p, l, item * 4 + i, sm);
  }
}
DEVI void phase0_item(const Params& p, int it, unsigned char* sm) {
  const int tid = TIDX;
  if (it < P0_NMOD) {
    const int l = it / 96, n0 = (it % 96) * 64;
    const int kg = tid >> 4, c4 = (tid & 15) * 4;
    float acc[3][4];
#pragma unroll
    for (int r = 0; r < 3; ++r)
#pragma unroll
      for (int i = 0; i < 4; ++i) acc[r][i] = 0.f;
    const float* wm = p.in[8] + (size_t)l * 1024 * 6144;
#pragma unroll 8
    for (int k = kg * 64; k < kg * 64 + 64; ++k) {
      float4 w = *(const float4*)(wm + (size_t)k * 6144 + n0 + c4);
      float c0 = p.in[7][k], c1 = p.in[6][k], c2 = p.in[6][1024 + k];
      float s0 = c0 * sigmoidf_(c0), s1 = c1 * sigmoidf_(c1), s2 = c2 * sigmoidf_(c2);
      acc[0][0] += s0 * w.x; acc[0][1] += s0 * w.y; acc[0][2] += s0 * w.z; acc[0][3] += s0 * w.w;
      acc[1][0] += s1 * w.x; acc[1][1] += s1 * w.y; acc[1][2] += s1 * w.z; acc[1][3] += s1 * w.w;
      acc[2][0] += s2 * w.x; acc[2][1] += s2 * w.y; acc[2][2] += s2 * w.z; acc[2][3] += s2 * w.w;
    }
    float* red = (float*)sm;
#pragma unroll
    for (int r = 0; r < 3; ++r)
#pragma unroll
      for (int i = 0; i < 4; ++i) red[(kg * 3 + r) * 64 + c4 + i] = acc[r][i];
    __syncthreads();
    if (tid < 192) {
      int r = tid >> 6, col = tid & 63;
      float s = p.in[9][(size_t)l * 6144 + n0 + col];
      for (int g = 0; g < 16; ++g) s += red[(g * 3 + r) * 64 + col];
      ((float*)(p.ws + OFF_MOD))[((size_t)l * 3 + r) * 6144 + n0 + col] = s;
    }
    return;
  }
  it -= P0_NMOD;
  if (it < P0_NT) {
    p0_tiles(p, 0, it, sm);
    return;
  }
  if (0) {
    int t = it;
    const float* src; u16* dst; int K, N, kt, nt;
    if (t < 4032) { int l = t / 2016, r = t % 2016; kt = r / 126; nt = r % 126; K = 1024; N = 8064;
      src = p.in[10] + (size_t)l * 1024 * 8064; dst = (u16*)(p.ws + OFF_WINT) + (size_t)l * 8064 * 1024; }
    else if ((t -= 4032) < 768) { int j = t / 128, r = t % 128; kt = r / 16; nt = r % 16; K = 512; N = 1024;
      src = p.in[26] + (size_t)j * 512 * 1024; dst = (u16*)(p.ws + OFF_WBRT) + (size_t)j * 1024 * 512; }
    else if ((t -= 768) < 512) { int l = t / 256, r = t % 256; kt = r / 16; nt = r % 16; K = 1024; N = 1024;
      src = p.in[27] + (size_t)l * 1048576; dst = (u16*)(p.ws + OFF_WOUTT) + (size_t)l * 1048576; }
    else if ((t -= 512) < 512) { int l = t / 256, r = t % 256; kt = r / 16; nt = r % 16; K = 1024; N = 1024;
      src = p.in[32] + (size_t)l * 1048576; dst = (u16*)(p.ws + OFF_WQT) + (size_t)l * 1048576; }
    else if ((t -= 512) < 32) { int j = t / 8; kt = 0; nt = t % 8; K = 64; N = 512;
      src = p.in[17] + (size_t)j * 32768; dst = (u16*)(p.ws + OFF_WUPT) + (size_t)j * 32768; }
    else if ((t -= 32) < 32) { int j = t / 8; kt = 0; nt = t % 8; K = 64; N = 512;
      src = p.in[19] + (size_t)j * 32768; dst = (u16*)(p.ws + OFF_AUPT) + (size_t)j * 32768; }
    else { t -= 32; int l = t / 16, r = t % 16; kt = r / 8; nt = r % 8; K = 128; N = 512;
      src = p.in[20] + (size_t)l * 65536; dst = (u16*)(p.ws + OFF_GUPT) + (size_t)l * 65536; }
    transpose_tile(src, K, N, dst, kt, nt, sm);
    return;
  }
  it -= P0_NT;
  if (it < P0_NUV) { convert_uv_item(p, 0, it); return; }
  float* tab = (float*)(p.ws + OFF_TAB);
  for (int e = tid; e < 1024; e += 256) {
    int pos = e >> 4, f = e & 15;
    double rev = (double)pos * ROPE_FREQ[f] * 0.15915494309189535;
    rev -= floor(rev);
    float rf = (float)rev;
    tab[e] = __builtin_amdgcn_cosf(rf);
    tab[1024 + e] = __builtin_amdgcn_sinf(rf);
  }
}

DEVI void ln1_item(const Params& p, int it) {
  const int lane = TIDX & 63, w = TIDX >> 6;
  const int tok = it * 4 + w;
  const float* x = xin_row(p, tok);
  const float* mod = (const float*)(p.ws + OFF_MOD) + (size_t)modrow(tok) * 6144;
  float4 v[4];
  float s = 0.f;
#pragma unroll
  for (int i = 0; i < 4; ++i) { v[i] = *(const float4*)(x + lane * 4 + 256 * i); s += v[i].x + v[i].y + v[i].z + v[i].w; }
  float mu = wave_sum(s) * (1.f / 1024.f);
  float q = 0.f;
#pragma unroll
  for (int i = 0; i < 4; ++i) { float a = v[i].x - mu, b = v[i].y - mu, c = v[i].z - mu, d = v[i].w - mu; q += a * a + b * b + c * c + d * d; }
  float rs = rsqrtf(wave_sum(q) * (1.f / 1024.f) + 1e-5f);
  u16* H = (u16*)(p.ws + OFF_H) + (size_t)tok * 1024;
#pragma unroll
  for (int i = 0; i < 4; ++i) {
    int c = lane * 4 + 256 * i;
    float4 sh = *(const float4*)(mod + c), sc = *(const float4*)(mod + 1024 + c);
    uint2 o;
    o.x = cvtpk((v[i].x - mu) * rs * (1.f + sc.x) + sh.x, (v[i].y - mu) * rs * (1.f + sc.y) + sh.y);
    o.y = cvtpk((v[i].z - mu) * rs * (1.f + sc.z) + sh.z, (v[i].w - mu) * rs * (1.f + sc.w) + sh.w);
    *(uint2*)(H + c) = o;
  }
}

DEVI void g1_item(const Params& p, int l, int it, unsigned char* sm) {
  const int nt = it >> 6, mt = it & 63;
  const int m0 = mt * 128, n0 = nt * 128;
  f32x4 acc[4][4];
  zero_acc(acc);
  gemm_acc((const u16*)(p.ws + OFF_H), 1024, (const u16*)(p.ws + OFF_WINT) + (size_t)l * 8064 * 1024, 1024, 1024, m0, n0, sm, acc);
  u16* Z = (u16*)(p.ws + OFF_Z);
  EPI_LOOP {
    int row = EPI_ROW, col = EPI_COL;
    float v = acc[m][n][j];
    Z[(size_t)row * PIN + col] = f2bf(v);
    if (row < 4096 && col >= 512 && col < 1536) {
      int which = (col - 512) >> 9, cc = (col - 512) & 511, h = cc >> 6, d = cc & 63, b = row >> 8, s = row & 255;
      p.out[OUT_NAK + (size_t)which * 4194304 + ((((size_t)(b * 2 + l) * 8 + h) * 256 + s) * 64 + d)] = v;
    }
  }
}
DEVI void g2_item(const Params& p, int l, int it, unsigned char* sm) {
  const int nt = it >> 6, mt = it & 63;
  const int m0 = mt * 128, n0 = nt * 128;
  f32x4 tot[4][4];
  zero_acc(tot);
  const u16* Z = (const u16*)(p.ws + OFF_Z);
  for (int i = 0; i < 3; ++i) {
    f32x4 acc[4][4];
    zero_acc(acc);
    const u16* A = (const u16*)(p.ws + (i == 0 ? OFF_ONA : (i == 1 ? OFF_ORT : OFF_ORW)));
    gemm_acc(A, 512, (const u16*)(p.ws + OFF_WBRT) + (size_t)(l * 3 + i) * 1024 * 512, 512, 512, m0, n0, sm, acc);
    EPI_LOOP {
      int row = EPI_ROW, col = EPI_COL;
      float g = bf2f(Z[(size_t)row * PIN + 4992 + i * 1024 + col]);
      tot[m][n][j] += sigmoidf_(g) * acc[m][n][j];
    }
  }
  u16* MG = (u16*)(p.ws + OFF_H);
  EPI_LOOP { MG[(size_t)EPI_ROW * 1024 + EPI_COL] = f2bf(tot[m][n][j]); }
}
DEVI void g3_item(const Params& p, int l, int it, unsigned char* sm) {
  const int nt = it >> 6, mt = it & 63;
  const int m0 = mt * 128, n0 = nt * 128;
  f32x4 acc[4][4];
  zero_acc(acc);
  gemm_acc((const u16*)(p.ws + OFF_H), 1024, (const u16*)(p.ws + OFF_WOUTT) + (size_t)l * 1048576, 1024, 1024, m0, n0, sm, acc);
  float* Y = (float*)(p.ws + OFF_Y);
  const float* mod = (const float*)(p.ws + OFF_MOD) + (size_t)l * 3 * 6144;
  const float* X = (const float*)(p.ws + OFF_X);
  EPI_LOOP {
    int row = EPI_ROW, col = EPI_COL;
    float xr = (l == 0) ? xin_row(p, row)[col] : X[(size_t)row * 1024 + col];
    float gt = mod[(size_t)modrow(row) * 6144 + 2048 + col];
    Y[(size_t)row * 1024 + col] = ALPHA * xr + gt * acc[m][n][j];
  }
}
DEVI void g4_item(const Params& p, int l, int it, unsigned char* sm) {
  const int nt = it >> 6, mt = it & 63;
  const int m0 = mt * 128, n0 = nt * 128;
  f32x4 acc[4][4];
  zero_acc(acc);
  gemm_acc((const u16*)(p.ws + OFF_H2), 1024, (const u16*)(p.ws + OFF_WQT) + (size_t)l * 1048576, 1024, 1024, m0, n0, sm, acc);
  float* Q = (float*)(p.ws + OFF_Q);
  EPI_LOOP { Q[(size_t)EPI_ROW * 1024 + EPI_COL] = acc[m][n][j]; }
}

DEVI void load_qk16(const u16* zp  , int part, bool lat, int prow, int pcol, const float* tab,
                    float scale, float* out) {
  if (!lat) {
    float t[16];
    unpack8(*(const uint4*)(zp + part * 16), t);
    unpack8(*(const uint4*)(zp + part * 16 + 8), t + 8);
#pragma unroll
    for (int i = 0; i < 16; ++i) out[i] = t[i] * scale;
    return;
  }
  const int half = part >> 1, isp2 = part & 1;
  float p1[16], p2[16];
  unpack8(*(const uint4*)(zp + half * 32), p1);
  unpack8(*(const uint4*)(zp + half * 32 + 8), p1 + 8);
  unpack8(*(const uint4*)(zp + half * 32 + 16), p2);
  unpack8(*(const uint4*)(zp + half * 32 + 24), p2 + 8);
  const int pos = half ? pcol : prow;
  const float* ct = tab + pos * 16;
  const float* st = tab + 1024 + pos * 16;
#pragma unroll
  for (int f = 0; f < 16; ++f) {
    float c = ct[f], s = st[f];
    out[f] = (isp2 ? (p1[f] * s + p2[f] * c) : (p1[f] * c - p2[f] * s)) * scale;
  }
}
struct RetItem { int lat, b, h, n, N, seqbase, kvbase; };
DEVI RetItem ret_decode(int it) {
  RetItem r;
  if (it < 256) { r.lat = 1; r.b = it >> 7; r.h = (it >> 5) & 3; r.n = it & 31; r.N = 32; r.seqbase = 4096 + r.b * 2048; r.kvbase = 256 + (r.b * 4 + r.h) * 32; }
  else { int j = it - 256; r.lat = 0; r.b = j >> 4; r.h = (j >> 2) & 3; r.n = j & 3; r.N = 4; r.seqbase = r.b * 256; r.kvbase = (r.b * 4 + r.h) * 4; }
  return r;
}
DEVI void ret_gammas(const Params& p, int l, int h, float& lgf, float& lgb) {
  float xf = p.in[12][(l * 2 + 0) * 4 + h], xb = p.in[12][(l * 2 + 1) * 4 + h];
  lgf = -log2f(1.f + expf(-xf));
  lgb = -log2f(1.f + expf(-xb));
}

DEVI void ret1_item(const Params& p, int l, int it, unsigned char* sm) {
  const RetItem r = ret_decode(it);
  const int tid = TIDX, lane = tid & 63, w = tid >> 6, fr = lane & 15, fq = lane >> 4;
  u16* KTf = (u16*)sm;
  u16* KTb = (u16*)(sm + 9216);
  u16* VT = (u16*)(sm + 18432);
  const u16* Z = (const u16*)(p.ws + OFF_Z);
  const float* tab = (const float*)(p.ws + OFF_TAB);
  float lgf, lgb;
  ret_gammas(p, l, r.h, lgf, lgb);
  const int tok0 = r.seqbase + r.n * 64;
  {
    const int j = tid >> 2, part = tid & 3;
    float kv[16];
    load_qk16(Z + (size_t)(tok0 + j) * PIN + 1792 + r.h * 64, part, r.lat, r.n, j, tab, 0.125f, kv);
    const float df = exp2f(lgf * (float)(63 - j)), db = exp2f(lgb * (float)j);
#pragma unroll
    for (int i = 0; i < 16; ++i) {
      KTf[(part * 16 + i) * 72 + j] = f2bf(kv[i] * df);
      KTb[(part * 16 + i) * 72 + j] = f2bf(kv[i] * db);
    }
    const int jj = tid & 63, vp = (tid >> 6) * 32;
    const u16* vz = Z + (size_t)(tok0 + jj) * PIN + 2048 + r.h * 128 + vp;
#pragma unroll
    for (int c = 0; c < 4; ++c) {
      uint4 raw = *(const uint4*)(vz + c * 8);
      const u16* rv = (const u16*)&raw;
#pragma unroll
      for (int i = 0; i < 8; ++i) VT[(vp + c * 8 + i) * 72 + jj] = rv[i];
    }
  }
  __syncthreads();
  float* KV = (float*)(p.ws + OFF_KV) + (size_t)(r.kvbase + r.n) * 2 * 8192;
#pragma unroll
  for (int dir = 0; dir < 2; ++dir) {
    f32x4 acc[8];
#pragma unroll
    for (int n = 0; n < 8; ++n) acc[n] = f32x4{0.f, 0.f, 0.f, 0.f};
    wave_mma<8>((dir ? KTb : KTf) + w * 16 * 72, 72, VT, 72, 64, acc);
#pragma unroll
    for (int n = 0; n < 8; ++n)
#pragma unroll
      for (int j = 0; j < 4; ++j) KV[(size_t)dir * 8192 + (w * 16 + fq * 4 + j) * 128 + n * 16 + fr] = acc[n][j];
  }
}

DEVI void ret3_item(const Params& p, int l, int it, unsigned char* sm) {
  const RetItem r = ret_decode(it);
  const int tid = TIDX, lane = tid & 63, w = tid >> 6, fr = lane & 15, fq = lane >> 4;
  u16* Qs = (u16*)sm;
  u16* Ks = (u16*)(sm + 9216);
  u16* VT = (u16*)(sm + 18432);
  u16* ST = (u16*)(sm + 36864);
  const u16* Z = (const u16*)(p.ws + OFF_Z);
  const float* tab = (const float*)(p.ws + OFF_TAB);
  float lgf, lgb;
  ret_gammas(p, l, r.h, lgf, lgb);
  const int tok0 = r.seqbase + r.n * 64;
  {
    const int i = tid >> 2, part = tid & 3;
    float t[16];
    load_qk16(Z + (size_t)(tok0 + i) * PIN + 1536 + r.h * 64, part, r.lat, r.n, i, tab, 1.f, t);
    *(uint4*)(Qs + i * 72 + part * 16) = pack8(t);
    *(uint4*)(Qs + i * 72 + part * 16 + 8) = pack8(t + 8);
    load_qk16(Z + (size_t)(tok0 + i) * PIN + 1792 + r.h * 64, part, r.lat, r.n, i, tab, 0.125f, t);
    *(uint4*)(Ks + i * 72 + part * 16) = pack8(t);
    *(uint4*)(Ks + i * 72 + part * 16 + 8) = pack8(t + 8);
    const int jj = tid & 63, vp = (tid >> 6) * 32;
    const u16* vz = Z + (size_t)(tok0 + jj) * PIN + 2048 + r.h * 128 + vp;
#pragma unroll
    for (int c = 0; c < 4; ++c) {
      uint4 raw = *(const uint4*)(vz + c * 8);
      const u16* rv = (const u16*)&raw;
#pragma unroll
      for (int e = 0; e < 8; ++e) VT[(vp + c * 8 + e) * 72 + jj] = rv[e];
    }
  }
  __syncthreads();
  f32x4 at[4];
#pragma unroll
  for (int n = 0; n < 4; ++n) at[n] = f32x4{0.f, 0.f, 0.f, 0.f};
  wave_mma<4>(Qs + w * 16 * 72, 72, Ks, 72, 64, at);
  __syncthreads();
#pragma unroll
  for (int n = 0; n < 4; ++n)
#pragma unroll
    for (int j = 0; j < 4; ++j) {
      int i = w * 16 + fq * 4 + j, jc = n * 16 + fr;
      float mval = (i > jc) ? exp2f(lgf * (float)(i - jc)) : ((i < jc) ? exp2f(lgb * (float)(jc - i)) : 2.f);
      Ks[i * 72 + jc] = f2bf(at[n][j] * mval);
    }
  __syncthreads();
  f32x4 o[8];
#pragma unroll
  for (int n = 0; n < 8; ++n) o[n] = f32x4{0.f, 0.f, 0.f, 0.f};
  wave_mma<8>(Ks + w * 16 * 72, 72, VT, 72, 64, o);
  const float* KVb_ = (const float*)(p.ws + OFF_KV);
  for (int dir = 0; dir < 2; ++dir) {
    const float lg = dir ? lgb : lgf;
    const float cdec = exp2f(lg * 64.f);
    const int nprev = dir ? (r.N - 1 - r.n) : r.n;
    __syncthreads();
    {
      float S[32];
#pragma unroll
      for (int e8 = 0; e8 < 32; ++e8) {
        int e = e8 * 256 + tid;
        S[e8] = r.lat ? p.in[4][((((size_t)(r.b * 2 + l) * 2 + dir) * 4 + r.h) * 64) * 128 + e] : 0.f;
      }
#pragma unroll 2
      for (int m = 0; m < nprev; ++m) {
        const int ch = dir ? (r.N - 1 - m) : m;
        const float* kvp = KVb_ + ((size_t)(r.kvbase + ch) * 2 + dir) * 8192 + tid;
#pragma unroll
        for (int e8 = 0; e8 < 32; ++e8) S[e8] = S[e8] * cdec + kvp[e8 * 256];
      }
      const bool fin = (!r.lat) && (nprev == r.N - 1);
      const float* kvn = KVb_ + ((size_t)(r.kvbase + r.n) * 2 + dir) * 8192 + tid;
      float* so = (float*)p.out + OUT_SRET + ((((size_t)(r.b * 2 + l) * 2 + dir) * 4 + r.h) * 64) * 128 + tid;
#pragma unroll
      for (int e8 = 0; e8 < 32; ++e8) {
        int e = e8 * 256 + tid, d = e >> 7, v = e & 127;
        ST[v * 72 + d] = f2bf(S[e8]);
        if (fin) so[e8 * 256] = S[e8] * cdec + kvn[e8 * 256];
      }
    }
    __syncthreads();
    f32x4 t2[8];
#pragma unroll
    for (int n = 0; n < 8; ++n) t2[n] = f32x4{0.f, 0.f, 0.f, 0.f};
    wave_mma<8>(Qs + w * 16 * 72, 72, ST, 72, 64, t2);
#pragma unroll
    for (int j = 0; j < 4; ++j) {
      int i = w * 16 + fq * 4 + j;
      float dec = dir ? exp2f(lg * (float)(64 - i)) : exp2f(lg * (float)(i + 1));
#pragma unroll
      for (int n = 0; n < 8; ++n) o[n][j] += dec * t2[n][j];
    }
  }
  const float* gw = p.in[13] + l * 512 + r.h * 128;
  const float* gb = p.in[14] + l * 512 + r.h * 128;
  u16* ORT = (u16*)(p.ws + OFF_ORT);
#pragma unroll
  for (int j = 0; j < 4; ++j) {
    float s = 0.f;
#pragma unroll
    for (int n = 0; n < 8; ++n) s += o[n][j];
    float mu = row16_sum(s) * (1.f / 128.f);
    float q = 0.f;
#pragma unroll
    for (int n = 0; n < 8; ++n) { float d = o[n][j] - mu; q += d * d; }
    float rs = rsqrtf(row16_sum(q) * (1.f / 128.f) + 1e-5f);
    const int tok = tok0 + w * 16 + fq * 4 + j;
#pragma unroll
    for (int n = 0; n < 8; ++n) {
      int v = n * 16 + fr;
      float g = bf2f(Z[(size_t)tok * PIN + 2560 + r.h * 128 + v]);
      float y = ((o[n][j] - mu) * rs * gw[v] + gb[v]) * (g * sigmoidf_(g));
      ORT[(size_t)tok * 512 + r.h * 128 + v] = f2bf(y);
    }
  }
}

DEVI void shifted8(const u16* Z, int tok, bool hasp, bool hasn, int col, const float* mu, float* out) {
  float z[8], zp[8], zn[8];
  unpack8(*(const uint4*)(Z + (size_t)tok * PIN + col), z);
  if (hasp) unpack8(*(const uint4*)(Z + (size_t)(tok - 1) * PIN + col), zp);
  else {
#pragma unroll
    for (int i = 0; i < 8; ++i) zp[i] = 0.f;
  }
  if (hasn) unpack8(*(const uint4*)(Z + (size_t)(tok + 1) * PIN + col), zn);
  else {
#pragma unroll
    for (int i = 0; i < 8; ++i) zn[i] = 0.f;
  }
  float4 m0 = *(const float4*)(mu + col - 3072), m1 = *(const float4*)(mu + col - 3072 + 4);
  float mm[8] = {m0.x, m0.y, m0.z, m0.w, m1.x, m1.y, m1.z, m1.w};
#pragma unroll
  for (int i = 0; i < 8; ++i) out[i] = z[i] + mm[i] * (0.5f * (zp[i] + zn[i]) - z[i]);
}
DEVI void tok_neighbors(int tok, bool& hasp, bool& hasn) {
  if (tok < 4096) { int s = tok & 255; hasp = s > 0; hasn = s < 255; }
  else { int s = (tok - 4096) & 2047; hasp = s > 0; hasn = s < 2047; }
}

DEVI void rwprep_item(const Params& p, int l, int it) {
  const int tid = TIDX, lane = tid & 63, w = tid >> 6, fr = lane & 15, fq = lane >> 4;
  const u16* Z = (const u16*)(p.ws + OFF_Z);
  const float* mu = p.in[15] + l * 1920;
  const int tok0 = (it >> 2) * 64, hq = it & 3;
  u16* R = (u16*)(p.ws + OFF_RWR);
  u16* V = (u16*)(p.ws + OFF_RWV);
  u16* KC = (u16*)(p.ws + OFF_RWKC);
  for (int e = tid; e < 64 * 48; e += 256) {
    int ti = e / 48, u = e % 48, arr = u >> 4, c8 = hq * 128 + (u & 15) * 8;
    int tok = tok0 + ti;
    bool hp, hn;
    tok_neighbors(tok, hp, hn);
    float zs[8];
    shifted8(Z, tok, hp, hn, 3072 + arr * 512 + c8, mu, zs);
    u16* dst = (arr == 0) ? R : (arr == 1 ? KC : V);
    *(uint4*)(dst + (size_t)tok * 512 + c8) = pack8(zs);
  }
  __threadfence_block();
  __syncthreads();
  bf16x8 af[12];
  {
    const int tok = tok0 + w * 16 + fr;
    bool hp, hn;
    tok_neighbors(tok, hp, hn);
#pragma unroll
    for (int f = 0; f < 12; ++f) {
      int col = 4608 + f * 32 + fq * 8;
      float zs[8];
      shifted8(Z, tok, hp, hn, col, mu, zs);
      if (f < 4) {
#pragma unroll
        for (int i = 0; i < 8; ++i) zs[i] = tanhf(zs[i]);
      } else if (f >= 8) {
#pragma unroll
        for (int i = 0; i < 8; ++i) zs[i] = sigmoidf_(zs[i]);
      }
      uint4 pk = pack8(zs);
      af[f] = __builtin_bit_cast(bf16x8, pk);
    }
  }
  const u16* WUP = (const u16*)(p.ws + OFF_WUPT) + (size_t)l * 2 * 32768;
  const u16* AUP = (const u16*)(p.ws + OFF_AUPT) + (size_t)l * 2 * 32768;
  const u16* GUP = (const u16*)(p.ws + OFF_GUPT) + (size_t)l * 65536;
  float* Wd = (float*)(p.ws + OFF_RWW);
  u16* KK = (u16*)(p.ws + OFF_RWKK);
  u16* KD = (u16*)(p.ws + OFF_RWKD);
  u16* KKA = (u16*)(p.ws + OFF_RWKKA);
  u16* G = (u16*)(p.ws + OFF_RWG);
  u16* BON = (u16*)(p.ws + OFF_RWBON);
  const float* kkw = p.in[21] + l * 512;
  const float* kaw = p.in[22] + l * 512;
  const float* rkw = p.in[23] + l * 512;
  const float* w0 = p.in[16] + l * 1024;
  const float* a0 = p.in[18] + l * 1024;
  for (int h = hq * 2; h < hq * 2 + 2; ++h) {
    float inv[4], sbv[4];
#pragma unroll
    for (int j = 0; j < 4; ++j) {
      const int tok = tok0 + w * 16 + fq * 4 + j;
      float ssq = 0.f, sb = 0.f;
#pragma unroll
      for (int n = 0; n < 4; ++n) {
        int c = h * 64 + n * 16 + fr;
        float rr = bf2f(R[(size_t)tok * 512 + c]);
        float kc = bf2f(KC[(size_t)tok * 512 + c]);
        float kk = kc * kkw[c];
        ssq += kk * kk;
        sb += rr * kc * rkw[c];
      }
      ssq = row16_sum(ssq);
      sbv[j] = row16_sum(sb);
      inv[j] = rsqrtf(fmaxf(ssq, 1e-24f));
    }
#pragma unroll 1
    for (int n = 0; n < 4; ++n) {
      f32x4 acc[5];
#pragma unroll
      for (int m = 0; m < 5; ++m) acc[m] = f32x4{0.f, 0.f, 0.f, 0.f};
      const int c = h * 64 + n * 16 + fr;
#pragma unroll
      for (int ks = 0; ks < 2; ++ks) {
        acc[0] = mfma16(af[0 + ks], *(const bf16x8*)(WUP + (size_t)c * 64 + ks * 32 + fq * 8), acc[0]);
        acc[1] = mfma16(af[2 + ks], *(const bf16x8*)(WUP + 32768 + (size_t)c * 64 + ks * 32 + fq * 8), acc[1]);
        acc[2] = mfma16(af[4 + ks], *(const bf16x8*)(AUP + (size_t)c * 64 + ks * 32 + fq * 8), acc[2]);
        acc[3] = mfma16(af[6 + ks], *(const bf16x8*)(AUP + 32768 + (size_t)c * 64 + ks * 32 + fq * 8), acc[3]);
      }
#pragma unroll
      for (int ks = 0; ks < 4; ++ks)
        acc[4] = mfma16(af[8 + ks], *(const bf16x8*)(GUP + (size_t)c * 128 + ks * 32 + fq * 8), acc[4]);
      const float kkc = kkw[c], ka = kaw[c];
      const float w0f = w0[c], w0b = w0[512 + c], a0f = a0[c], a0b = a0[512 + c];
#pragma unroll
      for (int j = 0; j < 4; ++j) {
        const int tok = tok0 + w * 16 + fq * 4 + j;
        const size_t o = (size_t)tok * 512 + c;
        const float kc = bf2f(KC[o]), vv = bf2f(V[o]);
        const float kkn = kc * kkc * inv[j];
        KK[o] = f2bf(kkn);
        G[o] = f2bf(acc[4][j]);
        BON[o] = f2bf(sbv[j] * vv);
#pragma unroll
        for (int d = 0; d < 2; ++d) {
          float wv = __expf(-0.606531f * sigmoidf_((d ? w0b : w0f) + acc[d][j]));
          float a = sigmoidf_((d ? a0b : a0f) + acc[2 + d][j]);
          Wd[(size_t)d * NTOK * 512 + o] = wv;
          KD[(size_t)d * NTOK * 512 + o] = f2bf(kc * (1.f + (a - 1.f) * ka));
          KKA[(size_t)d * NTOK * 512 + o] = f2bf(kkn * a);
        }
      }
    }
  }
}

template <int KPT>
DEVI void scan_run(const Params& p, int l, bool lat, int b, int h, int dir, int rowbase, unsigned char* sm) {
  constexpr int LPR = 64 / KPT;
  constexpr int CH = 32;
  const int tid = TIDX;
  const int row = rowbase + tid / LPR, ks = (tid % LPR) * KPT;
  const int lir = tid % LPR;
  const int T = lat ? 2048 : 256, seq0 = lat ? 4096 + b * 2048 : b * 256;
  float S[KPT];
  if (lat) {
    const float* s0 = p.in[5] + ((((size_t)(b * 2 + l) * 2 + dir) * 8 + h) * 64 + row) * 64 + ks;
#pragma unroll
    for (int i = 0; i < KPT; ++i) S[i] = s0[i];
  } else {
#pragma unroll
    for (int i = 0; i < KPT; ++i) S[i] = 0.f;
  }
  float* buf = (float*)sm;
  float* obuf = buf + CH * 384;
  const float* Wd = (const float*)(p.ws + OFF_RWW) + (size_t)dir * NTOK * 512;
  const u16* R = (const u16*)(p.ws + OFF_RWR);
  const u16* V = (const u16*)(p.ws + OFF_RWV);
  const u16* KK = (const u16*)(p.ws + OFF_RWKK);
  const u16* KD = (const u16*)(p.ws + OFF_RWKD) + (size_t)dir * NTOK * 512;
  const u16* KKA = (const u16*)(p.ws + OFF_RWKKA) + (size_t)dir * NTOK * 512;
  float* O = (float*)(p.ws + OFF_OF) + (size_t)dir * NTOK * 512;
  const int pst = tid >> 3, c8 = (tid & 7) * 8;
  const int nch = T / CH;
  struct Pf { float4 qw0, qw1; uint4 qr, qk, qv, qd, qa; };
  auto issue = [&](Pf& q, int chunk) {
    float4& qw0 = q.qw0; float4& qw1 = q.qw1; uint4& qr = q.qr; uint4& qk = q.qk; uint4& qv = q.qv; uint4& qd = q.qd; uint4& qa = q.qa;
    int s_ = chunk * CH + pst;
    int tok_ = dir ? (seq0 + T - 1 - s_) : (seq0 + s_);
    size_t o_ = (size_t)tok_ * 512 + h * 64 + c8;
    qw0 = *(const float4*)(Wd + o_); qw1 = *(const float4*)(Wd + o_ + 4);
    qr = *(const uint4*)(R + o_); qk = *(const uint4*)(KK + o_); qv = *(const uint4*)(V + o_);
    qd = *(const uint4*)(KD + o_); qa = *(const uint4*)(KKA + o_);
  };
  auto commit = [&](const Pf& q) {
    const float4 qw0 = q.qw0, qw1 = q.qw1; const uint4 qr = q.qr, qk = q.qk, qv = q.qv, qd = q.qd, qa = q.qa;
    float* bp = buf + pst * 384 + c8;
    float t[8];
    *(float4*)bp = qw0; *(float4*)(bp + 4) = qw1;
    unpack8(qr, t); *(float4*)(bp + 64) = *(float4*)t; *(float4*)(bp + 68) = *(float4*)(t + 4);
    unpack8(qk, t); *(float4*)(bp + 128) = *(float4*)t; *(float4*)(bp + 132) = *(float4*)(t + 4);
    unpack8(qv, t); *(float4*)(bp + 192) = *(float4*)t; *(float4*)(bp + 196) = *(float4*)(t + 4);
    unpack8(qd, t); *(float4*)(bp + 256) = *(float4*)t; *(float4*)(bp + 260) = *(float4*)(t + 4);
    unpack8(qa, t); *(float4*)(bp + 320) = *(float4*)t; *(float4*)(bp + 324) = *(float4*)(t + 4);
    if (KPT == 4) {
      float rr[8];
      unpack8(qr, rr);
      float ar = 0.f;
#pragma unroll
      for (int i = 0; i < 8; ++i) ar += t[i] * rr[i];
      ar += dpp<0xB1>(ar); ar += dpp<0x4E>(ar); ar += dpp<0x141>(ar);
      if ((tid & 7) == 0) obuf[pst] = ar;
    }
  };
  auto compute = [&](int chunk) {
    if constexpr (KPT == 4) {
      typedef float f2 __attribute__((ext_vector_type(2)));
      f2 S01 = {S[0], S[1]}, S23 = {S[2], S[3]};
      float4 w4 = *(const float4*)(buf + ks), r4 = *(const float4*)(buf + 64 + ks), k4 = *(const float4*)(buf + 128 + ks),
             d4 = *(const float4*)(buf + 256 + ks), a4 = *(const float4*)(buf + 320 + ks);
      float vr = buf[192 + row], ar = obuf[0];
      float myo = 0.f;
#pragma unroll 1
      for (int sb = 0; sb < CH; sb += 16) {
#pragma unroll
        for (int si = 0; si < 16; ++si) {
          const int s = sb + si;
          float4 nw = w4, nr = r4, nk = k4, nd = d4, na = a4;
          float nv = vr, nar = ar;
          if (s + 1 < CH) {
            const float* bp = buf + (s + 1) * 384;
            nw = *(const float4*)(bp + ks); nr = *(const float4*)(bp + 64 + ks); nk = *(const float4*)(bp + 128 + ks);
            nd = *(const float4*)(bp + 256 + ks); na = *(const float4*)(bp + 320 + ks);
            nv = bp[192 + row]; nar = obuf[s + 1];
          }
          const f2 w01 = {w4.x, w4.y}, w23 = {w4.z, w4.w}, k01 = {k4.x, k4.y}, k23 = {k4.z, k4.w};
          const f2 d01 = {d4.x, d4.y}, d23 = {d4.z, d4.w}, a01 = {a4.x, a4.y}, a23 = {a4.z, a4.w};
          const f2 r01 = {r4.x, r4.y}, r23 = {r4.z, r4.w};
          const f2 m = S01 * k01 + S23 * k23;
          const f2 pre01 = S01 * w01 + d01 * vr, pre23 = S23 * w23 + d23 * vr;
          const f2 pq = pre01 * r01 + pre23 * r23;
          float x = m.x + m.y, y = pq.x + pq.y;
          x += dpp<0xB1>(x); y += dpp<0xB1>(y);
          x += dpp<0x4E>(x); y += dpp<0x4E>(y);
          x += dpp<0x141>(x); y += dpp<0x141>(y);
          x += dpp<0x140>(x); y += dpp<0x140>(y);
          S01 = pre01 - a01 * x;
          S23 = pre23 - a23 * x;
          const float o = y - x * ar;
          myo = (si == lir) ? o : myo;
          w4 = nw; r4 = nr; k4 = nk; d4 = nd; a4 = na; vr = nv; ar = nar;
        }
        {
          int st = chunk * CH + sb + lir;
          int tok = dir ? (seq0 + T - 1 - st) : (seq0 + st);
          O[(size_t)tok * 512 + h * 64 + row] = myo;
        }
      }
      S[0] = S01.x; S[1] = S01.y; S[2] = S23.x; S[3] = S23.y;
      return;
    } else {
      float myo = 0.f;
#pragma unroll 1
      for (int sb = 0; sb < CH; sb += 4)
#pragma unroll
        for (int si = 0; si < 4; ++si) {
          const int s = sb + si;
          const float* bp = buf + s * 384;
          float wv[KPT], rv[KPT], kkv[KPT], kdv[KPT], kav[KPT];
#pragma unroll
          for (int i = 0; i < KPT; i += 4) {
            *(float4*)(wv + i) = *(const float4*)(bp + ks + i);
            *(float4*)(rv + i) = *(const float4*)(bp + 64 + ks + i);
            *(float4*)(kkv + i) = *(const float4*)(bp + 128 + ks + i);
            *(float4*)(kdv + i) = *(const float4*)(bp + 256 + ks + i);
            *(float4*)(kav + i) = *(const float4*)(bp + 320 + ks + i);
          }
          const float vr = bp[192 + row];
          float sk = 0.f;
#pragma unroll
          for (int i = 0; i < KPT; ++i) sk += S[i] * kkv[i];
          sk = quad_sum(sk);
          float o = 0.f;
#pragma unroll
          for (int i = 0; i < KPT; ++i) {
            S[i] = S[i] * wv[i] - sk * kav[i] + vr * kdv[i];
            o += S[i] * rv[i];
          }
          o = quad_sum(o);
          myo = (si == lir) ? o : myo;
          if (si == 3) {
            int st = chunk * CH + sb + lir;
            int tok = dir ? (seq0 + T - 1 - st) : (seq0 + st);
            O[(size_t)tok * 512 + h * 64 + row] = myo;
          }
        }
    }
  };
  if (KPT == 4) __builtin_amdgcn_s_setprio(3);
  Pf qA;
  issue(qA, 0);
  if constexpr (KPT == 4) {
    Pf qB;
    issue(qB, 1);
    for (int c0 = 0; c0 < nch; c0 += 2) {
      asm volatile("s_waitcnt lgkmcnt(0)\n\ts_barrier" ::: "memory");
      commit(qA);
      asm volatile("s_waitcnt lgkmcnt(0)\n\ts_barrier" ::: "memory");
      if (c0 + 2 < nch) issue(qA, c0 + 2);
      compute(c0);
      asm volatile("s_waitcnt lgkmcnt(0)\n\ts_barrier" ::: "memory");
      commit(qB);
      asm volatile("s_waitcnt lgkmcnt(0)\n\ts_barrier" ::: "memory");
      if (c0 + 3 < nch) issue(qB, c0 + 3);
      compute(c0 + 1);
    }
  } else {
    for (int c0 = 0; c0 < nch; ++c0) {
      asm volatile("s_waitcnt lgkmcnt(0)\n\ts_barrier" ::: "memory");
      commit(qA);
      asm volatile("s_waitcnt lgkmcnt(0)\n\ts_barrier" ::: "memory");
      if (c0 + 1 < nch) issue(qA, c0 + 1);
      compute(c0);
    }
  }
  if (KPT == 4) __builtin_amdgcn_s_setprio(0);
  if (!lat) {
    float* so = (float*)p.out + OUT_SRW + ((((size_t)(b * 2 + l) * 2 + dir) * 8 + h) * 64 + row) * 64 + ks;
#pragma unroll
    for (int i = 0; i < KPT; ++i) so[i] = S[i];
  }
}

DEVI void attn_item(const Params& p, int l, int it, unsigned char* sm) {
  const int tid = TIDX, lane = tid & 63, w = tid >> 6, fr = lane & 15, fq = lane >> 4;
  u16* Ks = (u16*)sm;
  u16* VT = (u16*)(sm + 9216);
  float* rpbs = (float*)(sm + 18432);
  const u16* Z = (const u16*)(p.ws + OFF_Z);
  const bool lat = it < 512;
  int b, h, r = 0, seqbase, qtok0;
  if (lat) { b = it >> 8; h = (it >> 5) & 7; r = it & 31; seqbase = 4096 + b * 2048; qtok0 = seqbase + r * 64; }
  else { int j = it - 512; b = j >> 5; h = (j >> 2) & 7; int qb = j & 3; seqbase = b * 256; qtok0 = seqbase + qb * 64; }
  bf16x8 qf[2];
#pragma unroll
  for (int ks = 0; ks < 2; ++ks) qf[ks] = *(const bf16x8*)(Z + (size_t)(qtok0 + w * 16 + fr) * PIN + h * 64 + ks * 32 + fq * 8);
  if (lat)
    for (int i = tid; i < 465; i += 256) rpbs[i] = p.in[11][(size_t)(l * 8 + h) * 465 + i];
  float m_run = -3e38f, l_run = 0.f;
  f32x4 o[4];
#pragma unroll
  for (int d = 0; d < 4; ++d) o[d] = f32x4{0.f, 0.f, 0.f, 0.f};
  const int ntiles = lat ? 16 : 4;
  const int row_start = lat ? clampi(r - 4, 0, 24) : 0;
  const int cbs = lat ? clampi(w * 16 - 8, 0, 32) : 0;
  for (int ti = 0; ti < ntiles; ++ti) {
    __syncthreads();
    const bool ctxtile = lat && ti < 8;
    if (ctxtile) {
      const float* kc = p.in[2] + ((((size_t)b * 2 + l) * 8 + h) * 512 + ti * 64) * 64;
      const float* vc = p.in[3] + ((((size_t)b * 2 + l) * 8 + h) * 512 + ti * 64) * 64;
      {
        const int key = tid >> 2, dp = (tid & 3) * 16;
        float t[16];
#pragma unroll
        for (int c = 0; c < 4; ++c) *(float4*)(t + c * 4) = *(const float4*)(kc + key * 64 + dp + c * 4);
        *(uint4*)(Ks + key * 72 + dp) = pack8(t);
        *(uint4*)(Ks + key * 72 + dp + 8) = pack8(t + 8);
      }
      {
        const int key = tid & 63, dp = (tid >> 6) * 16;
        float t[16];
#pragma unroll
        for (int c = 0; c < 4; ++c) *(float4*)(t + c * 4) = *(const float4*)(vc + key * 64 + dp + c * 4);
#pragma unroll
        for (int i = 0; i < 16; ++i) VT[(dp + i) * 72 + key] = f2bf(t[i]);
      }
    } else {
      const int trow = lat ? (row_start + ti - 8) : ti;
      const u16* zr = Z + (size_t)(seqbase + trow * 64) * PIN;
      {
        const int key = tid >> 2, dp = (tid & 3) * 16;
        const u16* src = zr + (size_t)key * PIN + 512 + h * 64 + dp;
        *(uint4*)(Ks + key * 72 + dp) = *(const uint4*)src;
        *(uint4*)(Ks + key * 72 + dp + 8) = *(const uint4*)(src + 8);
      }
      {
        const int key = tid & 63, dp = (tid >> 6) * 16;
        const u16* src = zr + (size_t)key * PIN + 1024 + h * 64 + dp;
        uint4 r0 = *(const uint4*)src, r1 = *(const uint4*)(src + 8);
        const u16* a0 = (const u16*)&r0;
        const u16* a1 = (const u16*)&r1;
#pragma unroll
        for (int i = 0; i < 8; ++i) { VT[(dp + i) * 72 + key] = a0[i]; VT[(dp + 8 + i) * 72 + key] = a1[i]; }
      }
    }
    __syncthreads();
    const bool win = lat && !ctxtile;
    const int nsteps = win ? 1 : 2;
    for (int st = 0; st < nsteps; ++st) {
      const int ko = win ? cbs : st * 32;
      f32x4 s0 = f32x4{0.f, 0.f, 0.f, 0.f}, s1 = s0;
#pragma unroll
      for (int ks = 0; ks < 2; ++ks) {
        bf16x8 a0 = *(const bf16x8*)(Ks + (ko + fr) * 72 + ks * 32 + fq * 8);
        bf16x8 a1 = *(const bf16x8*)(Ks + (ko + 16 + fr) * 72 + ks * 32 + fq * 8);
        s0 = mfma16(a0, qf[ks], s0);
        s1 = mfma16(a1, qf[ks], s1);
      }
      float sv[8];
#pragma unroll
      for (int j = 0; j < 4; ++j) { sv[j] = s0[j] * 0.125f; sv[4 + j] = s1[j] * 0.125f; }
      if (win) {
        const int qc = w * 16 + fr;
        const int dr = (row_start + ti - 8) - r + 7;
        const int qs = clampi(qc - 8, 0, 48);
#pragma unroll
        for (int e = 0; e < 8; ++e) {
          int kc_ = ko + ((e < 4) ? (fq * 4 + e) : (16 + fq * 4 + e - 4));
          int dc = clampi(kc_ - qc, -15, 15) + 15;
          int rel = kc_ - qs;
          sv[e] = (rel >= 0 && rel < 16) ? (sv[e] + rpbs[dr * 31 + dc]) : -1e30f;
        }
      }
      float mx = sv[0];
#pragma unroll
      for (int e = 1; e < 8; ++e) mx = fmaxf(mx, sv[e]);
      mx = fmaxf(mx, __shfl_xor(mx, 16));
      mx = fmaxf(mx, __shfl_xor(mx, 32));
      const float m_new = fmaxf(m_run, mx);
      const float alpha = __expf(m_run - m_new);
      float pe[8], ps = 0.f;
#pragma unroll
      for (int e = 0; e < 8; ++e) { pe[e] = __expf(sv[e] - m_new); ps += pe[e]; }
      l_run = l_run * alpha + ps;
      m_run = m_new;
#pragma unroll
      for (int d = 0; d < 4; ++d) o[d] *= alpha;
      uint4 pk = pack8(pe);
      bf16x8 pb = __builtin_bit_cast(bf16x8, pk);
#pragma unroll
      for (int d = 0; d < 4; ++d) {
        uint2 lo = *(const uint2*)(VT + (d * 16 + fr) * 72 + ko + fq * 4);
        uint2 hi = *(const uint2*)(VT + (d * 16 + fr) * 72 + ko + 16 + fq * 4);
        uint4 vv; vv.x = lo.x; vv.y = lo.y; vv.z = hi.x; vv.w = hi.y;
        o[d] = mfma16(__builtin_bit_cast(bf16x8, vv), pb, o[d]);
      }
    }
  }
  float lt = l_run + __shfl_xor(l_run, 16);
  lt += __shfl_xor(lt, 32);
  const float inv = 1.f / lt;
  u16* ONA = (u16*)(p.ws + OFF_ONA);
  const int tok = qtok0 + w * 16 + fr;
#pragma unroll
  for (int d = 0; d < 4; ++d) {
    uint2 ov; ov.x = cvtpk(o[d][0] * inv, o[d][1] * inv); ov.y = cvtpk(o[d][2] * inv, o[d][3] * inv);
    *(uint2*)(ONA + (size_t)tok * 512 + h * 64 + d * 16 + fq * 4) = ov;
  }
}

constexpr int MIX_NSCAN_LAT = 128, MIX_NSCAN_CTX = 256, MIX_NATT = 1024, MIX_NRET = 512;
constexpr int MIX_TOTAL = MIX_NSCAN_LAT + MIX_NSCAN_CTX + MIX_NATT + MIX_NRET;
#ifndef ONLYP
#define ONLYP -1
#endif
#define PH_ON(x) (ONLYP < 0 || ONLYP == (x))
DEVI void mix_item(const Params& p, int l, int it, unsigned char* sm) {
  if (it < MIX_NSCAN_LAT) {
    int ch = it >> 2, rq = it & 3;
    if (PH_ON(12)) scan_run<4>(p, l, true, ch >> 4, ch & 7, (ch >> 3) & 1, rq * 16, sm);
    return;
  }
  it -= MIX_NSCAN_LAT;
  if (it < 256) { if (PH_ON(15)) ret3_item(p, l, it, sm); return; }
  it -= 256;
  if (it < MIX_NSCAN_CTX) { if (PH_ON(13)) scan_run<16>(p, l, false, it >> 4, it & 7, (it >> 3) & 1, 0, sm); return; }
  it -= MIX_NSCAN_CTX;
  if (it < MIX_NATT) { if (PH_ON(14)) attn_item(p, l, it, sm); return; }
  it -= MIX_NATT;
  if (PH_ON(15)) ret3_item(p, l, 256 + it, sm);
}

DEVI void fin_item(const Params& p, int l, int it0) {
  const int tid = TIDX;
#pragma unroll 2
  for (int sub = 0; sub < 8; ++sub) {
  const int it = it0 * 8 + sub;
  const int tok = it * 2 + (tid >> 7), c4 = (tid & 127) * 4;
  const size_t o = (size_t)tok * 512 + c4;
  float4 a = *(const float4*)((const float*)(p.ws + OFF_OF) + o);
  float4 b = *(const float4*)((const float*)(p.ws + OFF_OF) + (size_t)NTOK * 512 + o);
  float x[4] = {a.x + b.x, a.y + b.y, a.z + b.z, a.w + b.w};
  float mu = row16_sum(x[0] + x[1] + x[2] + x[3]) * (1.f / 64.f);
  float q = 0.f;
#pragma unroll
  for (int i = 0; i < 4; ++i) { float d = x[i] - mu; q += d * d; }
  float rs = rsqrtf(row16_sum(q) * (1.f / 64.f) + 64e-5f);
  float4 gw = *(const float4*)(p.in[24] + l * 512 + c4), gb = *(const float4*)(p.in[25] + l * 512 + c4);
  float gwv[4] = {gw.x, gw.y, gw.z, gw.w}, gbv[4] = {gb.x, gb.y, gb.z, gb.w};
  float bon[4], g[4];
  unpack4(*(const uint2*)((const u16*)(p.ws + OFF_RWBON) + o), bon);
  unpack4(*(const uint2*)((const u16*)(p.ws + OFF_RWG) + o), g);
  float y[4];
#pragma unroll
  for (int i = 0; i < 4; ++i) y[i] = ((x[i] - mu) * rs * gwv[i] + gbv[i] + bon[i]) * g[i];
  uint2 ov; ov.x = cvtpk(y[0], y[1]); ov.y = cvtpk(y[2], y[3]);
  *(uint2*)((u16*)(p.ws + OFF_ORW) + o) = ov;
  }
}

DEVI void ln2_item(const Params& p, int l, int it0) {
  const int lane = TIDX & 63, w = TIDX >> 6;
#pragma unroll 1
  for (int sub = 0; sub < 4; ++sub) {
  const int it = it0 * 4 + sub;
  const int tok = it * 4 + w;
  const float* y = (const float*)(p.ws + OFF_Y) + (size_t)tok * 1024;
  const float* mod = (const float*)(p.ws + OFF_MOD) + ((size_t)l * 3 + modrow(tok)) * 6144;
  float v[16];
  float s = 0.f;
#pragma unroll
  for (int i = 0; i < 4; ++i) { *(float4*)(v + i * 4) = *(const float4*)(y + lane * 4 + 256 * i); }
#pragma unroll
  for (int i = 0; i < 16; ++i) s += v[i];
  float mu = wave_sum(s) * (1.f / 1024.f);
  float q = 0.f;
#pragma unroll
  for (int i = 0; i < 16; ++i) { float d = v[i] - mu; q += d * d; }
  float rs = rsqrtf(wave_sum(q) * (1.f / 1024.f) + 1e-5f);
  float* X1 = (float*)(p.ws + OFF_X1) + (size_t)tok * 1024;
  s = 0.f;
#pragma unroll
  for (int i = 0; i < 4; ++i) {
    int c = lane * 4 + 256 * i;
    float4 g = *(const float4*)(p.in[28] + l * 1024 + c), bb = *(const float4*)(p.in[29] + l * 1024 + c);
    v[i * 4 + 0] = (v[i * 4 + 0] - mu) * rs * g.x + bb.x;
    v[i * 4 + 1] = (v[i * 4 + 1] - mu) * rs * g.y + bb.y;
    v[i * 4 + 2] = (v[i * 4 + 2] - mu) * rs * g.z + bb.z;
    v[i * 4 + 3] = (v[i * 4 + 3] - mu) * rs * g.w + bb.w;
    *(float4*)(X1 + c) = *(float4*)(v + i * 4);
    s += v[i * 4] + v[i * 4 + 1] + v[i * 4 + 2] + v[i * 4 + 3];
  }
  mu = wave_sum(s) * (1.f / 1024.f);
  q = 0.f;
#pragma unroll
  for (int i = 0; i < 16; ++i) { float d = v[i] - mu; q += d * d; }
  rs = rsqrtf(wave_sum(q) * (1.f / 1024.f) + 1e-5f);
  u16* H2 = (u16*)(p.ws + OFF_H2) + (size_t)tok * 1024;
#pragma unroll
  for (int i = 0; i < 4; ++i) {
    int c = lane * 4 + 256 * i;
    float4 sh = *(const float4*)(mod + 3072 + c), sc = *(const float4*)(mod + 4096 + c);
    uint2 o;
    o.x = cvtpk((v[i * 4] - mu) * rs * (1.f + sc.x) + sh.x, (v[i * 4 + 1] - mu) * rs * (1.f + sc.y) + sh.y);
    o.y = cvtpk((v[i * 4 + 2] - mu) * rs * (1.f + sc.z) + sh.z, (v[i * 4 + 3] - mu) * rs * (1.f + sc.w) + sh.w);
    *(uint2*)(H2 + c) = o;
  }
  }
}

DEVI int f2ord(float f) { int i = __float_as_int(f); return i ^ ((i >> 31) & 0x7fffffff); }
DEVI float ord2f(int i) { return __int_as_float(i ^ ((i >> 31) & 0x7fffffff)); }
DEVI void insert16(int (&t)[16], int x) {
#pragma unroll
  for (int i = 0; i < 16; ++i) { int hi = max(t[i], x); x = min(t[i], x); t[i] = hi; }
}
DEVI void route_item(const Params& p, int l, int it, unsigned char* sm) {
  const int tid = TIDX, lane = tid & 63, w = tid >> 6;
  const int g = w >> 1, pp = w & 1;
  const int tb = it >> 3, h = it & 7;
  const int tok = tb * 128 + g * 64 + lane;
  float* kl = (float*)sm;
  const float* Q = (const float*)(p.ws + OFF_Q) + (size_t)tok * 1024 + h * 128 + pp * 64;
  float q[64];
#pragma unroll
  for (int i = 0; i < 16; ++i) *(float4*)(q + i * 4) = *(const float4*)(Q + i * 4);
  int T[16];
#pragma unroll
  for (int i = 0; i < 16; ++i) T[i] = (int)0x80000000;
  const float* keys = p.in[33] + (size_t)((l * 8 + h) * 2) * 8192;
  for (int half = 0; half < 2; ++half) {
    __syncthreads();
#pragma unroll
    for (int i = 0; i < 8; ++i) {
      int e = (i * 256 + tid) * 4;
      int ps = e >> 12, r = e & 4095;
      *(float4*)(kl + e) = *(const float4*)(keys + (size_t)ps * 8192 + half * 4096 + r);
    }
    __syncthreads();
    const float* kb = kl + pp * 4096;
#pragma unroll 4
    for (int k = 0; k < 64; ++k) {
      const float* kp = kb + k * 64;
      float s0 = 0.f, s1 = 0.f, s2 = 0.f, s3 = 0.f;
#pragma unroll
      for (int d = 0; d < 64; d += 4) {
        float4 kv = *(const float4*)(kp + d);
        s0 += q[d] * kv.x; s1 += q[d + 1] * kv.y; s2 += q[d + 2] * kv.z; s3 += q[d + 3] * kv.w;
      }
      float sc = (s0 + s1) + (s2 + s3);
      int bits = (f2ord(sc) & ~127) | (127 - (half * 64 + k));
      insert16(T, bits);
    }
  }
  __syncthreads();
  int* xb = (int*)sm;
  if (pp == 1) {
#pragma unroll
    for (int i = 0; i < 16; ++i) xb[(g * 16 + i) * 64 + lane] = T[i];
  }
  __syncthreads();
  if (pp == 0) {
    int T1[16];
#pragma unroll
    for (int i = 0; i < 16; ++i) T1[i] = xb[(g * 16 + i) * 64 + lane];
    int F[16];
#pragma unroll
    for (int i = 0; i < 16; ++i) F[i] = (int)0x80000000;
#pragma unroll
    for (int i = 0; i < 16; ++i) {
#pragma unroll
      for (int j = 0; j < 16; ++j) {
        if ((i + 1) * (j + 1) <= 16) {
          float c = ord2f(T[i] & ~127) + ord2f(T1[j] & ~127);
          int bits = (f2ord(c) & ~255) | (255 - (i * 16 + j));
          insert16(F, bits);
        }
      }
    }
    float fs[16], den = 0.f;
    const float f0 = ord2f(F[0] & ~255);
#pragma unroll
    for (int i = 0; i < 16; ++i) { fs[i] = __expf(ord2f(F[i] & ~255) - f0); den += fs[i]; }
    const float inv = 1.f / den;
    int* EIDX = (int*)(p.ws + OFF_EIDX) + (size_t)tok * 128 + h * 16;
    float* GATE = (float*)(p.ws + OFF_GATE) + (size_t)tok * 128 + h * 16;
    int eo[16]; float go[16];
#pragma unroll
    for (int i = 0; i < 16; ++i) {
      int pos = 255 - (F[i] & 255);
      int i0 = pos >> 4, j0 = pos & 15;
      int k0 = 0, k1 = 0;
#pragma unroll
      for (int c = 0; c < 16; ++c) {
        int a0 = 127 - (T[c] & 127), a1 = 127 - (T1[c] & 127);
        k0 = (i0 == c) ? a0 : k0;
        k1 = (j0 == c) ? a1 : k1;
      }
      eo[i] = k0 * 128 + k1;
      go[i] = fs[i] * inv;
    }
#pragma unroll
    for (int i = 0; i < 16; i += 4) {
      *(int4*)(EIDX + i) = make_int4(eo[i], eo[i + 1], eo[i + 2], eo[i + 3]);
      *(float4*)(GATE + i) = make_float4(go[i], go[i + 1], go[i + 2], go[i + 3]);
    }
  }
}

DEVI void fp8x16_to_f32(int4 r, float* f) {
  const int w[4] = {r.x, r.y, r.z, r.w};
#pragma unroll
  for (int i = 0; i < 4; ++i) {
    f32x2_ lo = __builtin_amdgcn_cvt_pk_f32_fp8(w[i], false);
    f32x2_ hi = __builtin_amdgcn_cvt_pk_f32_fp8(w[i], true);
    f[i * 4] = lo.x; f[i * 4 + 1] = lo.y; f[i * 4 + 2] = hi.x; f[i * 4 + 3] = hi.y;
  }
}
DEVI void expert_item(const Params& p, int l, int it) {
  const int lane = TIDX & 63;
  const int w = __builtin_amdgcn_readfirstlane(TIDX >> 6);
  const int tok = it * 4 + w;
  const u16* H2 = (const u16*)(p.ws + OFF_H2) + (size_t)tok * 1024;
  float hv[16];
  unpack8(*(const uint4*)(H2 + lane * 16), hv);
  unpack8(*(const uint4*)(H2 + lane * 16 + 8), hv + 8);
  const int* EIDX = (const int*)(p.ws + OFF_EIDX) + (size_t)tok * 128;
  const float* GATE = (const float*)(p.ws + OFF_GATE) + (size_t)tok * 128;
  const unsigned char* UB = (const unsigned char*)(p.ws + OFF_UB) + (size_t)l * UV_LSTRIDE;
  const unsigned char* VB = (const unsigned char*)(p.ws + OFF_VB) + (size_t)l * UV_LSTRIDE;
  const float* USC = (const float*)(p.ws + OFF_SC) + (0 * 2 + l) * 16384;
  const float* VSC = (const float*)(p.ws + OFF_SC) + (1 * 2 + l) * 16384;
  float f[16];
#pragma unroll
  for (int i = 0; i < 16; ++i) f[i] = 0.f;
  const int ei0 = EIDX[lane], ei1 = EIDX[64 + lane];
  const float ga0 = GATE[lane] * VSC[ei0], ga1 = GATE[64 + lane] * VSC[ei1];
  const float us0 = USC[ei0], us1 = USC[ei1];
  float dl0 = 0.f, dl1 = 0.f;
  int4 ba[8], bb[8];
#define ROW_LOAD(BUF, BASE, G)                                                                       \
  {                                                                                                  \
    const int src_ = ((G) < 8) ? ei0 : ei1;                                                          \
    _Pragma("unroll") for (int j = 0; j < 8; ++j) {                                                  \
      const int idx = __builtin_amdgcn_readlane(src_, (((G) & 7) << 3) + j);                         \
      BUF[j] = *(const int4*)(BASE + (size_t)idx * 1024 + lane * 16);                                \
    }                                                                                                \
  }
#define U_COMP(BUF, G)                                                                               \
  {                                                                                                  \
    const bool lo_ = (G) < 8;                                                                        \
    _Pragma("unroll") for (int j = 0; j < 8; ++j) {                                                  \
      const int ln_ = (((G) & 7) << 3) + j;                                                          \
      float uu[16];                                                                                  \
      fp8x16_to_f32(BUF[j], uu);                                                                     \
      float d0 = 0.f, d1 = 0.f;                                                                      \
      _Pragma("unroll") for (int i = 0; i < 16; i += 2) { d0 += uu[i] * hv[i]; d1 += uu[i + 1] * hv[i + 1]; } \
      float dd = row16_sum(d0 + d1);                                                                 \
      const float r0 = __int_as_float(__builtin_amdgcn_readlane(__float_as_int(dd), 0));            \
      const float r1 = __int_as_float(__builtin_amdgcn_readlane(__float_as_int(dd), 16));           \
      const float r2 = __int_as_float(__builtin_amdgcn_readlane(__float_as_int(dd), 32));           \
      const float r3 = __int_as_float(__builtin_amdgcn_readlane(__float_as_int(dd), 48));           \
      const float d = (r0 + r1) + (r2 + r3);                                                         \
      dl0 = (lo_ && lane == ln_) ? d : dl0;                                                          \
      dl1 = (!lo_ && lane == ln_) ? d : dl1;                                                         \
    }                                                                                                \
  }
#define V_COMP(BUF, G)                                                                               \
  {                                                                                                  \
    const float asrc_ = ((G) < 8) ? act0 : act1;                                                     \
    _Pragma("unroll") for (int j = 0; j < 8; ++j) {                                                  \
      const int ln_ = (((G) & 7) << 3) + j;                                                          \
      const float act = __int_as_float(__builtin_amdgcn_readlane(__float_as_int(asrc_), ln_));      \
      float vv[16];                                                                                  \
      fp8x16_to_f32(BUF[j], vv);                                                                     \
      _Pragma("unroll") for (int i = 0; i < 16; ++i) f[i] += act * vv[i];                            \
    }                                                                                                \
  }
  ROW_LOAD(ba, UB, 0);
#pragma unroll 1
  for (int g = 0; g < 16; g += 2) {
    ROW_LOAD(bb, UB, g + 1);
    U_COMP(ba, g);
    if (g + 2 < 16) { ROW_LOAD(ba, UB, g + 2); } else { ROW_LOAD(ba, VB, 0); }
    U_COMP(bb, g + 1);
  }
  const float x0 = dl0 * us0, x1 = dl1 * us1;
  const float act0 = 0.5f * x0 * (1.f + erff(x0 * 0.70710678118654752f)) * ga0;
  const float act1 = 0.5f * x1 * (1.f + erff(x1 * 0.70710678118654752f)) * ga1;
#pragma unroll 1
  for (int g = 0; g < 16; g += 2) {
    ROW_LOAD(bb, VB, g + 1);
    V_COMP(ba, g);
    if (g + 2 < 16) ROW_LOAD(ba, VB, g + 2);
    V_COMP(bb, g + 1);
  }
#undef ROW_LOAD
#undef U_COMP
#undef V_COMP
  const float* X1 = (const float*)(p.ws + OFF_X1) + (size_t)tok * 1024 + lane * 16;
  const float* mod = (const float*)(p.ws + OFF_MOD) + ((size_t)l * 3 + modrow(tok)) * 6144 + lane * 16;
  float y[16];
  float s = 0.f;
#pragma unroll
  for (int c = 0; c < 4; ++c) {
    float4 x = *(const float4*)(X1 + c * 4), gt = *(const float4*)(mod + 5120 + c * 4);
    int o = c * 4;
    y[o] = ALPHA * x.x + gt.x * f[o]; y[o + 1] = ALPHA * x.y + gt.y * f[o + 1];
    y[o + 2] = ALPHA * x.z + gt.z * f[o + 2]; y[o + 3] = ALPHA * x.w + gt.w * f[o + 3];
    s += y[o] + y[o + 1] + y[o + 2] + y[o + 3];
  }
  float mu = wave_sum(s) * (1.f / 1024.f);
  float q = 0.f;
#pragma unroll
  for (int i = 0; i < 16; ++i) { float d = y[i] - mu; q += d * d; }
  float rs = rsqrtf(wave_sum(q) * (1.f / 1024.f) + 1e-5f);
  float* xo = ((l == 1) ? ((float*)p.out + OUT_Y + (size_t)tok * 1024) : ((float*)(p.ws + OFF_X) + (size_t)tok * 1024)) + lane * 16;
  s = 0.f;
#pragma unroll
  for (int c = 0; c < 4; ++c) {
    int o = c * 4;
    float4 g = *(const float4*)(p.in[30] + l * 1024 + lane * 16 + o), bb = *(const float4*)(p.in[31] + l * 1024 + lane * 16 + o);
    y[o] = (y[o] - mu) * rs * g.x + bb.x; y[o + 1] = (y[o + 1] - mu) * rs * g.y + bb.y;
    y[o + 2] = (y[o + 2] - mu) * rs * g.z + bb.z; y[o + 3] = (y[o + 3] - mu) * rs * g.w + bb.w;
    *(float4*)(xo + o) = make_float4(y[o], y[o + 1], y[o + 2], y[o + 3]);
    s += y[o] + y[o + 1] + y[o + 2] + y[o + 3];
  }
  if (l == 0) {
    const float* mod1 = (const float*)(p.ws + OFF_MOD) + ((size_t)3 + modrow(tok)) * 6144 + lane * 16;
    mu = wave_sum(s) * (1.f / 1024.f);
    q = 0.f;
#pragma unroll
    for (int i = 0; i < 16; ++i) { float d = y[i] - mu; q += d * d; }
    rs = rsqrtf(wave_sum(q) * (1.f / 1024.f) + 1e-5f);
    u16* H = (u16*)(p.ws + OFF_H) + (size_t)tok * 1024 + lane * 16;
    float t[16];
#pragma unroll
    for (int c = 0; c < 4; ++c) {
      float4 sh = *(const float4*)(mod1 + c * 4), sc = *(const float4*)(mod1 + 1024 + c * 4);
      int o = c * 4;
      t[o] = (y[o] - mu) * rs * (1.f + sc.x) + sh.x; t[o + 1] = (y[o + 1] - mu) * rs * (1.f + sc.y) + sh.y;
      t[o + 2] = (y[o + 2] - mu) * rs * (1.f + sc.z) + sh.z; t[o + 3] = (y[o + 3] - mu) * rs * (1.f + sc.w) + sh.w;
    }
    *(uint4*)(H) = pack8(t);
    *(uint4*)(H + 8) = pack8(t + 8);
  }
}

constexpr int NPHASES = 22;
DEVI int phase_total(int idx) {
  if (idx == 0) return P0_TOTAL;
  if (idx == 1) return 2048;
  const int l = (idx - 2) / 10, t = (idx - 2) % 10;
  switch (t) {
    case 0: return 0;
    case 1: return 512 + 512;
    case 2: return MIX_TOTAL + (l == 0 ? (P0_NT + P0_NUV) : 0);
    case 3: return 512;
    case 4: return 0;
    case 5: return 0;
    case 6: return 512;
    case 7: return 0;
    case 8: return 512;
    default: return 2048;
  }
}
DEVI int phase_xcd_total(int idx) {
  if (idx < 2) return 0;
  const int t = (idx - 2) % 10;
  if (t == 0) return 504;
  if (t == 4 || t == 5 || t == 7) return 64;
  return 0;
}
DEVI void phase_item_x(const Params& p, int idx, int xcd, int q, unsigned char* sm) {
  const int l = (idx - 2) / 10, t = (idx - 2) % 10;
  const int it = (q >> 3) * 64 + xcd * 8 + (q & 7);
  if (t == 0) { if (PH_ON(2)) g1_item(p, l, it, sm); }
  else if (t == 4) { if (PH_ON(6)) g2_item(p, l, it, sm); }
  else if (t == 5) { if (PH_ON(7)) g3_item(p, l, it, sm); }
  else { if (PH_ON(9)) g4_item(p, l, it, sm); }
}
DEVI void phase_item(const Params& p, int idx, int it, unsigned char* sm) {
  if (idx == 0) { if (PH_ON(0)) phase0_item(p, it, sm); return; }
  if (idx == 1) { if (PH_ON(1)) ln1_item(p, it); return; }
  const int l = (idx - 2) / 10, t = (idx - 2) % 10;
  switch (t) {
    case 0: break;
    case 1: if (it < 512) { if (PH_ON(3)) rwprep_item(p, l, it); } else { if (PH_ON(4)) ret1_item(p, l, it - 512, sm); } break;
    case 2:
      if (it < MIX_TOTAL) mix_item(p, l, it, sm);
      else if (it < MIX_TOTAL + P0_NT) p0_tiles(p, 1, it - MIX_TOTAL, sm);
      else convert_uv_item(p, 1, it - MIX_TOTAL - P0_NT);
      break;
    case 3: if (PH_ON(5)) fin_item(p, l, it); break;
    case 4: break;
    case 5: break;
    case 6: if (PH_ON(8)) ln2_item(p, l, it); break;
    case 7: break;
    case 8: if (PH_ON(10)) route_item(p, l, it, sm); break;
    default: if (PH_ON(11)) expert_item(p, l, it); break;
  }
}

#define XB_TMO      128
#define XB_XCNT(j)  (256  + 64 * (j))
#define XB_XSUB(j)  (1280 + 64 * (j))
#define XB_XGEN(j)  (2304 + 64 * (j))
#define XB_TOP      3328
#define XB_TOPGEN   3392
#define XCD_BAR_WORDS 3456
#define XB_SPIN_CAP (1u << 18)
#define LAS __attribute__((address_space(3)))
DEVI unsigned xb_ld(unsigned* p) { return __hip_atomic_load(p, __ATOMIC_RELAXED, __HIP_MEMORY_SCOPE_AGENT); }
DEVI unsigned xb_add(unsigned* p, unsigned v) { return __hip_atomic_fetch_add(p, v, __ATOMIC_RELAXED, __HIP_MEMORY_SCOPE_AGENT); }
DEVI unsigned xb_xcc_id() { return (unsigned)__builtin_amdgcn_s_getreg((3 << 11) | 20) & 0xFu; }
#define XB_SPIN(cond, bar) do { unsigned _sp = 0; while (cond) { __builtin_amdgcn_s_sleep(1); \
    if ((++_sp & 255u) == 0u) { if (xb_ld(&(bar)[XB_TMO])) break; if (_sp > XB_SPIN_CAP) { atomicAdd(&(bar)[XB_TMO], 1u); break; } } } } while (0)
struct XcdBarrier { unsigned* bar; unsigned x; volatile LAS unsigned* st; };
DEVI XcdBarrier xcd_barrier_post(unsigned* bar, volatile LAS unsigned* st) {
  XcdBarrier b; b.bar = bar; b.x = xb_xcc_id(); b.st = st;
  if (threadIdx.x == 0) (void)xb_add(&bar[XB_XCNT(b.x)], 1u);
  return b;
}
DEVI void xcd_barrier_complete(unsigned* bar, unsigned x, unsigned& nloc, unsigned& nx) {
  const unsigned G = gridDim.x * gridDim.y * gridDim.z;
  unsigned sum, cnt, mine, sp = 0u;
  for (;;) {
    sum = 0u; cnt = 0u; mine = 0u;
#pragma unroll
    for (unsigned j = 0; j < 16; ++j) { const unsigned c = xb_ld(&bar[XB_XCNT(j)]); sum += c; cnt += (c > 0u) ? 1u : 0u; mine = (j == x) ? c : mine; }
    if (sum == G) break;
    __builtin_amdgcn_s_sleep(1);
    if ((++sp & 255u) == 0u) { if (xb_ld(&bar[XB_TMO])) break; if (sp > XB_SPIN_CAP) { atomicAdd(&bar[XB_TMO], 1u); break; } }
  }
  nloc = mine > 0u ? mine : 1u; nx = cnt > 0u ? cnt : 1u;
}
DEVI void xcd_barrier(const XcdBarrier& b) {
  asm volatile("s_waitcnt vmcnt(0)" ::: "memory");
  __syncthreads();
  if (threadIdx.x == 0) {
    unsigned* bar = b.bar;
    __builtin_amdgcn_s_waitcnt(0);
    unsigned nloc = b.st[0], nx = b.st[1];
    if (nloc == 0u) { xcd_barrier_complete(bar, b.x, nloc, nx); b.st[0] = nloc; b.st[1] = nx; }
    const unsigned old = xb_add(&bar[XB_XSUB(b.x)], 1u);
    const unsigned gen = old / nloc;
    if (old + 1u == (gen + 1u) * nloc) {
      __builtin_amdgcn_fence(__ATOMIC_RELEASE, "agent");
      asm volatile("s_waitcnt vmcnt(0)" ::: "memory");
      const unsigned og = xb_add(&bar[XB_TOP], 1u);
      const unsigned tg = og / nx;
      if (og + 1u == (tg + 1u) * nx) xb_add(&bar[XB_TOPGEN], 1u);
      else XB_SPIN(xb_ld(&bar[XB_TOPGEN]) == tg, bar);
      __builtin_amdgcn_fence(__ATOMIC_ACQUIRE, "agent");
      xb_add(&bar[XB_XGEN(b.x)], 1u);
      asm volatile("s_waitcnt vmcnt(0)" ::: "memory");
    } else {
      XB_SPIN(xb_ld(&bar[XB_XGEN(b.x)]) == gen, bar);
      __builtin_amdgcn_fence(__ATOMIC_ACQUIRE, "agent");
      asm volatile("s_waitcnt vmcnt(0)" ::: "memory");
    }
  }
  __syncthreads();
}

__global__ void __launch_bounds__(256, 2) mega_kernel(KArgs ka, int ph_lo, int ph_hi) {
  __shared__ __attribute__((aligned(16))) unsigned char sm[57344];
  __shared__ int s_item;
  __shared__ g_cf32* s_in[36];
  __shared__ __attribute__((aligned(16))) unsigned s_xb[4];
  cg::grid_group grid = cg::this_grid();
  if (threadIdx.x < 4) s_xb[threadIdx.x] = 0u;
  if (threadIdx.x < 36) {
    const float* const* kp = (const float* const*)__builtin_amdgcn_kernarg_segment_ptr();
    s_in[threadIdx.x] = (g_cf32*)kp[threadIdx.x];
  }
  __syncthreads();
  Params p;
  p.in.t = s_in; p.out = (g_f32*)ka.out; p.ws = (g_u8*)ka.ws;
  int* ctr = (int*)(p.ws + OFF_CTR);
  const XcdBarrier xb = xcd_barrier_post((unsigned*)(p.ws + OFF_BAR), (volatile LAS unsigned*)s_xb);
  for (int idx = ph_lo; idx < ph_hi; ++idx) {
    const int total = phase_total(idx);
#ifdef PROBE_T
    const int ptype = idx < 2 ? idx : 2 + (idx - 2) % 10;
    const int reps = (ptype == PROBE_T) ? 2 : 1;
#else
    const int reps = 1;
#endif
    for (int rep = 0; rep < reps; ++rep) {
      const int nx = phase_xcd_total(idx);
      if (nx) {
        const int xcd = blockIdx.x & 7;
        while (true) {
          __syncthreads();
          if (TIDX == 0) s_item = atomicAdd(&ctr[64 + (idx + 32 * rep) * 8 + xcd], 1);
          __syncthreads();
          const int q_ = s_item;
          if (q_ >= nx) break;
          Params q = p;
          asm volatile("" : "+s"(q.ws));
          asm volatile("" : "+s"(q.out));
          asm volatile("" : "+s"(q.in.t));
          phase_item_x(q, idx, xcd, q_, sm);
        }
      }
      while (true) {
        __syncthreads();
        if (TIDX == 0) s_item = atomicAdd(&ctr[512 + (idx + 32 * rep) * 8 + (blockIdx.x & 7)], 1);
        __syncthreads();
        const int it = s_item * 8 + (blockIdx.x & 7);
        if (it >= total) break;
        Params q = p;
        asm volatile("" : "+s"(q.ws));
        asm volatile("" : "+s"(q.out));
        asm volatile("" : "+s"(q.in.t));
        phase_item(q, idx, it, sm);
      }
      if (rep + 1 < reps) xcd_barrier(xb);
    }
    if (idx + 1 < ph_hi) {
      if (ph_lo < 0) grid.sync();
      xcd_barrier(xb);
    }
  }
}

#ifndef MULTI_LAUNCH
#define MULTI_LAUNCH 0
#endif

extern "C" void kernel_launch(void* const* d_in, const int* in_sizes, int n_in, void* d_out, int out_size, void* d_ws,
                              size_t ws_size, hipStream_t stream) {
  static int grid_blocks = 0;
  if (!grid_blocks) {
    int dev = 0, cus = 0, per_cu = 0;
    hipGetDevice(&dev);
    hipDeviceGetAttribute(&cus, hipDeviceAttributeMultiprocessorCount, dev);
    hipOccupancyMaxActiveBlocksPerMultiprocessor(&per_cu, mega_kernel, 256, 0);
    if (per_cu > 2) per_cu = 2;
    if (per_cu < 1) per_cu = 1;
    grid_blocks = cus * per_cu;
  }
  KArgs p{};
  for (int i = 0; i < 36; ++i) p.in[i] = (const float*)d_in[i];
  p.out = (float*)d_out;
  p.ws = (unsigned char*)d_ws;
  if (ws_size < OFF_END) { fprintf(stderr, "workspace too small: %zu < %zu\n", ws_size, (size_t)OFF_END); return; }
  hipMemsetAsync(d_ws, 0, 4096, stream);
  hipMemsetAsync((unsigned char*)d_ws + OFF_BAR, 0, 16384, stream);
#if MULTI_LAUNCH
  for (int ph = 0; ph < NPHASES; ++ph) {
    hipLaunchKernelGGL(mega_kernel, dim3(grid_blocks), dim3(256), 0, stream, p, ph, ph + 1);
  }
#else
  int lo = 0, hi = NPHASES;
  void* args[] = {&p, &lo, &hi};
  hipError_t e = hipLaunchCooperativeKernel((void*)mega_kernel, dim3(grid_blocks), dim3(256), args, 0, stream);
  if (e != hipSuccess) fprintf(stderr, "cooperative launch failed: %s (grid %d)\n", hipGetErrorString(e), grid_blocks);
#endif
}
```

```cpp
#include <hip/hip_runtime.h>
#include <hip/hip_bf16.h>
#include <hip/hip_cooperative_groups.h>
#include <cstdio>
namespace cg = cooperative_groups;

typedef unsigned short u16;
using bf16x8 = __attribute__((ext_vector_type(8))) short;
using f32x4 = __attribute__((ext_vector_type(4))) float;
#define DEVI __device__ __forceinline__
__device__ __forceinline__ int ltid_() { int t = threadIdx.x; asm volatile("" : "+v"(t)); return t; }
#define TIDX ltid_()

constexpr int NTOK = 8192;
constexpr int PIN = 8064;
constexpr float ALPHA = 1.4142135623730951f;
constexpr size_t OUT_Y = 0;
constexpr size_t OUT_NAK = 8388608;
constexpr size_t OUT_NAV = 12582912;
constexpr size_t OUT_SRET = 16777216;
constexpr size_t OUT_SRW = 18874368;
constexpr size_t OFF_CTR = 0;
constexpr size_t OFF_TAB = 4096;
constexpr size_t OFF_MOD = 16384;
constexpr size_t OFF_WINT = 1048576;
constexpr size_t OFF_WBRT = OFF_WINT + 33030144;
constexpr size_t OFF_WOUTT = OFF_WBRT + 6291456;
constexpr size_t OFF_WQT = OFF_WOUTT + 4194304;
constexpr size_t OFF_WUPT = OFF_WQT + 4194304;
constexpr size_t OFF_AUPT = OFF_WUPT + 262144;
constexpr size_t OFF_GUPT = OFF_AUPT + 262144;
constexpr size_t OFF_UB = OFF_GUPT + 262144;
constexpr size_t OFF_VB = OFF_UB + 33554432;
constexpr size_t OFF_Z = OFF_VB + 33554432;
constexpr size_t OFF_X = OFF_Z + 132120576;
constexpr size_t OFF_H = OFF_X + 33554432;
constexpr size_t OFF_ONA = OFF_H + 16777216;
constexpr size_t OFF_ORT = OFF_ONA + 8388608;
constexpr size_t OFF_ORW = OFF_ORT + 8388608;
constexpr size_t OFF_GA = OFF_ORW + 8388608;
constexpr size_t SZB = 8388608;
constexpr size_t OFF_RWW = OFF_GA;
constexpr size_t OFF_RWR = OFF_RWW + 4 * SZB;
constexpr size_t OFF_RWV = OFF_RWR + SZB;
constexpr size_t OFF_RWKK = OFF_RWV + SZB;
constexpr size_t OFF_RWKC = OFF_RWKK + SZB;
constexpr size_t OFF_RWKD = OFF_RWKC + SZB;
constexpr size_t OFF_RWKKA = OFF_RWKD + 2 * SZB;
constexpr size_t OFF_RWG = OFF_RWKKA + 2 * SZB;
constexpr size_t OFF_RWBON = OFF_RWG + SZB;
constexpr size_t OFF_OF = OFF_RWBON + SZB;
constexpr size_t OFF_KV = OFF_OF + 4 * SZB;
constexpr size_t OFF_BAR = OFF_KV + 33554432;
constexpr size_t OFF_SC = OFF_BAR + 16384;
constexpr size_t OFF_CUT = OFF_SC + 4 * 65536;
constexpr size_t OFF_END = OFF_CUT + 8192;
constexpr size_t OFF_Y = OFF_GA;
constexpr size_t OFF_X1 = OFF_GA + 33554432;
constexpr size_t OFF_Q = OFF_GA + 2 * 33554432;
constexpr size_t OFF_H2 = OFF_GA + 3 * 33554432;
constexpr size_t OFF_EIDX = OFF_H2 + 16777216;
constexpr size_t OFF_GATE = OFF_EIDX + 4194304;

constexpr size_t UV_LSTRIDE = 16777216;
struct KArgs {
  const float* in[36];
  float* out;
  unsigned char* ws;
};
typedef __attribute__((address_space(1))) unsigned char g_u8;
typedef __attribute__((address_space(1))) float g_f32;
typedef const __attribute__((address_space(1))) float g_cf32;
struct InTab {
  g_cf32* const* t;
  DEVI const float* operator[](int k) const { return (const float*)t[k]; }
};
struct Params {
  InTab in;
  g_f32* out;
  g_u8* ws;
};
DEVI const float* uniform_ptr(const float* q) {
  unsigned long long v = (unsigned long long)q;
  unsigned lo = __builtin_amdgcn_readfirstlane((unsigned)v), hi = __builtin_amdgcn_readfirstlane((unsigned)(v >> 32));
  return (const float*)(((unsigned long long)hi << 32) | lo);
}

DEVI float bf2f(u16 h) { return __uint_as_float(((unsigned)h) << 16); }
DEVI unsigned cvtpk(float lo, float hi) {
  unsigned r;
  asm volatile("v_cvt_pk_bf16_f32 %0, %1, %2" : "=v"(r) : "v"(lo), "v"(hi));
  return r;
}
DEVI u16 f2bf(float f) { return (u16)(cvtpk(f, f) & 0xffffu); }
DEVI float sigmoidf_(float x) { return 1.f / (1.f + __expf(-x)); }
template <int CTRL> DEVI float dpp(float x) {
  return __builtin_bit_cast(float, __builtin_amdgcn_update_dpp(0, __builtin_bit_cast(int, x), CTRL, 0xf, 0xf, true));
}
DEVI float quad_sum(float x) { x += dpp<0xB1>(x); x += dpp<0x4E>(x); return x; }
DEVI float row16_sum(float x) { x = quad_sum(x); x += dpp<0x141>(x); x += dpp<0x140>(x); return x; }
DEVI float wave_sum(float x) { x = row16_sum(x); x += __shfl_xor(x, 16); x += __shfl_xor(x, 32); return x; }
DEVI void unpack8(uint4 v, float* f) {
  f[0] = __uint_as_float(v.x << 16); f[1] = __uint_as_float(v.x & 0xffff0000u);
  f[2] = __uint_as_float(v.y << 16); f[3] = __uint_as_float(v.y & 0xffff0000u);
  f[4] = __uint_as_float(v.z << 16); f[5] = __uint_as_float(v.z & 0xffff0000u);
  f[6] = __uint_as_float(v.w << 16); f[7] = __uint_as_float(v.w & 0xffff0000u);
}
DEVI void unpack4(uint2 v, float* f) {
  f[0] = __uint_as_float(v.x << 16); f[1] = __uint_as_float(v.x & 0xffff0000u);
  f[2] = __uint_as_float(v.y << 16); f[3] = __uint_as_float(v.y & 0xffff0000u);
}
DEVI uint4 pack8(const float* f) {
  uint4 r; r.x = cvtpk(f[0], f[1]); r.y = cvtpk(f[2], f[3]); r.z = cvtpk(f[4], f[5]); r.w = cvtpk(f[6], f[7]); return r;
}
DEVI f32x4 mfma16(bf16x8 a, bf16x8 b, f32x4 c) { return __builtin_amdgcn_mfma_f32_16x16x32_bf16(a, b, c, 0, 0, 0); }
DEVI int modrow(int tok) { return tok < 4096 ? 0 : 1 + ((tok - 4096) >> 11); }
DEVI const float* xin_row(const Params& p, int tok) {
  return tok < 4096 ? p.in[0] + (size_t)tok * 1024 : p.in[1] + (size_t)(tok - 4096) * 1024;
}
DEVI int clampi(int v, int lo, int hi) { return v < lo ? lo : (v > hi ? hi : v); }

template <int NT> DEVI void wave_mma(const u16* A, int lda, const u16* B, int ldb, int K, f32x4* acc) {
  const int lane = TIDX & 63, fr = lane & 15, fq = lane >> 4;
  for (int k0 = 0; k0 < K; k0 += 32) {
    bf16x8 a = *(const bf16x8*)(A + fr * lda + k0 + fq * 8);
#pragma unroll
    for (int n = 0; n < NT; ++n) {
      bf16x8 b = *(const bf16x8*)(B + (n * 16 + fr) * ldb + k0 + fq * 8);
      acc[n] = mfma16(a, b, acc[n]);
    }
  }
}

#define LDS_RD(dst, addr, off) asm volatile("ds_read_b128 %0, %1 offset:" #off : "=v"(dst) : "v"(addr))
DEVI void gemm_acc(const u16* __restrict__ A, int lda, const u16* __restrict__ Bt, int ldb, int K, int m0, int n0,
                   unsigned char* sm, f32x4 (&acc)[4][4]) {
  const int tid = TIDX, lane = tid & 63, wid = tid >> 6, wr = wid >> 1, wc = wid & 1, fr = lane & 15, fq = lane >> 4;
  const int nk = K >> 5;
  const int b0 = tid * 16, r0 = b0 >> 6, c0 = (b0 & 63) >> 1;
  const u16* Ap = A + (size_t)(m0 + r0) * lda + c0;
  const u16* Bp = Bt + (size_t)(n0 + r0) * ldb + c0;
  const unsigned lbase = (unsigned)(size_t)(__attribute__((address_space(3))) unsigned char*)sm;
  const unsigned aoff = lbase + (wr * 64 + fr) * 64 + fq * 16;
  const unsigned boff = lbase + 8192 + (wc * 64 + fr) * 64 + fq * 16;
  auto issue = [&](int kt, int st) {
    unsigned char* SA = sm + st * 16384;
    unsigned char* SB = SA + 8192;
    __builtin_amdgcn_global_load_lds((const unsigned*)(Ap + kt * 32), (__attribute__((address_space(3))) unsigned*)(SA + b0), 16, 0, 0);
    __builtin_amdgcn_global_load_lds((const unsigned*)(Ap + (size_t)64 * lda + kt * 32), (__attribute__((address_space(3))) unsigned*)(SA + b0 + 4096), 16, 0, 0);
    __builtin_amdgcn_global_load_lds((const unsigned*)(Bp + kt * 32), (__attribute__((address_space(3))) unsigned*)(SB + b0), 16, 0, 0);
    __builtin_amdgcn_global_load_lds((const unsigned*)(Bp + (size_t)64 * ldb + kt * 32), (__attribute__((address_space(3))) unsigned*)(SB + b0 + 4096), 16, 0, 0);
  };
  issue(0, 0);
  if (nk > 1) issue(1, 1);
  int st = 0;
  for (int kt = 0; kt < nk; ++kt) {
    if (kt + 1 < nk) asm volatile("s_waitcnt vmcnt(4)\n\ts_barrier" ::: "memory");
    else asm volatile("s_waitcnt vmcnt(0)\n\ts_barrier" ::: "memory");
    if (kt + 2 < nk) { int s2 = st + 2; if (s2 >= 3) s2 -= 3; issue(kt + 2, s2); }
    const unsigned aa = aoff + st * 16384, bb = boff + st * 16384;
    bf16x8 a0, a1, a2, a3, b0_, b1_, b2_, b3_;
    LDS_RD(a0, aa, 0); LDS_RD(b0_, bb, 0); LDS_RD(b1_, bb, 1024); LDS_RD(b2_, bb, 2048); LDS_RD(b3_, bb, 3072);
    LDS_RD(a1, aa, 1024); LDS_RD(a2, aa, 2048); LDS_RD(a3, aa, 3072);
    asm volatile("s_waitcnt lgkmcnt(0)" : "+v"(a0), "+v"(a1), "+v"(a2), "+v"(a3), "+v"(b0_), "+v"(b1_), "+v"(b2_), "+v"(b3_));
    acc[0][0] = mfma16(a0, b0_, acc[0][0]); acc[0][1] = mfma16(a0, b1_, acc[0][1]);
    acc[0][2] = mfma16(a0, b2_, acc[0][2]); acc[0][3] = mfma16(a0, b3_, acc[0][3]);
    acc[1][0] = mfma16(a1, b0_, acc[1][0]); acc[1][1] = mfma16(a1, b1_, acc[1][1]);
    acc[1][2] = mfma16(a1, b2_, acc[1][2]); acc[1][3] = mfma16(a1, b3_, acc[1][3]);
    acc[2][0] = mfma16(a2, b0_, acc[2][0]); acc[2][1] = mfma16(a2, b1_, acc[2][1]);
    acc[2][2] = mfma16(a2, b2_, acc[2][2]); acc[2][3] = mfma16(a2, b3_, acc[2][3]);
    acc[3][0] = mfma16(a3, b0_, acc[3][0]); acc[3][1] = mfma16(a3, b1_, acc[3][1]);
    acc[3][2] = mfma16(a3, b2_, acc[3][2]); acc[3][3] = mfma16(a3, b3_, acc[3][3]);
    st = (st == 2) ? 0 : st + 1;
  }
  __syncthreads();
}
#define EPI_LOOP                                                                                         \
  const int _lane = TIDX & 63, _wid = TIDX >> 6, _wr = _wid >> 1, _wc = _wid & 1, _fr = _lane & 15, \
            _fq = _lane >> 4;                                                                            \
  _Pragma("unroll") for (int m = 0; m < 4; ++m) _Pragma("unroll") for (int n = 0; n < 4; ++n)            \
      _Pragma("unroll") for (int j = 0; j < 4; ++j)
#define EPI_ROW (m0 + _wr * 64 + m * 16 + _fq * 4 + j)
#define EPI_COL (n0 + _wc * 64 + n * 16 + _fr)

DEVI void zero_acc(f32x4 (&acc)[4][4]) {
#pragma unroll
  for (int m = 0; m < 4; ++m)
#pragma unroll
    for (int n = 0; n < 4; ++n) acc[m][n] = f32x4{0.f, 0.f, 0.f, 0.f};
}

__constant__ double ROPE_FREQ[16] = {1.0, 0.5623413251903491, 0.31622776601683794, 0.1778279410038923, 0.1,
                                     0.05623413251903491, 0.03162277660168379, 0.01778279410038923, 0.01,
                                     0.005623413251903491, 0.0031622776601683794, 0.0017782794100389228, 0.001,
                                     0.0005623413251903491, 0.00031622776601683794, 0.00017782794100389227};

DEVI void transpose_tile(const float* __restrict__ src, int K, int N, u16* __restrict__ dst, int kt, int nt, unsigned char* sm) {
  float* tile = (float*)sm;
  const int tid = TIDX;
  const int k0 = kt * 64, n0 = nt * 64;
#pragma unroll
  for (int i = 0; i < 16; ++i) {
    int kk = i * 4 + (tid >> 6), nn = tid & 63;
    tile[kk * 65 + nn] = src[(size_t)(k0 + kk) * N + n0 + nn];
  }
  __syncthreads();
#pragma unroll
  for (int i = 0; i < 16; ++i) {
    int nn = i * 4 + (tid >> 6), kk = tid & 63;
    dst[(size_t)(n0 + nn) * K + k0 + kk] = f2bf(tile[kk * 65 + nn]);
  }
}

typedef float f32x2_ __attribute__((ext_vector_type(2)));
DEVI void convert_uv_item(const Params& p, int l, int it) {
  const int which = it >> 9, chunk = it & 511;
  const int lane = TIDX & 63, w = TIDX >> 6;
#pragma unroll 2
  for (int sub = 0; sub < 8; ++sub) {
  const int row = chunk * 32 + sub * 4 + w;
  const float* src = p.in[34 + which] + (size_t)l * 16777216 + (size_t)row * 1024 + lane * 16;
  unsigned char* base = (unsigned char*)(p.ws + (which ? OFF_VB : OFF_UB)) + (size_t)l * UV_LSTRIDE;
  float v[16];
#pragma unroll
  for (int i = 0; i < 4; ++i) *(float4*)(v + i * 4) = *(const float4*)(src + i * 4);
  float am = 0.f;
#pragma unroll
  for (int i = 0; i < 16; ++i) am = fmaxf(am, fabsf(v[i]));
  am = fmaxf(am, dpp<0xB1>(am)); am = fmaxf(am, dpp<0x4E>(am)); am = fmaxf(am, dpp<0x141>(am)); am = fmaxf(am, dpp<0x140>(am));
  am = fmaxf(am, __shfl_xor(am, 16)); am = fmaxf(am, __shfl_xor(am, 32));
  const float sc = (am > 0.f) ? (240.f / am) : 1.f;
  int o[4];
#pragma unroll
  for (int i = 0; i < 4; ++i) {
    int wv = 0;
    wv = __builtin_amdgcn_cvt_pk_fp8_f32(v[i * 4] * sc, v[i * 4 + 1] * sc, wv, false);
    wv = __builtin_amdgcn_cvt_pk_fp8_f32(v[i * 4 + 2] * sc, v[i * 4 + 3] * sc, wv, true);
    o[i] = wv;
  }
  *(int4*)(base + (size_t)row * 1024 + lane * 16) = make_int4(o[0], o[1], o[2], o[3]);
  if (lane == 0) ((float*)(p.ws + OFF_SC))[(which * 2 + l) * 16384 + row] = am * (1.f / 240.f);
  }
}

constexpr int P0_NT = 740;
constexpr int P0_NUV = 1024;
constexpr int P0_NMOD = 192;
constexpr int P0_TOTAL = P0_NMOD + P0_NT + P0_NUV + 1;

constexpr int P0_TILES_L = 2960;
constexpr int P0_NT_ITEMS = P0_TILES_L / 4;
DEVI void p0_tile1(const Params& p, int l, int u, unsigned char* sm) {
  const float* src; u16* dst; int K, N, kt, nt;
  if (u < 2016) { kt = u / 126; nt = u % 126; K = 1024; N = 8064;
    src = p.in[10] + (size_t)l * 1024 * 8064; dst = (u16*)(p.ws + OFF_WINT) + (size_t)l * 8064 * 1024; }
  else if ((u -= 2016) < 384) { int j = l * 3 + u / 128, r = u % 128; kt = r / 16; nt = r % 16; K = 512; N = 1024;
    src = p.in[26] + (size_t)j * 512 * 1024; dst = (u16*)(p.ws + OFF_WBRT) + (size_t)j * 1024 * 512; }
  else if ((u -= 384) < 256) { kt = u / 16; nt = u % 16; K = 1024; N = 1024;
    src = p.in[27] + (size_t)l * 1048576; dst = (u16*)(p.ws + OFF_WOUTT) + (size_t)l * 1048576; }
  else if ((u -= 256) < 256) { kt = u / 16; nt = u % 16; K = 1024; N = 1024;
    src = p.in[32] + (size_t)l * 1048576; dst = (u16*)(p.ws + OFF_WQT) + (size_t)l * 1048576; }
  else if ((u -= 256) < 16) { int j = l * 2 + u / 8; kt = 0; nt = u % 8; K = 64; N = 512;
    src = p.in[17] + (size_t)j * 32768; dst = (u16*)(p.ws + OFF_WUPT) + (size_t)j * 32768; }
  else if ((u -= 16) < 16) { int j = l * 2 + u / 8; kt = 0; nt = u % 8; K = 64; N = 512;
    src = p.in[19] + (size_t)j * 32768; dst = (u16*)(p.ws + OFF_AUPT) + (size_t)j * 32768; }
  else { u -= 16; kt = u / 8; nt = u % 8; K = 128; N = 512;
    src = p.in[20] + (size_t)l * 65536; dst = (u16*)(p.ws + OFF_GUPT) + (size_t)l * 65536; }
  transpose_tile(src, K, N, dst, kt, nt, sm);
}
DEVI void p0_tiles(const Params& p, int l, int item, unsigned char* sm) {
  for (int i = 0; i < 4; ++i) {
    if (i) __syncthreads();
    p0_tile1(p, l, item * 4 + i, sm);
  }
}
DEVI void phase0_item(const Params& p, int it, unsigned char* sm) {
  const int tid = TIDX;
  if (it < P0_NMOD) {
    const int l = it / 96, n0 = (it % 96) * 64;
    const int kg = tid >> 4, c4 = (tid & 15) * 4;
    float acc[3][4];
#pragma unroll
    for (int r = 0; r < 3; ++r)
#pragma unroll
      for (int i = 0; i < 4; ++i) acc[r][i] = 0.f;
    const float* wm = p.in[8] + (size_t)l * 1024 * 6144;
#pragma unroll 8
    for (int k = kg * 64; k < kg * 64 + 64; ++k) {
      float4 w = *(const float4*)(wm + (size_t)k * 6144 + n0 + c4);
      float c0 = p.in[7][k], c1 = p.in[6][k], c2 = p.in[6][1024 + k];
      float s0 = c0 * sigmoidf_(c0), s1 = c1 * sigmoidf_(c1), s2 = c2 * sigmoidf_(c2);
      acc[0][0] += s0 * w.x; acc[0][1] += s0 * w.y; acc[0][2] += s0 * w.z; acc[0][3] += s0 * w.w;
      acc[1][0] += s1 * w.x; acc[1][1] += s1 * w.y; acc[1][2] += s1 * w.z; acc[1][3] += s1 * w.w;
      acc[2][0] += s2 * w.x; acc[2][1] += s2 * w.y; acc[2][2] += s2 * w.z; acc[2][3] += s2 * w.w;
    }
    float* red = (float*)sm;
#pragma unroll
    for (int r = 0; r < 3; ++r)
#pragma unroll
      for (int i = 0; i < 4; ++i) red[(kg * 3 + r) * 64 + c4 + i] = acc[r][i];
    __syncthreads();
    if (tid < 192) {
      int r = tid >> 6, col = tid & 63;
      float s = p.in[9][(size_t)l * 6144 + n0 + col];
      for (int g = 0; g < 16; ++g) s += red[(g * 3 + r) * 64 + col];
      ((float*)(p.ws + OFF_MOD))[((size_t)l * 3 + r) * 6144 + n0 + col] = s;
    }
    return;
  }
  it -= P0_NMOD;
  if (it < P0_NT) {
    p0_tiles(p, 0, it, sm);
    return;
  }
  if (0) {
    int t = it;
    const float* src; u16* dst; int K, N, kt, nt;
    if (t < 4032) { int l = t / 2016, r = t % 2016; kt = r / 126; nt = r % 126; K = 1024; N = 8064;
      src = p.in[10] + (size_t)l * 1024 * 8064; dst = (u16*)(p.ws + OFF_WINT) + (size_t)l * 8064 * 1024; }
    else if ((t -= 4032) < 768) { int j = t / 128, r = t % 128; kt = r / 16; nt = r % 16; K = 512; N = 1024;
      src = p.in[26] + (size_t)j * 512 * 1024; dst = (u16*)(p.ws + OFF_WBRT) + (size_t)j * 1024 * 512; }
    else if ((t -= 768) < 512) { int l = t / 256, r = t % 256; kt = r / 16; nt = r % 16; K = 1024; N = 1024;
      src = p.in[27] + (size_t)l * 1048576; dst = (u16*)(p.ws + OFF_WOUTT) + (size_t)l * 1048576; }
    else if ((t -= 512) < 512) { int l = t / 256, r = t % 256; kt = r / 16; nt = r % 16; K = 1024; N = 1024;
      src = p.in[32] + (size_t)l * 1048576; dst = (u16*)(p.ws + OFF_WQT) + (size_t)l * 1048576; }
    else if ((t -= 512) < 32) { int j = t / 8; kt = 0; nt = t % 8; K = 64; N = 512;
      src = p.in[17] + (size_t)j * 32768; dst = (u16*)(p.ws + OFF_WUPT) + (size_t)j * 32768; }
    else if ((t -= 32) < 32) { int j = t / 8; kt = 0; nt = t % 8; K = 64; N = 512;
      src = p.in[19] + (size_t)j * 32768; dst = (u16*)(p.ws + OFF_AUPT) + (size_t)j * 32768; }
    else { t -= 32; int l = t / 16, r = t % 16; kt = r / 8; nt = r % 8; K = 128; N = 512;
      src = p.in[20] + (size_t)l * 65536; dst = (u16*)(p.ws + OFF_GUPT) + (size_t)l * 65536; }
    transpose_tile(src, K, N, dst, kt, nt, sm);
    return;
  }
  it -= P0_NT;
  if (it < P0_NUV) { convert_uv_item(p, 0, it); return; }
  float* tab = (float*)(p.ws + OFF_TAB);
  for (int e = tid; e < 1024; e += 256) {
    int pos = e >> 4, f = e & 15;
    double rev = (double)pos * ROPE_FREQ[f] * 0.15915494309189535;
    rev -= floor(rev);
    float rf = (float)rev;
    tab[e] = __builtin_amdgcn_cosf(rf);
    tab[1024 + e] = __builtin_amdgcn_sinf(rf);
  }
}

DEVI void ln1_item(const Params& p, int it) {
  const int lane = TIDX & 63, w = TIDX >> 6;
  const int tok = it * 4 + w;
  const float* x = xin_row(p, tok);
  const float* mod = (const float*)(p.ws + OFF_MOD) + (size_t)modrow(tok) * 6144;
  float4 v[4];
  float s = 0.f;
#pragma unroll
  for (int i = 0; i < 4; ++i) { v[i] = *(const float4*)(x + lane * 4 + 256 * i); s += v[i].x + v[i].y + v[i].z + v[i].w; }
  float mu = wave_sum(s) * (1.f / 1024.f);
  float q = 0.f;
#pragma unroll
  for (int i = 0; i < 4; ++i) { float a = v[i].x - mu, b = v[i].y - mu, c = v[i].z - mu, d = v[i].w - mu; q += a * a + b * b + c * c + d * d; }
  float rs = rsqrtf(wave_sum(q) * (1.f / 1024.f) + 1e-5f);
  u16* H = (u16*)(p.ws + OFF_H) + (size_t)tok * 1024;
#pragma unroll
  for (int i = 0; i < 4; ++i) {
    int c = lane * 4 + 256 * i;
    float4 sh = *(const float4*)(mod + c), sc = *(const float4*)(mod + 1024 + c);
    uint2 o;
    o.x = cvtpk((v[i].x - mu) * rs * (1.f + sc.x) + sh.x, (v[i].y - mu) * rs * (1.f + sc.y) + sh.y);
    o.y = cvtpk((v[i].z - mu) * rs * (1.f + sc.z) + sh.z, (v[i].w - mu) * rs * (1.f + sc.w) + sh.w);
    *(uint2*)(H + c) = o;
  }
}

DEVI void g1_item(const Params& p, int l, int it, unsigned char* sm) {
  const int nt = it >> 6, mt = it & 63;
  const int m0 = mt * 128, n0 = nt * 128;
  f32x4 acc[4][4];
  zero_acc(acc);
  gemm_acc((const u16*)(p.ws + OFF_H), 1024, (const u16*)(p.ws + OFF_WINT) + (size_t)l * 8064 * 1024, 1024, 1024, m0, n0, sm, acc);
  u16* Z = (u16*)(p.ws + OFF_Z);
  EPI_LOOP {
    int row = EPI_ROW, col = EPI_COL;
    float v = acc[m][n][j];
    Z[(size_t)row * PIN + col] = f2bf(v);
    if (row < 4096 && col >= 512 && col < 1536) {
      int which = (col - 512) >> 9, cc = (col - 512) & 511, h = cc >> 6, d = cc & 63, b = row >> 8, s = row & 255;
      p.out[OUT_NAK + (size_t)which * 4194304 + ((((size_t)(b * 2 + l) * 8 + h) * 256 + s) * 64 + d)] = v;
    }
  }
}
DEVI void g2_item(const Params& p, int l, int it, unsigned char* sm) {
  const int nt = it >> 6, mt = it & 63;
  const int m0 = mt * 128, n0 = nt * 128;
  f32x4 tot[4][4];
  zero_acc(tot);
  const u16* Z = (const u16*)(p.ws + OFF_Z);
  for (int i = 0; i < 3; ++i) {
    f32x4 acc[4][4];
    zero_acc(acc);
    const u16* A = (const u16*)(p.ws + (i == 0 ? OFF_ONA : (i == 1 ? OFF_ORT : OFF_ORW)));
    gemm_acc(A, 512, (const u16*)(p.ws + OFF_WBRT) + (size_t)(l * 3 + i) * 1024 * 512, 512, 512, m0, n0, sm, acc);
    EPI_LOOP {
      int row = EPI_ROW, col = EPI_COL;
      float g = bf2f(Z[(size_t)row * PIN + 4992 + i * 1024 + col]);
      tot[m][n][j] += sigmoidf_(g) * acc[m][n][j];
    }
  }
  u16* MG = (u16*)(p.ws + OFF_H);
  EPI_LOOP { MG[(size_t)EPI_ROW * 1024 + EPI_COL] = f2bf(tot[m][n][j]); }
}
DEVI void g3_item(const Params& p, int l, int it, unsigned char* sm) {
  const int nt = it >> 6, mt = it & 63;
  const int m0 = mt * 128, n0 = nt * 128;
  f32x4 acc[4][4];
  zero_acc(acc);
  gemm_acc((const u16*)(p.ws + OFF_H), 1024, (const u16*)(p.ws + OFF_WOUTT) + (size_t)l * 1048576, 1024, 1024, m0, n0, sm, acc);
  float* Y = (float*)(p.ws + OFF_Y);
  const float* mod = (const float*)(p.ws + OFF_MOD) + (size_t)l * 3 * 6144;
  const float* X = (const float*)(p.ws + OFF_X);
  EPI_LOOP {
    int row = EPI_ROW, col = EPI_COL;
    float xr = (l == 0) ? xin_row(p, row)[col] : X[(size_t)row * 1024 + col];
    float gt = mod[(size_t)modrow(row) * 6144 + 2048 + col];
    Y[(size_t)row * 1024 + col] = ALPHA * xr + gt * acc[m][n][j];
  }
}
DEVI void g4_item(const Params& p, int l, int it, unsigned char* sm) {
  const int nt = it >> 6, mt = it & 63;
  const int m0 = mt * 128, n0 = nt * 128;
  f32x4 acc[4][4];
  zero_acc(acc);
  gemm_acc((const u16*)(p.ws + OFF_H2), 1024, (const u16*)(p.ws + OFF_WQT) + (size_t)l * 1048576, 1024, 1024, m0, n0, sm, acc);
  float* Q = (float*)(p.ws + OFF_Q);
  EPI_LOOP { Q[(size_t)EPI_ROW * 1024 + EPI_COL] = acc[m][n][j]; }
}

DEVI void load_qk16(const u16* zp  , int part, bool lat, int prow, int pcol, const float* tab,
                    float scale, float* out) {
  if (!lat) {
    float t[16];
    unpack8(*(const uint4*)(zp + part * 16), t);
    unpack8(*(const uint4*)(zp + part * 16 + 8), t + 8);
#pragma unroll
    for (int i = 0; i < 16; ++i) out[i] = t[i] * scale;
    return;
  }
  const int half = part >> 1, isp2 = part & 1;
  float p1[16], p2[16];
  unpack8(*(const uint4*)(zp + half * 32), p1);
  unpack8(*(const uint4*)(zp + half * 32 + 8), p1 + 8);
  unpack8(*(const uint4*)(zp + half * 32 + 16), p2);
  unpack8(*(const uint4*)(zp + half * 32 + 24), p2 + 8);
  const int pos = half ? pcol : prow;
  const float* ct = tab + pos * 16;
  const float* st = tab + 1024 + pos * 16;
#pragma unroll
  for (int f = 0; f < 16; ++f) {
    float c = ct[f], s = st[f];
    out[f] = (isp2 ? (p1[f] * s + p2[f] * c) : (p1[f] * c - p2[f] * s)) * scale;
  }
}
struct RetItem { int lat, b, h, n, N, seqbase, kvbase; };
DEVI RetItem ret_decode(int it) {
  RetItem r;
  if (it < 256) { r.lat = 1; r.b = it >> 7; r.h = (it >> 5) & 3; r.n = it & 31; r.N = 32; r.seqbase = 4096 + r.b * 2048; r.kvbase = 256 + (r.b * 4 + r.h) * 32; }
  else { int j = it - 256; r.lat = 0; r.b = j >> 4; r.h = (j >> 2) & 3; r.n = j & 3; r.N = 4; r.seqbase = r.b * 256; r.kvbase = (r.b * 4 + r.h) * 4; }
  return r;
}
DEVI void ret_gammas(const Params& p, int l, int h, float& lgf, float& lgb) {
  float xf = p.in[12][(l * 2 + 0) * 4 + h], xb = p.in[12][(l * 2 + 1) * 4 + h];
  lgf = -log2f(1.f + expf(-xf));
  lgb = -log2f(1.f + expf(-xb));
}

DEVI void ret1_item(const Params& p, int l, int it, unsigned char* sm) {
  const RetItem r = ret_decode(it);
  const int tid = TIDX, lane = tid & 63, w = tid >> 6, fr = lane & 15, fq = lane >> 4;
  u16* KTf = (u16*)sm;
  u16* KTb = (u16*)(sm + 9216);
  u16* VT = (u16*)(sm + 18432);
  const u16* Z = (const u16*)(p.ws + OFF_Z);
  const float* tab = (const float*)(p.ws + OFF_TAB);
  float lgf, lgb;
  ret_gammas(p, l, r.h, lgf, lgb);
  const int tok0 = r.seqbase + r.n * 64;
  {
    const int j = tid >> 2, part = tid & 3;
    float kv[16];
    load_qk16(Z + (size_t)(tok0 + j) * PIN + 1792 + r.h * 64, part, r.lat, r.n, j, tab, 0.125f, kv);
    const float df = exp2f(lgf * (float)(63 - j)), db = exp2f(lgb * (float)j);
#pragma unroll
    for (int i = 0; i < 16; ++i) {
      KTf[(part * 16 + i) * 72 + j] = f2bf(kv[i] * df);
      KTb[(part * 16 + i) * 72 + j] = f2bf(kv[i] * db);
    }
    const int jj = tid & 63, vp = (tid >> 6) * 32;
    const u16* vz = Z + (size_t)(tok0 + jj) * PIN + 2048 + r.h * 128 + vp;
#pragma unroll
    for (int c = 0; c < 4; ++c) {
      uint4 raw = *(const uint4*)(vz + c * 8);
      const u16* rv = (const u16*)&raw;
#pragma unroll
      for (int i = 0; i < 8; ++i) VT[(vp + c * 8 + i) * 72 + jj] = rv[i];
    }
  }
  __syncthreads();
  float* KV = (float*)(p.ws + OFF_KV) + (size_t)(r.kvbase + r.n) * 2 * 8192;
#pragma unroll
  for (int dir = 0; dir < 2; ++dir) {
    f32x4 acc[8];
#pragma unroll
    for (int n = 0; n < 8; ++n) acc[n] = f32x4{0.f, 0.f, 0.f, 0.f};
    wave_mma<8>((dir ? KTb : KTf) + w * 16 * 72, 72, VT, 72, 64, acc);
#pragma unroll
    for (int n = 0; n < 8; ++n)
#pragma unroll
      for (int j = 0; j < 4; ++j) KV[(size_t)dir * 8192 + (w * 16 + fq * 4 + j) * 128 + n * 16 + fr] = acc[n][j];
  }
}

DEVI void ret3_item(const Params& p, int l, int it, unsigned char* sm) {
  const RetItem r = ret_decode(it);
  const int tid = TIDX, lane = tid & 63, w = tid >> 6, fr = lane & 15, fq = lane >> 4;
  u16* Qs = (u16*)sm;
  u16* Ks = (u16*)(sm + 9216);
  u16* VT = (u16*)(sm + 18432);
  u16* ST = (u16*)(sm + 36864);
  const u16* Z = (const u16*)(p.ws + OFF_Z);
  const float* tab = (const float*)(p.ws + OFF_TAB);
  float lgf, lgb;
  ret_gammas(p, l, r.h, lgf, lgb);
  const int tok0 = r.seqbase + r.n * 64;
  {
    const int i = tid >> 2, part = tid & 3;
    float t[16];
    load_qk16(Z + (size_t)(tok0 + i) * PIN + 1536 + r.h * 64, part, r.lat, r.n, i, tab, 1.f, t);
    *(uint4*)(Qs + i * 72 + part * 16) = pack8(t);
    *(uint4*)(Qs + i * 72 + part * 16 + 8) = pack8(t + 8);
    load_qk16(Z + (size_t)(tok0 + i) * PIN + 1792 + r.h * 64, part, r.lat, r.n, i, tab, 0.125f, t);
    *(uint4*)(Ks + i * 72 + part * 16) = pack8(t);
    *(uint4*)(Ks + i * 72 + part * 16 + 8) = pack8(t + 8);
    const int jj = tid & 63, vp = (tid >> 6) * 32;
    const u16* vz = Z + (size_t)(tok0 + jj) * PIN + 2048 + r.h * 128 + vp;
#pragma unroll
    for (int c = 0; c < 4; ++c) {
      uint4 raw = *(const uint4*)(vz + c * 8);
      const u16* rv = (const u16*)&raw;
#pragma unroll
      for (int e = 0; e < 8; ++e) VT[(vp + c * 8 + e) * 72 + jj] = rv[e];
    }
  }
  __syncthreads();
  f32x4 at[4];
#pragma unroll
  for (int n = 0; n < 4; ++n) at[n] = f32x4{0.f, 0.f, 0.f, 0.f};
  wave_mma<4>(Qs + w * 16 * 72, 72, Ks, 72, 64, at);
  __syncthreads();
#pragma unroll
  for (int n = 0; n < 4; ++n)
#pragma unroll
    for (int j = 0; j < 4; ++j) {
      int i = w * 16 + fq * 4 + j, jc = n * 16 + fr;
      float mval = (i > jc) ? exp2f(lgf * (float)(i - jc)) : ((i < jc) ? exp2f(lgb * (float)(jc - i)) : 2.f);
      Ks[i * 72 + jc] = f2bf(at[n][j] * mval);
    }
  __syncthreads();
  f32x4 o[8];
#pragma unroll
  for (int n = 0; n < 8; ++n) o[n] = f32x4{0.f, 0.f, 0.f, 0.f};
  wave_mma<8>(Ks + w * 16 * 72, 72, VT, 72, 64, o);
  const float* KVb_ = (const float*)(p.ws + OFF_KV);
  for (int dir = 0; dir < 2; ++dir) {
    const float lg = dir ? lgb : lgf;
    const float cdec = exp2f(lg * 64.f);
    const int nprev = dir ? (r.N - 1 - r.n) : r.n;
    __syncthreads();
    {
      float S[32];
#pragma unroll
      for (int e8 = 0; e8 < 32; ++e8) {
        int e = e8 * 256 + tid;
        S[e8] = r.lat ? p.in[4][((((size_t)(r.b * 2 + l) * 2 + dir) * 4 + r.h) * 64) * 128 + e] : 0.f;
      }
#pragma unroll 2
      for (int m = 0; m < nprev; ++m) {
        const int ch = dir ? (r.N - 1 - m) : m;
        const float* kvp = KVb_ + ((size_t)(r.kvbase + ch) * 2 + dir) * 8192 + tid;
#pragma unroll
        for (int e8 = 0; e8 < 32; ++e8) S[e8] = S[e8] * cdec + kvp[e8 * 256];
      }
      const bool fin = (!r.lat) && (nprev == r.N - 1);
      const float* kvn = KVb_ + ((size_t)(r.kvbase + r.n) * 2 + dir) * 8192 + tid;
      float* so = (float*)p.out + OUT_SRET + ((((size_t)(r.b * 2 + l) * 2 + dir) * 4 + r.h) * 64) * 128 + tid;
#pragma unroll
      for (int e8 = 0; e8 < 32; ++e8) {
        int e = e8 * 256 + tid, d = e >> 7, v = e & 127;
        ST[v * 72 + d] = f2bf(S[e8]);
        if (fin) so[e8 * 256] = S[e8] * cdec + kvn[e8 * 256];
      }
    }
    __syncthreads();
    f32x4 t2[8];
#pragma unroll
    for (int n = 0; n < 8; ++n) t2[n] = f32x4{0.f, 0.f, 0.f, 0.f};
    wave_mma<8>(Qs + w * 16 * 72, 72, ST, 72, 64, t2);
#pragma unroll
    for (int j = 0; j < 4; ++j) {
      int i = w * 16 + fq * 4 + j;
      float dec = dir ? exp2f(lg * (float)(64 - i)) : exp2f(lg * (float)(i + 1));
#pragma unroll
      for (int n = 0; n < 8; ++n) o[n][j] += dec * t2[n][j];
    }
  }
  const float* gw = p.in[13] + l * 512 + r.h * 128;
  const float* gb = p.in[14] + l * 512 + r.h * 128;
  u16* ORT = (u16*)(p.ws + OFF_ORT);
#pragma unroll
  for (int j = 0; j < 4; ++j) {
    float s = 0.f;
#pragma unroll
    for (int n = 0; n < 8; ++n) s += o[n][j];
    float mu = row16_sum(s) * (1.f / 128.f);
    float q = 0.f;
#pragma unroll
    for (int n = 0; n < 8; ++n) { float d = o[n][j] - mu; q += d * d; }
    float rs = rsqrtf(row16_sum(q) * (1.f / 128.f) + 1e-5f);
    const int tok = tok0 + w * 16 + fq * 4 + j;
#pragma unroll
    for (int n = 0; n < 8; ++n) {
      int v = n * 16 + fr;
      float g = bf2f(Z[(size_t)tok * PIN + 2560 + r.h * 128 + v]);
      float y = ((o[n][j] - mu) * rs * gw[v] + gb[v]) * (g * sigmoidf_(g));
      ORT[(size_t)tok * 512 + r.h * 128 + v] = f2bf(y);
    }
  }
}

DEVI void shifted8(const u16* Z, int tok, bool hasp, bool hasn, int col, const float* mu, float* out) {
  float z[8], zp[8], zn[8];
  unpack8(*(const uint4*)(Z + (size_t)tok * PIN + col), z);
  if (hasp) unpack8(*(const uint4*)(Z + (size_t)(tok - 1) * PIN + col), zp);
  else {
#pragma unroll
    for (int i = 0; i < 8; ++i) zp[i] = 0.f;
  }
  if (hasn) unpack8(*(const uint4*)(Z + (size_t)(tok + 1) * PIN + col), zn);
  else {
#pragma unroll
    for (int i = 0; i < 8; ++i) zn[i] = 0.f;
  }
  float4 m0 = *(const float4*)(mu + col - 3072), m1 = *(const float4*)(mu + col - 3072 + 4);
  float mm[8] = {m0.x, m0.y, m0.z, m0.w, m1.x, m1.y, m1.z, m1.w};
#pragma unroll
  for (int i = 0; i < 8; ++i) out[i] = z[i] + mm[i] * (0.5f * (zp[i] + zn[i]) - z[i]);
}
DEVI void tok_neighbors(int tok, bool& hasp, bool& hasn) {
  if (tok < 4096) { int s = tok & 255; hasp = s > 0; hasn = s < 255; }
  else { int s = (tok - 4096) & 2047; hasp = s > 0; hasn = s < 2047; }
}

DEVI void rwprep_item(const Params& p, int l, int it) {
  const int tid = TIDX, lane = tid & 63, w = tid >> 6, fr = lane & 15, fq = lane >> 4;
  const u16* Z = (const u16*)(p.ws + OFF_Z);
  const float* mu = p.in[15] + l * 1920;
  const int tok0 = (it >> 2) * 64, hq = it & 3;
  u16* R = (u16*)(p.ws + OFF_RWR);
  u16* V = (u16*)(p.ws + OFF_RWV);
  u16* KC = (u16*)(p.ws + OFF_RWKC);
  for (int e = tid; e < 64 * 48; e += 256) {
    int ti = e / 48, u = e % 48, arr = u >> 4, c8 = hq * 128 + (u & 15) * 8;
    int tok = tok0 + ti;
    bool hp, hn;
    tok_neighbors(tok, hp, hn);
    float zs[8];
    shifted8(Z, tok, hp, hn, 3072 + arr * 512 + c8, mu, zs);
    u16* dst = (arr == 0) ? R : (arr == 1 ? KC : V);
    *(uint4*)(dst + (size_t)tok * 512 + c8) = pack8(zs);
  }
  __threadfence_block();
  __syncthreads();
  bf16x8 af[12];
  {
    const int tok = tok0 + w * 16 + fr;
    bool hp, hn;
    tok_neighbors(tok, hp, hn);
#pragma unroll
    for (int f = 0; f < 12; ++f) {
      int col = 4608 + f * 32 + fq * 8;
      float zs[8];
      shifted8(Z, tok, hp, hn, col, mu, zs);
      if (f < 4) {
#pragma unroll
        for (int i = 0; i < 8; ++i) zs[i] = tanhf(zs[i]);
      } else if (f >= 8) {
#pragma unroll
        for (int i = 0; i < 8; ++i) zs[i] = sigmoidf_(zs[i]);
      }
      uint4 pk = pack8(zs);
      af[f] = __builtin_bit_cast(bf16x8, pk);
    }
  }
  const u16* WUP = (const u16*)(p.ws + OFF_WUPT) + (size_t)l * 2 * 32768;
  const u16* AUP = (const u16*)(p.ws + OFF_AUPT) + (size_t)l * 2 * 32768;
  const u16* GUP = (const u16*)(p.ws + OFF_GUPT) + (size_t)l * 65536;
  float* Wd = (float*)(p.ws + OFF_RWW);
  u16* KK = (u16*)(p.ws + OFF_RWKK);
  u16* KD = (u16*)(p.ws + OFF_RWKD);
  u16* KKA = (u16*)(p.ws + OFF_RWKKA);
  u16* G = (u16*)(p.ws + OFF_RWG);
  u16* BON = (u16*)(p.ws + OFF_RWBON);
  const float* kkw = p.in[21] + l * 512;
  const float* kaw = p.in[22] + l * 512;
  const float* rkw = p.in[23] + l * 512;
  const float* w0 = p.in[16] + l * 1024;
  const float* a0 = p.in[18] + l * 1024;
  for (int h = hq * 2; h < hq * 2 + 2; ++h) {
    float inv[4], sbv[4];
#pragma unroll
    for (int j = 0; j < 4; ++j) {
      const int tok = tok0 + w * 16 + fq * 4 + j;
      float ssq = 0.f, sb = 0.f;
#pragma unroll
      for (int n = 0; n < 4; ++n) {
        int c = h * 64 + n * 16 + fr;
        float rr = bf2f(R[(size_t)tok * 512 + c]);
        float kc = bf2f(KC[(size_t)tok * 512 + c]);
        float kk = kc * kkw[c];
        ssq += kk * kk;
        sb += rr * kc * rkw[c];
      }
      ssq = row16_sum(ssq);
      sbv[j] = row16_sum(sb);
      inv[j] = rsqrtf(fmaxf(ssq, 1e-24f));
    }
#pragma unroll 1
    for (int n = 0; n < 4; ++n) {
      f32x4 acc[5];
#pragma unroll
      for (int m = 0; m < 5; ++m) acc[m] = f32x4{0.f, 0.f, 0.f, 0.f};
      const int c = h * 64 + n * 16 + fr;
#pragma unroll
      for (int ks = 0; ks < 2; ++ks) {
        acc[0] = mfma16(af[0 + ks], *(const bf16x8*)(WUP + (size_t)c * 64 + ks * 32 + fq * 8), acc[0]);
        acc[1] = mfma16(af[2 + ks], *(const bf16x8*)(WUP + 32768 + (size_t)c * 64 + ks * 32 + fq * 8), acc[1]);
        acc[2] = mfma16(af[4 + ks], *(const bf16x8*)(AUP + (size_t)c * 64 + ks * 32 + fq * 8), acc[2]);
        acc[3] = mfma16(af[6 + ks], *(const bf16x8*)(AUP + 32768 + (size_t)c * 64 + ks * 32 + fq * 8), acc[3]);
      }
#pragma unroll
      for (int ks = 0; ks < 4; ++ks)
        acc[4] = mfma16(af[8 + ks], *(const bf16x8*)(GUP + (size_t)c * 128 + ks * 32 + fq * 8), acc[4]);
      const float kkc = kkw[c], ka = kaw[c];
      const float w0f = w0[c], w0b = w0[512 + c], a0f = a0[c], a0b = a0[512 + c];
#pragma unroll
      for (int j = 0; j < 4; ++j) {
        const int tok = tok0 + w * 16 + fq * 4 + j;
        const size_t o = (size_t)tok * 512 + c;
        const float kc = bf2f(KC[o]), vv = bf2f(V[o]);
        const float kkn = kc * kkc * inv[j];
        KK[o] = f2bf(kkn);
        G[o] = f2bf(acc[4][j]);
        BON[o] = f2bf(sbv[j] * vv);
#pragma unroll
        for (int d = 0; d < 2; ++d) {
          float wv = __expf(-0.606531f * sigmoidf_((d ? w0b : w0f) + acc[d][j]));
          float a = sigmoidf_((d ? a0b : a0f) + acc[2 + d][j]);
          Wd[(size_t)d * NTOK * 512 + o] = wv;
          KD[(size_t)d * NTOK * 512 + o] = f2bf(kc * (1.f + (a - 1.f) * ka));
          KKA[(size_t)d * NTOK * 512 + o] = f2bf(kkn * a);
        }
      }
    }
  }
}

template <int KPT>
DEVI void scan_run(const Params& p, int l, bool lat, int b, int h, int dir, int rowbase, unsigned char* sm) {
  constexpr int LPR = 64 / KPT;
  constexpr int CH = 32;
  const int tid = TIDX;
  const int row = rowbase + tid / LPR, ks = (tid % LPR) * KPT;
  const int lir = tid % LPR;
  const int T = lat ? 2048 : 256, seq0 = lat ? 4096 + b * 2048 : b * 256;
  float S[KPT];
  if (lat) {
    const float* s0 = p.in[5] + ((((size_t)(b * 2 + l) * 2 + dir) * 8 + h) * 64 + row) * 64 + ks;
#pragma unroll
    for (int i = 0; i < KPT; ++i) S[i] = s0[i];
  } else {
#pragma unroll
    for (int i = 0; i < KPT; ++i) S[i] = 0.f;
  }
  float* buf = (float*)sm;
  float* obuf = buf + CH * 384;
  const float* Wd = (const float*)(p.ws + OFF_RWW) + (size_t)dir * NTOK * 512;
  const u16* R = (const u16*)(p.ws + OFF_RWR);
  const u16* V = (const u16*)(p.ws + OFF_RWV);
  const u16* KK = (const u16*)(p.ws + OFF_RWKK);
  const u16* KD = (const u16*)(p.ws + OFF_RWKD) + (size_t)dir * NTOK * 512;
  const u16* KKA = (const u16*)(p.ws + OFF_RWKKA) + (size_t)dir * NTOK * 512;
  float* O = (float*)(p.ws + OFF_OF) + (size_t)dir * NTOK * 512;
  const int pst = tid >> 3, c8 = (tid & 7) * 8;
  const int nch = T / CH;
  struct Pf { float4 qw0, qw1; uint4 qr, qk, qv, qd, qa; };
  auto issue = [&](Pf& q, int chunk) {
    float4& qw0 = q.qw0; float4& qw1 = q.qw1; uint4& qr = q.qr; uint4& qk = q.qk; uint4& qv = q.qv; uint4& qd = q.qd; uint4& qa = q.qa;
    int s_ = chunk * CH + pst;
    int tok_ = dir ? (seq0 + T - 1 - s_) : (seq0 + s_);
    size_t o_ = (size_t)tok_ * 512 + h * 64 + c8;
    qw0 = *(const float4*)(Wd + o_); qw1 = *(const float4*)(Wd + o_ + 4);
    qr = *(const uint4*)(R + o_); qk = *(const uint4*)(KK + o_); qv = *(const uint4*)(V + o_);
    qd = *(const uint4*)(KD + o_); qa = *(const uint4*)(KKA + o_);
  };
  auto commit = [&](const Pf& q) {
    const float4 qw0 = q.qw0, qw1 = q.qw1; const uint4 qr = q.qr, qk = q.qk, qv = q.qv, qd = q.qd, qa = q.qa;
    float* bp = buf + pst * 384 + c8;
    float t[8];
    *(float4*)bp = qw0; *(float4*)(bp + 4) = qw1;
    unpack8(qr, t); *(float4*)(bp + 64) = *(float4*)t; *(float4*)(bp + 68) = *(float4*)(t + 4);
    unpack8(qk, t); *(float4*)(bp + 128) = *(float4*)t; *(float4*)(bp + 132) = *(float4*)(t + 4);
    unpack8(qv, t); *(float4*)(bp + 192) = *(float4*)t; *(float4*)(bp + 196) = *(float4*)(t + 4);
    unpack8(qd, t); *(float4*)(bp + 256) = *(float4*)t; *(float4*)(bp + 260) = *(float4*)(t + 4);
    unpack8(qa, t); *(float4*)(bp + 320) = *(float4*)t; *(float4*)(bp + 324) = *(float4*)(t + 4);
    if (KPT == 4) {
      float rr[8];
      unpack8(qr, rr);
      float ar = 0.f;
#pragma unroll
      for (int i = 0; i < 8; ++i) ar += t[i] * rr[i];
      ar += dpp<0xB1>(ar); ar += dpp<0x4E>(ar); ar += dpp<0x141>(ar);
      if ((tid & 7) == 0) obuf[pst] = ar;
    }
  };
  auto compute = [&](int chunk) {
    if constexpr (KPT == 4) {
      typedef float f2 __attribute__((ext_vector_type(2)));
      f2 S01 = {S[0], S[1]}, S23 = {S[2], S[3]};
      float4 w4 = *(const float4*)(buf + ks), r4 = *(const float4*)(buf + 64 + ks), k4 = *(const float4*)(buf + 128 + ks),
             d4 = *(const float4*)(buf + 256 + ks), a4 = *(const float4*)(buf + 320 + ks);
      float vr = buf[192 + row], ar = obuf[0];
      float myo = 0.f;
#pragma unroll 1
      for (int sb = 0; sb < CH; sb += 16) {
#pragma unroll
        for (int si = 0; si < 16; ++si) {
          const int s = sb + si;
          float4 nw = w4, nr = r4, nk = k4, nd = d4, na = a4;
          float nv = vr, nar = ar;
          if (s + 1 < CH) {
            const float* bp = buf + (s + 1) * 384;
            nw = *(const float4*)(bp + ks); nr = *(const float4*)(bp + 64 + ks); nk = *(const float4*)(bp + 128 + ks);
            nd = *(const float4*)(bp + 256 + ks); na = *(const float4*)(bp + 320 + ks);
            nv = bp[192 + row]; nar = obuf[s + 1];
          }
          const f2 w01 = {w4.x, w4.y}, w23 = {w4.z, w4.w}, k01 = {k4.x, k4.y}, k23 = {k4.z, k4.w};
          const f2 d01 = {d4.x, d4.y}, d23 = {d4.z, d4.w}, a01 = {a4.x, a4.y}, a23 = {a4.z, a4.w};
          const f2 r01 = {r4.x, r4.y}, r23 = {r4.z, r4.w};
          const f2 m = S01 * k01 + S23 * k23;
          const f2 pre01 = S01 * w01 + d01 * vr, pre23 = S23 * w23 + d23 * vr;
          const f2 pq = pre01 * r01 + pre23 * r23;
          float x = m.x + m.y, y = pq.x + pq.y;
          x += dpp<0xB1>(x); y += dpp<0xB1>(y);
          x += dpp<0x4E>(x); y += dpp<0x4E>(y);
          x += dpp<0x141>(x); y += dpp<0x141>(y);
          x += dpp<0x140>(x); y += dpp<0x140>(y);
          S01 = pre01 - a01 * x;
          S23 = pre23 - a23 * x;
          const float o = y - x * ar;
          myo = (si == lir) ? o : myo;
          w4 = nw; r4 = nr; k4 = nk; d4 = nd; a4 = na; vr = nv; ar = nar;
        }
        {
          int st = chunk * CH + sb + lir;
          int tok = dir ? (seq0 + T - 1 - st) : (seq0 + st);
          O[(size_t)tok * 512 + h * 64 + row] = myo;
        }
      }
      S[0] = S01.x; S[1] = S01.y; S[2] = S23.x; S[3] = S23.y;
      return;
    } else {
      float myo = 0.f;
#pragma unroll 1
      for (int sb = 0; sb < CH; sb += 4)
#pragma unroll
        for (int si = 0; si < 4; ++si) {
          const int s = sb + si;
          const float* bp = buf + s * 384;
          float wv[KPT], rv[KPT], kkv[KPT], kdv[KPT], kav[KPT];
#pragma unroll
          for (int i = 0; i < KPT; i += 4) {
            *(float4*)(wv + i) = *(const float4*)(bp + ks + i);
            *(float4*)(rv + i) = *(const float4*)(bp + 64 + ks + i);
            *(float4*)(kkv + i) = *(const float4*)(bp + 128 + ks + i);
            *(float4*)(kdv + i) = *(const float4*)(bp + 256 + ks + i);
            *(float4*)(kav + i) = *(const float4*)(bp + 320 + ks + i);
          }
          const float vr = bp[192 + row];
          float sk = 0.f;
#pragma unroll
          for (int i = 0; i < KPT; ++i) sk += S[i] * kkv[i];
          sk = quad_sum(sk);
          float o = 0.f;
#pragma unroll
          for (int i = 0; i < KPT; ++i) {
            S[i] = S[i] * wv[i] - sk * kav[i] + vr * kdv[i];
            o += S[i] * rv[i];
          }
          o = quad_sum(o);
          myo = (si == lir) ? o : myo;
          if (si == 3) {
            int st = chunk * CH + sb + lir;
            int tok = dir ? (seq0 + T - 1 - st) : (seq0 + st);
            O[(size_t)tok * 512 + h * 64 + row] = myo;
          }
        }
    }
  };
  if (KPT == 4) __builtin_amdgcn_s_setprio(3);
  Pf qA;
  issue(qA, 0);
  if constexpr (KPT == 4) {
    Pf qB;
    issue(qB, 1);
    for (int c0 = 0; c0 < nch; c0 += 2) {
      asm volatile("s_waitcnt lgkmcnt(0)\n\ts_barrier" ::: "memory");
      commit(qA);
      asm volatile("s_waitcnt lgkmcnt(0)\n\ts_barrier" ::: "memory");
      if (c0 + 2 < nch) issue(qA, c0 + 2);
      compute(c0);
      asm volatile("s_waitcnt lgkmcnt(0)\n\ts_barrier" ::: "memory");
      commit(qB);
      asm volatile("s_waitcnt lgkmcnt(0)\n\ts_barrier" ::: "memory");
      if (c0 + 3 < nch) issue(qB, c0 + 3);
      compute(c0 + 1);
    }
  } else {
    for (int c0 = 0; c0 < nch; ++c0) {
      asm volatile("s_waitcnt lgkmcnt(0)\n\ts_barrier" ::: "memory");
      commit(qA);
      asm volatile("s_waitcnt lgkmcnt(0)\n\ts_barrier" ::: "memory");
      if (c0 + 1 < nch) issue(qA, c0 + 1);
      compute(c0);
    }
  }
  if (KPT == 4) __builtin_amdgcn_s_setprio(0);
  if (!lat) {
    float* so = (float*)p.out + OUT_SRW + ((((size_t)(b * 2 + l) * 2 + dir) * 8 + h) * 64 + row) * 64 + ks;
#pragma unroll
    for (int i = 0; i < KPT; ++i) so[i] = S[i];
  }
}

DEVI void attn_item(const Params& p, int l, int it, unsigned char* sm) {
  const int tid = TIDX, lane = tid & 63, w = tid >> 6, fr = lane & 15, fq = lane >> 4;
  u16* Ks = (u16*)sm;
  u16* VT = (u16*)(sm + 9216);
  float* rpbs = (float*)(sm + 18432);
  const u16* Z = (const u16*)(p.ws + OFF_Z);
  const bool lat = it < 512;
  int b, h, r = 0, seqbase, qtok0;
  if (lat) { b = it >> 8; h = (it >> 5) & 7; r = it & 31; seqbase = 4096 + b * 2048; qtok0 = seqbase + r * 64; }
  else { int j = it - 512; b = j >> 5; h = (j >> 2) & 7; int qb = j & 3; seqbase = b * 256; qtok0 = seqbase + qb * 64; }
  bf16x8 qf[2];
#pragma unroll
  for (int ks = 0; ks < 2; ++ks) qf[ks] = *(const bf16x8*)(Z + (size_t)(qtok0 + w * 16 + fr) * PIN + h * 64 + ks * 32 + fq * 8);
  if (lat)
    for (int i = tid; i < 465; i += 256) rpbs[i] = p.in[11][(size_t)(l * 8 + h) * 465 + i];
  float m_run = -3e38f, l_run = 0.f;
  f32x4 o[4];
#pragma unroll
  for (int d = 0; d < 4; ++d) o[d] = f32x4{0.f, 0.f, 0.f, 0.f};
  const int ntiles = lat ? 16 : 4;
  const int row_start = lat ? clampi(r - 4, 0, 24) : 0;
  const int cbs = lat ? clampi(w * 16 - 8, 0, 32) : 0;
  for (int ti = 0; ti < ntiles; ++ti) {
    __syncthreads();
    const bool ctxtile = lat && ti < 8;
    if (ctxtile) {
      const float* kc = p.in[2] + ((((size_t)b * 2 + l) * 8 + h) * 512 + ti * 64) * 64;
      const float* vc = p.in[3] + ((((size_t)b * 2 + l) * 8 + h) * 512 + ti * 64) * 64;
      {
        const int key = tid >> 2, dp = (tid & 3) * 16;
        float t[16];
#pragma unroll
        for (int c = 0; c < 4; ++c) *(float4*)(t + c * 4) = *(const float4*)(kc + key * 64 + dp + c * 4);
        *(uint4*)(Ks + key * 72 + dp) = pack8(t);
        *(uint4*)(Ks + key * 72 + dp + 8) = pack8(t + 8);
      }
      {
        const int key = tid & 63, dp = (tid >> 6) * 16;
        float t[16];
#pragma unroll
        for (int c = 0; c < 4; ++c) *(float4*)(t + c * 4) = *(const float4*)(vc + key * 64 + dp + c * 4);
#pragma unroll
        for (int i = 0; i < 16; ++i) VT[(dp + i) * 72 + key] = f2bf(t[i]);
      }
    } else {
      const int trow = lat ? (row_start + ti - 8) : ti;
      const u16* zr = Z + (size_t)(seqbase + trow * 64) * PIN;
      {
        const int key = tid >> 2, dp = (tid & 3) * 16;
        const u16* src = zr + (size_t)key * PIN + 512 + h * 64 + dp;
        *(uint4*)(Ks + key * 72 + dp) = *(const uint4*)src;
        *(uint4*)(Ks + key * 72 + dp + 8) = *(const uint4*)(src + 8);
      }
      {
        const int key = tid & 63, dp = (tid >> 6) * 16;
        const u16* src = zr + (size_t)key * PIN + 1024 + h * 64 + dp;
        uint4 r0 = *(const uint4*)src, r1 = *(const uint4*)(src + 8);
        const u16* a0 = (const u16*)&r0;
        const u16* a1 = (const u16*)&r1;
#pragma unroll
        for (int i = 0; i < 8; ++i) { VT[(dp + i) * 72 + key] = a0[i]; VT[(dp + 8 + i) * 72 + key] = a1[i]; }
      }
    }
    __syncthreads();
    const bool win = lat && !ctxtile;
    const int nsteps = win ? 1 : 2;
    for (int st = 0; st < nsteps; ++st) {
      const int ko = win ? cbs : st * 32;
      f32x4 s0 = f32x4{0.f, 0.f, 0.f, 0.f}, s1 = s0;
#pragma unroll
      for (int ks = 0; ks < 2; ++ks) {
        bf16x8 a0 = *(const bf16x8*)(Ks + (ko + fr) * 72 + ks * 32 + fq * 8);
        bf16x8 a1 = *(const bf16x8*)(Ks + (ko + 16 + fr) * 72 + ks * 32 + fq * 8);
        s0 = mfma16(a0, qf[ks], s0);
        s1 = mfma16(a1, qf[ks], s1);
      }
      float sv[8];
#pragma unroll
      for (int j = 0; j < 4; ++j) { sv[j] = s0[j] * 0.125f; sv[4 + j] = s1[j] * 0.125f; }
      if (win) {
        const int qc = w * 16 + fr;
        const int dr = (row_start + ti - 8) - r + 7;
        const int qs = clampi(qc - 8, 0, 48);
#pragma unroll
        for (int e = 0; e < 8; ++e) {
          int kc_ = ko + ((e < 4) ? (fq * 4 + e) : (16 + fq * 4 + e - 4));
          int dc = clampi(kc_ - qc, -15, 15) + 15;
          int rel = kc_ - qs;
          sv[e] = (rel >= 0 && rel < 16) ? (sv[e] + rpbs[dr * 31 + dc]) : -1e30f;
        }
      }
      float mx = sv[0];
#pragma unroll
      for (int e = 1; e < 8; ++e) mx = fmaxf(mx, sv[e]);
      mx = fmaxf(mx, __shfl_xor(mx, 16));
      mx = fmaxf(mx, __shfl_xor(mx, 32));
      const float m_new = fmaxf(m_run, mx);
      const float alpha = __expf(m_run - m_new);
      float pe[8], ps = 0.f;
#pragma unroll
      for (int e = 0; e < 8; ++e) { pe[e] = __expf(sv[e] - m_new); ps += pe[e]; }
      l_run = l_run * alpha + ps;
      m_run = m_new;
#pragma unroll
      for (int d = 0; d < 4; ++d) o[d] *= alpha;
      uint4 pk = pack8(pe);
      bf16x8 pb = __builtin_bit_cast(bf16x8, pk);
#pragma unroll
      for (int d = 0; d < 4; ++d) {
        uint2 lo = *(const uint2*)(VT + (d * 16 + fr) * 72 + ko + fq * 4);
        uint2 hi = *(const uint2*)(VT + (d * 16 + fr) * 72 + ko + 16 + fq * 4);
        uint4 vv; vv.x = lo.x; vv.y = lo.y; vv.z = hi.x; vv.w = hi.y;
        o[d] = mfma16(__builtin_bit_cast(bf16x8, vv), pb, o[d]);
      }
    }
  }
  float lt = l_run + __shfl_xor(l_run, 16);
  lt += __shfl_xor(lt, 32);
  const float inv = 1.f / lt;
  u16* ONA = (u16*)(p.ws + OFF_ONA);
  const int tok = qtok0 + w * 16 + fr;
#pragma unroll
  for (int d = 0; d < 4; ++d) {
    uint2 ov; ov.x = cvtpk(o[d][0] * inv, o[d][1] * inv); ov.y = cvtpk(o[d][2] * inv, o[d][3] * inv);
    *(uint2*)(ONA + (size_t)tok * 512 + h * 64 + d * 16 + fq * 4) = ov;
  }
}

constexpr int MIX_NSCAN_LAT = 128, MIX_NSCAN_CTX = 256, MIX_NATT = 1024, MIX_NRET = 512;
constexpr int MIX_TOTAL = MIX_NSCAN_CTX + MIX_NATT + MIX_NRET;
#ifndef ONLYP
#define ONLYP -1
#endif
#define PH_ON(x) (ONLYP < 0 || ONLYP == (x))
DEVI void mix_scan_item(const Params& p, int l, int it, unsigned char* sm) {
  int ch = it >> 2, rq = it & 3;
  if (PH_ON(12)) scan_run<4>(p, l, true, ch >> 4, ch & 7, (ch >> 3) & 1, rq * 16, sm);
}
DEVI void mix_item(const Params& p, int l, int it, unsigned char* sm) {
  if (it < 256) { if (PH_ON(15)) ret3_item(p, l, it, sm); return; }
  it -= 256;
  if (it < MIX_NSCAN_CTX) { if (PH_ON(13)) scan_run<16>(p, l, false, it >> 4, it & 7, (it >> 3) & 1, 0, sm); return; }
  it -= MIX_NSCAN_CTX;
  if (it < MIX_NATT) { if (PH_ON(14)) attn_item(p, l, it, sm); return; }
  it -= MIX_NATT;
  if (PH_ON(15)) ret3_item(p, l, 256 + it, sm);
}

DEVI void fin_item(const Params& p, int l, int it0) {
  const int tid = TIDX;
#pragma unroll 2
  for (int sub = 0; sub < 8; ++sub) {
  const int it = it0 * 8 + sub;
  const int tok = it * 2 + (tid >> 7), c4 = (tid & 127) * 4;
  const size_t o = (size_t)tok * 512 + c4;
  float4 a = *(const float4*)((const float*)(p.ws + OFF_OF) + o);
  float4 b = *(const float4*)((const float*)(p.ws + OFF_OF) + (size_t)NTOK * 512 + o);
  float x[4] = {a.x + b.x, a.y + b.y, a.z + b.z, a.w + b.w};
  float mu = row16_sum(x[0] + x[1] + x[2] + x[3]) * (1.f / 64.f);
  float q = 0.f;
#pragma unroll
  for (int i = 0; i < 4; ++i) { float d = x[i] - mu; q += d * d; }
  float rs = rsqrtf(row16_sum(q) * (1.f / 64.f) + 64e-5f);
  float4 gw = *(const float4*)(p.in[24] + l * 512 + c4), gb = *(const float4*)(p.in[25] + l * 512 + c4);
  float gwv[4] = {gw.x, gw.y, gw.z, gw.w}, gbv[4] = {gb.x, gb.y, gb.z, gb.w};
  float bon[4], g[4];
  unpack4(*(const uint2*)((const u16*)(p.ws + OFF_RWBON) + o), bon);
  unpack4(*(const uint2*)((const u16*)(p.ws + OFF_RWG) + o), g);
  float y[4];
#pragma unroll
  for (int i = 0; i < 4; ++i) y[i] = ((x[i] - mu) * rs * gwv[i] + gbv[i] + bon[i]) * g[i];
  uint2 ov; ov.x = cvtpk(y[0], y[1]); ov.y = cvtpk(y[2], y[3]);
  *(uint2*)((u16*)(p.ws + OFF_ORW) + o) = ov;
  }
}

DEVI void ln2_item(const Params& p, int l, int it0) {
  const int lane = TIDX & 63, w = TIDX >> 6;
#pragma unroll 1
  for (int sub = 0; sub < 4; ++sub) {
  const int it = it0 * 4 + sub;
  const int tok = it * 4 + w;
  const float* y = (const float*)(p.ws + OFF_Y) + (size_t)tok * 1024;
  const float* mod = (const float*)(p.ws + OFF_MOD) + ((size_t)l * 3 + modrow(tok)) * 6144;
  float v[16];
  float s = 0.f;
#pragma unroll
  for (int i = 0; i < 4; ++i) { *(float4*)(v + i * 4) = *(const float4*)(y + lane * 4 + 256 * i); }
#pragma unroll
  for (int i = 0; i < 16; ++i) s += v[i];
  float mu = wave_sum(s) * (1.f / 1024.f);
  float q = 0.f;
#pragma unroll
  for (int i = 0; i < 16; ++i) { float d = v[i] - mu; q += d * d; }
  float rs = rsqrtf(wave_sum(q) * (1.f / 1024.f) + 1e-5f);
  float* X1 = (float*)(p.ws + OFF_X1) + (size_t)tok * 1024;
  s = 0.f;
#pragma unroll
  for (int i = 0; i < 4; ++i) {
    int c = lane * 4 + 256 * i;
    float4 g = *(const float4*)(p.in[28] + l * 1024 + c), bb = *(const float4*)(p.in[29] + l * 1024 + c);
    v[i * 4 + 0] = (v[i * 4 + 0] - mu) * rs * g.x + bb.x;
    v[i * 4 + 1] = (v[i * 4 + 1] - mu) * rs * g.y + bb.y;
    v[i * 4 + 2] = (v[i * 4 + 2] - mu) * rs * g.z + bb.z;
    v[i * 4 + 3] = (v[i * 4 + 3] - mu) * rs * g.w + bb.w;
    *(float4*)(X1 + c) = *(float4*)(v + i * 4);
    s += v[i * 4] + v[i * 4 + 1] + v[i * 4 + 2] + v[i * 4 + 3];
  }
  mu = wave_sum(s) * (1.f / 1024.f);
  q = 0.f;
#pragma unroll
  for (int i = 0; i < 16; ++i) { float d = v[i] - mu; q += d * d; }
  rs = rsqrtf(wave_sum(q) * (1.f / 1024.f) + 1e-5f);
  u16* H2 = (u16*)(p.ws + OFF_H2) + (size_t)tok * 1024;
#pragma unroll
  for (int i = 0; i < 4; ++i) {
    int c = lane * 4 + 256 * i;
    float4 sh = *(const float4*)(mod + 3072 + c), sc = *(const float4*)(mod + 4096 + c);
    uint2 o;
    o.x = cvtpk((v[i * 4] - mu) * rs * (1.f + sc.x) + sh.x, (v[i * 4 + 1] - mu) * rs * (1.f + sc.y) + sh.y);
    o.y = cvtpk((v[i * 4 + 2] - mu) * rs * (1.f + sc.z) + sh.z, (v[i * 4 + 3] - mu) * rs * (1.f + sc.w) + sh.w);
    *(uint2*)(H2 + c) = o;
  }
  }
}

DEVI int f2ord(float f) { int i = __float_as_int(f); return i ^ ((i >> 31) & 0x7fffffff); }
DEVI float ord2f(int i) { return __int_as_float(i ^ ((i >> 31) & 0x7fffffff)); }
DEVI void insert16(int (&t)[16], int x) {
#pragma unroll
  for (int i = 0; i < 16; ++i) { int hi = max(t[i], x); x = min(t[i], x); t[i] = hi; }
}
DEVI void route_item(const Params& p, int l, int it, unsigned char* sm) {
  const int tid = TIDX, lane = tid & 63, w = tid >> 6;
  const int g = w >> 1, pp = w & 1;
  const int tb = it >> 3, h = it & 7;
  const int tok = tb * 128 + g * 64 + lane;
  float* kl = (float*)sm;
  const float* Q = (const float*)(p.ws + OFF_Q) + (size_t)tok * 1024 + h * 128 + pp * 64;
  float q[64];
#pragma unroll
  for (int i = 0; i < 16; ++i) *(float4*)(q + i * 4) = *(const float4*)(Q + i * 4);
  int T[16];
#pragma unroll
  for (int i = 0; i < 16; ++i) T[i] = (int)0x80000000;
  const float* keys = p.in[33] + (size_t)((l * 8 + h) * 2) * 8192;
  for (int half = 0; half < 2; ++half) {
    __syncthreads();
#pragma unroll
    for (int i = 0; i < 8; ++i) {
      int e = (i * 256 + tid) * 4;
      int ps = e >> 12, r = e & 4095;
      *(float4*)(kl + e) = *(const float4*)(keys + (size_t)ps * 8192 + half * 4096 + r);
    }
    __syncthreads();
    const float* kb = kl + pp * 4096;
#pragma unroll 4
    for (int k = 0; k < 64; ++k) {
      const float* kp = kb + k * 64;
      float s0 = 0.f, s1 = 0.f, s2 = 0.f, s3 = 0.f;
#pragma unroll
      for (int d = 0; d < 64; d += 4) {
        float4 kv = *(const float4*)(kp + d);
        s0 += q[d] * kv.x; s1 += q[d + 1] * kv.y; s2 += q[d + 2] * kv.z; s3 += q[d + 3] * kv.w;
      }
      float sc = (s0 + s1) + (s2 + s3);
      int bits = (f2ord(sc) & ~127) | (127 - (half * 64 + k));
      insert16(T, bits);
    }
  }
  __syncthreads();
  int* xb = (int*)sm;
  if (pp == 1) {
#pragma unroll
    for (int i = 0; i < 16; ++i) xb[(g * 16 + i) * 64 + lane] = T[i];
  }
  __syncthreads();
  if (pp == 0) {
    int T1[16];
#pragma unroll
    for (int i = 0; i < 16; ++i) T1[i] = xb[(g * 16 + i) * 64 + lane];
    int F[16];
#pragma unroll
    for (int i = 0; i < 16; ++i) F[i] = (int)0x80000000;
#pragma unroll
    for (int i = 0; i < 16; ++i) {
#pragma unroll
      for (int j = 0; j < 16; ++j) {
        if ((i + 1) * (j + 1) <= 16) {
          float c = ord2f(T[i] & ~127) + ord2f(T1[j] & ~127);
          int bits = (f2ord(c) & ~255) | (255 - (i * 16 + j));
          insert16(F, bits);
        }
      }
    }
    float fs[16], den = 0.f;
    const float f0 = ord2f(F[0] & ~255);
#pragma unroll
    for (int i = 0; i < 16; ++i) { fs[i] = __expf(ord2f(F[i] & ~255) - f0); den += fs[i]; }
    const float inv = 1.f / den;
    int* EIDX = (int*)(p.ws + OFF_EIDX) + (size_t)tok * 128 + h * 16;
    float* GATE = (float*)(p.ws + OFF_GATE) + (size_t)tok * 128 + h * 16;
    int eo[16]; float go[16];
#pragma unroll
    for (int i = 0; i < 16; ++i) {
      int pos = 255 - (F[i] & 255);
      int i0 = pos >> 4, j0 = pos & 15;
      int k0 = 0, k1 = 0;
#pragma unroll
      for (int c = 0; c < 16; ++c) {
        int a0 = 127 - (T[c] & 127), a1 = 127 - (T1[c] & 127);
        k0 = (i0 == c) ? a0 : k0;
        k1 = (j0 == c) ? a1 : k1;
      }
      eo[i] = k0 * 128 + k1;
      go[i] = fs[i] * inv;
    }
#pragma unroll
    for (int i = 0; i < 16; i += 4) {
      *(int4*)(EIDX + i) = make_int4(eo[i], eo[i + 1], eo[i + 2], eo[i + 3]);
      *(float4*)(GATE + i) = make_float4(go[i], go[i + 1], go[i + 2], go[i + 3]);
    }
  }
}

DEVI void fp8x16_to_f32(int4 r, float* f) {
  const int w[4] = {r.x, r.y, r.z, r.w};
#pragma unroll
  for (int i = 0; i < 4; ++i) {
    f32x2_ lo = __builtin_amdgcn_cvt_pk_f32_fp8(w[i], false);
    f32x2_ hi = __builtin_amdgcn_cvt_pk_f32_fp8(w[i], true);
    f[i * 4] = lo.x; f[i * 4 + 1] = lo.y; f[i * 4 + 2] = hi.x; f[i * 4 + 3] = hi.y;
  }
}
DEVI void expert_item(const Params& p, int l, int it) {
  const int lane = TIDX & 63;
  const int w = __builtin_amdgcn_readfirstlane(TIDX >> 6);
  const int tok = it * 4 + w;
  const u16* H2 = (const u16*)(p.ws + OFF_H2) + (size_t)tok * 1024;
  float hv[16];
  unpack8(*(const uint4*)(H2 + lane * 16), hv);
  unpack8(*(const uint4*)(H2 + lane * 16 + 8), hv + 8);
  const int* EIDX = (const int*)(p.ws + OFF_EIDX) + (size_t)tok * 128;
  const float* GATE = (const float*)(p.ws + OFF_GATE) + (size_t)tok * 128;
  const unsigned char* UB = (const unsigned char*)(p.ws + OFF_UB) + (size_t)l * UV_LSTRIDE;
  const unsigned char* VB = (const unsigned char*)(p.ws + OFF_VB) + (size_t)l * UV_LSTRIDE;
  const float* USC = (const float*)(p.ws + OFF_SC) + (0 * 2 + l) * 16384;
  const float* VSC = (const float*)(p.ws + OFF_SC) + (1 * 2 + l) * 16384;
  float f[16];
#pragma unroll
  for (int i = 0; i < 16; ++i) f[i] = 0.f;
  const int ei0 = EIDX[lane], ei1 = EIDX[64 + lane];
  const float ga0 = GATE[lane] * VSC[ei0], ga1 = GATE[64 + lane] * VSC[ei1];
  const float us0 = USC[ei0], us1 = USC[ei1];
  float dl0 = 0.f, dl1 = 0.f;
  int4 ba[8], bb[8];
#define ROW_LOAD(BUF, BASE, G)                                                                       \
  {                                                                                                  \
    const int src_ = ((G) < 8) ? ei0 : ei1;                                                          \
    _Pragma("unroll") for (int j = 0; j < 8; ++j) {                                                  \
      const int idx = __builtin_amdgcn_readlane(src_, (((G) & 7) << 3) + j);                         \
      BUF[j] = *(const int4*)(BASE + (size_t)idx * 1024 + lane * 16);                                \
    }                                                                                                \
  }
#define U_COMP(BUF, G)                                                                               \
  {                                                                                                  \
    const bool lo_ = (G) < 8;                                                                        \
    _Pragma("unroll") for (int j = 0; j < 8; ++j) {                                                  \
      const int ln_ = (((G) & 7) << 3) + j;                                                          \
      float uu[16];                                                                                  \
      fp8x16_to_f32(BUF[j], uu);                                                                     \
      float d0 = 0.f, d1 = 0.f;                                                                      \
      _Pragma("unroll") for (int i = 0; i < 16; i += 2) { d0 += uu[i] * hv[i]; d1 += uu[i + 1] * hv[i + 1]; } \
      float dd = row16_sum(d0 + d1);                                                                 \
      const float r0 = __int_as_float(__builtin_amdgcn_readlane(__float_as_int(dd), 0));            \
      const float r1 = __int_as_float(__builtin_amdgcn_readlane(__float_as_int(dd), 16));           \
      const float r2 = __int_as_float(__builtin_amdgcn_readlane(__float_as_int(dd), 32));           \
      const float r3 = __int_as_float(__builtin_amdgcn_readlane(__float_as_int(dd), 48));           \
      const float d = (r0 + r1) + (r2 + r3);                                                         \
      dl0 = (lo_ && lane == ln_) ? d : dl0;                                                          \
      dl1 = (!lo_ && lane == ln_) ? d : dl1;                                                         \
    }                                                                                                \
  }
#define V_COMP(BUF, G)                                                                               \
  {                                                                                                  \
    const float asrc_ = ((G) < 8) ? act0 : act1;                                                     \
    _Pragma("unroll") for (int j = 0; j < 8; ++j) {                                                  \
      const int ln_ = (((G) & 7) << 3) + j;                                                          \
      const float act = __int_as_float(__builtin_amdgcn_readlane(__float_as_int(asrc_), ln_));      \
      float vv[16];                                                                                  \
      fp8x16_to_f32(BUF[j], vv);                                                                     \
      _Pragma("unroll") for (int i = 0; i < 16; ++i) f[i] += act * vv[i];                            \
    }                                                                                                \
  }
  ROW_LOAD(ba, UB, 0);
#pragma unroll 1
  for (int g = 0; g < 16; g += 2) {
    ROW_LOAD(bb, UB, g + 1);
    U_COMP(ba, g);
    if (g + 2 < 16) { ROW_LOAD(ba, UB, g + 2); } else { ROW_LOAD(ba, VB, 0); }
    U_COMP(bb, g + 1);
  }
  const float x0 = dl0 * us0, x1 = dl1 * us1;
  const float act0 = 0.5f * x0 * (1.f + erff(x0 * 0.70710678118654752f)) * ga0;
  const float act1 = 0.5f * x1 * (1.f + erff(x1 * 0.70710678118654752f)) * ga1;
#pragma unroll 1
  for (int g = 0; g < 16; g += 2) {
    ROW_LOAD(bb, VB, g + 1);
    V_COMP(ba, g);
    if (g + 2 < 16) ROW_LOAD(ba, VB, g + 2);
    V_COMP(bb, g + 1);
  }
#undef ROW_LOAD
#undef U_COMP
#undef V_COMP
  const float* X1 = (const float*)(p.ws + OFF_X1) + (size_t)tok * 1024 + lane * 16;
  const float* mod = (const float*)(p.ws + OFF_MOD) + ((size_t)l * 3 + modrow(tok)) * 6144 + lane * 16;
  float y[16];
  float s = 0.f;
#pragma unroll
  for (int c = 0; c < 4; ++c) {
    float4 x = *(const float4*)(X1 + c * 4), gt = *(const float4*)(mod + 5120 + c * 4);
    int o = c * 4;
    y[o] = ALPHA * x.x + gt.x * f[o]; y[o + 1] = ALPHA * x.y + gt.y * f[o + 1];
    y[o + 2] = ALPHA * x.z + gt.z * f[o + 2]; y[o + 3] = ALPHA * x.w + gt.w * f[o + 3];
    s += y[o] + y[o + 1] + y[o + 2] + y[o + 3];
  }
  float mu = wave_sum(s) * (1.f / 1024.f);
  float q = 0.f;
#pragma unroll
  for (int i = 0; i < 16; ++i) { float d = y[i] - mu; q += d * d; }
  float rs = rsqrtf(wave_sum(q) * (1.f / 1024.f) + 1e-5f);
  float* xo = ((l == 1) ? ((float*)p.out + OUT_Y + (size_t)tok * 1024) : ((float*)(p.ws + OFF_X) + (size_t)tok * 1024)) + lane * 16;
  s = 0.f;
#pragma unroll
  for (int c = 0; c < 4; ++c) {
    int o = c * 4;
    float4 g = *(const float4*)(p.in[30] + l * 1024 + lane * 16 + o), bb = *(const float4*)(p.in[31] + l * 1024 + lane * 16 + o);
    y[o] = (y[o] - mu) * rs * g.x + bb.x; y[o + 1] = (y[o + 1] - mu) * rs * g.y + bb.y;
    y[o + 2] = (y[o + 2] - mu) * rs * g.z + bb.z; y[o + 3] = (y[o + 3] - mu) * rs * g.w + bb.w;
    *(float4*)(xo + o) = make_float4(y[o], y[o + 1], y[o + 2], y[o + 3]);
    s += y[o] + y[o + 1] + y[o + 2] + y[o + 3];
  }
  if (l == 0) {
    const float* mod1 = (const float*)(p.ws + OFF_MOD) + ((size_t)3 + modrow(tok)) * 6144 + lane * 16;
    mu = wave_sum(s) * (1.f / 1024.f);
    q = 0.f;
#pragma unroll
    for (int i = 0; i < 16; ++i) { float d = y[i] - mu; q += d * d; }
    rs = rsqrtf(wave_sum(q) * (1.f / 1024.f) + 1e-5f);
    u16* H = (u16*)(p.ws + OFF_H) + (size_t)tok * 1024 + lane * 16;
    float t[16];
#pragma unroll
    for (int c = 0; c < 4; ++c) {
      float4 sh = *(const float4*)(mod1 + c * 4), sc = *(const float4*)(mod1 + 1024 + c * 4);
      int o = c * 4;
      t[o] = (y[o] - mu) * rs * (1.f + sc.x) + sh.x; t[o + 1] = (y[o + 1] - mu) * rs * (1.f + sc.y) + sh.y;
      t[o + 2] = (y[o + 2] - mu) * rs * (1.f + sc.z) + sh.z; t[o + 3] = (y[o + 3] - mu) * rs * (1.f + sc.w) + sh.w;
    }
    *(uint4*)(H) = pack8(t);
    *(uint4*)(H + 8) = pack8(t + 8);
  }
}

constexpr int NPHASES = 22;
DEVI int phase_total(int idx) {
  if (idx == 0) return P0_TOTAL;
  if (idx == 1) return 2048;
  const int l = (idx - 2) / 10, t = (idx - 2) % 10;
  switch (t) {
    case 0: return 0;
    case 1: return 512 + 512;
    case 2: return MIX_TOTAL + (l == 0 ? (P0_NT + P0_NUV) : 0);
    case 3: return 512;
    case 4: return 0;
    case 5: return 0;
    case 6: return 512;
    case 7: return 0;
    case 8: return 512;
    default: return 2048;
  }
}
DEVI int phase_xcd_total(int idx) {
  if (idx < 2) return 0;
  const int t = (idx - 2) % 10;
  if (t == 0) return 504;
  if (t == 4 || t == 5 || t == 7) return 64;
  return 0;
}
DEVI void phase_item_x(const Params& p, int idx, int xcd, int q, unsigned char* sm) {
  const int l = (idx - 2) / 10, t = (idx - 2) % 10;
  const int it = (q >> 3) * 64 + xcd * 8 + (q & 7);
  if (t == 0) { if (PH_ON(2)) g1_item(p, l, it, sm); }
  else if (t == 4) { if (PH_ON(6)) g2_item(p, l, it, sm); }
  else if (t == 5) { if (PH_ON(7)) g3_item(p, l, it, sm); }
  else { if (PH_ON(9)) g4_item(p, l, it, sm); }
}
DEVI void phase_item(const Params& p, int idx, int it, unsigned char* sm) {
  if (idx == 0) { if (PH_ON(0)) phase0_item(p, it, sm); return; }
  if (idx == 1) { if (PH_ON(1)) ln1_item(p, it); return; }
  const int l = (idx - 2) / 10, t = (idx - 2) % 10;
  switch (t) {
    case 0: break;
    case 1: if (it < 512) { if (PH_ON(3)) rwprep_item(p, l, it); } else { if (PH_ON(4)) ret1_item(p, l, it - 512, sm); } break;
    case 2:
      if (it < MIX_TOTAL) mix_item(p, l, it, sm);
      else if (it < MIX_TOTAL + P0_NT) p0_tiles(p, 1, it - MIX_TOTAL, sm);
      else convert_uv_item(p, 1, it - MIX_TOTAL - P0_NT);
      break;
    case 3: if (PH_ON(5)) fin_item(p, l, it); break;
    case 4: break;
    case 5: break;
    case 6: if (PH_ON(8)) ln2_item(p, l, it); break;
    case 7: break;
    case 8: if (PH_ON(10)) route_item(p, l, it, sm); break;
    default: if (PH_ON(11)) expert_item(p, l, it); break;
  }
}

#define XB_TMO      128
#define XB_XCNT(j)  (256  + 64 * (j))
#define XB_XSUB(j)  (1280 + 64 * (j))
#define XB_XGEN(j)  (2304 + 64 * (j))
#define XB_TOP      3328
#define XB_TOPGEN   3392
#define XCD_BAR_WORDS 3456
#define XB_SPIN_CAP (1u << 18)
#define LAS __attribute__((address_space(3)))
DEVI unsigned xb_ld(unsigned* p) { return __hip_atomic_load(p, __ATOMIC_RELAXED, __HIP_MEMORY_SCOPE_AGENT); }
DEVI unsigned xb_add(unsigned* p, unsigned v) { return __hip_atomic_fetch_add(p, v, __ATOMIC_RELAXED, __HIP_MEMORY_SCOPE_AGENT); }
DEVI unsigned xb_xcc_id() { return (unsigned)__builtin_amdgcn_s_getreg((3 << 11) | 20) & 0xFu; }
#define XB_SPIN(cond, bar) do { unsigned _sp = 0; while (cond) { __builtin_amdgcn_s_sleep(1); \
    if ((++_sp & 255u) == 0u) { if (xb_ld(&(bar)[XB_TMO])) break; if (_sp > XB_SPIN_CAP) { atomicAdd(&(bar)[XB_TMO], 1u); break; } } } } while (0)
struct XcdBarrier { unsigned* bar; unsigned x; volatile LAS unsigned* st; };
DEVI XcdBarrier xcd_barrier_post(unsigned* bar, volatile LAS unsigned* st) {
  XcdBarrier b; b.bar = bar; b.x = xb_xcc_id(); b.st = st;
  if (threadIdx.x == 0) (void)xb_add(&bar[XB_XCNT(b.x)], 1u);
  return b;
}
DEVI void xcd_barrier_complete(unsigned* bar, unsigned x, unsigned& nloc, unsigned& nx) {
  const unsigned G = gridDim.x * gridDim.y * gridDim.z;
  unsigned sum, cnt, mine, sp = 0u;
  for (;;) {
    sum = 0u; cnt = 0u; mine = 0u;
#pragma unroll
    for (unsigned j = 0; j < 16; ++j) { const unsigned c = xb_ld(&bar[XB_XCNT(j)]); sum += c; cnt += (c > 0u) ? 1u : 0u; mine = (j == x) ? c : mine; }
    if (sum == G) break;
    __builtin_amdgcn_s_sleep(1);
    if ((++sp & 255u) == 0u) { if (xb_ld(&bar[XB_TMO])) break; if (sp > XB_SPIN_CAP) { atomicAdd(&bar[XB_TMO], 1u); break; } }
  }
  nloc = mine > 0u ? mine : 1u; nx = cnt > 0u ? cnt : 1u;
}
DEVI void xcd_barrier(const XcdBarrier& b) {
  asm volatile("s_waitcnt vmcnt(0)" ::: "memory");
  __syncthreads();
  if (threadIdx.x == 0) {
    unsigned* bar = b.bar;
    __builtin_amdgcn_s_waitcnt(0);
    unsigned nloc = b.st[0], nx = b.st[1];
    if (nloc == 0u) { xcd_barrier_complete(bar, b.x, nloc, nx); b.st[0] = nloc; b.st[1] = nx; }
    const unsigned old = xb_add(&bar[XB_XSUB(b.x)], 1u);
    const unsigned gen = old / nloc;
    if (old + 1u == (gen + 1u) * nloc) {
      __builtin_amdgcn_fence(__ATOMIC_RELEASE, "agent");
      asm volatile("s_waitcnt vmcnt(0)" ::: "memory");
      const unsigned og = xb_add(&bar[XB_TOP], 1u);
      const unsigned tg = og / nx;
      if (og + 1u == (tg + 1u) * nx) xb_add(&bar[XB_TOPGEN], 1u);
      else XB_SPIN(xb_ld(&bar[XB_TOPGEN]) == tg, bar);
      __builtin_amdgcn_fence(__ATOMIC_ACQUIRE, "agent");
      xb_add(&bar[XB_XGEN(b.x)], 1u);
      asm volatile("s_waitcnt vmcnt(0)" ::: "memory");
    } else {
      XB_SPIN(xb_ld(&bar[XB_XGEN(b.x)]) == gen, bar);
      __builtin_amdgcn_fence(__ATOMIC_ACQUIRE, "agent");
      asm volatile("s_waitcnt vmcnt(0)" ::: "memory");
    }
  }
  __syncthreads();
}

__global__ void __launch_bounds__(256, 2) mega_kernel(KArgs ka, int ph_lo, int ph_hi) {
  __shared__ __attribute__((aligned(16))) unsigned char sm[57344];
  __shared__ int s_item;
  __shared__ g_cf32* s_in[36];
  __shared__ __attribute__((aligned(16))) unsigned s_xb[4];
  cg::grid_group grid = cg::this_grid();
  if (threadIdx.x < 4) s_xb[threadIdx.x] = 0u;
  __shared__ int s_first;
  if (threadIdx.x == 0) {
    const unsigned hw = (unsigned)__builtin_amdgcn_s_getreg((31 << 11) | 4);
    const unsigned key = (xb_xcc_id() << 8) | ((hw >> 8) & 0xFFu);
    s_first = (atomicAdd((int*)(ka.ws + OFF_CUT) + key, 1) == 0) ? 1 : 0;
  }
  if (threadIdx.x < 36) {
    const float* const* kp = (const float* const*)__builtin_amdgcn_kernarg_segment_ptr();
    s_in[threadIdx.x] = (g_cf32*)kp[threadIdx.x];
  }
  __syncthreads();
  Params p;
  p.in.t = s_in; p.out = (g_f32*)ka.out; p.ws = (g_u8*)ka.ws;
  int* ctr = (int*)(p.ws + OFF_CTR);
  const XcdBarrier xb = xcd_barrier_post((unsigned*)(p.ws + OFF_BAR), (volatile LAS unsigned*)s_xb);
  for (int idx = ph_lo; idx < ph_hi; ++idx) {
    const int total = phase_total(idx);
#ifdef PROBE_T
    const int ptype = idx < 2 ? idx : 2 + (idx - 2) % 10;
    const int reps = (ptype == PROBE_T) ? 2 : 1;
#else
    const int reps = 1;
#endif
    for (int rep = 0; rep < reps; ++rep) {
      const bool is_mix = (idx >= 2) && ((idx - 2) % 10 == 2);
      auto scan_queue = [&]() {
        const int l_ = (idx - 2) / 10;
        while (true) {
          __syncthreads();
          if (TIDX == 0) s_item = atomicAdd(&ctr[960 + (rep * 2 + l_) * 8 + (blockIdx.x & 7)], 1);
          __syncthreads();
          const int it = s_item * 8 + (blockIdx.x & 7);
          if (it >= MIX_NSCAN_LAT) break;
          Params q = p;
          asm volatile("" : "+s"(q.ws));
          asm volatile("" : "+s"(q.out));
          asm volatile("" : "+s"(q.in.t));
          mix_scan_item(q, l_, it, sm);
        }
      };
      if (is_mix && s_first) scan_queue();
      const int nx = phase_xcd_total(idx);
      if (nx) {
        const int xcd = blockIdx.x & 7;
        while (true) {
          __syncthreads();
          if (TIDX == 0) s_item = atomicAdd(&ctr[64 + (idx + 32 * rep) * 8 + xcd], 1);
          __syncthreads();
          const int q_ = s_item;
          if (q_ >= nx) break;
          Params q = p;
          asm volatile("" : "+s"(q.ws));
          asm volatile("" : "+s"(q.out));
          asm volatile("" : "+s"(q.in.t));
          phase_item_x(q, idx, xcd, q_, sm);
        }
      }
      while (true) {
        __syncthreads();
        if (TIDX == 0) s_item = atomicAdd(&ctr[512 + (idx + 32 * rep) * 8 + (blockIdx.x & 7)], 1);
        __syncthreads();
        const int it = s_item * 8 + (blockIdx.x & 7);
        if (it >= total) break;
        Params q = p;
        asm volatile("" : "+s"(q.ws));
        asm volatile("" : "+s"(q.out));
        asm volatile("" : "+s"(q.in.t));
        phase_item(q, idx, it, sm);
      }
      if (is_mix) scan_queue();
      if (rep + 1 < reps) xcd_barrier(xb);
    }
    if (idx + 1 < ph_hi) {
      if (ph_lo < 0) grid.sync();
      xcd_barrier(xb);
    }
  }
}

#ifndef MULTI_LAUNCH
#define MULTI_LAUNCH 0
#endif

extern "C" void kernel_launch(void* const* d_in, const int* in_sizes, int n_in, void* d_out, int out_size, void* d_ws,
                              size_t ws_size, hipStream_t stream) {
  static int grid_blocks = 0;
  if (!grid_blocks) {
    int dev = 0, cus = 0, per_cu = 0;
    hipGetDevice(&dev);
    hipDeviceGetAttribute(&cus, hipDeviceAttributeMultiprocessorCount, dev);
    hipOccupancyMaxActiveBlocksPerMultiprocessor(&per_cu, mega_kernel, 256, 0);
    if (per_cu > 2) per_cu = 2;
    if (per_cu < 1) per_cu = 1;
    grid_blocks = cus * per_cu;
  }
  KArgs p{};
  for (int i = 0; i < 36; ++i) p.in[i] = (const float*)d_in[i];
  p.out = (float*)d_out;
  p.ws = (unsigned char*)d_ws;
  if (ws_size < OFF_END) { fprintf(stderr, "workspace too small: %zu < %zu\n", ws_size, (size_t)OFF_END); return; }
  hipMemsetAsync(d_ws, 0, 4096, stream);
  hipMemsetAsync((unsigned char*)d_ws + OFF_BAR, 0, 16384, stream);
  hipMemsetAsync((unsigned char*)d_ws + OFF_CUT, 0, 8192, stream);
#if MULTI_LAUNCH
  for (int ph = 0; ph < NPHASES; ++ph) {
    hipLaunchKernelGGL(mega_kernel, dim3(grid_blocks), dim3(256), 0, stream, p, ph, ph + 1);
  }
#else
  int lo = 0, hi = NPHASES;
  void* args[] = {&p, &lo, &hi};
  hipError_t e = hipLaunchCooperativeKernel((void*)mega_kernel, dim3(grid_blocks), dim3(256), args, 0, stream);
  if (e != hipSuccess) fprintf(stderr, "cooperative launch failed: %s (grid %d)\n", hipGetErrorString(e), grid_blocks);
#endif
}
```

```cpp
#include <hip/hip_runtime.h>
#include <hip/hip_bf16.h>
#include <hip/hip_cooperative_groups.h>
#include <cstdio>
namespace cg = cooperative_groups;

typedef unsigned short u16;
using bf16x8 = __attribute__((ext_vector_type(8))) short;
using f32x4 = __attribute__((ext_vector_type(4))) float;
#define DEVI __device__ __forceinline__
__device__ __forceinline__ int ltid_() { int t = threadIdx.x; asm volatile("" : "+v"(t)); return t; }
#define TIDX ltid_()

constexpr int NTOK = 8192;
constexpr int PIN = 8064;
constexpr float ALPHA = 1.4142135623730951f;
constexpr size_t OUT_Y = 0;
constexpr size_t OUT_NAK = 8388608;
constexpr size_t OUT_NAV = 12582912;
constexpr size_t OUT_SRET = 16777216;
constexpr size_t OUT_SRW = 18874368;
constexpr size_t OFF_CTR = 0;
constexpr size_t OFF_TAB = 4096;
constexpr size_t OFF_MOD = 16384;
constexpr size_t OFF_WINT = 1048576;
constexpr size_t OFF_WBRT = OFF_WINT + 33030144;
constexpr size_t OFF_WOUTT = OFF_WBRT + 6291456;
constexpr size_t OFF_WQT = OFF_WOUTT + 4194304;
constexpr size_t OFF_WUPT = OFF_WQT + 4194304;
constexpr size_t OFF_AUPT = OFF_WUPT + 262144;
constexpr size_t OFF_GUPT = OFF_AUPT + 262144;
constexpr size_t OFF_UB = OFF_GUPT + 262144;
constexpr size_t OFF_VB = OFF_UB + 33554432;
constexpr size_t OFF_Z = OFF_VB + 33554432;
constexpr size_t OFF_X = OFF_Z + 132120576;
constexpr size_t OFF_H = OFF_X + 33554432;
constexpr size_t OFF_ONA = OFF_H + 16777216;
constexpr size_t OFF_ORT = OFF_ONA + 8388608;
constexpr size_t OFF_ORW = OFF_ORT + 8388608;
constexpr size_t OFF_GA = OFF_ORW + 8388608;
constexpr size_t SZB = 8388608;
constexpr size_t OFF_RWW = OFF_GA;
constexpr size_t OFF_RWR = OFF_RWW + 4 * SZB;
constexpr size_t OFF_RWV = OFF_RWR + SZB;
constexpr size_t OFF_RWKK = OFF_RWV + SZB;
constexpr size_t OFF_RWKC = OFF_RWKK + SZB;
constexpr size_t OFF_RWKD = OFF_RWKC + SZB;
constexpr size_t OFF_RWKKA = OFF_RWKD + 2 * SZB;
constexpr size_t OFF_RWG = OFF_RWKKA + 2 * SZB;
constexpr size_t OFF_RWBON = OFF_RWG + SZB;
constexpr size_t OFF_OF = OFF_RWBON + SZB;
constexpr size_t OFF_KV = OFF_OF + 4 * SZB;
constexpr size_t OFF_BAR = OFF_KV + 33554432;
constexpr size_t OFF_SC = OFF_BAR + 16384;
constexpr size_t OFF_CUT = OFF_SC + 4 * 65536;
constexpr size_t OFF_END = OFF_CUT + 8192;
constexpr size_t OFF_Y = OFF_GA;
constexpr size_t OFF_X1 = OFF_GA + 33554432;
constexpr size_t OFF_Q = OFF_GA + 2 * 33554432;
constexpr size_t OFF_H2 = OFF_GA + 3 * 33554432;
constexpr size_t OFF_EIDX = OFF_H2 + 16777216;
constexpr size_t OFF_GATE = OFF_EIDX + 4194304;

constexpr size_t UV_LSTRIDE = 16777216;
struct KArgs {
  const float* in[36];
  float* out;
  unsigned char* ws;
};
typedef __attribute__((address_space(1))) unsigned char g_u8;
typedef __attribute__((address_space(1))) float g_f32;
typedef const __attribute__((address_space(1))) float g_cf32;
struct InTab {
  g_cf32* const* t;
  DEVI const float* operator[](int k) const { return (const float*)t[k]; }
};
struct Params {
  InTab in;
  g_f32* out;
  g_u8* ws;
};
DEVI const float* uniform_ptr(const float* q) {
  unsigned long long v = (unsigned long long)q;
  unsigned lo = __builtin_amdgcn_readfirstlane((unsigned)v), hi = __builtin_amdgcn_readfirstlane((unsigned)(v >> 32));
  return (const float*)(((unsigned long long)hi << 32) | lo);
}

DEVI float bf2f(u16 h) { return __uint_as_float(((unsigned)h) << 16); }
DEVI unsigned cvtpk(float lo, float hi) {
  unsigned r;
  asm volatile("v_cvt_pk_bf16_f32 %0, %1, %2" : "=v"(r) : "v"(lo), "v"(hi));
  return r;
}
DEVI u16 f2bf(float f) { return (u16)(cvtpk(f, f) & 0xffffu); }
DEVI float sigmoidf_(float x) { return 1.f / (1.f + __expf(-x)); }
template <int CTRL> DEVI float dpp(float x) {
  return __builtin_bit_cast(float, __builtin_amdgcn_update_dpp(0, __builtin_bit_cast(int, x), CTRL, 0xf, 0xf, true));
}
DEVI float quad_sum(float x) { x += dpp<0xB1>(x); x += dpp<0x4E>(x); return x; }
DEVI float row16_sum(float x) { x = quad_sum(x); x += dpp<0x141>(x); x += dpp<0x140>(x); return x; }
DEVI float wave_sum(float x) { x = row16_sum(x); x += __shfl_xor(x, 16); x += __shfl_xor(x, 32); return x; }
DEVI void unpack8(uint4 v, float* f) {
  f[0] = __uint_as_float(v.x << 16); f[1] = __uint_as_float(v.x & 0xffff0000u);
  f[2] = __uint_as_float(v.y << 16); f[3] = __uint_as_float(v.y & 0xffff0000u);
  f[4] = __uint_as_float(v.z << 16); f[5] = __uint_as_float(v.z & 0xffff0000u);
  f[6] = __uint_as_float(v.w << 16); f[7] = __uint_as_float(v.w & 0xffff0000u);
}
DEVI void unpack4(uint2 v, float* f) {
  f[0] = __uint_as_float(v.x << 16); f[1] = __uint_as_float(v.x & 0xffff0000u);
  f[2] = __uint_as_float(v.y << 16); f[3] = __uint_as_float(v.y & 0xffff0000u);
}
DEVI uint4 pack8(const float* f) {
  uint4 r; r.x = cvtpk(f[0], f[1]); r.y = cvtpk(f[2], f[3]); r.z = cvtpk(f[4], f[5]); r.w = cvtpk(f[6], f[7]); return r;
}
DEVI f32x4 mfma16(bf16x8 a, bf16x8 b, f32x4 c) { return __builtin_amdgcn_mfma_f32_16x16x32_bf16(a, b, c, 0, 0, 0); }
DEVI int modrow(int tok) { return tok < 4096 ? 0 : 1 + ((tok - 4096) >> 11); }
DEVI const float* xin_row(const Params& p, int tok) {
  return tok < 4096 ? p.in[0] + (size_t)tok * 1024 : p.in[1] + (size_t)(tok - 4096) * 1024;
}
DEVI int clampi(int v, int lo, int hi) { return v < lo ? lo : (v > hi ? hi : v); }

template <int NT> DEVI void wave_mma(const u16* A, int lda, const u16* B, int ldb, int K, f32x4* acc) {
  const int lane = TIDX & 63, fr = lane & 15, fq = lane >> 4;
  for (int k0 = 0; k0 < K; k0 += 32) {
    bf16x8 a = *(const bf16x8*)(A + fr * lda + k0 + fq * 8);
#pragma unroll
    for (int n = 0; n < NT; ++n) {
      bf16x8 b = *(const bf16x8*)(B + (n * 16 + fr) * ldb + k0 + fq * 8);
      acc[n] = mfma16(a, b, acc[n]);
    }
  }
}

#define LDS_RD(dst, addr, off) asm volatile("ds_read_b128 %0, %1 offset:" #off : "=v"(dst) : "v"(addr))
DEVI void gemm_acc(const u16* __restrict__ A, int lda, const u16* __restrict__ Bt, int ldb, int K, int m0, int n0,
                   unsigned char* sm, f32x4 (&acc)[4][4]) {
  const int tid = TIDX, lane = tid & 63, wid = tid >> 6, wr = wid >> 1, wc = wid & 1, fr = lane & 15, fq = lane >> 4;
  const int nk = K >> 5;
  const int b0 = tid * 16, r0 = b0 >> 6, c0 = (b0 & 63) >> 1;
  const u16* Ap = A + (size_t)(m0 + r0) * lda + c0;
  const u16* Bp = Bt + (size_t)(n0 + r0) * ldb + c0;
  const unsigned lbase = (unsigned)(size_t)(__attribute__((address_space(3))) unsigned char*)sm;
  const unsigned aoff = lbase + (wr * 64 + fr) * 64 + fq * 16;
  const unsigned boff = lbase + 8192 + (wc * 64 + fr) * 64 + fq * 16;
  auto issue = [&](int kt, int st) {
    unsigned char* SA = sm + st * 16384;
    unsigned char* SB = SA + 8192;
    __builtin_amdgcn_global_load_lds((const unsigned*)(Ap + kt * 32), (__attribute__((address_space(3))) unsigned*)(SA + b0), 16, 0, 0);
    __builtin_amdgcn_global_load_lds((const unsigned*)(Ap + (size_t)64 * lda + kt * 32), (__attribute__((address_space(3))) unsigned*)(SA + b0 + 4096), 16, 0, 0);
    __builtin_amdgcn_global_load_lds((const unsigned*)(Bp + kt * 32), (__attribute__((address_space(3))) unsigned*)(SB + b0), 16, 0, 0);
    __builtin_amdgcn_global_load_lds((const unsigned*)(Bp + (size_t)64 * ldb + kt * 32), (__attribute__((address_space(3))) unsigned*)(SB + b0 + 4096), 16, 0, 0);
  };
  issue(0, 0);
  if (nk > 1) issue(1, 1);
  int st = 0;
  for (int kt = 0; kt < nk; ++kt) {
    if (kt + 1 < nk) asm volatile("s_waitcnt vmcnt(4)\n\ts_barrier" ::: "memory");
    else asm volatile("s_waitcnt vmcnt(0)\n\ts_barrier" ::: "memory");
    if (kt + 2 < nk) { int s2 = st + 2; if (s2 >= 3) s2 -= 3; issue(kt + 2, s2); }
    const unsigned aa = aoff + st * 16384, bb = boff + st * 16384;
    bf16x8 a0, a1, a2, a3, b0_, b1_, b2_, b3_;
    LDS_RD(a0, aa, 0); LDS_RD(b0_, bb, 0); LDS_RD(b1_, bb, 1024); LDS_RD(b2_, bb, 2048); LDS_RD(b3_, bb, 3072);
    LDS_RD(a1, aa, 1024); LDS_RD(a2, aa, 2048); LDS_RD(a3, aa, 3072);
    asm volatile("s_waitcnt lgkmcnt(0)" : "+v"(a0), "+v"(a1), "+v"(a2), "+v"(a3), "+v"(b0_), "+v"(b1_), "+v"(b2_), "+v"(b3_));
    acc[0][0] = mfma16(a0, b0_, acc[0][0]); acc[0][1] = mfma16(a0, b1_, acc[0][1]);
    acc[0][2] = mfma16(a0, b2_, acc[0][2]); acc[0][3] = mfma16(a0, b3_, acc[0][3]);
    acc[1][0] = mfma16(a1, b0_, acc[1][0]); acc[1][1] = mfma16(a1, b1_, acc[1][1]);
    acc[1][2] = mfma16(a1, b2_, acc[1][2]); acc[1][3] = mfma16(a1, b3_, acc[1][3]);
    acc[2][0] = mfma16(a2, b0_, acc[2][0]); acc[2][1] = mfma16(a2, b1_, acc[2][1]);
    acc[2][2] = mfma16(a2, b2_, acc[2][2]); acc[2][3] = mfma16(a2, b3_, acc[2][3]);
    acc[3][0] = mfma16(a3, b0_, acc[3][0]); acc[3][1] = mfma16(a3, b1_, acc[3][1]);
    acc[3][2] = mfma16(a3, b2_, acc[3][2]); acc[3][3] = mfma16(a3, b3_, acc[3][3]);
    st = (st == 2) ? 0 : st + 1;
  }
  __syncthreads();
}
#define EPI_LOOP                                                                                         \
  const int _lane = TIDX & 63, _wid = TIDX >> 6, _wr = _wid >> 1, _wc = _wid & 1, _fr = _lane & 15, \
            _fq = _lane >> 4;                                                                            \
  _Pragma("unroll") for (int m = 0; m < 4; ++m) _Pragma("unroll") for (int n = 0; n < 4; ++n)            \
      _Pragma("unroll") for (int j = 0; j < 4; ++j)
#define EPI_ROW (m0 + _wr * 64 + m * 16 + _fq * 4 + j)
#define EPI_COL (n0 + _wc * 64 + n * 16 + _fr)

DEVI void zero_acc(f32x4 (&acc)[4][4]) {
#pragma unroll
  for (int m = 0; m < 4; ++m)
#pragma unroll
    for (int n = 0; n < 4; ++n) acc[m][n] = f32x4{0.f, 0.f, 0.f, 0.f};
}

__constant__ double ROPE_FREQ[16] = {1.0, 0.5623413251903491, 0.31622776601683794, 0.1778279410038923, 0.1,
                                     0.05623413251903491, 0.03162277660168379, 0.01778279410038923, 0.01,
                                     0.005623413251903491, 0.0031622776601683794, 0.0017782794100389228, 0.001,
                                     0.0005623413251903491, 0.00031622776601683794, 0.00017782794100389227};

DEVI void transpose_tile(const float* __restrict__ src, int K, int N, u16* __restrict__ dst, int kt, int nt, unsigned char* sm) {
  float* tile = (float*)sm;
  const int tid = TIDX;
  const int k0 = kt * 64, n0 = nt * 64;
#pragma unroll
  for (int i = 0; i < 16; ++i) {
    int kk = i * 4 + (tid >> 6), nn = tid & 63;
    tile[kk * 65 + nn] = src[(size_t)(k0 + kk) * N + n0 + nn];
  }
  __syncthreads();
#pragma unroll
  for (int i = 0; i < 16; ++i) {
    int nn = i * 4 + (tid >> 6), kk = tid & 63;
    dst[(size_t)(n0 + nn) * K + k0 + kk] = f2bf(tile[kk * 65 + nn]);
  }
}

typedef float f32x2_ __attribute__((ext_vector_type(2)));
DEVI void convert_uv_item(const Params& p, int l, int it) {
  const int which = it >> 9, chunk = it & 511;
  const int lane = TIDX & 63, w = TIDX >> 6;
#pragma unroll 2
  for (int sub = 0; sub < 8; ++sub) {
  const int row = chunk * 32 + sub * 4 + w;
  const float* src = p.in[34 + which] + (size_t)l * 16777216 + (size_t)row * 1024 + lane * 16;
  unsigned char* base = (unsigned char*)(p.ws + (which ? OFF_VB : OFF_UB)) + (size_t)l * UV_LSTRIDE;
  float v[16];
#pragma unroll
  for (int i = 0; i < 4; ++i) *(float4*)(v + i * 4) = *(const float4*)(src + i * 4);
  float am = 0.f;
#pragma unroll
  for (int i = 0; i < 16; ++i) am = fmaxf(am, fabsf(v[i]));
  am = fmaxf(am, dpp<0xB1>(am)); am = fmaxf(am, dpp<0x4E>(am)); am = fmaxf(am, dpp<0x141>(am)); am = fmaxf(am, dpp<0x140>(am));
  am = fmaxf(am, __shfl_xor(am, 16)); am = fmaxf(am, __shfl_xor(am, 32));
  const float sc = (am > 0.f) ? (240.f / am) : 1.f;
  int o[4];
#pragma unroll
  for (int i = 0; i < 4; ++i) {
    int wv = 0;
    wv = __builtin_amdgcn_cvt_pk_fp8_f32(v[i * 4] * sc, v[i * 4 + 1] * sc, wv, false);
    wv = __builtin_amdgcn_cvt_pk_fp8_f32(v[i * 4 + 2] * sc, v[i * 4 + 3] * sc, wv, true);
    o[i] = wv;
  }
  *(int4*)(base + (size_t)row * 1024 + lane * 16) = make_int4(o[0], o[1], o[2], o[3]);
  if (lane == 0) ((float*)(p.ws + OFF_SC))[(which * 2 + l) * 16384 + row] = am * (1.f / 240.f);
  }
}

constexpr int P0_NT = 740;
constexpr int P0_NUV = 1024;
constexpr int P0_NMOD = 192;
constexpr int P0_TOTAL = P0_NMOD + P0_NT + P0_NUV + 1;

constexpr int P0_TILES_L = 2960;
constexpr int P0_NT_ITEMS = P0_TILES_L / 4;
DEVI void p0_tile1(const Params& p, int l, int u, unsigned char* sm) {
  const float* src; u16* dst; int K, N, kt, nt;
  if (u < 2016) { kt = u / 126; nt = u % 126; K = 1024; N = 8064;
    src = p.in[10] + (size_t)l * 1024 * 8064; dst = (u16*)(p.ws + OFF_WINT) + (size_t)l * 8064 * 1024; }
  else if ((u -= 2016) < 384) { int j = l * 3 + u / 128, r = u % 128; kt = r / 16; nt = r % 16; K = 512; N = 1024;
    src = p.in[26] + (size_t)j * 512 * 1024; dst = (u16*)(p.ws + OFF_WBRT) + (size_t)j * 1024 * 512; }
  else if ((u -= 384) < 256) { kt = u / 16; nt = u % 16; K = 1024; N = 1024;
    src = p.in[27] + (size_t)l * 1048576; dst = (u16*)(p.ws + OFF_WOUTT) + (size_t)l * 1048576; }
  else if ((u -= 256) < 256) { kt = u / 16; nt = u % 16; K = 1024; N = 1024;
    src = p.in[32] + (size_t)l * 1048576; dst = (u16*)(p.ws + OFF_WQT) + (size_t)l * 1048576; }
  else if ((u -= 256) < 16) { int j = l * 2 + u / 8; kt = 0; nt = u % 8; K = 64; N = 512;
    src = p.in[17] + (size_t)j * 32768; dst = (u16*)(p.ws + OFF_WUPT) + (size_t)j * 32768; }
  else if ((u -= 16) < 16) { int j = l * 2 + u / 8; kt = 0; nt = u % 8; K = 64; N = 512;
    src = p.in[19] + (size_t)j * 32768; dst = (u16*)(p.ws + OFF_AUPT) + (size_t)j * 32768; }
  else { u -= 16; kt = u / 8; nt = u % 8; K = 128; N = 512;
    src = p.in[20] + (size_t)l * 65536; dst = (u16*)(p.ws + OFF_GUPT) + (size_t)l * 65536; }
  transpose_tile(src, K, N, dst, kt, nt, sm);
}
DEVI void p0_tiles(const Params& p, int l, int item, unsigned char* sm) {
  for (int i = 0; i < 4; ++i) {
    if (i) __syncthreads();
    p0_tile1(p, l, item * 4 + i, sm);
  }
}
DEVI void phase0_item(const Params& p, int it, unsigned char* sm) {
  const int tid = TIDX;
  if (it < P0_NMOD) {
    const int l = it / 96, n0 = (it % 96) * 64;
    const int kg = tid >> 4, c4 = (tid & 15) * 4;
    float acc[3][4];
#pragma unroll
    for (int r = 0; r < 3; ++r)
#pragma unroll
      for (int i = 0; i < 4; ++i) acc[r][i] = 0.f;
    const float* wm = p.in[8] + (size_t)l * 1024 * 6144;
#pragma unroll 8
    for (int k = kg * 64; k < kg * 64 + 64; ++k) {
      float4 w = *(const float4*)(wm + (size_t)k * 6144 + n0 + c4);
      float c0 = p.in[7][k], c1 = p.in[6][k], c2 = p.in[6][1024 + k];
      float s0 = c0 * sigmoidf_(c0), s1 = c1 * sigmoidf_(c1), s2 = c2 * sigmoidf_(c2);
      acc[0][0] += s0 * w.x; acc[0][1] += s0 * w.y; acc[0][2] += s0 * w.z; acc[0][3] += s0 * w.w;
      acc[1][0] += s1 * w.x; acc[1][1] += s1 * w.y; acc[1][2] += s1 * w.z; acc[1][3] += s1 * w.w;
      acc[2][0] += s2 * w.x; acc[2][1] += s2 * w.y; acc[2][2] += s2 * w.z; acc[2][3] += s2 * w.w;
    }
    float* red = (float*)sm;
#pragma unroll
    for (int r = 0; r < 3; ++r)
#pragma unroll
      for (int i = 0; i < 4; ++i) red[(kg * 3 + r) * 64 + c4 + i] = acc[r][i];
    __syncthreads();
    if (tid < 192) {
      int r = tid >> 6, col = tid & 63;
      float s = p.in[9][(size_t)l * 6144 + n0 + col];
      for (int g = 0; g < 16; ++g) s += red[(g * 3 + r) * 64 + col];
      ((float*)(p.ws + OFF_MOD))[((size_t)l * 3 + r) * 6144 + n0 + col] = s;
    }
    return;
  }
  it -= P0_NMOD;
  if (it < P0_NT) {
    p0_tiles(p, 0, it, sm);
    return;
  }
  if (0) {
    int t = it;
    const float* src; u16* dst; int K, N, kt, nt;
    if (t < 4032) { int l = t / 2016, r = t % 2016; kt = r / 126; nt = r % 126; K = 1024; N = 8064;
      src = p.in[10] + (size_t)l * 1024 * 8064; dst = (u16*)(p.ws + OFF_WINT) + (size_t)l * 8064 * 1024; }
    else if ((t -= 4032) < 768) { int j = t / 128, r = t % 128; kt = r / 16; nt = r % 16; K = 512; N = 1024;
      src = p.in[26] + (size_t)j * 512 * 1024; dst = (u16*)(p.ws + OFF_WBRT) + (size_t)j * 1024 * 512; }
    else if ((t -= 768) < 512) { int l = t / 256, r = t % 256; kt = r / 16; nt = r % 16; K = 1024; N = 1024;
      src = p.in[27] + (size_t)l * 1048576; dst = (u16*)(p.ws + OFF_WOUTT) + (size_t)l * 1048576; }
    else if ((t -= 512) < 512) { int l = t / 256, r = t % 256; kt = r / 16; nt = r % 16; K = 1024; N = 1024;
      src = p.in[32] + (size_t)l * 1048576; dst = (u16*)(p.ws + OFF_WQT) + (size_t)l * 1048576; }
    else if ((t -= 512) < 32) { int j = t / 8; kt = 0; nt = t % 8; K = 64; N = 512;
      src = p.in[17] + (size_t)j * 32768; dst = (u16*)(p.ws + OFF_WUPT) + (size_t)j * 32768; }
    else if ((t -= 32) < 32) { int j = t / 8; kt = 0; nt = t % 8; K = 64; N = 512;
      src = p.in[19] + (size_t)j * 32768; dst = (u16*)(p.ws + OFF_AUPT) + (size_t)j * 32768; }
    else { t -= 32; int l = t / 16, r = t % 16; kt = r / 8; nt = r % 8; K = 128; N = 512;
      src = p.in[20] + (size_t)l * 65536; dst = (u16*)(p.ws + OFF_GUPT) + (size_t)l * 65536; }
    transpose_tile(src, K, N, dst, kt, nt, sm);
    return;
  }
  it -= P0_NT;
  if (it < P0_NUV) { convert_uv_item(p, 0, it); return; }
  float* tab = (float*)(p.ws + OFF_TAB);
  for (int e = tid; e < 1024; e += 256) {
    int pos = e >> 4, f = e & 15;
    double rev = (double)pos * ROPE_FREQ[f] * 0.15915494309189535;
    rev -= floor(rev);
    float rf = (float)rev;
    tab[e] = __builtin_amdgcn_cosf(rf);
    tab[1024 + e] = __builtin_amdgcn_sinf(rf);
  }
}

DEVI void ln1_item(const Params& p, int it) {
  const int lane = TIDX & 63, w = TIDX >> 6;
  const int tok = it * 4 + w;
  const float* x = xin_row(p, tok);
  const float* mod = (const float*)(p.ws + OFF_MOD) + (size_t)modrow(tok) * 6144;
  float4 v[4];
  float s = 0.f;
#pragma unroll
  for (int i = 0; i < 4; ++i) { v[i] = *(const float4*)(x + lane * 4 + 256 * i); s += v[i].x + v[i].y + v[i].z + v[i].w; }
  float mu = wave_sum(s) * (1.f / 1024.f);
  float q = 0.f;
#pragma unroll
  for (int i = 0; i < 4; ++i) { float a = v[i].x - mu, b = v[i].y - mu, c = v[i].z - mu, d = v[i].w - mu; q += a * a + b * b + c * c + d * d; }
  float rs = rsqrtf(wave_sum(q) * (1.f / 1024.f) + 1e-5f);
  u16* H = (u16*)(p.ws + OFF_H) + (size_t)tok * 1024;
#pragma unroll
  for (int i = 0; i < 4; ++i) {
    int c = lane * 4 + 256 * i;
    float4 sh = *(const float4*)(mod + c), sc = *(const float4*)(mod + 1024 + c);
    uint2 o;
    o.x = cvtpk((v[i].x - mu) * rs * (1.f + sc.x) + sh.x, (v[i].y - mu) * rs * (1.f + sc.y) + sh.y);
    o.y = cvtpk((v[i].z - mu) * rs * (1.f + sc.z) + sh.z, (v[i].w - mu) * rs * (1.f + sc.w) + sh.w);
    *(uint2*)(H + c) = o;
  }
}

DEVI void g1_item(const Params& p, int l, int it, unsigned char* sm) {
  const int nt = it >> 6, mt = it & 63;
  const int m0 = mt * 128, n0 = nt * 128;
  f32x4 acc[4][4];
  zero_acc(acc);
  gemm_acc((const u16*)(p.ws + OFF_H), 1024, (const u16*)(p.ws + OFF_WINT) + (size_t)l * 8064 * 1024, 1024, 1024, m0, n0, sm, acc);
  u16* Z = (u16*)(p.ws + OFF_Z);
  EPI_LOOP {
    int row = EPI_ROW, col = EPI_COL;
    float v = acc[m][n][j];
    Z[(size_t)row * PIN + col] = f2bf(v);
    if (row < 4096 && col >= 512 && col < 1536) {
      int which = (col - 512) >> 9, cc = (col - 512) & 511, h = cc >> 6, d = cc & 63, b = row >> 8, s = row & 255;
      p.out[OUT_NAK + (size_t)which * 4194304 + ((((size_t)(b * 2 + l) * 8 + h) * 256 + s) * 64 + d)] = v;
    }
  }
}
DEVI void g2_item(const Params& p, int l, int it, unsigned char* sm) {
  const int nt = it >> 6, mt = it & 63;
  const int m0 = mt * 128, n0 = nt * 128;
  f32x4 tot[4][4];
  zero_acc(tot);
  const u16* Z = (const u16*)(p.ws + OFF_Z);
  for (int i = 0; i < 3; ++i) {
    f32x4 acc[4][4];
    zero_acc(acc);
    const u16* A = (const u16*)(p.ws + (i == 0 ? OFF_ONA : (i == 1 ? OFF_ORT : OFF_ORW)));
    gemm_acc(A, 512, (const u16*)(p.ws + OFF_WBRT) + (size_t)(l * 3 + i) * 1024 * 512, 512, 512, m0, n0, sm, acc);
    EPI_LOOP {
      int row = EPI_ROW, col = EPI_COL;
      float g = bf2f(Z[(size_t)row * PIN + 4992 + i * 1024 + col]);
      tot[m][n][j] += sigmoidf_(g) * acc[m][n][j];
    }
  }
  u16* MG = (u16*)(p.ws + OFF_H);
  EPI_LOOP { MG[(size_t)EPI_ROW * 1024 + EPI_COL] = f2bf(tot[m][n][j]); }
}
DEVI void g3_item(const Params& p, int l, int it, unsigned char* sm) {
  const int nt = it >> 6, mt = it & 63;
  const int m0 = mt * 128, n0 = nt * 128;
  f32x4 acc[4][4];
  zero_acc(acc);
  gemm_acc((const u16*)(p.ws + OFF_H), 1024, (const u16*)(p.ws + OFF_WOUTT) + (size_t)l * 1048576, 1024, 1024, m0, n0, sm, acc);
  float* Y = (float*)(p.ws + OFF_Y);
  const float* mod = (const float*)(p.ws + OFF_MOD) + (size_t)l * 3 * 6144;
  const float* X = (const float*)(p.ws + OFF_X);
  EPI_LOOP {
    int row = EPI_ROW, col = EPI_COL;
    float xr = (l == 0) ? xin_row(p, row)[col] : X[(size_t)row * 1024 + col];
    float gt = mod[(size_t)modrow(row) * 6144 + 2048 + col];
    Y[(size_t)row * 1024 + col] = ALPHA * xr + gt * acc[m][n][j];
  }
}
DEVI void g4_item(const Params& p, int l, int it, unsigned char* sm) {
  const int nt = it >> 6, mt = it & 63;
  const int m0 = mt * 128, n0 = nt * 128;
  f32x4 acc[4][4];
  zero_acc(acc);
  gemm_acc((const u16*)(p.ws + OFF_H2), 1024, (const u16*)(p.ws + OFF_WQT) + (size_t)l * 1048576, 1024, 1024, m0, n0, sm, acc);
  float* Q = (float*)(p.ws + OFF_Q);
  EPI_LOOP { Q[(size_t)EPI_ROW * 1024 + EPI_COL] = acc[m][n][j]; }
}

DEVI void load_qk16(const u16* zp  , int part, bool lat, int prow, int pcol, const float* tab,
                    float scale, float* out) {
  if (!lat) {
    float t[16];
    unpack8(*(const uint4*)(zp + part * 16), t);
    unpack8(*(const uint4*)(zp + part * 16 + 8), t + 8);
#pragma unroll
    for (int i = 0; i < 16; ++i) out[i] = t[i] * scale;
    return;
  }
  const int half = part >> 1, isp2 = part & 1;
  float p1[16], p2[16];
  unpack8(*(const uint4*)(zp + half * 32), p1);
  unpack8(*(const uint4*)(zp + half * 32 + 8), p1 + 8);
  unpack8(*(const uint4*)(zp + half * 32 + 16), p2);
  unpack8(*(const uint4*)(zp + half * 32 + 24), p2 + 8);
  const int pos = half ? pcol : prow;
  const float* ct = tab + pos * 16;
  const float* st = tab + 1024 + pos * 16;
#pragma unroll
  for (int f = 0; f < 16; ++f) {
    float c = ct[f], s = st[f];
    out[f] = (isp2 ? (p1[f] * s + p2[f] * c) : (p1[f] * c - p2[f] * s)) * scale;
  }
}
struct RetItem { int lat, b, h, n, N, seqbase, kvbase; };
DEVI RetItem ret_decode(int it) {
  RetItem r;
  if (it < 256) { r.lat = 1; r.b = it >> 7; r.h = (it >> 5) & 3; r.n = it & 31; r.N = 32; r.seqbase = 4096 + r.b * 2048; r.kvbase = 256 + (r.b * 4 + r.h) * 32; }
  else { int j = it - 256; r.lat = 0; r.b = j >> 4; r.h = (j >> 2) & 3; r.n = j & 3; r.N = 4; r.seqbase = r.b * 256; r.kvbase = (r.b * 4 + r.h) * 4; }
  return r;
}
DEVI void ret_gammas(const Params& p, int l, int h, float& lgf, float& lgb) {
  float xf = p.in[12][(l * 2 + 0) * 4 + h], xb = p.in[12][(l * 2 + 1) * 4 + h];
  lgf = -log2f(1.f + expf(-xf));
  lgb = -log2f(1.f + expf(-xb));
}

DEVI void ret1_item(const Params& p, int l, int it, unsigned char* sm) {
  const RetItem r = ret_decode(it);
  const int tid = TIDX, lane = tid & 63, w = tid >> 6, fr = lane & 15, fq = lane >> 4;
  u16* KTf = (u16*)sm;
  u16* KTb = (u16*)(sm + 9216);
  u16* VT = (u16*)(sm + 18432);
  const u16* Z = (const u16*)(p.ws + OFF_Z);
  const float* tab = (const float*)(p.ws + OFF_TAB);
  float lgf, lgb;
  ret_gammas(p, l, r.h, lgf, lgb);
  const int tok0 = r.seqbase + r.n * 64;
  {
    const int j = tid >> 2, part = tid & 3;
    float kv[16];
    load_qk16(Z + (size_t)(tok0 + j) * PIN + 1792 + r.h * 64, part, r.lat, r.n, j, tab, 0.125f, kv);
    const float df = exp2f(lgf * (float)(63 - j)), db = exp2f(lgb * (float)j);
#pragma unroll
    for (int i = 0; i < 16; ++i) {
      KTf[(part * 16 + i) * 72 + j] = f2bf(kv[i] * df);
      KTb[(part * 16 + i) * 72 + j] = f2bf(kv[i] * db);
    }
    const int jj = tid & 63, vp = (tid >> 6) * 32;
    const u16* vz = Z + (size_t)(tok0 + jj) * PIN + 2048 + r.h * 128 + vp;
#pragma unroll
    for (int c = 0; c < 4; ++c) {
      uint4 raw = *(const uint4*)(vz + c * 8);
      const u16* rv = (const u16*)&raw;
#pragma unroll
      for (int i = 0; i < 8; ++i) VT[(vp + c * 8 + i) * 72 + jj] = rv[i];
    }
  }
  __syncthreads();
  float* KV = (float*)(p.ws + OFF_KV) + (size_t)(r.kvbase + r.n) * 2 * 8192;
#pragma unroll
  for (int dir = 0; dir < 2; ++dir) {
    f32x4 acc[8];
#pragma unroll
    for (int n = 0; n < 8; ++n) acc[n] = f32x4{0.f, 0.f, 0.f, 0.f};
    wave_mma<8>((dir ? KTb : KTf) + w * 16 * 72, 72, VT, 72, 64, acc);
#pragma unroll
    for (int n = 0; n < 8; ++n)
#pragma unroll
      for (int j = 0; j < 4; ++j) KV[(size_t)dir * 8192 + (w * 16 + fq * 4 + j) * 128 + n * 16 + fr] = acc[n][j];
  }
}

DEVI void ret3_item(const Params& p, int l, int it, unsigned char* sm) {
  const RetItem r = ret_decode(it);
  const int tid = TIDX, lane = tid & 63, w = tid >> 6, fr = lane & 15, fq = lane >> 4;
  u16* Qs = (u16*)sm;
  u16* Ks = (u16*)(sm + 9216);
  u16* VT = (u16*)(sm + 18432);
  u16* ST = (u16*)(sm + 36864);
  const u16* Z = (const u16*)(p.ws + OFF_Z);
  const float* tab = (const float*)(p.ws + OFF_TAB);
  float lgf, lgb;
  ret_gammas(p, l, r.h, lgf, lgb);
  const int tok0 = r.seqbase + r.n * 64;
  {
    const int i = tid >> 2, part = tid & 3;
    float t[16];
    load_qk16(Z + (size_t)(tok0 + i) * PIN + 1536 + r.h * 64, part, r.lat, r.n, i, tab, 1.f, t);
    *(uint4*)(Qs + i * 72 + part * 16) = pack8(t);
    *(uint4*)(Qs + i * 72 + part * 16 + 8) = pack8(t + 8);
    load_qk16(Z + (size_t)(tok0 + i) * PIN + 1792 + r.h * 64, part, r.lat, r.n, i, tab, 0.125f, t);
    *(uint4*)(Ks + i * 72 + part * 16) = pack8(t);
    *(uint4*)(Ks + i * 72 + part * 16 + 8) = pack8(t + 8);
    const int jj = tid & 63, vp = (tid >> 6) * 32;
    const u16* vz = Z + (size_t)(tok0 + jj) * PIN + 2048 + r.h * 128 + vp;
#pragma unroll
    for (int c = 0; c < 4; ++c) {
      uint4 raw = *(const uint4*)(vz + c * 8);
      const u16* rv = (const u16*)&raw;
#pragma unroll
      for (int e = 0; e < 8; ++e) VT[(vp + c * 8 + e) * 72 + jj] = rv[e];
    }
  }
  __syncthreads();
  f32x4 at[4];
#pragma unroll
  for (int n = 0; n < 4; ++n) at[n] = f32x4{0.f, 0.f, 0.f, 0.f};
  wave_mma<4>(Qs + w * 16 * 72, 72, Ks, 72, 64, at);
  __syncthreads();
#pragma unroll
  for (int n = 0; n < 4; ++n)
#pragma unroll
    for (int j = 0; j < 4; ++j) {
      int i = w * 16 + fq * 4 + j, jc = n * 16 + fr;
      float mval = (i > jc) ? exp2f(lgf * (float)(i - jc)) : ((i < jc) ? exp2f(lgb * (float)(jc - i)) : 2.f);
      Ks[i * 72 + jc] = f2bf(at[n][j] * mval);
    }
  __syncthreads();
  f32x4 o[8];
#pragma unroll
  for (int n = 0; n < 8; ++n) o[n] = f32x4{0.f, 0.f, 0.f, 0.f};
  wave_mma<8>(Ks + w * 16 * 72, 72, VT, 72, 64, o);
  const float* KVb_ = (const float*)(p.ws + OFF_KV);
  for (int dir = 0; dir < 2; ++dir) {
    const float lg = dir ? lgb : lgf;
    const float cdec = exp2f(lg * 64.f);
    const int nprev = dir ? (r.N - 1 - r.n) : r.n;
    __syncthreads();
    {
      float S[32];
#pragma unroll
      for (int e8 = 0; e8 < 32; ++e8) {
        int e = e8 * 256 + tid;
        S[e8] = r.lat ? p.in[4][((((size_t)(r.b * 2 + l) * 2 + dir) * 4 + r.h) * 64) * 128 + e] : 0.f;
      }
#pragma unroll 2
      for (int m = 0; m < nprev; ++m) {
        const int ch = dir ? (r.N - 1 - m) : m;
        const float* kvp = KVb_ + ((size_t)(r.kvbase + ch) * 2 + dir) * 8192 + tid;
#pragma unroll
        for (int e8 = 0; e8 < 32; ++e8) S[e8] = S[e8] * cdec + kvp[e8 * 256];
      }
      const bool fin = (!r.lat) && (nprev == r.N - 1);
      const float* kvn = KVb_ + ((size_t)(r.kvbase + r.n) * 2 + dir) * 8192 + tid;
      float* so = (float*)p.out + OUT_SRET + ((((size_t)(r.b * 2 + l) * 2 + dir) * 4 + r.h) * 64) * 128 + tid;
#pragma unroll
      for (int e8 = 0; e8 < 32; ++e8) {
        int e = e8 * 256 + tid, d = e >> 7, v = e & 127;
        ST[v * 72 + d] = f2bf(S[e8]);
        if (fin) so[e8 * 256] = S[e8] * cdec + kvn[e8 * 256];
      }
    }
    __syncthreads();
    f32x4 t2[8];
#pragma unroll
    for (int n = 0; n < 8; ++n) t2[n] = f32x4{0.f, 0.f, 0.f, 0.f};
    wave_mma<8>(Qs + w * 16 * 72, 72, ST, 72, 64, t2);
#pragma unroll
    for (int j = 0; j < 4; ++j) {
      int i = w * 16 + fq * 4 + j;
      float dec = dir ? exp2f(lg * (float)(64 - i)) : exp2f(lg * (float)(i + 1));
#pragma unroll
      for (int n = 0; n < 8; ++n) o[n][j] += dec * t2[n][j];
    }
  }
  const float* gw = p.in[13] + l * 512 + r.h * 128;
  const float* gb = p.in[14] + l * 512 + r.h * 128;
  u16* ORT = (u16*)(p.ws + OFF_ORT);
#pragma unroll
  for (int j = 0; j < 4; ++j) {
    float s = 0.f;
#pragma unroll
    for (int n = 0; n < 8; ++n) s += o[n][j];
    float mu = row16_sum(s) * (1.f / 128.f);
    float q = 0.f;
#pragma unroll
    for (int n = 0; n < 8; ++n) { float d = o[n][j] - mu; q += d * d; }
    float rs = rsqrtf(row16_sum(q) * (1.f / 128.f) + 1e-5f);
    const int tok = tok0 + w * 16 + fq * 4 + j;
#pragma unroll
    for (int n = 0; n < 8; ++n) {
      int v = n * 16 + fr;
      float g = bf2f(Z[(size_t)tok * PIN + 2560 + r.h * 128 + v]);
      float y = ((o[n][j] - mu) * rs * gw[v] + gb[v]) * (g * sigmoidf_(g));
      ORT[(size_t)tok * 512 + r.h * 128 + v] = f2bf(y);
    }
  }
}

DEVI void shifted8(const u16* Z, int tok, bool hasp, bool hasn, int col, const float* mu, float* out) {
  float z[8], zp[8], zn[8];
  unpack8(*(const uint4*)(Z + (size_t)tok * PIN + col), z);
  if (hasp) unpack8(*(const uint4*)(Z + (size_t)(tok - 1) * PIN + col), zp);
  else {
#pragma unroll
    for (int i = 0; i < 8; ++i) zp[i] = 0.f;
  }
  if (hasn) unpack8(*(const uint4*)(Z + (size_t)(tok + 1) * PIN + col), zn);
  else {
#pragma unroll
    for (int i = 0; i < 8; ++i) zn[i] = 0.f;
  }
  float4 m0 = *(const float4*)(mu + col - 3072), m1 = *(const float4*)(mu + col - 3072 + 4);
  float mm[8] = {m0.x, m0.y, m0.z, m0.w, m1.x, m1.y, m1.z, m1.w};
#pragma unroll
  for (int i = 0; i < 8; ++i) out[i] = z[i] + mm[i] * (0.5f * (zp[i] + zn[i]) - z[i]);
}
DEVI void tok_neighbors(int tok, bool& hasp, bool& hasn) {
  if (tok < 4096) { int s = tok & 255; hasp = s > 0; hasn = s < 255; }
  else { int s = (tok - 4096) & 2047; hasp = s > 0; hasn = s < 2047; }
}

DEVI void rwprep_item(const Params& p, int l, int it) {
  const int tid = TIDX, lane = tid & 63, w = tid >> 6, fr = lane & 15, fq = lane >> 4;
  const u16* Z = (const u16*)(p.ws + OFF_Z);
  const float* mu = p.in[15] + l * 1920;
  const int tok0 = (it >> 2) * 64, hq = it & 3;
  u16* R = (u16*)(p.ws + OFF_RWR);
  u16* V = (u16*)(p.ws + OFF_RWV);
  u16* KC = (u16*)(p.ws + OFF_RWKC);
  for (int e = tid; e < 64 * 48; e += 256) {
    int ti = e / 48, u = e % 48, arr = u >> 4, c8 = hq * 128 + (u & 15) * 8;
    int tok = tok0 + ti;
    bool hp, hn;
    tok_neighbors(tok, hp, hn);
    float zs[8];
    shifted8(Z, tok, hp, hn, 3072 + arr * 512 + c8, mu, zs);
    u16* dst = (arr == 0) ? R : (arr == 1 ? KC : V);
    *(uint4*)(dst + (size_t)tok * 512 + c8) = pack8(zs);
  }
  __threadfence_block();
  __syncthreads();
  bf16x8 af[12];
  {
    const int tok = tok0 + w * 16 + fr;
    bool hp, hn;
    tok_neighbors(tok, hp, hn);
#pragma unroll
    for (int f = 0; f < 12; ++f) {
      int col = 4608 + f * 32 + fq * 8;
      float zs[8];
      shifted8(Z, tok, hp, hn, col, mu, zs);
      if (f < 4) {
#pragma unroll
        for (int i = 0; i < 8; ++i) zs[i] = tanhf(zs[i]);
      } else if (f >= 8) {
#pragma unroll
        for (int i = 0; i < 8; ++i) zs[i] = sigmoidf_(zs[i]);
      }
      uint4 pk = pack8(zs);
      af[f] = __builtin_bit_cast(bf16x8, pk);
    }
  }
  const u16* WUP = (const u16*)(p.ws + OFF_WUPT) + (size_t)l * 2 * 32768;
  const u16* AUP = (const u16*)(p.ws + OFF_AUPT) + (size_t)l * 2 * 32768;
  const u16* GUP = (const u16*)(p.ws + OFF_GUPT) + (size_t)l * 65536;
  float* Wd = (float*)(p.ws + OFF_RWW);
  u16* KK = (u16*)(p.ws + OFF_RWKK);
  u16* KD = (u16*)(p.ws + OFF_RWKD);
  u16* KKA = (u16*)(p.ws + OFF_RWKKA);
  u16* G = (u16*)(p.ws + OFF_RWG);
  u16* BON = (u16*)(p.ws + OFF_RWBON);
  const float* kkw = p.in[21] + l * 512;
  const float* kaw = p.in[22] + l * 512;
  const float* rkw = p.in[23] + l * 512;
  const float* w0 = p.in[16] + l * 1024;
  const float* a0 = p.in[18] + l * 1024;
  for (int h = hq * 2; h < hq * 2 + 2; ++h) {
    float inv[4], sbv[4];
#pragma unroll
    for (int j = 0; j < 4; ++j) {
      const int tok = tok0 + w * 16 + fq * 4 + j;
      float ssq = 0.f, sb = 0.f;
#pragma unroll
      for (int n = 0; n < 4; ++n) {
        int c = h * 64 + n * 16 + fr;
        float rr = bf2f(R[(size_t)tok * 512 + c]);
        float kc = bf2f(KC[(size_t)tok * 512 + c]);
        float kk = kc * kkw[c];
        ssq += kk * kk;
        sb += rr * kc * rkw[c];
      }
      ssq = row16_sum(ssq);
      sbv[j] = row16_sum(sb);
      inv[j] = rsqrtf(fmaxf(ssq, 1e-24f));
    }
#pragma unroll 1
    for (int n = 0; n < 4; ++n) {
      f32x4 acc[5];
#pragma unroll
      for (int m = 0; m < 5; ++m) acc[m] = f32x4{0.f, 0.f, 0.f, 0.f};
      const int c = h * 64 + n * 16 + fr;
#pragma unroll
      for (int ks = 0; ks < 2; ++ks) {
        acc[0] = mfma16(af[0 + ks], *(const bf16x8*)(WUP + (size_t)c * 64 + ks * 32 + fq * 8), acc[0]);
        acc[1] = mfma16(af[2 + ks], *(const bf16x8*)(WUP + 32768 + (size_t)c * 64 + ks * 32 + fq * 8), acc[1]);
        acc[2] = mfma16(af[4 + ks], *(const bf16x8*)(AUP + (size_t)c * 64 + ks * 32 + fq * 8), acc[2]);
        acc[3] = mfma16(af[6 + ks], *(const bf16x8*)(AUP + 32768 + (size_t)c * 64 + ks * 32 + fq * 8), acc[3]);
      }
#pragma unroll
      for (int ks = 0; ks < 4; ++ks)
        acc[4] = mfma16(af[8 + ks], *(const bf16x8*)(GUP + (size_t)c * 128 + ks * 32 + fq * 8), acc[4]);
      const float kkc = kkw[c], ka = kaw[c];
      const float w0f = w0[c], w0b = w0[512 + c], a0f = a0[c], a0b = a0[512 + c];
#pragma unroll
      for (int j = 0; j < 4; ++j) {
        const int tok = tok0 + w * 16 + fq * 4 + j;
        const size_t o = (size_t)tok * 512 + c;
        const float kc = bf2f(KC[o]), vv = bf2f(V[o]);
        const float kkn = kc * kkc * inv[j];
        KK[o] = f2bf(kkn);
        G[o] = f2bf(acc[4][j]);
        BON[o] = f2bf(sbv[j] * vv);
#pragma unroll
        for (int d = 0; d < 2; ++d) {
          float wv = __expf(-0.606531f * sigmoidf_((d ? w0b : w0f) + acc[d][j]));
          float a = sigmoidf_((d ? a0b : a0f) + acc[2 + d][j]);
          Wd[(size_t)d * NTOK * 512 + o] = wv;
          KD[(size_t)d * NTOK * 512 + o] = f2bf(kc * (1.f + (a - 1.f) * ka));
          KKA[(size_t)d * NTOK * 512 + o] = f2bf(kkn * a);
        }
      }
    }
  }
}

template <int KPT>
DEVI void scan_run(const Params& p, int l, bool lat, int b, int h, int dir, int rowbase, unsigned char* sm) {
  constexpr int LPR = 64 / KPT;
  constexpr int CH = 32;
  const int tid = TIDX;
  const int row = rowbase + tid / LPR, ks = (tid % LPR) * KPT;
  const int lir = tid % LPR;
  const int T = lat ? 2048 : 256, seq0 = lat ? 4096 + b * 2048 : b * 256;
  float S[KPT];
  if (lat) {
    const float* s0 = p.in[5] + ((((size_t)(b * 2 + l) * 2 + dir) * 8 + h) * 64 + row) * 64 + ks;
#pragma unroll
    for (int i = 0; i < KPT; ++i) S[i] = s0[i];
  } else {
#pragma unroll
    for (int i = 0; i < KPT; ++i) S[i] = 0.f;
  }
  float* buf = (float*)sm;
  float* obuf = buf + CH * 384;
  const float* Wd = (const float*)(p.ws + OFF_RWW) + (size_t)dir * NTOK * 512;
  const u16* R = (const u16*)(p.ws + OFF_RWR);
  const u16* V = (const u16*)(p.ws + OFF_RWV);
  const u16* KK = (const u16*)(p.ws + OFF_RWKK);
  const u16* KD = (const u16*)(p.ws + OFF_RWKD) + (size_t)dir * NTOK * 512;
  const u16* KKA = (const u16*)(p.ws + OFF_RWKKA) + (size_t)dir * NTOK * 512;
  float* O = (float*)(p.ws + OFF_OF) + (size_t)dir * NTOK * 512;
  const int pst = tid >> 3, c8 = (tid & 7) * 8;
  const int nch = T / CH;
  struct Pf { float4 qw0, qw1; uint4 qr, qk, qv, qd, qa; };
  auto issue = [&](Pf& q, int chunk) {
    float4& qw0 = q.qw0; float4& qw1 = q.qw1; uint4& qr = q.qr; uint4& qk = q.qk; uint4& qv = q.qv; uint4& qd = q.qd; uint4& qa = q.qa;
    int s_ = chunk * CH + pst;
    int tok_ = dir ? (seq0 + T - 1 - s_) : (seq0 + s_);
    size_t o_ = (size_t)tok_ * 512 + h * 64 + c8;
    qw0 = *(const float4*)(Wd + o_); qw1 = *(const float4*)(Wd + o_ + 4);
    qr = *(const uint4*)(R + o_); qk = *(const uint4*)(KK + o_); qv = *(const uint4*)(V + o_);
    qd = *(const uint4*)(KD + o_); qa = *(const uint4*)(KKA + o_);
  };
  auto commit = [&](const Pf& q) {
    const float4 qw0 = q.qw0, qw1 = q.qw1; const uint4 qr = q.qr, qk = q.qk, qv = q.qv, qd = q.qd, qa = q.qa;
    float* bp = buf + pst * 384 + c8;
    float t[8];
    *(float4*)bp = qw0; *(float4*)(bp + 4) = qw1;
    unpack8(qr, t); *(float4*)(bp + 64) = *(float4*)t; *(float4*)(bp + 68) = *(float4*)(t + 4);
    unpack8(qk, t); *(float4*)(bp + 128) = *(float4*)t; *(float4*)(bp + 132) = *(float4*)(t + 4);
    unpack8(qv, t); *(float4*)(bp + 192) = *(float4*)t; *(float4*)(bp + 196) = *(float4*)(t + 4);
    unpack8(qd, t); *(float4*)(bp + 256) = *(float4*)t; *(float4*)(bp + 260) = *(float4*)(t + 4);
    unpack8(qa, t); *(float4*)(bp + 320) = *(float4*)t; *(float4*)(bp + 324) = *(float4*)(t + 4);
    if (KPT == 4) {
      float rr[8];
      unpack8(qr, rr);
      float ar = 0.f;
#pragma unroll
      for (int i = 0; i < 8; ++i) ar += t[i] * rr[i];
      ar += dpp<0xB1>(ar); ar += dpp<0x4E>(ar); ar += dpp<0x141>(ar);
      if ((tid & 7) == 0) obuf[pst] = ar;
    }
  };
  auto compute = [&](int chunk) {
    if constexpr (KPT == 4) {
      typedef float f2 __attribute__((ext_vector_type(2)));
      f2 S01 = {S[0], S[1]}, S23 = {S[2], S[3]};
      float4 w4 = *(const float4*)(buf + ks), r4 = *(const float4*)(buf + 64 + ks), k4 = *(const float4*)(buf + 128 + ks),
             d4 = *(const float4*)(buf + 256 + ks), a4 = *(const float4*)(buf + 320 + ks);
      float vr = buf[192 + row], ar = obuf[0];
      float myo = 0.f;
#pragma unroll 1
      for (int sb = 0; sb < CH; sb += 16) {
#pragma unroll
        for (int si = 0; si < 16; ++si) {
          const int s = sb + si;
          float4 nw = w4, nr = r4, nk = k4, nd = d4, na = a4;
          float nv = vr, nar = ar;
          if (s + 1 < CH) {
            const float* bp = buf + (s + 1) * 384;
            nw = *(const float4*)(bp + ks); nr = *(const float4*)(bp + 64 + ks); nk = *(const float4*)(bp + 128 + ks);
            nd = *(const float4*)(bp + 256 + ks); na = *(const float4*)(bp + 320 + ks);
            nv = bp[192 + row]; nar = obuf[s + 1];
          }
          const f2 w01 = {w4.x, w4.y}, w23 = {w4.z, w4.w}, k01 = {k4.x, k4.y}, k23 = {k4.z, k4.w};
          const f2 d01 = {d4.x, d4.y}, d23 = {d4.z, d4.w}, a01 = {a4.x, a4.y}, a23 = {a4.z, a4.w};
          const f2 r01 = {r4.x, r4.y}, r23 = {r4.z, r4.w};
          const f2 m = S01 * k01 + S23 * k23;
          const f2 pre01 = S01 * w01 + d01 * vr, pre23 = S23 * w23 + d23 * vr;
          const f2 pq = pre01 * r01 + pre23 * r23;
          float x = m.x + m.y, y = pq.x + pq.y;
          x += dpp<0xB1>(x); y += dpp<0xB1>(y);
          x += dpp<0x4E>(x); y += dpp<0x4E>(y);
          x += dpp<0x141>(x); y += dpp<0x141>(y);
          x += dpp<0x140>(x); y += dpp<0x140>(y);
          S01 = pre01 - a01 * x;
          S23 = pre23 - a23 * x;
          const float o = y - x * ar;
          myo = (si == lir) ? o : myo;
          w4 = nw; r4 = nr; k4 = nk; d4 = nd; a4 = na; vr = nv; ar = nar;
        }
        {
          int st = chunk * CH + sb + lir;
          int tok = dir ? (seq0 + T - 1 - st) : (seq0 + st);
          O[(size_t)tok * 512 + h * 64 + row] = myo;
        }
      }
      S[0] = S01.x; S[1] = S01.y; S[2] = S23.x; S[3] = S23.y;
      return;
    } else {
      float myo = 0.f;
#pragma unroll 1
      for (int sb = 0; sb < CH; sb += 4)
#pragma unroll
        for (int si = 0; si < 4; ++si) {
          const int s = sb + si;
          const float* bp = buf + s * 384;
          float wv[KPT], rv[KPT], kkv[KPT], kdv[KPT], kav[KPT];
#pragma unroll
          for (int i = 0; i < KPT; i += 4) {
            *(float4*)(wv + i) = *(const float4*)(bp + ks + i);
            *(float4*)(rv + i) = *(const float4*)(bp + 64 + ks + i);
            *(float4*)(kkv + i) = *(const float4*)(bp + 128 + ks + i);
            *(float4*)(kdv + i) = *(const float4*)(bp + 256 + ks + i);
            *(float4*)(kav + i) = *(const float4*)(bp + 320 + ks + i);
          }
          const float vr = bp[192 + row];
          float sk = 0.f;
#pragma unroll
          for (int i = 0; i < KPT; ++i) sk += S[i] * kkv[i];
          sk = quad_sum(sk);
          float o = 0.f;
#pragma unroll
          for (int i = 0; i < KPT; ++i) {
            S[i] = S[i] * wv[i] - sk * kav[i] + vr * kdv[i];
            o += S[i] * rv[i];
          }
          o = quad_sum(o);
          myo = (si == lir) ? o : myo;
          if (si == 3) {
            int st = chunk * CH + sb + lir;
            int tok = dir ? (seq0 + T - 1 - st) : (seq0 + st);
            O[(size_t)tok * 512 + h * 64 + row] = myo;
          }
        }
    }
  };
  if (KPT == 4) __builtin_amdgcn_s_setprio(3);
  Pf qA;
  issue(qA, 0);
  if constexpr (KPT == 4) {
    Pf qB;
    issue(qB, 1);
    for (int c0 = 0; c0 < nch; c0 += 2) {
      asm volatile("s_waitcnt lgkmcnt(0)\n\ts_barrier" ::: "memory");
      commit(qA);
      asm volatile("s_waitcnt lgkmcnt(0)\n\ts_barrier" ::: "memory");
      if (c0 + 2 < nch) issue(qA, c0 + 2);
      compute(c0);
      asm volatile("s_waitcnt lgkmcnt(0)\n\ts_barrier" ::: "memory");
      commit(qB);
      asm volatile("s_waitcnt lgkmcnt(0)\n\ts_barrier" ::: "memory");
      if (c0 + 3 < nch) issue(qB, c0 + 3);
      compute(c0 + 1);
    }
  } else {
    for (int c0 = 0; c0 < nch; ++c0) {
      asm volatile("s_waitcnt lgkmcnt(0)\n\ts_barrier" ::: "memory");
      commit(qA);
      asm volatile("s_waitcnt lgkmcnt(0)\n\ts_barrier" ::: "memory");
      if (c0 + 1 < nch) issue(qA, c0 + 1);
      compute(c0);
    }
  }
  if (KPT == 4) __builtin_amdgcn_s_setprio(0);
  if (!lat) {
    float* so = (float*)p.out + OUT_SRW + ((((size_t)(b * 2 + l) * 2 + dir) * 8 + h) * 64 + row) * 64 + ks;
#pragma unroll
    for (int i = 0; i < KPT; ++i) so[i] = S[i];
  }
}

DEVI void attn_item(const Params& p, int l, int it, unsigned char* sm) {
  const int tid = TIDX, lane = tid & 63, w = tid >> 6, fr = lane & 15, fq = lane >> 4;
  u16* Ks = (u16*)sm;
  u16* VT = (u16*)(sm + 9216);
  float* rpbs = (float*)(sm + 18432);
  const u16* Z = (const u16*)(p.ws + OFF_Z);
  const bool lat = it < 512;
  int b, h, r = 0, seqbase, qtok0;
  if (lat) { b = it >> 8; h = (it >> 5) & 7; r = it & 31; seqbase = 4096 + b * 2048; qtok0 = seqbase + r * 64; }
  else { int j = it - 512; b = j >> 5; h = (j >> 2) & 7; int qb = j & 3; seqbase = b * 256; qtok0 = seqbase + qb * 64; }
  bf16x8 qf[2];
#pragma unroll
  for (int ks = 0; ks < 2; ++ks) qf[ks] = *(const bf16x8*)(Z + (size_t)(qtok0 + w * 16 + fr) * PIN + h * 64 + ks * 32 + fq * 8);
  if (lat)
    for (int i = tid; i < 465; i += 256) rpbs[i] = p.in[11][(size_t)(l * 8 + h) * 465 + i];
  float m_run = -3e38f, l_run = 0.f;
  f32x4 o[4];
#pragma unroll
  for (int d = 0; d < 4; ++d) o[d] = f32x4{0.f, 0.f, 0.f, 0.f};
  const int ntiles = lat ? 16 : 4;
  const int row_start = lat ? clampi(r - 4, 0, 24) : 0;
  const int cbs = lat ? clampi(w * 16 - 8, 0, 32) : 0;
  for (int ti = 0; ti < ntiles; ++ti) {
    __syncthreads();
    const bool ctxtile = lat && ti < 8;
    if (ctxtile) {
      const float* kc = p.in[2] + ((((size_t)b * 2 + l) * 8 + h) * 512 + ti * 64) * 64;
      const float* vc = p.in[3] + ((((size_t)b * 2 + l) * 8 + h) * 512 + ti * 64) * 64;
      {
        const int key = tid >> 2, dp = (tid & 3) * 16;
        float t[16];
#pragma unroll
        for (int c = 0; c < 4; ++c) *(float4*)(t + c * 4) = *(const float4*)(kc + key * 64 + dp + c * 4);
        *(uint4*)(Ks + key * 72 + dp) = pack8(t);
        *(uint4*)(Ks + key * 72 + dp + 8) = pack8(t + 8);
      }
      {
        const int key = tid & 63, dp = (tid >> 6) * 16;
        float t[16];
#pragma unroll
        for (int c = 0; c < 4; ++c) *(float4*)(t + c * 4) = *(const float4*)(vc + key * 64 + dp + c * 4);
#pragma unroll
        for (int i = 0; i < 16; ++i) VT[(dp + i) * 72 + key] = f2bf(t[i]);
      }
    } else {
      const int trow = lat ? (row_start + ti - 8) : ti;
      const u16* zr = Z + (size_t)(seqbase + trow * 64) * PIN;
      {
        const int key = tid >> 2, dp = (tid & 3) * 16;
        const u16* src = zr + (size_t)key * PIN + 512 + h * 64 + dp;
        *(uint4*)(Ks + key * 72 + dp) = *(const uint4*)src;
        *(uint4*)(Ks + key * 72 + dp + 8) = *(const uint4*)(src + 8);
      }
      {
        const int key = tid & 63, dp = (tid >> 6) * 16;
        const u16* src = zr + (size_t)key * PIN + 1024 + h * 64 + dp;
        uint4 r0 = *(const uint4*)src, r1 = *(const uint4*)(src + 8);
        const u16* a0 = (const u16*)&r0;
        const u16* a1 = (const u16*)&r1;
#pragma unroll
        for (int i = 0; i < 8; ++i) { VT[(dp + i) * 72 + key] = a0[i]; VT[(dp + 8 + i) * 72 + key] = a1[i]; }
      }
    }
    __syncthreads();
    const bool win = lat && !ctxtile;
    const int nsteps = win ? 1 : 2;
    for (int st = 0; st < nsteps; ++st) {
      const int ko = win ? cbs : st * 32;
      f32x4 s0 = f32x4{0.f, 0.f, 0.f, 0.f}, s1 = s0;
#pragma unroll
      for (int ks = 0; ks < 2; ++ks) {
        bf16x8 a0 = *(const bf16x8*)(Ks + (ko + fr) * 72 + ks * 32 + fq * 8);
        bf16x8 a1 = *(const bf16x8*)(Ks + (ko + 16 + fr) * 72 + ks * 32 + fq * 8);
        s0 = mfma16(a0, qf[ks], s0);
        s1 = mfma16(a1, qf[ks], s1);
      }
      float sv[8];
#pragma unroll
      for (int j = 0; j < 4; ++j) { sv[j] = s0[j] * 0.125f; sv[4 + j] = s1[j] * 0.125f; }
      if (win) {
        const int qc = w * 16 + fr;
        const int dr = (row_start + ti - 8) - r + 7;
        const int qs = clampi(qc - 8, 0, 48);
#pragma unroll
        for (int e = 0; e < 8; ++e) {
          int kc_ = ko + ((e < 4) ? (fq * 4 + e) : (16 + fq * 4 + e - 4));
          int dc = clampi(kc_ - qc, -15, 15) + 15;
          int rel = kc_ - qs;
          sv[e] = (rel >= 0 && rel < 16) ? (sv[e] + rpbs[dr * 31 + dc]) : -1e30f;
        }
      }
      float mx = sv[0];
#pragma unroll
      for (int e = 1; e < 8; ++e) mx = fmaxf(mx, sv[e]);
      mx = fmaxf(mx, __shfl_xor(mx, 16));
      mx = fmaxf(mx, __shfl_xor(mx, 32));
      const float m_new = fmaxf(m_run, mx);
      const float alpha = __expf(m_run - m_new);
      float pe[8], ps = 0.f;
#pragma unroll
      for (int e = 0; e < 8; ++e) { pe[e] = __expf(sv[e] - m_new); ps += pe[e]; }
      l_run = l_run * alpha + ps;
      m_run = m_new;
#pragma unroll
      for (int d = 0; d < 4; ++d) o[d] *= alpha;
      uint4 pk = pack8(pe);
      bf16x8 pb = __builtin_bit_cast(bf16x8, pk);
#pragma unroll
      for (int d = 0; d < 4; ++d) {
        uint2 lo = *(const uint2*)(VT + (d * 16 + fr) * 72 + ko + fq * 4);
        uint2 hi = *(const uint2*)(VT + (d * 16 + fr) * 72 + ko + 16 + fq * 4);
        uint4 vv; vv.x = lo.x; vv.y = lo.y; vv.z = hi.x; vv.w = hi.y;
        o[d] = mfma16(__builtin_bit_cast(bf16x8, vv), pb, o[d]);
      }
    }
  }
  float lt = l_run + __shfl_xor(l_run, 16);
  lt += __shfl_xor(lt, 32);
  const float inv = 1.f / lt;
  u16* ONA = (u16*)(p.ws + OFF_ONA);
  const int tok = qtok0 + w * 16 + fr;
#pragma unroll
  for (int d = 0; d < 4; ++d) {
    uint2 ov; ov.x = cvtpk(o[d][0] * inv, o[d][1] * inv); ov.y = cvtpk(o[d][2] * inv, o[d][3] * inv);
    *(uint2*)(ONA + (size_t)tok * 512 + h * 64 + d * 16 + fq * 4) = ov;
  }
}

constexpr int MIX_NSCAN_LAT = 128, MIX_NSCAN_CTX = 256, MIX_NATT = 1024, MIX_NRET = 512;
constexpr int MIX_TOTAL = MIX_NSCAN_CTX + MIX_NATT + MIX_NRET;
#ifndef ONLYP
#define ONLYP -1
#endif
#define PH_ON(x) (ONLYP < 0 || ONLYP == (x))
DEVI void mix_scan_item(const Params& p, int l, int it, unsigned char* sm) {
  int ch = it >> 2, rq = it & 3;
  if (PH_ON(12)) scan_run<4>(p, l, true, ch >> 4, ch & 7, (ch >> 3) & 1, rq * 16, sm);
}
DEVI void mix_item(const Params& p, int l, int it, unsigned char* sm) {
  if (it < 256) { if (PH_ON(15)) ret3_item(p, l, it, sm); return; }
  it -= 256;
  if (it < MIX_NSCAN_CTX) { if (PH_ON(13)) scan_run<16>(p, l, false, it >> 4, it & 7, (it >> 3) & 1, 0, sm); return; }
  it -= MIX_NSCAN_CTX;
  if (it < MIX_NATT) { if (PH_ON(14)) attn_item(p, l, it, sm); return; }
  it -= MIX_NATT;
  if (PH_ON(15)) ret3_item(p, l, 256 + it, sm);
}

DEVI void fin_item(const Params& p, int l, int it0) {
  const int tid = TIDX;
#pragma unroll 2
  for (int sub = 0; sub < 8; ++sub) {
  const int it = it0 * 8 + sub;
  const int tok = it * 2 + (tid >> 7), c4 = (tid & 127) * 4;
  const size_t o = (size_t)tok * 512 + c4;
  float4 a = *(const float4*)((const float*)(p.ws + OFF_OF) + o);
  float4 b = *(const float4*)((const float*)(p.ws + OFF_OF) + (size_t)NTOK * 512 + o);
  float x[4] = {a.x + b.x, a.y + b.y, a.z + b.z, a.w + b.w};
  float mu = row16_sum(x[0] + x[1] + x[2] + x[3]) * (1.f / 64.f);
  float q = 0.f;
#pragma unroll
  for (int i = 0; i < 4; ++i) { float d = x[i] - mu; q += d * d; }
  float rs = rsqrtf(row16_sum(q) * (1.f / 64.f) + 64e-5f);
  float4 gw = *(const float4*)(p.in[24] + l * 512 + c4), gb = *(const float4*)(p.in[25] + l * 512 + c4);
  float gwv[4] = {gw.x, gw.y, gw.z, gw.w}, gbv[4] = {gb.x, gb.y, gb.z, gb.w};
  float bon[4], g[4];
  unpack4(*(const uint2*)((const u16*)(p.ws + OFF_RWBON) + o), bon);
  unpack4(*(const uint2*)((const u16*)(p.ws + OFF_RWG) + o), g);
  float y[4];
#pragma unroll
  for (int i = 0; i < 4; ++i) y[i] = ((x[i] - mu) * rs * gwv[i] + gbv[i] + bon[i]) * g[i];
  uint2 ov; ov.x = cvtpk(y[0], y[1]); ov.y = cvtpk(y[2], y[3]);
  *(uint2*)((u16*)(p.ws + OFF_ORW) + o) = ov;
  }
}

DEVI void ln2_item(const Params& p, int l, int it0) {
  const int lane = TIDX & 63, w = TIDX >> 6;
#pragma unroll 1
  for (int sub = 0; sub < 4; ++sub) {
  const int it = it0 * 4 + sub;
  const int tok = it * 4 + w;
  const float* y = (const float*)(p.ws + OFF_Y) + (size_t)tok * 1024;
  const float* mod = (const float*)(p.ws + OFF_MOD) + ((size_t)l * 3 + modrow(tok)) * 6144;
  float v[16];
  float s = 0.f;
#pragma unroll
  for (int i = 0; i < 4; ++i) { *(float4*)(v + i * 4) = *(const float4*)(y + lane * 4 + 256 * i); }
#pragma unroll
  for (int i = 0; i < 16; ++i) s += v[i];
  float mu = wave_sum(s) * (1.f / 1024.f);
  float q = 0.f;
#pragma unroll
  for (int i = 0; i < 16; ++i) { float d = v[i] - mu; q += d * d; }
  float rs = rsqrtf(wave_sum(q) * (1.f / 1024.f) + 1e-5f);
  float* X1 = (float*)(p.ws + OFF_X1) + (size_t)tok * 1024;
  s = 0.f;
#pragma unroll
  for (int i = 0; i < 4; ++i) {
    int c = lane * 4 + 256 * i;
    float4 g = *(const float4*)(p.in[28] + l * 1024 + c), bb = *(const float4*)(p.in[29] + l * 1024 + c);
    v[i * 4 + 0] = (v[i * 4 + 0] - mu) * rs * g.x + bb.x;
    v[i * 4 + 1] = (v[i * 4 + 1] - mu) * rs * g.y + bb.y;
    v[i * 4 + 2] = (v[i * 4 + 2] - mu) * rs * g.z + bb.z;
    v[i * 4 + 3] = (v[i * 4 + 3] - mu) * rs * g.w + bb.w;
    *(float4*)(X1 + c) = *(float4*)(v + i * 4);
    s += v[i * 4] + v[i * 4 + 1] + v[i * 4 + 2] + v[i * 4 + 3];
  }
  mu = wave_sum(s) * (1.f / 1024.f);
  q = 0.f;
#pragma unroll
  for (int i = 0; i < 16; ++i) { float d = v[i] - mu; q += d * d; }
  rs = rsqrtf(wave_sum(q) * (1.f / 1024.f) + 1e-5f);
  u16* H2 = (u16*)(p.ws + OFF_H2) + (size_t)tok * 1024;
#pragma unroll
  for (int i = 0; i < 4; ++i) {
    int c = lane * 4 + 256 * i;
    float4 sh = *(const float4*)(mod + 3072 + c), sc = *(const float4*)(mod + 4096 + c);
    uint2 o;
    o.x = cvtpk((v[i * 4] - mu) * rs * (1.f + sc.x) + sh.x, (v[i * 4 + 1] - mu) * rs * (1.f + sc.y) + sh.y);
    o.y = cvtpk((v[i * 4 + 2] - mu) * rs * (1.f + sc.z) + sh.z, (v[i * 4 + 3] - mu) * rs * (1.f + sc.w) + sh.w);
    *(uint2*)(H2 + c) = o;
  }
  }
}

DEVI int f2ord(float f) { int i = __float_as_int(f); return i ^ ((i >> 31) & 0x7fffffff); }
DEVI float ord2f(int i) { return __int_as_float(i ^ ((i >> 31) & 0x7fffffff)); }
DEVI void insert16(int (&t)[16], int x) {
#pragma unroll
  for (int i = 0; i < 16; ++i) { int hi = max(t[i], x); x = min(t[i], x); t[i] = hi; }
}
DEVI void insert16x2(int (&ta)[16], int xa, int (&tb)[16], int xb) {
#pragma unroll
  for (int i = 0; i < 16; ++i) {
    int ha = max(ta[i], xa), hb = max(tb[i], xb);
    xa = min(ta[i], xa); xb = min(tb[i], xb);
    ta[i] = ha; tb[i] = hb;
  }
}
DEVI void route_item(const Params& p, int l, int it, unsigned char* sm) {
  const int tid = TIDX, lane = tid & 63, w = tid >> 6;
  const int g = w >> 1, pp = w & 1;
  const int tb = it >> 3, h = it & 7;
  const int tok = tb * 128 + g * 64 + lane;
  float* kl = (float*)sm;
  const float* Q = (const float*)(p.ws + OFF_Q) + (size_t)tok * 1024 + h * 128 + pp * 64;
  float q[64];
#pragma unroll
  for (int i = 0; i < 16; ++i) *(float4*)(q + i * 4) = *(const float4*)(Q + i * 4);
  int T[16], TB[16];
#pragma unroll
  for (int i = 0; i < 16; ++i) { T[i] = (int)0x80000000; TB[i] = (int)0x80000000; }
  const float* keys = p.in[33] + (size_t)((l * 8 + h) * 2) * 8192;
  for (int half = 0; half < 2; ++half) {
    __syncthreads();
#pragma unroll
    for (int i = 0; i < 8; ++i) {
      int e = (i * 256 + tid) * 4;
      int ps = e >> 12, r = e & 4095;
      *(float4*)(kl + e) = *(const float4*)(keys + (size_t)ps * 8192 + half * 4096 + r);
    }
    __syncthreads();
    const float* kb = kl + pp * 4096;
#pragma unroll 1
    for (int k = 0; k < 64; k += 2) {
      const float* kp = kb + k * 64;
      typedef float f2 __attribute__((ext_vector_type(2)));
      f2 s01 = {0.f, 0.f}, s23 = {0.f, 0.f}, u01 = {0.f, 0.f}, u23 = {0.f, 0.f};
#pragma unroll
      for (int dh = 0; dh < 64; dh += 32) {
        float4 kv[8], kw[8];
#pragma unroll
        for (int i = 0; i < 8; ++i) { kv[i] = *(const float4*)(kp + dh + i * 4); kw[i] = *(const float4*)(kp + 64 + dh + i * 4); }
        asm volatile("" ::: "memory");
#pragma unroll
        for (int i = 0; i < 8; ++i) {
          const int d = dh + i * 4;
          const f2 qlo = {q[d], q[d + 1]}, qhi = {q[d + 2], q[d + 3]};
          const f2 klo = {kv[i].x, kv[i].y}, khi = {kv[i].z, kv[i].w}, wlo = {kw[i].x, kw[i].y}, whi = {kw[i].z, kw[i].w};
          s01 += qlo * klo; s23 += qhi * khi;
          u01 += qlo * wlo; u23 += qhi * whi;
        }
      }
      const float s0 = s01.x, s1 = s01.y, s2 = s23.x, s3 = s23.y, u0 = u01.x, u1 = u01.y, u2 = u23.x, u3 = u23.y;
      const int ka = half * 64 + k;
      const int ba = (f2ord((s0 + s1) + (s2 + s3)) & ~127) | (127 - ka);
      const int bb = (f2ord((u0 + u1) + (u2 + u3)) & ~127) | (127 - (ka + 1));
      insert16x2(T, ba, TB, bb);
    }
  }
#pragma unroll
  for (int i = 0; i < 16; ++i) insert16(T, TB[i]);
  __syncthreads();
  int* xb = (int*)sm;
  if (pp == 1) {
#pragma unroll
    for (int i = 0; i < 16; ++i) xb[(g * 16 + i) * 64 + lane] = T[i];
  }
  __syncthreads();
  if (pp == 0) {
    int T1[16];
#pragma unroll
    for (int i = 0; i < 16; ++i) T1[i] = xb[(g * 16 + i) * 64 + lane];
    int F[16];
#pragma unroll
    for (int i = 0; i < 16; ++i) F[i] = (int)0x80000000;
#pragma unroll
    for (int i = 0; i < 16; ++i) {
#pragma unroll
      for (int j = 0; j < 16; ++j) {
        if ((i + 1) * (j + 1) <= 16) {
          float c = ord2f(T[i] & ~127) + ord2f(T1[j] & ~127);
          int bits = (f2ord(c) & ~255) | (255 - (i * 16 + j));
          insert16(F, bits);
        }
      }
    }
    float fs[16], den = 0.f;
    const float f0 = ord2f(F[0] & ~255);
#pragma unroll
    for (int i = 0; i < 16; ++i) { fs[i] = __expf(ord2f(F[i] & ~255) - f0); den += fs[i]; }
    const float inv = 1.f / den;
    int* EIDX = (int*)(p.ws + OFF_EIDX) + (size_t)tok * 128 + h * 16;
    float* GATE = (float*)(p.ws + OFF_GATE) + (size_t)tok * 128 + h * 16;
    int eo[16]; float go[16];
#pragma unroll
    for (int i = 0; i < 16; ++i) {
      int pos = 255 - (F[i] & 255);
      int i0 = pos >> 4, j0 = pos & 15;
      int k0 = 0, k1 = 0;
#pragma unroll
      for (int c = 0; c < 16; ++c) {
        int a0 = 127 - (T[c] & 127), a1 = 127 - (T1[c] & 127);
        k0 = (i0 == c) ? a0 : k0;
        k1 = (j0 == c) ? a1 : k1;
      }
      eo[i] = k0 * 128 + k1;
      go[i] = fs[i] * inv;
    }
#pragma unroll
    for (int i = 0; i < 16; i += 4) {
      *(int4*)(EIDX + i) = make_int4(eo[i], eo[i + 1], eo[i + 2], eo[i + 3]);
      *(float4*)(GATE + i) = make_float4(go[i], go[i + 1], go[i + 2], go[i + 3]);
    }
  }
}

DEVI void fp8x16_to_f32(int4 r, float* f) {
  const int w[4] = {r.x, r.y, r.z, r.w};
#pragma unroll
  for (int i = 0; i < 4; ++i) {
    f32x2_ lo = __builtin_amdgcn_cvt_pk_f32_fp8(w[i], false);
    f32x2_ hi = __builtin_amdgcn_cvt_pk_f32_fp8(w[i], true);
    f[i * 4] = lo.x; f[i * 4 + 1] = lo.y; f[i * 4 + 2] = hi.x; f[i * 4 + 3] = hi.y;
  }
}
DEVI void expert_item(const Params& p, int l, int it) {
  const int lane = TIDX & 63;
  const int w = __builtin_amdgcn_readfirstlane(TIDX >> 6);
  const int tok = it * 4 + w;
  const u16* H2 = (const u16*)(p.ws + OFF_H2) + (size_t)tok * 1024;
  float hv[16];
  unpack8(*(const uint4*)(H2 + lane * 16), hv);
  unpack8(*(const uint4*)(H2 + lane * 16 + 8), hv + 8);
  const int* EIDX = (const int*)(p.ws + OFF_EIDX) + (size_t)tok * 128;
  const float* GATE = (const float*)(p.ws + OFF_GATE) + (size_t)tok * 128;
  const unsigned char* UB = (const unsigned char*)(p.ws + OFF_UB) + (size_t)l * UV_LSTRIDE;
  const unsigned char* VB = (const unsigned char*)(p.ws + OFF_VB) + (size_t)l * UV_LSTRIDE;
  const float* USC = (const float*)(p.ws + OFF_SC) + (0 * 2 + l) * 16384;
  const float* VSC = (const float*)(p.ws + OFF_SC) + (1 * 2 + l) * 16384;
  float f[16];
#pragma unroll
  for (int i = 0; i < 16; ++i) f[i] = 0.f;
  const int ei0 = EIDX[lane], ei1 = EIDX[64 + lane];
  const float ga0 = GATE[lane] * VSC[ei0], ga1 = GATE[64 + lane] * VSC[ei1];
  const float us0 = USC[ei0], us1 = USC[ei1];
  float dl0 = 0.f, dl1 = 0.f;
  int4 ba[8], bb[8];
#define ROW_LOAD(BUF, BASE, G)                                                                       \
  {                                                                                                  \
    const int src_ = ((G) < 8) ? ei0 : ei1;                                                          \
    _Pragma("unroll") for (int j = 0; j < 8; ++j) {                                                  \
      const int idx = __builtin_amdgcn_readlane(src_, (((G) & 7) << 3) + j);                         \
      BUF[j] = *(const int4*)(BASE + (size_t)idx * 1024 + lane * 16);                                \
    }                                                                                                \
  }
#define U_COMP(BUF, G)                                                                               \
  {                                                                                                  \
    const bool lo_ = (G) < 8;                                                                        \
    _Pragma("unroll") for (int j = 0; j < 8; ++j) {                                                  \
      const int ln_ = (((G) & 7) << 3) + j;                                                          \
      float uu[16];                                                                                  \
      fp8x16_to_f32(BUF[j], uu);                                                                     \
      float d0 = 0.f, d1 = 0.f;                                                                      \
      _Pragma("unroll") for (int i = 0; i < 16; i += 2) { d0 += uu[i] * hv[i]; d1 += uu[i + 1] * hv[i + 1]; } \
      float dd = row16_sum(d0 + d1);                                                                 \
      const float r0 = __int_as_float(__builtin_amdgcn_readlane(__float_as_int(dd), 0));            \
      const float r1 = __int_as_float(__builtin_amdgcn_readlane(__float_as_int(dd), 16));           \
      const float r2 = __int_as_float(__builtin_amdgcn_readlane(__float_as_int(dd), 32));           \
      const float r3 = __int_as_float(__builtin_amdgcn_readlane(__float_as_int(dd), 48));           \
      const float d = (r0 + r1) + (r2 + r3);                                                         \
      dl0 = (lo_ && lane == ln_) ? d : dl0;                                                          \
      dl1 = (!lo_ && lane == ln_) ? d : dl1;                                                         \
    }                                                                                                \
  }
#define V_COMP(BUF, G)                                                                               \
  {                                                                                                  \
    const float asrc_ = ((G) < 8) ? act0 : act1;                                                     \
    _Pragma("unroll") for (int j = 0; j < 8; ++j) {                                                  \
      const int ln_ = (((G) & 7) << 3) + j;                                                          \
      const float act = __int_as_float(__builtin_amdgcn_readlane(__float_as_int(asrc_), ln_));      \
      float vv[16];                                                                                  \
      fp8x16_to_f32(BUF[j], vv);                                                                     \
      _Pragma("unroll") for (int i = 0; i < 16; ++i) f[i] += act * vv[i];                            \
    }                                                                                                \
  }
  ROW_LOAD(ba, UB, 0);
#pragma unroll 1
  for (int g = 0; g < 16; g += 2) {
    ROW_LOAD(bb, UB, g + 1);
    U_COMP(ba, g);
    if (g + 2 < 16) { ROW_LOAD(ba, UB, g + 2); } else { ROW_LOAD(ba, VB, 0); }
    U_COMP(bb, g + 1);
  }
  const float x0 = dl0 * us0, x1 = dl1 * us1;
  const float act0 = 0.5f * x0 * (1.f + erff(x0 * 0.70710678118654752f)) * ga0;
  const float act1 = 0.5f * x1 * (1.f + erff(x1 * 0.70710678118654752f)) * ga1;
#pragma unroll 1
  for (int g = 0; g < 16; g += 2) {
    ROW_LOAD(bb, VB, g + 1);
    V_COMP(ba, g);
    if (g + 2 < 16) ROW_LOAD(ba, VB, g + 2);
    V_COMP(bb, g + 1);
  }
#undef ROW_LOAD
#undef U_COMP
#undef V_COMP
  const float* X1 = (const float*)(p.ws + OFF_X1) + (size_t)tok * 1024 + lane * 16;
  const float* mod = (const float*)(p.ws + OFF_MOD) + ((size_t)l * 3 + modrow(tok)) * 6144 + lane * 16;
  float y[16];
  float s = 0.f;
#pragma unroll
  for (int c = 0; c < 4; ++c) {
    float4 x = *(const float4*)(X1 + c * 4), gt = *(const float4*)(mod + 5120 + c * 4);
    int o = c * 4;
    y[o] = ALPHA * x.x + gt.x * f[o]; y[o + 1] = ALPHA * x.y + gt.y * f[o + 1];
    y[o + 2] = ALPHA * x.z + gt.z * f[o + 2]; y[o + 3] = ALPHA * x.w + gt.w * f[o + 3];
    s += y[o] + y[o + 1] + y[o + 2] + y[o + 3];
  }
  float mu = wave_sum(s) * (1.f / 1024.f);
  float q = 0.f;
#pragma unroll
  for (int i = 0; i < 16; ++i) { float d = y[i] - mu; q += d * d; }
  float rs = rsqrtf(wave_sum(q) * (1.f / 1024.f) + 1e-5f);
  float* xo = ((l == 1) ? ((float*)p.out + OUT_Y + (size_t)tok * 1024) : ((float*)(p.ws + OFF_X) + (size_t)tok * 1024)) + lane * 16;
  s = 0.f;
#pragma unroll
  for (int c = 0; c < 4; ++c) {
    int o = c * 4;
    float4 g = *(const float4*)(p.in[30] + l * 1024 + lane * 16 + o), bb = *(const float4*)(p.in[31] + l * 1024 + lane * 16 + o);
    y[o] = (y[o] - mu) * rs * g.x + bb.x; y[o + 1] = (y[o + 1] - mu) * rs * g.y + bb.y;
    y[o + 2] = (y[o + 2] - mu) * rs * g.z + bb.z; y[o + 3] = (y[o + 3] - mu) * rs * g.w + bb.w;
    *(float4*)(xo + o) = make_float4(y[o], y[o + 1], y[o + 2], y[o + 3]);
    s += y[o] + y[o + 1] + y[o + 2] + y[o + 3];
  }
  if (l == 0) {
    const float* mod1 = (const float*)(p.ws + OFF_MOD) + ((size_t)3 + modrow(tok)) * 6144 + lane * 16;
    mu = wave_sum(s) * (1.f / 1024.f);
    q = 0.f;
#pragma unroll
    for (int i = 0; i < 16; ++i) { float d = y[i] - mu; q += d * d; }
    rs = rsqrtf(wave_sum(q) * (1.f / 1024.f) + 1e-5f);
    u16* H = (u16*)(p.ws + OFF_H) + (size_t)tok * 1024 + lane * 16;
    float t[16];
#pragma unroll
    for (int c = 0; c < 4; ++c) {
      float4 sh = *(const float4*)(mod1 + c * 4), sc = *(const float4*)(mod1 + 1024 + c * 4);
      int o = c * 4;
      t[o] = (y[o] - mu) * rs * (1.f + sc.x) + sh.x; t[o + 1] = (y[o + 1] - mu) * rs * (1.f + sc.y) + sh.y;
      t[o + 2] = (y[o + 2] - mu) * rs * (1.f + sc.z) + sh.z; t[o + 3] = (y[o + 3] - mu) * rs * (1.f + sc.w) + sh.w;
    }
    *(uint4*)(H) = pack8(t);
    *(uint4*)(H + 8) = pack8(t + 8);
  }
}

constexpr int NPHASES = 22;
DEVI int phase_total(int idx) {
  if (idx == 0) return P0_TOTAL;
  if (idx == 1) return 2048;
  const int l = (idx - 2) / 10, t = (idx - 2) % 10;
  switch (t) {
    case 0: return 0;
    case 1: return 512 + 512;
    case 2: return MIX_TOTAL + (l == 0 ? (P0_NT + P0_NUV) : 0);
    case 3: return 512;
    case 4: return 0;
    case 5: return 0;
    case 6: return 512;
    case 7: return 0;
    case 8: return 512;
    default: return 2048;
  }
}
DEVI int phase_xcd_total(int idx) {
  if (idx < 2) return 0;
  const int t = (idx - 2) % 10;
  if (t == 0) return 504;
  if (t == 4 || t == 5 || t == 7) return 64;
  return 0;
}
DEVI void phase_item_x(const Params& p, int idx, int xcd, int q, unsigned char* sm) {
  const int l = (idx - 2) / 10, t = (idx - 2) % 10;
  const int it = (q >> 3) * 64 + xcd * 8 + (q & 7);
  if (t == 0) { if (PH_ON(2)) g1_item(p, l, it, sm); }
  else if (t == 4) { if (PH_ON(6)) g2_item(p, l, it, sm); }
  else if (t == 5) { if (PH_ON(7)) g3_item(p, l, it, sm); }
  else { if (PH_ON(9)) g4_item(p, l, it, sm); }
}
DEVI void phase_item(const Params& p, int idx, int it, unsigned char* sm) {
  if (idx == 0) { if (PH_ON(0)) phase0_item(p, it, sm); return; }
  if (idx == 1) { if (PH_ON(1)) ln1_item(p, it); return; }
  const int l = (idx - 2) / 10, t = (idx - 2) % 10;
  switch (t) {
    case 0: break;
    case 1: if (it < 512) { if (PH_ON(3)) rwprep_item(p, l, it); } else { if (PH_ON(4)) ret1_item(p, l, it - 512, sm); } break;
    case 2:
      if (it < MIX_TOTAL) mix_item(p, l, it, sm);
      else if (it < MIX_TOTAL + P0_NT) p0_tiles(p, 1, it - MIX_TOTAL, sm);
      else convert_uv_item(p, 1, it - MIX_TOTAL - P0_NT);
      break;
    case 3: if (PH_ON(5)) fin_item(p, l, it); break;
    case 4: break;
    case 5: break;
    case 6: if (PH_ON(8)) ln2_item(p, l, it); break;
    case 7: break;
    case 8: if (PH_ON(10)) route_item(p, l, it, sm); break;
    default: if (PH_ON(11)) expert_item(p, l, it); break;
  }
}

#define XB_TMO      128
#define XB_XCNT(j)  (256  + 64 * (j))
#define XB_XSUB(j)  (1280 + 64 * (j))
#define XB_XGEN(j)  (2304 + 64 * (j))
#define XB_TOP      3328
#define XB_TOPGEN   3392
#define XCD_BAR_WORDS 3456
#define XB_SPIN_CAP (1u << 18)
#define LAS __attribute__((address_space(3)))
DEVI unsigned xb_ld(unsigned* p) { return __hip_atomic_load(p, __ATOMIC_RELAXED, __HIP_MEMORY_SCOPE_AGENT); }
DEVI unsigned xb_add(unsigned* p, unsigned v) { return __hip_atomic_fetch_add(p, v, __ATOMIC_RELAXED, __HIP_MEMORY_SCOPE_AGENT); }
DEVI unsigned xb_xcc_id() { return (unsigned)__builtin_amdgcn_s_getreg((3 << 11) | 20) & 0xFu; }
#define XB_SPIN(cond, bar) do { unsigned _sp = 0; while (cond) { __builtin_amdgcn_s_sleep(1); \
    if ((++_sp & 255u) == 0u) { if (xb_ld(&(bar)[XB_TMO])) break; if (_sp > XB_SPIN_CAP) { atomicAdd(&(bar)[XB_TMO], 1u); break; } } } } while (0)
struct XcdBarrier { unsigned* bar; unsigned x; volatile LAS unsigned* st; };
DEVI XcdBarrier xcd_barrier_post(unsigned* bar, volatile LAS unsigned* st) {
  XcdBarrier b; b.bar = bar; b.x = xb_xcc_id(); b.st = st;
  if (threadIdx.x == 0) (void)xb_add(&bar[XB_XCNT(b.x)], 1u);
  return b;
}
DEVI void xcd_barrier_complete(unsigned* bar, unsigned x, unsigned& nloc, unsigned& nx) {
  const unsigned G = gridDim.x * gridDim.y * gridDim.z;
  unsigned sum, cnt, mine, sp = 0u;
  for (;;) {
    sum = 0u; cnt = 0u; mine = 0u;
#pragma unroll
    for (unsigned j = 0; j < 16; ++j) { const unsigned c = xb_ld(&bar[XB_XCNT(j)]); sum += c; cnt += (c > 0u) ? 1u : 0u; mine = (j == x) ? c : mine; }
    if (sum == G) break;
    __builtin_amdgcn_s_sleep(1);
    if ((++sp & 255u) == 0u) { if (xb_ld(&bar[XB_TMO])) break; if (sp > XB_SPIN_CAP) { atomicAdd(&bar[XB_TMO], 1u); break; } }
  }
  nloc = mine > 0u ? mine : 1u; nx = cnt > 0u ? cnt : 1u;
}
DEVI void xcd_barrier(const XcdBarrier& b) {
  asm volatile("s_waitcnt vmcnt(0)" ::: "memory");
  __syncthreads();
  if (threadIdx.x == 0) {
    unsigned* bar = b.bar;
    __builtin_amdgcn_s_waitcnt(0);
    unsigned nloc = b.st[0], nx = b.st[1];
    if (nloc == 0u) { xcd_barrier_complete(bar, b.x, nloc, nx); b.st[0] = nloc; b.st[1] = nx; }
    const unsigned old = xb_add(&bar[XB_XSUB(b.x)], 1u);
    const unsigned gen = old / nloc;
    if (old + 1u == (gen + 1u) * nloc) {
      __builtin_amdgcn_fence(__ATOMIC_RELEASE, "agent");
      asm volatile("s_waitcnt vmcnt(0)" ::: "memory");
      const unsigned og = xb_add(&bar[XB_TOP], 1u);
      const unsigned tg = og / nx;
      if (og + 1u == (tg + 1u) * nx) xb_add(&bar[XB_TOPGEN], 1u);
      else XB_SPIN(xb_ld(&bar[XB_TOPGEN]) == tg, bar);
      __builtin_amdgcn_fence(__ATOMIC_ACQUIRE, "agent");
      xb_add(&bar[XB_XGEN(b.x)], 1u);
      asm volatile("s_waitcnt vmcnt(0)" ::: "memory");
    } else {
      XB_SPIN(xb_ld(&bar[XB_XGEN(b.x)]) == gen, bar);
      __builtin_amdgcn_fence(__ATOMIC_ACQUIRE, "agent");
      asm volatile("s_waitcnt vmcnt(0)" ::: "memory");
    }
  }
  __syncthreads();
}

__global__ void __launch_bounds__(256, 2) __attribute__((amdgpu_waves_per_eu(2, 2))) mega_kernel(KArgs ka, int ph_lo, int ph_hi) {
  __shared__ __attribute__((aligned(16))) unsigned char sm[57344];
  __shared__ int s_item;
  __shared__ g_cf32* s_in[36];
  __shared__ __attribute__((aligned(16))) unsigned s_xb[4];
  cg::grid_group grid = cg::this_grid();
  if (threadIdx.x < 4) s_xb[threadIdx.x] = 0u;
  __shared__ int s_first;
  if (threadIdx.x == 0) {
    const unsigned hw = (unsigned)__builtin_amdgcn_s_getreg((31 << 11) | 4);
    const unsigned key = (xb_xcc_id() << 8) | ((hw >> 8) & 0xFFu);
    s_first = (atomicAdd((int*)(ka.ws + OFF_CUT) + key, 1) == 0) ? 1 : 0;
  }
  if (threadIdx.x < 36) {
    const float* const* kp = (const float* const*)__builtin_amdgcn_kernarg_segment_ptr();
    s_in[threadIdx.x] = (g_cf32*)kp[threadIdx.x];
  }
  __syncthreads();
  Params p;
  p.in.t = s_in; p.out = (g_f32*)ka.out; p.ws = (g_u8*)ka.ws;
  int* ctr = (int*)(p.ws + OFF_CTR);
  const XcdBarrier xb = xcd_barrier_post((unsigned*)(p.ws + OFF_BAR), (volatile LAS unsigned*)s_xb);
  for (int idx = ph_lo; idx < ph_hi; ++idx) {
    const int total = phase_total(idx);
#ifdef PROBE_T
    const int ptype = idx < 2 ? idx : 2 + (idx - 2) % 10;
    const int reps = (ptype == PROBE_T) ? 2 : 1;
#else
    const int reps = 1;
#endif
    for (int rep = 0; rep < reps; ++rep) {
      const bool is_mix = (idx >= 2) && ((idx - 2) % 10 == 2);
      auto scan_queue = [&]() {
        const int l_ = (idx - 2) / 10;
        while (true) {
          __syncthreads();
          if (TIDX == 0) s_item = atomicAdd(&ctr[960 + (rep * 2 + l_) * 8 + (blockIdx.x & 7)], 1);
          __syncthreads();
          const int it = s_item * 8 + (blockIdx.x & 7);
          if (it >= MIX_NSCAN_LAT) break;
          Params q = p;
          asm volatile("" : "+s"(q.ws));
          asm volatile("" : "+s"(q.out));
          asm volatile("" : "+s"(q.in.t));
          mix_scan_item(q, l_, it, sm);
        }
      };
      if (is_mix && s_first) scan_queue();
      const int nx = phase_xcd_total(idx);
      if (nx) {
        const int xcd = blockIdx.x & 7;
        while (true) {
          __syncthreads();
          if (TIDX == 0) s_item = atomicAdd(&ctr[64 + (idx + 32 * rep) * 8 + xcd], 1);
          __syncthreads();
          const int q_ = s_item;
          if (q_ >= nx) break;
          Params q = p;
          asm volatile("" : "+s"(q.ws));
          asm volatile("" : "+s"(q.out));
          asm volatile("" : "+s"(q.in.t));
          phase_item_x(q, idx, xcd, q_, sm);
        }
      }
      while (true) {
        __syncthreads();
        if (TIDX == 0) s_item = atomicAdd(&ctr[512 + (idx + 32 * rep) * 8 + (blockIdx.x & 7)], 1);
        __syncthreads();
        const int it = s_item * 8 + (blockIdx.x & 7);
        if (it >= total) break;
        Params q = p;
        asm volatile("" : "+s"(q.ws));
        asm volatile("" : "+s"(q.out));
        asm volatile("" : "+s"(q.in.t));
        phase_item(q, idx, it, sm);
      }
      if (is_mix) scan_queue();
      if (rep + 1 < reps) xcd_barrier(xb);
    }
    if (idx + 1 < ph_hi) {
      if (ph_lo < 0) grid.sync();
      xcd_barrier(xb);
    }
  }
}

#ifndef MULTI_LAUNCH
#define MULTI_LAUNCH 0
#endif

extern "C" void kernel_launch(void* const* d_in, const int* in_sizes, int n_in, void* d_out, int out_size, void* d_ws,
                              size_t ws_size, hipStream_t stream) {
  static int grid_blocks = 0;
  if (!grid_blocks) {
    int dev = 0, cus = 0, per_cu = 0;
    hipGetDevice(&dev);
    hipDeviceGetAttribute(&cus, hipDeviceAttributeMultiprocessorCount, dev);
    hipOccupancyMaxActiveBlocksPerMultiprocessor(&per_cu, mega_kernel, 256, 0);
    if (per_cu > 2) per_cu = 2;
    if (per_cu < 1) per_cu = 1;
    grid_blocks = cus * per_cu;
  }
  KArgs p{};
  for (int i = 0; i < 36; ++i) p.in[i] = (const float*)d_in[i];
  p.out = (float*)d_out;
  p.ws = (unsigned char*)d_ws;
  if (ws_size < OFF_END) { fprintf(stderr, "workspace too small: %zu < %zu\n", ws_size, (size_t)OFF_END); return; }
  hipMemsetAsync(d_ws, 0, 4096, stream);
  hipMemsetAsync((unsigned char*)d_ws + OFF_BAR, 0, 16384, stream);
  hipMemsetAsync((unsigned char*)d_ws + OFF_CUT, 0, 8192, stream);
#if MULTI_LAUNCH
  for (int ph = 0; ph < NPHASES; ++ph) {
    hipLaunchKernelGGL(mega_kernel, dim3(grid_blocks), dim3(256), 0, stream, p, ph, ph + 1);
  }
#else
  int lo = 0, hi = NPHASES;
  void* args[] = {&p, &lo, &hi};
  hipError_t e = hipLaunchCooperativeKernel((void*)mega_kernel, dim3(grid_blocks), dim3(256), args, 0, stream);
  if (e != hipSuccess) fprintf(stderr, "cooperative launch failed: %s (grid %d)\n", hipGetErrorString(e), grid_blocks);
#endif
}
```

```cpp
#include <hip/hip_runtime.h>
#include <hip/hip_bf16.h>
#include <hip/hip_cooperative_groups.h>
#include <cstdio>
namespace cg = cooperative_groups;

typedef unsigned short u16;
using bf16x8 = __attribute__((ext_vector_type(8))) short;
using f32x4 = __attribute__((ext_vector_type(4))) float;
#define DEVI __device__ __forceinline__
__device__ __forceinline__ int ltid_() { int t = threadIdx.x; asm volatile("" : "+v"(t)); return t; }
#define TIDX ltid_()

constexpr int NTOK = 8192;
constexpr int PIN = 8064;
constexpr float ALPHA = 1.4142135623730951f;
constexpr size_t OUT_Y = 0;
constexpr size_t OUT_NAK = 8388608;
constexpr size_t OUT_NAV = 12582912;
constexpr size_t OUT_SRET = 16777216;
constexpr size_t OUT_SRW = 18874368;
constexpr size_t OFF_CTR = 0;
constexpr size_t OFF_TAB = 4096;
constexpr size_t OFF_MOD = 16384;
constexpr size_t OFF_WINT = 1048576;
constexpr size_t OFF_WBRT = OFF_WINT + 33030144;
constexpr size_t OFF_WOUTT = OFF_WBRT + 6291456;
constexpr size_t OFF_WQT = OFF_WOUTT + 4194304;
constexpr size_t OFF_WUPT = OFF_WQT + 4194304;
constexpr size_t OFF_AUPT = OFF_WUPT + 262144;
constexpr size_t OFF_GUPT = OFF_AUPT + 262144;
constexpr size_t OFF_UB = OFF_GUPT + 262144;
constexpr size_t OFF_VB = OFF_UB + 33554432;
constexpr size_t OFF_Z = OFF_VB + 33554432;
constexpr size_t OFF_X = OFF_Z + 132120576;
constexpr size_t OFF_H = OFF_X + 33554432;
constexpr size_t OFF_ONA = OFF_H + 16777216;
constexpr size_t OFF_ORT = OFF_ONA + 8388608;
constexpr size_t OFF_ORW = OFF_ORT + 8388608;
constexpr size_t OFF_GA = OFF_ORW + 8388608;
constexpr size_t SZB = 8388608;
constexpr size_t OFF_RWW = OFF_GA;
constexpr size_t OFF_RWR = OFF_RWW + 4 * SZB;
constexpr size_t OFF_RWV = OFF_RWR + SZB;
constexpr size_t OFF_RWKK = OFF_RWV + SZB;
constexpr size_t OFF_RWKC = OFF_RWKK + SZB;
constexpr size_t OFF_RWKD = OFF_RWKC + SZB;
constexpr size_t OFF_RWKKA = OFF_RWKD + 2 * SZB;
constexpr size_t OFF_RWG = OFF_RWKKA + 2 * SZB;
constexpr size_t OFF_RWBON = OFF_RWG + SZB;
constexpr size_t OFF_OF = OFF_RWBON + SZB;
constexpr size_t OFF_KV = OFF_OF + 4 * SZB;
constexpr size_t OFF_BAR = OFF_KV + 33554432;
constexpr size_t OFF_SC = OFF_BAR + 16384;
constexpr size_t OFF_CUT = OFF_SC + 4 * 65536;
constexpr size_t OFF_END = OFF_CUT + 8192;
constexpr size_t OFF_Y = OFF_GA;
constexpr size_t OFF_X1 = OFF_GA + 33554432;
constexpr size_t OFF_Q = OFF_GA + 2 * 33554432;
constexpr size_t OFF_H2 = OFF_GA + 3 * 33554432;
constexpr size_t OFF_EIDX = OFF_H2 + 16777216;
constexpr size_t OFF_GATE = OFF_EIDX + 4194304;

constexpr size_t UV_LSTRIDE = 16777216;
struct KArgs {
  const float* in[36];
  float* out;
  unsigned char* ws;
};
typedef __attribute__((address_space(1))) unsigned char g_u8;
typedef __attribute__((address_space(1))) float g_f32;
typedef const __attribute__((address_space(1))) float g_cf32;
struct InTab {
  g_cf32* const* t;
  DEVI const float* operator[](int k) const { return (const float*)t[k]; }
};
struct Params {
  InTab in;
  g_f32* out;
  g_u8* ws;
};
DEVI const float* uniform_ptr(const float* q) {
  unsigned long long v = (unsigned long long)q;
  unsigned lo = __builtin_amdgcn_readfirstlane((unsigned)v), hi = __builtin_amdgcn_readfirstlane((unsigned)(v >> 32));
  return (const float*)(((unsigned long long)hi << 32) | lo);
}

DEVI float bf2f(u16 h) { return __uint_as_float(((unsigned)h) << 16); }
DEVI unsigned cvtpk(float lo, float hi) {
  unsigned r;
  asm volatile("v_cvt_pk_bf16_f32 %0, %1, %2" : "=v"(r) : "v"(lo), "v"(hi));
  return r;
}
DEVI u16 f2bf(float f) { return (u16)(cvtpk(f, f) & 0xffffu); }
DEVI float sigmoidf_(float x) { return 1.f / (1.f + __expf(-x)); }
template <int CTRL> DEVI float dpp(float x) {
  return __builtin_bit_cast(float, __builtin_amdgcn_update_dpp(0, __builtin_bit_cast(int, x), CTRL, 0xf, 0xf, true));
}
DEVI float quad_sum(float x) { x += dpp<0xB1>(x); x += dpp<0x4E>(x); return x; }
DEVI float row16_sum(float x) { x = quad_sum(x); x += dpp<0x141>(x); x += dpp<0x140>(x); return x; }
DEVI float wave_sum(float x) { x = row16_sum(x); x += __shfl_xor(x, 16); x += __shfl_xor(x, 32); return x; }
DEVI void unpack8(uint4 v, float* f) {
  f[0] = __uint_as_float(v.x << 16); f[1] = __uint_as_float(v.x & 0xffff0000u);
  f[2] = __uint_as_float(v.y << 16); f[3] = __uint_as_float(v.y & 0xffff0000u);
  f[4] = __uint_as_float(v.z << 16); f[5] = __uint_as_float(v.z & 0xffff0000u);
  f[6] = __uint_as_float(v.w << 16); f[7] = __uint_as_float(v.w & 0xffff0000u);
}
DEVI void unpack4(uint2 v, float* f) {
  f[0] = __uint_as_float(v.x << 16); f[1] = __uint_as_float(v.x & 0xffff0000u);
  f[2] = __uint_as_float(v.y << 16); f[3] = __uint_as_float(v.y & 0xffff0000u);
}
DEVI uint4 pack8(const float* f) {
  uint4 r; r.x = cvtpk(f[0], f[1]); r.y = cvtpk(f[2], f[3]); r.z = cvtpk(f[4], f[5]); r.w = cvtpk(f[6], f[7]); return r;
}
DEVI f32x4 mfma16(bf16x8 a, bf16x8 b, f32x4 c) { return __builtin_amdgcn_mfma_f32_16x16x32_bf16(a, b, c, 0, 0, 0); }
DEVI int modrow(int tok) { return tok < 4096 ? 0 : 1 + ((tok - 4096) >> 11); }
DEVI const float* xin_row(const Params& p, int tok) {
  return tok < 4096 ? p.in[0] + (size_t)tok * 1024 : p.in[1] + (size_t)(tok - 4096) * 1024;
}
DEVI int clampi(int v, int lo, int hi) { return v < lo ? lo : (v > hi ? hi : v); }

template <int NT> DEVI void wave_mma(const u16* A, int lda, const u16* B, int ldb, int K, f32x4* acc) {
  const int lane = TIDX & 63, fr = lane & 15, fq = lane >> 4;
  for (int k0 = 0; k0 < K; k0 += 32) {
    bf16x8 a = *(const bf16x8*)(A + fr * lda + k0 + fq * 8);
#pragma unroll
    for (int n = 0; n < NT; ++n) {
      bf16x8 b = *(const bf16x8*)(B + (n * 16 + fr) * ldb + k0 + fq * 8);
      acc[n] = mfma16(a, b, acc[n]);
    }
  }
}

#define LDS_RD(dst, addr, off) asm volatile("ds_read_b128 %0, %1 offset:" #off : "=v"(dst) : "v"(addr))
DEVI void gemm_acc(const u16* __restrict__ A, int lda, const u16* __restrict__ Bt, int ldb, int K, int m0, int n0,
                   unsigned char* sm, f32x4 (&acc)[4][4]) {
  const int tid = TIDX, lane = tid & 63, wid = tid >> 6, wr = wid >> 1, wc = wid & 1, fr = lane & 15, fq = lane >> 4;
  const int nk = K >> 5;
  const int b0 = tid * 16, r0 = b0 >> 6, c0 = (b0 & 63) >> 1;
  const u16* Ap = A + (size_t)(m0 + r0) * lda + c0;
  const u16* Bp = Bt + (size_t)(n0 + r0) * ldb + c0;
  const unsigned lbase = (unsigned)(size_t)(__attribute__((address_space(3))) unsigned char*)sm;
  const unsigned aoff = lbase + (wr * 64 + fr) * 64 + fq * 16;
  const unsigned boff = lbase + 8192 + (wc * 64 + fr) * 64 + fq * 16;
  auto issue = [&](int kt, int st) {
    unsigned char* SA = sm + st * 16384;
    unsigned char* SB = SA + 8192;
    __builtin_amdgcn_global_load_lds((const unsigned*)(Ap + kt * 32), (__attribute__((address_space(3))) unsigned*)(SA + b0), 16, 0, 0);
    __builtin_amdgcn_global_load_lds((const unsigned*)(Ap + (size_t)64 * lda + kt * 32), (__attribute__((address_space(3))) unsigned*)(SA + b0 + 4096), 16, 0, 0);
    __builtin_amdgcn_global_load_lds((const unsigned*)(Bp + kt * 32), (__attribute__((address_space(3))) unsigned*)(SB + b0), 16, 0, 0);
    __builtin_amdgcn_global_load_lds((const unsigned*)(Bp + (size_t)64 * ldb + kt * 32), (__attribute__((address_space(3))) unsigned*)(SB + b0 + 4096), 16, 0, 0);
  };
  issue(0, 0);
  if (nk > 1) issue(1, 1);
  int st = 0;
  for (int kt = 0; kt < nk; ++kt) {
    if (kt + 1 < nk) asm volatile("s_waitcnt vmcnt(4)\n\ts_barrier" ::: "memory");
    else asm volatile("s_waitcnt vmcnt(0)\n\ts_barrier" ::: "memory");
    if (kt + 2 < nk) { int s2 = st + 2; if (s2 >= 3) s2 -= 3; issue(kt + 2, s2); }
    const unsigned aa = aoff + st * 16384, bb = boff + st * 16384;
    bf16x8 a0, a1, a2, a3, b0_, b1_, b2_, b3_;
    LDS_RD(a0, aa, 0); LDS_RD(b0_, bb, 0); LDS_RD(b1_, bb, 1024); LDS_RD(b2_, bb, 2048); LDS_RD(b3_, bb, 3072);
    LDS_RD(a1, aa, 1024); LDS_RD(a2, aa, 2048); LDS_RD(a3, aa, 3072);
    asm volatile("s_waitcnt lgkmcnt(0)" : "+v"(a0), "+v"(a1), "+v"(a2), "+v"(a3), "+v"(b0_), "+v"(b1_), "+v"(b2_), "+v"(b3_));
    acc[0][0] = mfma16(a0, b0_, acc[0][0]); acc[0][1] = mfma16(a0, b1_, acc[0][1]);
    acc[0][2] = mfma16(a0, b2_, acc[0][2]); acc[0][3] = mfma16(a0, b3_, acc[0][3]);
    acc[1][0] = mfma16(a1, b0_, acc[1][0]); acc[1][1] = mfma16(a1, b1_, acc[1][1]);
    acc[1][2] = mfma16(a1, b2_, acc[1][2]); acc[1][3] = mfma16(a1, b3_, acc[1][3]);
    acc[2][0] = mfma16(a2, b0_, acc[2][0]); acc[2][1] = mfma16(a2, b1_, acc[2][1]);
    acc[2][2] = mfma16(a2, b2_, acc[2][2]); acc[2][3] = mfma16(a2, b3_, acc[2][3]);
    acc[3][0] = mfma16(a3, b0_, acc[3][0]); acc[3][1] = mfma16(a3, b1_, acc[3][1]);
    acc[3][2] = mfma16(a3, b2_, acc[3][2]); acc[3][3] = mfma16(a3, b3_, acc[3][3]);
    st = (st == 2) ? 0 : st + 1;
  }
  __syncthreads();
}
#define EPI_LOOP                                                                                         \
  const int _lane = TIDX & 63, _wid = TIDX >> 6, _wr = _wid >> 1, _wc = _wid & 1, _fr = _lane & 15, \
            _fq = _lane >> 4;                                                                            \
  _Pragma("unroll") for (int m = 0; m < 4; ++m) _Pragma("unroll") for (int n = 0; n < 4; ++n)            \
      _Pragma("unroll") for (int j = 0; j < 4; ++j)
#define EPI_ROW (m0 + _wr * 64 + m * 16 + _fq * 4 + j)
#define EPI_COL (n0 + _wc * 64 + n * 16 + _fr)

DEVI void zero_acc(f32x4 (&acc)[4][4]) {
#pragma unroll
  for (int m = 0; m < 4; ++m)
#pragma unroll
    for (int n = 0; n < 4; ++n) acc[m][n] = f32x4{0.f, 0.f, 0.f, 0.f};
}

__constant__ double ROPE_FREQ[16] = {1.0, 0.5623413251903491, 0.31622776601683794, 0.1778279410038923, 0.1,
                                     0.05623413251903491, 0.03162277660168379, 0.01778279410038923, 0.01,
                                     0.005623413251903491, 0.0031622776601683794, 0.0017782794100389228, 0.001,
                                     0.0005623413251903491, 0.00031622776601683794, 0.00017782794100389227};

DEVI void transpose_tile(const float* __restrict__ src, int K, int N, u16* __restrict__ dst, int kt, int nt, unsigned char* sm) {
  float* tile = (float*)sm;
  const int tid = TIDX;
  const int k0 = kt * 64, n0 = nt * 64;
#pragma unroll
  for (int i = 0; i < 16; ++i) {
    int kk = i * 4 + (tid >> 6), nn = tid & 63;
    tile[kk * 65 + nn] = src[(size_t)(k0 + kk) * N + n0 + nn];
  }
  __syncthreads();
#pragma unroll
  for (int i = 0; i < 16; ++i) {
    int nn = i * 4 + (tid >> 6), kk = tid & 63;
    dst[(size_t)(n0 + nn) * K + k0 + kk] = f2bf(tile[kk * 65 + nn]);
  }
}

typedef float f32x2_ __attribute__((ext_vector_type(2)));
DEVI void convert_uv_item(const Params& p, int l, int it) {
  const int which = it >> 9, chunk = it & 511;
  const int lane = TIDX & 63, w = TIDX >> 6;
#pragma unroll 2
  for (int sub = 0; sub < 8; ++sub) {
  const int row = chunk * 32 + sub * 4 + w;
  const float* src = p.in[34 + which] + (size_t)l * 16777216 + (size_t)row * 1024 + lane * 16;
  unsigned char* base = (unsigned char*)(p.ws + (which ? OFF_VB : OFF_UB)) + (size_t)l * UV_LSTRIDE;
  float v[16];
#pragma unroll
  for (int i = 0; i < 4; ++i) *(float4*)(v + i * 4) = *(const float4*)(src + i * 4);
  float am = 0.f;
#pragma unroll
  for (int i = 0; i < 16; ++i) am = fmaxf(am, fabsf(v[i]));
  am = fmaxf(am, dpp<0xB1>(am)); am = fmaxf(am, dpp<0x4E>(am)); am = fmaxf(am, dpp<0x141>(am)); am = fmaxf(am, dpp<0x140>(am));
  am = fmaxf(am, __shfl_xor(am, 16)); am = fmaxf(am, __shfl_xor(am, 32));
  const float sc = (am > 0.f) ? (240.f / am) : 1.f;
  int o[4];
#pragma unroll
  for (int i = 0; i < 4; ++i) {
    int wv = 0;
    wv = __builtin_amdgcn_cvt_pk_fp8_f32(v[i * 4] * sc, v[i * 4 + 1] * sc, wv, false);
    wv = __builtin_amdgcn_cvt_pk_fp8_f32(v[i * 4 + 2] * sc, v[i * 4 + 3] * sc, wv, true);
    o[i] = wv;
  }
  *(int4*)(base + (size_t)row * 1024 + lane * 16) = make_int4(o[0], o[1], o[2], o[3]);
  if (lane == 0) ((float*)(p.ws + OFF_SC))[(which * 2 + l) * 16384 + row] = am * (1.f / 240.f);
  }
}

constexpr int P0_NT = 740;
constexpr int P0_NUV = 1024;
constexpr int P0_NMOD = 192;
constexpr int P0_TOTAL = P0_NMOD + P0_NT + P0_NUV + 1;

constexpr int P0_TILES_L = 2960;
constexpr int P0_NT_ITEMS = P0_TILES_L / 4;
DEVI void p0_tile1(const Params& p, int l, int u, unsigned char* sm) {
  const float* src; u16* dst; int K, N, kt, nt;
  if (u < 2016) { kt = u / 126; nt = u % 126; K = 1024; N = 8064;
    src = p.in[10] + (size_t)l * 1024 * 8064; dst = (u16*)(p.ws + OFF_WINT) + (size_t)l * 8064 * 1024; }
  else if ((u -= 2016) < 384) { int j = l * 3 + u / 128, r = u % 128; kt = r / 16; nt = r % 16; K = 512; N = 1024;
    src = p.in[26] + (size_t)j * 512 * 1024; dst = (u16*)(p.ws + OFF_WBRT) + (size_t)j * 1024 * 512; }
  else if ((u -= 384) < 256) { kt = u / 16; nt = u % 16; K = 1024; N = 1024;
    src = p.in[27] + (size_t)l * 1048576; dst = (u16*)(p.ws + OFF_WOUTT) + (size_t)l * 1048576; }
  else if ((u -= 256) < 256) { kt = u / 16; nt = u % 16; K = 1024; N = 1024;
    src = p.in[32] + (size_t)l * 1048576; dst = (u16*)(p.ws + OFF_WQT) + (size_t)l * 1048576; }
  else if ((u -= 256) < 16) { int j = l * 2 + u / 8; kt = 0; nt = u % 8; K = 64; N = 512;
    src = p.in[17] + (size_t)j * 32768; dst = (u16*)(p.ws + OFF_WUPT) + (size_t)j * 32768; }
  else if ((u -= 16) < 16) { int j = l * 2 + u / 8; kt = 0; nt = u % 8; K = 64; N = 512;
    src = p.in[19] + (size_t)j * 32768; dst = (u16*)(p.ws + OFF_AUPT) + (size_t)j * 32768; }
  else { u -= 16; kt = u / 8; nt = u % 8; K = 128; N = 512;
    src = p.in[20] + (size_t)l * 65536; dst = (u16*)(p.ws + OFF_GUPT) + (size_t)l * 65536; }
  transpose_tile(src, K, N, dst, kt, nt, sm);
}
DEVI void p0_tiles(const Params& p, int l, int item, unsigned char* sm) {
  for (int i = 0; i < 4; ++i) {
    if (i) __syncthreads();
    p0_tile1(p, l, item * 4 + i, sm);
  }
}
DEVI void phase0_item(const Params& p, int it, unsigned char* sm) {
  const int tid = TIDX;
  if (it < P0_NMOD) {
    const int l = it / 96, n0 = (it % 96) * 64;
    const int kg = tid >> 4, c4 = (tid & 15) * 4;
    float acc[3][4];
#pragma unroll
    for (int r = 0; r < 3; ++r)
#pragma unroll
      for (int i = 0; i < 4; ++i) acc[r][i] = 0.f;
    const float* wm = p.in[8] + (size_t)l * 1024 * 6144;
#pragma unroll 8
    for (int k = kg * 64; k < kg * 64 + 64; ++k) {
      float4 w = *(const float4*)(wm + (size_t)k * 6144 + n0 + c4);
      float c0 = p.in[7][k], c1 = p.in[6][k], c2 = p.in[6][1024 + k];
      float s0 = c0 * sigmoidf_(c0), s1 = c1 * sigmoidf_(c1), s2 = c2 * sigmoidf_(c2);
      acc[0][0] += s0 * w.x; acc[0][1] += s0 * w.y; acc[0][2] += s0 * w.z; acc[0][3] += s0 * w.w;
      acc[1][0] += s1 * w.x; acc[1][1] += s1 * w.y; acc[1][2] += s1 * w.z; acc[1][3] += s1 * w.w;
      acc[2][0] += s2 * w.x; acc[2][1] += s2 * w.y; acc[2][2] += s2 * w.z; acc[2][3] += s2 * w.w;
    }
    float* red = (float*)sm;
#pragma unroll
    for (int r = 0; r < 3; ++r)
#pragma unroll
      for (int i = 0; i < 4; ++i) red[(kg * 3 + r) * 64 + c4 + i] = acc[r][i];
    __syncthreads();
    if (tid < 192) {
      int r = tid >> 6, col = tid & 63;
      float s = p.in[9][(size_t)l * 6144 + n0 + col];
      for (int g = 0; g < 16; ++g) s += red[(g * 3 + r) * 64 + col];
      ((float*)(p.ws + OFF_MOD))[((size_t)l * 3 + r) * 6144 + n0 + col] = s;
    }
    return;
  }
  it -= P0_NMOD;
  if (it < P0_NT) {
    p0_tiles(p, 0, it, sm);
    return;
  }
  if (0) {
    int t = it;
    const float* src; u16* dst; int K, N, kt, nt;
    if (t < 4032) { int l = t / 2016, r = t % 2016; kt = r / 126; nt = r % 126; K = 1024; N = 8064;
      src = p.in[10] + (size_t)l * 1024 * 8064; dst = (u16*)(p.ws + OFF_WINT) + (size_t)l * 8064 * 1024; }
    else if ((t -= 4032) < 768) { int j = t / 128, r = t % 128; kt = r / 16; nt = r % 16; K = 512; N = 1024;
      src = p.in[26] + (size_t)j * 512 * 1024; dst = (u16*)(p.ws + OFF_WBRT) + (size_t)j * 1024 * 512; }
    else if ((t -= 768) < 512) { int l = t / 256, r = t % 256; kt = r / 16; nt = r % 16; K = 1024; N = 1024;
      src = p.in[27] + (size_t)l * 1048576; dst = (u16*)(p.ws + OFF_WOUTT) + (size_t)l * 1048576; }
    else if ((t -= 512) < 512) { int l = t / 256, r = t % 256; kt = r / 16; nt = r % 16; K = 1024; N = 1024;
      src = p.in[32] + (size_t)l * 1048576; dst = (u16*)(p.ws + OFF_WQT) + (size_t)l * 1048576; }
    else if ((t -= 512) < 32) { int j = t / 8; kt = 0; nt = t % 8; K = 64; N = 512;
      src = p.in[17] + (size_t)j * 32768; dst = (u16*)(p.ws + OFF_WUPT) + (size_t)j * 32768; }
    else if ((t -= 32) < 32) { int j = t / 8; kt = 0; nt = t % 8; K = 64; N = 512;
      src = p.in[19] + (size_t)j * 32768; dst = (u16*)(p.ws + OFF_AUPT) + (size_t)j * 32768; }
    else { t -= 32; int l = t / 16, r = t % 16; kt = r / 8; nt = r % 8; K = 128; N = 512;
      src = p.in[20] + (size_t)l * 65536; dst = (u16*)(p.ws + OFF_GUPT) + (size_t)l * 65536; }
    transpose_tile(src, K, N, dst, kt, nt, sm);
    return;
  }
  it -= P0_NT;
  if (it < P0_NUV) { convert_uv_item(p, 0, it); return; }
  float* tab = (float*)(p.ws + OFF_TAB);
  for (int e = tid; e < 1024; e += 256) {
    int pos = e >> 4, f = e & 15;
    double rev = (double)pos * ROPE_FREQ[f] * 0.15915494309189535;
    rev -= floor(rev);
    float rf = (float)rev;
    tab[e] = __builtin_amdgcn_cosf(rf);
    tab[1024 + e] = __builtin_amdgcn_sinf(rf);
  }
}

DEVI void ln1_item(const Params& p, int it) {
  const int lane = TIDX & 63, w = TIDX >> 6;
  const int tok = it * 4 + w;
  const float* x = xin_row(p, tok);
  const float* mod = (const float*)(p.ws + OFF_MOD) + (size_t)modrow(tok) * 6144;
  float4 v[4];
  float s = 0.f;
#pragma unroll
  for (int i = 0; i < 4; ++i) { v[i] = *(const float4*)(x + lane * 4 + 256 * i); s += v[i].x + v[i].y + v[i].z + v[i].w; }
  float mu = wave_sum(s) * (1.f / 1024.f);
  float q = 0.f;
#pragma unroll
  for (int i = 0; i < 4; ++i) { float a = v[i].x - mu, b = v[i].y - mu, c = v[i].z - mu, d = v[i].w - mu; q += a * a + b * b + c * c + d * d; }
  float rs = rsqrtf(wave_sum(q) * (1.f / 1024.f) + 1e-5f);
  u16* H = (u16*)(p.ws + OFF_H) + (size_t)tok * 1024;
#pragma unroll
  for (int i = 0; i < 4; ++i) {
    int c = lane * 4 + 256 * i;
    float4 sh = *(const float4*)(mod + c), sc = *(const float4*)(mod + 1024 + c);
    uint2 o;
    o.x = cvtpk((v[i].x - mu) * rs * (1.f + sc.x) + sh.x, (v[i].y - mu) * rs * (1.f + sc.y) + sh.y);
    o.y = cvtpk((v[i].z - mu) * rs * (1.f + sc.z) + sh.z, (v[i].w - mu) * rs * (1.f + sc.w) + sh.w);
    *(uint2*)(H + c) = o;
  }
}

DEVI void g1_item(const Params& p, int l, int it, unsigned char* sm) {
  const int nt = it >> 6, mt = it & 63;
  const int m0 = mt * 128, n0 = nt * 128;
  f32x4 acc[4][4];
  zero_acc(acc);
  gemm_acc((const u16*)(p.ws + OFF_H), 1024, (const u16*)(p.ws + OFF_WINT) + (size_t)l * 8064 * 1024, 1024, 1024, m0, n0, sm, acc);
  u16* Z = (u16*)(p.ws + OFF_Z);
  EPI_LOOP {
    int row = EPI_ROW, col = EPI_COL;
    float v = acc[m][n][j];
    Z[(size_t)row * PIN + col] = f2bf(v);
    if (row < 4096 && col >= 512 && col < 1536) {
      int which = (col - 512) >> 9, cc = (col - 512) & 511, h = cc >> 6, d = cc & 63, b = row >> 8, s = row & 255;
      p.out[OUT_NAK + (size_t)which * 4194304 + ((((size_t)(b * 2 + l) * 8 + h) * 256 + s) * 64 + d)] = v;
    }
  }
}
DEVI void g2_item(const Params& p, int l, int it, unsigned char* sm) {
  const int nt = it >> 6, mt = it & 63;
  const int m0 = mt * 128, n0 = nt * 128;
  f32x4 tot[4][4];
  zero_acc(tot);
  const u16* Z = (const u16*)(p.ws + OFF_Z);
  for (int i = 0; i < 3; ++i) {
    f32x4 acc[4][4];
    zero_acc(acc);
    const u16* A = (const u16*)(p.ws + (i == 0 ? OFF_ONA : (i == 1 ? OFF_ORT : OFF_ORW)));
    gemm_acc(A, 512, (const u16*)(p.ws + OFF_WBRT) + (size_t)(l * 3 + i) * 1024 * 512, 512, 512, m0, n0, sm, acc);
    EPI_LOOP {
      int row = EPI_ROW, col = EPI_COL;
      float g = bf2f(Z[(size_t)row * PIN + 4992 + i * 1024 + col]);
      tot[m][n][j] += sigmoidf_(g) * acc[m][n][j];
    }
  }
  u16* MG = (u16*)(p.ws + OFF_H);
  EPI_LOOP { MG[(size_t)EPI_ROW * 1024 + EPI_COL] = f2bf(tot[m][n][j]); }
}
DEVI void g3_item(const Params& p, int l, int it, unsigned char* sm) {
  const int nt = it >> 6, mt = it & 63;
  const int m0 = mt * 128, n0 = nt * 128;
  f32x4 acc[4][4];
  zero_acc(acc);
  gemm_acc((const u16*)(p.ws + OFF_H), 1024, (const u16*)(p.ws + OFF_WOUTT) + (size_t)l * 1048576, 1024, 1024, m0, n0, sm, acc);
  float* Y = (float*)(p.ws + OFF_Y);
  const float* mod = (const float*)(p.ws + OFF_MOD) + (size_t)l * 3 * 6144;
  const float* X = (const float*)(p.ws + OFF_X);
  EPI_LOOP {
    int row = EPI_ROW, col = EPI_COL;
    float xr = (l == 0) ? xin_row(p, row)[col] : X[(size_t)row * 1024 + col];
    float gt = mod[(size_t)modrow(row) * 6144 + 2048 + col];
    Y[(size_t)row * 1024 + col] = ALPHA * xr + gt * acc[m][n][j];
  }
}
DEVI void g4_item(const Params& p, int l, int it, unsigned char* sm) {
  const int nt = it >> 6, mt = it & 63;
  const int m0 = mt * 128, n0 = nt * 128;
  f32x4 acc[4][4];
  zero_acc(acc);
  gemm_acc((const u16*)(p.ws + OFF_H2), 1024, (const u16*)(p.ws + OFF_WQT) + (size_t)l * 1048576, 1024, 1024, m0, n0, sm, acc);
  float* Q = (float*)(p.ws + OFF_Q);
  EPI_LOOP { Q[(size_t)EPI_ROW * 1024 + EPI_COL] = acc[m][n][j]; }
}

DEVI void load_qk16(const u16* zp  , int part, bool lat, int prow, int pcol, const float* tab,
                    float scale, float* out) {
  if (!lat) {
    float t[16];
    unpack8(*(const uint4*)(zp + part * 16), t);
    unpack8(*(const uint4*)(zp + part * 16 + 8), t + 8);
#pragma unroll
    for (int i = 0; i < 16; ++i) out[i] = t[i] * scale;
    return;
  }
  const int half = part >> 1, isp2 = part & 1;
  float p1[16], p2[16];
  unpack8(*(const uint4*)(zp + half * 32), p1);
  unpack8(*(const uint4*)(zp + half * 32 + 8), p1 + 8);
  unpack8(*(const uint4*)(zp + half * 32 + 16), p2);
  unpack8(*(const uint4*)(zp + half * 32 + 24), p2 + 8);
  const int pos = half ? pcol : prow;
  const float* ct = tab + pos * 16;
  const float* st = tab + 1024 + pos * 16;
#pragma unroll
  for (int f = 0; f < 16; ++f) {
    float c = ct[f], s = st[f];
    out[f] = (isp2 ? (p1[f] * s + p2[f] * c) : (p1[f] * c - p2[f] * s)) * scale;
  }
}
struct RetItem { int lat, b, h, n, N, seqbase, kvbase; };
DEVI RetItem ret_decode(int it) {
  RetItem r;
  if (it < 256) { r.lat = 1; r.b = it >> 7; r.h = (it >> 5) & 3; r.n = it & 31; r.N = 32; r.seqbase = 4096 + r.b * 2048; r.kvbase = 256 + (r.b * 4 + r.h) * 32; }
  else { int j = it - 256; r.lat = 0; r.b = j >> 4; r.h = (j >> 2) & 3; r.n = j & 3; r.N = 4; r.seqbase = r.b * 256; r.kvbase = (r.b * 4 + r.h) * 4; }
  return r;
}
DEVI void ret_gammas(const Params& p, int l, int h, float& lgf, float& lgb) {
  float xf = p.in[12][(l * 2 + 0) * 4 + h], xb = p.in[12][(l * 2 + 1) * 4 + h];
  lgf = -log2f(1.f + expf(-xf));
  lgb = -log2f(1.f + expf(-xb));
}

DEVI void ret1_item(const Params& p, int l, int it, unsigned char* sm) {
  const RetItem r = ret_decode(it);
  const int tid = TIDX, lane = tid & 63, w = tid >> 6, fr = lane & 15, fq = lane >> 4;
  u16* KTf = (u16*)sm;
  u16* KTb = (u16*)(sm + 9216);
  u16* VT = (u16*)(sm + 18432);
  const u16* Z = (const u16*)(p.ws + OFF_Z);
  const float* tab = (const float*)(p.ws + OFF_TAB);
  float lgf, lgb;
  ret_gammas(p, l, r.h, lgf, lgb);
  const int tok0 = r.seqbase + r.n * 64;
  {
    const int j = tid >> 2, part = tid & 3;
    float kv[16];
    load_qk16(Z + (size_t)(tok0 + j) * PIN + 1792 + r.h * 64, part, r.lat, r.n, j, tab, 0.125f, kv);
    const float df = exp2f(lgf * (float)(63 - j)), db = exp2f(lgb * (float)j);
#pragma unroll
    for (int i = 0; i < 16; ++i) {
      KTf[(part * 16 + i) * 72 + j] = f2bf(kv[i] * df);
      KTb[(part * 16 + i) * 72 + j] = f2bf(kv[i] * db);
    }
    const int jj = tid & 63, vp = (tid >> 6) * 32;
    const u16* vz = Z + (size_t)(tok0 + jj) * PIN + 2048 + r.h * 128 + vp;
#pragma unroll
    for (int c = 0; c < 4; ++c) {
      uint4 raw = *(const uint4*)(vz + c * 8);
      const u16* rv = (const u16*)&raw;
#pragma unroll
      for (int i = 0; i < 8; ++i) VT[(vp + c * 8 + i) * 72 + jj] = rv[i];
    }
  }
  __syncthreads();
  float* KV = (float*)(p.ws + OFF_KV) + (size_t)(r.kvbase + r.n) * 2 * 8192;
#pragma unroll
  for (int dir = 0; dir < 2; ++dir) {
    f32x4 acc[8];
#pragma unroll
    for (int n = 0; n < 8; ++n) acc[n] = f32x4{0.f, 0.f, 0.f, 0.f};
    wave_mma<8>((dir ? KTb : KTf) + w * 16 * 72, 72, VT, 72, 64, acc);
#pragma unroll
    for (int n = 0; n < 8; ++n)
#pragma unroll
      for (int j = 0; j < 4; ++j) KV[(size_t)dir * 8192 + (w * 16 + fq * 4 + j) * 128 + n * 16 + fr] = acc[n][j];
  }
}

DEVI void ret3_item(const Params& p, int l, int it, unsigned char* sm) {
  const RetItem r = ret_decode(it);
  const int tid = TIDX, lane = tid & 63, w = tid >> 6, fr = lane & 15, fq = lane >> 4;
  u16* Qs = (u16*)sm;
  u16* Ks = (u16*)(sm + 9216);
  u16* VT = (u16*)(sm + 18432);
  u16* ST = (u16*)(sm + 36864);
  const u16* Z = (const u16*)(p.ws + OFF_Z);
  const float* tab = (const float*)(p.ws + OFF_TAB);
  float lgf, lgb;
  ret_gammas(p, l, r.h, lgf, lgb);
  const int tok0 = r.seqbase + r.n * 64;
  {
    const int i = tid >> 2, part = tid & 3;
    float t[16];
    load_qk16(Z + (size_t)(tok0 + i) * PIN + 1536 + r.h * 64, part, r.lat, r.n, i, tab, 1.f, t);
    *(uint4*)(Qs + i * 72 + part * 16) = pack8(t);
    *(uint4*)(Qs + i * 72 + part * 16 + 8) = pack8(t + 8);
    load_qk16(Z + (size_t)(tok0 + i) * PIN + 1792 + r.h * 64, part, r.lat, r.n, i, tab, 0.125f, t);
    *(uint4*)(Ks + i * 72 + part * 16) = pack8(t);
    *(uint4*)(Ks + i * 72 + part * 16 + 8) = pack8(t + 8);
    const int jj = tid & 63, vp = (tid >> 6) * 32;
    const u16* vz = Z + (size_t)(tok0 + jj) * PIN + 2048 + r.h * 128 + vp;
#pragma unroll
    for (int c = 0; c < 4; ++c) {
      uint4 raw = *(const uint4*)(vz + c * 8);
      const u16* rv = (const u16*)&raw;
#pragma unroll
      for (int e = 0; e < 8; ++e) VT[(vp + c * 8 + e) * 72 + jj] = rv[e];
    }
  }
  __syncthreads();
  f32x4 at[4];
#pragma unroll
  for (int n = 0; n < 4; ++n) at[n] = f32x4{0.f, 0.f, 0.f, 0.f};
  wave_mma<4>(Qs + w * 16 * 72, 72, Ks, 72, 64, at);
  __syncthreads();
#pragma unroll
  for (int n = 0; n < 4; ++n)
#pragma unroll
    for (int j = 0; j < 4; ++j) {
      int i = w * 16 + fq * 4 + j, jc = n * 16 + fr;
      float mval = (i > jc) ? exp2f(lgf * (float)(i - jc)) : ((i < jc) ? exp2f(lgb * (float)(jc - i)) : 2.f);
      Ks[i * 72 + jc] = f2bf(at[n][j] * mval);
    }
  __syncthreads();
  f32x4 o[8];
#pragma unroll
  for (int n = 0; n < 8; ++n) o[n] = f32x4{0.f, 0.f, 0.f, 0.f};
  wave_mma<8>(Ks + w * 16 * 72, 72, VT, 72, 64, o);
  const float* KVb_ = (const float*)(p.ws + OFF_KV);
  for (int dir = 0; dir < 2; ++dir) {
    const float lg = dir ? lgb : lgf;
    const float cdec = exp2f(lg * 64.f);
    const int nprev = dir ? (r.N - 1 - r.n) : r.n;
    __syncthreads();
    {
      float S[32];
#pragma unroll
      for (int e8 = 0; e8 < 32; ++e8) {
        int e = e8 * 256 + tid;
        S[e8] = r.lat ? p.in[4][((((size_t)(r.b * 2 + l) * 2 + dir) * 4 + r.h) * 64) * 128 + e] : 0.f;
      }
#pragma unroll 2
      for (int m = 0; m < nprev; ++m) {
        const int ch = dir ? (r.N - 1 - m) : m;
        const float* kvp = KVb_ + ((size_t)(r.kvbase + ch) * 2 + dir) * 8192 + tid;
#pragma unroll
        for (int e8 = 0; e8 < 32; ++e8) S[e8] = S[e8] * cdec + kvp[e8 * 256];
      }
      const bool fin = (!r.lat) && (nprev == r.N - 1);
      const float* kvn = KVb_ + ((size_t)(r.kvbase + r.n) * 2 + dir) * 8192 + tid;
      float* so = (float*)p.out + OUT_SRET + ((((size_t)(r.b * 2 + l) * 2 + dir) * 4 + r.h) * 64) * 128 + tid;
#pragma unroll
      for (int e8 = 0; e8 < 32; ++e8) {
        int e = e8 * 256 + tid, d = e >> 7, v = e & 127;
        ST[v * 72 + d] = f2bf(S[e8]);
        if (fin) so[e8 * 256] = S[e8] * cdec + kvn[e8 * 256];
      }
    }
    __syncthreads();
    f32x4 t2[8];
#pragma unroll
    for (int n = 0; n < 8; ++n) t2[n] = f32x4{0.f, 0.f, 0.f, 0.f};
    wave_mma<8>(Qs + w * 16 * 72, 72, ST, 72, 64, t2);
#pragma unroll
    for (int j = 0; j < 4; ++j) {
      int i = w * 16 + fq * 4 + j;
      float dec = dir ? exp2f(lg * (float)(64 - i)) : exp2f(lg * (float)(i + 1));
#pragma unroll
      for (int n = 0; n < 8; ++n) o[n][j] += dec * t2[n][j];
    }
  }
  const float* gw = p.in[13] + l * 512 + r.h * 128;
  const float* gb = p.in[14] + l * 512 + r.h * 128;
  u16* ORT = (u16*)(p.ws + OFF_ORT);
#pragma unroll
  for (int j = 0; j < 4; ++j) {
    float s = 0.f;
#pragma unroll
    for (int n = 0; n < 8; ++n) s += o[n][j];
    float mu = row16_sum(s) * (1.f / 128.f);
    float q = 0.f;
#pragma unroll
    for (int n = 0; n < 8; ++n) { float d = o[n][j] - mu; q += d * d; }
    float rs = rsqrtf(row16_sum(q) * (1.f / 128.f) + 1e-5f);
    const int tok = tok0 + w * 16 + fq * 4 + j;
#pragma unroll
    for (int n = 0; n < 8; ++n) {
      int v = n * 16 + fr;
      float g = bf2f(Z[(size_t)tok * PIN + 2560 + r.h * 128 + v]);
      float y = ((o[n][j] - mu) * rs * gw[v] + gb[v]) * (g * sigmoidf_(g));
      ORT[(size_t)tok * 512 + r.h * 128 + v] = f2bf(y);
    }
  }
}

DEVI void shifted8(const u16* Z, int tok, bool hasp, bool hasn, int col, const float* mu, float* out) {
  float z[8], zp[8], zn[8];
  unpack8(*(const uint4*)(Z + (size_t)tok * PIN + col), z);
  if (hasp) unpack8(*(const uint4*)(Z + (size_t)(tok - 1) * PIN + col), zp);
  else {
#pragma unroll
    for (int i = 0; i < 8; ++i) zp[i] = 0.f;
  }
  if (hasn) unpack8(*(const uint4*)(Z + (size_t)(tok + 1) * PIN + col), zn);
  else {
#pragma unroll
    for (int i = 0; i < 8; ++i) zn[i] = 0.f;
  }
  float4 m0 = *(const float4*)(mu + col - 3072), m1 = *(const float4*)(mu + col - 3072 + 4);
  float mm[8] = {m0.x, m0.y, m0.z, m0.w, m1.x, m1.y, m1.z, m1.w};
#pragma unroll
  for (int i = 0; i < 8; ++i) out[i] = z[i] + mm[i] * (0.5f * (zp[i] + zn[i]) - z[i]);
}
DEVI void tok_neighbors(int tok, bool& hasp, bool& hasn) {
  if (tok < 4096) { int s = tok & 255; hasp = s > 0; hasn = s < 255; }
  else { int s = (tok - 4096) & 2047; hasp = s > 0; hasn = s < 2047; }
}

DEVI void rwprep_item(const Params& p, int l, int it) {
  const int tid = TIDX, lane = tid & 63, w = tid >> 6, fr = lane & 15, fq = lane >> 4;
  const u16* Z = (const u16*)(p.ws + OFF_Z);
  const float* mu = p.in[15] + l * 1920;
  const int tok0 = (it >> 2) * 64, hq = it & 3;
  u16* R = (u16*)(p.ws + OFF_RWR);
  u16* V = (u16*)(p.ws + OFF_RWV);
  u16* KC = (u16*)(p.ws + OFF_RWKC);
  for (int e = tid; e < 64 * 48; e += 256) {
    int ti = e / 48, u = e % 48, arr = u >> 4, c8 = hq * 128 + (u & 15) * 8;
    int tok = tok0 + ti;
    bool hp, hn;
    tok_neighbors(tok, hp, hn);
    float zs[8];
    shifted8(Z, tok, hp, hn, 3072 + arr * 512 + c8, mu, zs);
    u16* dst = (arr == 0) ? R : (arr == 1 ? KC : V);
    *(uint4*)(dst + (size_t)tok * 512 + c8) = pack8(zs);
  }
  __threadfence_block();
  __syncthreads();
  bf16x8 af[12];
  {
    const int tok = tok0 + w * 16 + fr;
    bool hp, hn;
    tok_neighbors(tok, hp, hn);
#pragma unroll
    for (int f = 0; f < 12; ++f) {
      int col = 4608 + f * 32 + fq * 8;
      float zs[8];
      shifted8(Z, tok, hp, hn, col, mu, zs);
      if (f < 4) {
#pragma unroll
        for (int i = 0; i < 8; ++i) zs[i] = tanhf(zs[i]);
      } else if (f >= 8) {
#pragma unroll
        for (int i = 0; i < 8; ++i) zs[i] = sigmoidf_(zs[i]);
      }
      uint4 pk = pack8(zs);
      af[f] = __builtin_bit_cast(bf16x8, pk);
    }
  }
  const u16* WUP = (const u16*)(p.ws + OFF_WUPT) + (size_t)l * 2 * 32768;
  const u16* AUP = (const u16*)(p.ws + OFF_AUPT) + (size_t)l * 2 * 32768;
  const u16* GUP = (const u16*)(p.ws + OFF_GUPT) + (size_t)l * 65536;
  float* Wd = (float*)(p.ws + OFF_RWW);
  u16* KK = (u16*)(p.ws + OFF_RWKK);
  u16* KD = (u16*)(p.ws + OFF_RWKD);
  u16* KKA = (u16*)(p.ws + OFF_RWKKA);
  u16* G = (u16*)(p.ws + OFF_RWG);
  u16* BON = (u16*)(p.ws + OFF_RWBON);
  const float* kkw = p.in[21] + l * 512;
  const float* kaw = p.in[22] + l * 512;
  const float* rkw = p.in[23] + l * 512;
  const float* w0 = p.in[16] + l * 1024;
  const float* a0 = p.in[18] + l * 1024;
  for (int h = hq * 2; h < hq * 2 + 2; ++h) {
    float inv[4], sbv[4];
#pragma unroll
    for (int j = 0; j < 4; ++j) {
      const int tok = tok0 + w * 16 + fq * 4 + j;
      float ssq = 0.f, sb = 0.f;
#pragma unroll
      for (int n = 0; n < 4; ++n) {
        int c = h * 64 + n * 16 + fr;
        float rr = bf2f(R[(size_t)tok * 512 + c]);
        float kc = bf2f(KC[(size_t)tok * 512 + c]);
        float kk = kc * kkw[c];
        ssq += kk * kk;
        sb += rr * kc * rkw[c];
      }
      ssq = row16_sum(ssq);
      sbv[j] = row16_sum(sb);
      inv[j] = rsqrtf(fmaxf(ssq, 1e-24f));
    }
#pragma unroll 1
    for (int n = 0; n < 4; ++n) {
      f32x4 acc[5];
#pragma unroll
      for (int m = 0; m < 5; ++m) acc[m] = f32x4{0.f, 0.f, 0.f, 0.f};
      const int c = h * 64 + n * 16 + fr;
#pragma unroll
      for (int ks = 0; ks < 2; ++ks) {
        acc[0] = mfma16(af[0 + ks], *(const bf16x8*)(WUP + (size_t)c * 64 + ks * 32 + fq * 8), acc[0]);
        acc[1] = mfma16(af[2 + ks], *(const bf16x8*)(WUP + 32768 + (size_t)c * 64 + ks * 32 + fq * 8), acc[1]);
        acc[2] = mfma16(af[4 + ks], *(const bf16x8*)(AUP + (size_t)c * 64 + ks * 32 + fq * 8), acc[2]);
        acc[3] = mfma16(af[6 + ks], *(const bf16x8*)(AUP + 32768 + (size_t)c * 64 + ks * 32 + fq * 8), acc[3]);
      }
#pragma unroll
      for (int ks = 0; ks < 4; ++ks)
        acc[4] = mfma16(af[8 + ks], *(const bf16x8*)(GUP + (size_t)c * 128 + ks * 32 + fq * 8), acc[4]);
      const float kkc = kkw[c], ka = kaw[c];
      const float w0f = w0[c], w0b = w0[512 + c], a0f = a0[c], a0b = a0[512 + c];
#pragma unroll
      for (int j = 0; j < 4; ++j) {
        const int tok = tok0 + w * 16 + fq * 4 + j;
        const size_t o = (size_t)tok * 512 + c;
        const float kc = bf2f(KC[o]), vv = bf2f(V[o]);
        const float kkn = kc * kkc * inv[j];
        KK[o] = f2bf(kkn);
        G[o] = f2bf(acc[4][j]);
        BON[o] = f2bf(sbv[j] * vv);
#pragma unroll
        for (int d = 0; d < 2; ++d) {
          float wv = __expf(-0.606531f * sigmoidf_((d ? w0b : w0f) + acc[d][j]));
          float a = sigmoidf_((d ? a0b : a0f) + acc[2 + d][j]);
          Wd[(size_t)d * NTOK * 512 + o] = wv;
          KD[(size_t)d * NTOK * 512 + o] = f2bf(kc * (1.f + (a - 1.f) * ka));
          KKA[(size_t)d * NTOK * 512 + o] = f2bf(kkn * a);
        }
      }
    }
  }
}

template <int KPT>
DEVI void scan_run(const Params& p, int l, bool lat, int b, int h, int dir, int rowbase, unsigned char* sm) {
  constexpr int LPR = 64 / KPT;
  constexpr int CH = 32;
  const int tid = TIDX;
  const int row = rowbase + tid / LPR, ks = (tid % LPR) * KPT;
  const int lir = tid % LPR;
  const int T = lat ? 2048 : 256, seq0 = lat ? 4096 + b * 2048 : b * 256;
  float S[KPT];
  if (lat) {
    const float* s0 = p.in[5] + ((((size_t)(b * 2 + l) * 2 + dir) * 8 + h) * 64 + row) * 64 + ks;
#pragma unroll
    for (int i = 0; i < KPT; ++i) S[i] = s0[i];
  } else {
#pragma unroll
    for (int i = 0; i < KPT; ++i) S[i] = 0.f;
  }
  float* buf = (float*)sm;
  float* obuf = buf + CH * 384;
  const float* Wd = (const float*)(p.ws + OFF_RWW) + (size_t)dir * NTOK * 512;
  const u16* R = (const u16*)(p.ws + OFF_RWR);
  const u16* V = (const u16*)(p.ws + OFF_RWV);
  const u16* KK = (const u16*)(p.ws + OFF_RWKK);
  const u16* KD = (const u16*)(p.ws + OFF_RWKD) + (size_t)dir * NTOK * 512;
  const u16* KKA = (const u16*)(p.ws + OFF_RWKKA) + (size_t)dir * NTOK * 512;
  float* O = (float*)(p.ws + OFF_OF) + (size_t)dir * NTOK * 512;
  const int pst = tid >> 3, c8 = (tid & 7) * 8;
  const int nch = T / CH;
  struct Pf { float4 qw0, qw1; uint4 qr, qk, qv, qd, qa; };
  auto issue = [&](Pf& q, int chunk) {
    float4& qw0 = q.qw0; float4& qw1 = q.qw1; uint4& qr = q.qr; uint4& qk = q.qk; uint4& qv = q.qv; uint4& qd = q.qd; uint4& qa = q.qa;
    int s_ = chunk * CH + pst;
    int tok_ = dir ? (seq0 + T - 1 - s_) : (seq0 + s_);
    size_t o_ = (size_t)tok_ * 512 + h * 64 + c8;
    qw0 = *(const float4*)(Wd + o_); qw1 = *(const float4*)(Wd + o_ + 4);
    qr = *(const uint4*)(R + o_); qk = *(const uint4*)(KK + o_); qv = *(const uint4*)(V + o_);
    qd = *(const uint4*)(KD + o_); qa = *(const uint4*)(KKA + o_);
  };
  auto commit = [&](const Pf& q) {
    const float4 qw0 = q.qw0, qw1 = q.qw1; const uint4 qr = q.qr, qk = q.qk, qv = q.qv, qd = q.qd, qa = q.qa;
    float* bp = buf + pst * 384 + c8;
    float t[8];
    *(float4*)bp = qw0; *(float4*)(bp + 4) = qw1;
    unpack8(qr, t); *(float4*)(bp + 64) = *(float4*)t; *(float4*)(bp + 68) = *(float4*)(t + 4);
    unpack8(qk, t); *(float4*)(bp + 128) = *(float4*)t; *(float4*)(bp + 132) = *(float4*)(t + 4);
    unpack8(qv, t); *(float4*)(bp + 192) = *(float4*)t; *(float4*)(bp + 196) = *(float4*)(t + 4);
    unpack8(qd, t); *(float4*)(bp + 256) = *(float4*)t; *(float4*)(bp + 260) = *(float4*)(t + 4);
    unpack8(qa, t); *(float4*)(bp + 320) = *(float4*)t; *(float4*)(bp + 324) = *(float4*)(t + 4);
    {
      float rr[8];
      unpack8(qr, rr);
      float ar = 0.f;
#pragma unroll
      for (int i = 0; i < 8; ++i) ar += t[i] * rr[i];
      ar += dpp<0xB1>(ar); ar += dpp<0x4E>(ar); ar += dpp<0x141>(ar);
      if ((tid & 7) == 0) obuf[pst] = ar;
    }
  };
  auto compute = [&](int chunk) {
    if constexpr (KPT == 4) {
      typedef float f2 __attribute__((ext_vector_type(2)));
      f2 S01 = {S[0], S[1]}, S23 = {S[2], S[3]};
      float4 w4 = *(const float4*)(buf + ks), r4 = *(const float4*)(buf + 64 + ks), k4 = *(const float4*)(buf + 128 + ks),
             d4 = *(const float4*)(buf + 256 + ks), a4 = *(const float4*)(buf + 320 + ks);
      float vr = buf[192 + row], ar = obuf[0];
      float myo = 0.f;
#pragma unroll 1
      for (int sb = 0; sb < CH; sb += 16) {
#pragma unroll
        for (int si = 0; si < 16; ++si) {
          const int s = sb + si;
          float4 nw = w4, nr = r4, nk = k4, nd = d4, na = a4;
          float nv = vr, nar = ar;
          if (s + 1 < CH) {
            const float* bp = buf + (s + 1) * 384;
            nw = *(const float4*)(bp + ks); nr = *(const float4*)(bp + 64 + ks); nk = *(const float4*)(bp + 128 + ks);
            nd = *(const float4*)(bp + 256 + ks); na = *(const float4*)(bp + 320 + ks);
            nv = bp[192 + row]; nar = obuf[s + 1];
          }
          const f2 w01 = {w4.x, w4.y}, w23 = {w4.z, w4.w}, k01 = {k4.x, k4.y}, k23 = {k4.z, k4.w};
          const f2 d01 = {d4.x, d4.y}, d23 = {d4.z, d4.w}, a01 = {a4.x, a4.y}, a23 = {a4.z, a4.w};
          const f2 r01 = {r4.x, r4.y}, r23 = {r4.z, r4.w};
          const f2 m = S01 * k01 + S23 * k23;
          const f2 pre01 = S01 * w01 + d01 * vr, pre23 = S23 * w23 + d23 * vr;
          const f2 pq = pre01 * r01 + pre23 * r23;
          float x = m.x + m.y, y = pq.x + pq.y;
          x += dpp<0xB1>(x); y += dpp<0xB1>(y);
          x += dpp<0x4E>(x); y += dpp<0x4E>(y);
          x += dpp<0x141>(x); y += dpp<0x141>(y);
          x += dpp<0x140>(x); y += dpp<0x140>(y);
          S01 = pre01 - a01 * x;
          S23 = pre23 - a23 * x;
          const float o = y - x * ar;
          myo = (si == lir) ? o : myo;
          w4 = nw; r4 = nr; k4 = nk; d4 = nd; a4 = na; vr = nv; ar = nar;
        }
        {
          int st = chunk * CH + sb + lir;
          int tok = dir ? (seq0 + T - 1 - st) : (seq0 + st);
          O[(size_t)tok * 512 + h * 64 + row] = myo;
        }
      }
      S[0] = S01.x; S[1] = S01.y; S[2] = S23.x; S[3] = S23.y;
      return;
    } else {
      typedef float f2 __attribute__((ext_vector_type(2)));
      f2 S2[8];
#pragma unroll
      for (int i = 0; i < 8; ++i) S2[i] = f2{S[2 * i], S[2 * i + 1]};
      float myo = 0.f;
#pragma unroll 1
      for (int sb = 0; sb < CH; sb += 4) {
#pragma unroll
        for (int si = 0; si < 4; ++si) {
          const int s = sb + si;
          const float* bp = buf + s * 384;
          float4 w4[4], r4[4], k4[4], d4[4], a4[4];
#pragma unroll
          for (int i = 0; i < 4; ++i) {
            w4[i] = *(const float4*)(bp + ks + i * 4); r4[i] = *(const float4*)(bp + 64 + ks + i * 4);
            k4[i] = *(const float4*)(bp + 128 + ks + i * 4); d4[i] = *(const float4*)(bp + 256 + ks + i * 4);
            a4[i] = *(const float4*)(bp + 320 + ks + i * 4);
          }
          const float vr = bp[192 + row], ar = obuf[s];
          f2 pre[8];
          f2 m0 = {0.f, 0.f}, m1 = {0.f, 0.f}, y0 = {0.f, 0.f}, y1 = {0.f, 0.f};
#pragma unroll
          for (int i = 0; i < 4; ++i) {
            const f2 klo = {k4[i].x, k4[i].y}, khi = {k4[i].z, k4[i].w}, wlo = {w4[i].x, w4[i].y}, whi = {w4[i].z, w4[i].w};
            const f2 dlo = {d4[i].x, d4[i].y}, dhi = {d4[i].z, d4[i].w}, rlo = {r4[i].x, r4[i].y}, rhi = {r4[i].z, r4[i].w};
            m0 += S2[2 * i] * klo; m1 += S2[2 * i + 1] * khi;
            pre[2 * i] = S2[2 * i] * wlo + dlo * vr; pre[2 * i + 1] = S2[2 * i + 1] * whi + dhi * vr;
            y0 += pre[2 * i] * rlo; y1 += pre[2 * i + 1] * rhi;
          }
          const f2 mm = m0 + m1, yy = y0 + y1;
          float x = mm.x + mm.y, y = yy.x + yy.y;
          x += dpp<0xB1>(x); y += dpp<0xB1>(y);
          x += dpp<0x4E>(x); y += dpp<0x4E>(y);
#pragma unroll
          for (int i = 0; i < 4; ++i) {
            const f2 alo = {a4[i].x, a4[i].y}, ahi = {a4[i].z, a4[i].w};
            S2[2 * i] = pre[2 * i] - alo * x; S2[2 * i + 1] = pre[2 * i + 1] - ahi * x;
          }
          const float o = y - x * ar;
          myo = (si == lir) ? o : myo;
        }
        {
          int st = chunk * CH + sb + lir;
          int tok = dir ? (seq0 + T - 1 - st) : (seq0 + st);
          O[(size_t)tok * 512 + h * 64 + row] = myo;
        }
      }
#pragma unroll
      for (int i = 0; i < 8; ++i) { S[2 * i] = S2[i].x; S[2 * i + 1] = S2[i].y; }
    }
  };
  Pf qA;
  issue(qA, 0);
  if constexpr (KPT == 4) {
    Pf qB;
    issue(qB, 1);
    for (int c0 = 0; c0 < nch; c0 += 2) {
      asm volatile("s_waitcnt lgkmcnt(0)\n\ts_barrier" ::: "memory");
      commit(qA);
      asm volatile("s_waitcnt lgkmcnt(0)\n\ts_barrier" ::: "memory");
      if (c0 + 2 < nch) issue(qA, c0 + 2);
      compute(c0);
      asm volatile("s_waitcnt lgkmcnt(0)\n\ts_barrier" ::: "memory");
      commit(qB);
      asm volatile("s_waitcnt lgkmcnt(0)\n\ts_barrier" ::: "memory");
      if (c0 + 3 < nch) issue(qB, c0 + 3);
      compute(c0 + 1);
    }
  } else {
    for (int c0 = 0; c0 < nch; ++c0) {
      asm volatile("s_waitcnt lgkmcnt(0)\n\ts_barrier" ::: "memory");
      commit(qA);
      asm volatile("s_waitcnt lgkmcnt(0)\n\ts_barrier" ::: "memory");
      if (c0 + 1 < nch) issue(qA, c0 + 1);
      compute(c0);
    }
  }
  if (KPT == 4) __builtin_amdgcn_s_setprio(0);
  if (!lat) {
    float* so = (float*)p.out + OUT_SRW + ((((size_t)(b * 2 + l) * 2 + dir) * 8 + h) * 64 + row) * 64 + ks;
#pragma unroll
    for (int i = 0; i < KPT; ++i) so[i] = S[i];
  }
}

DEVI void attn_item(const Params& p, int l, int it, unsigned char* sm) {
  const int tid = TIDX, lane = tid & 63, w = tid >> 6, fr = lane & 15, fq = lane >> 4;
  u16* Ks = (u16*)sm;
  u16* VT = (u16*)(sm + 9216);
  float* rpbs = (float*)(sm + 18432);
  const u16* Z = (const u16*)(p.ws + OFF_Z);
  const bool lat = it < 512;
  int b, h, r = 0, seqbase, qtok0;
  if (lat) { b = it >> 8; h = (it >> 5) & 7; r = it & 31; seqbase = 4096 + b * 2048; qtok0 = seqbase + r * 64; }
  else { int j = it - 512; b = j >> 5; h = (j >> 2) & 7; int qb = j & 3; seqbase = b * 256; qtok0 = seqbase + qb * 64; }
  bf16x8 qf[2];
#pragma unroll
  for (int ks = 0; ks < 2; ++ks) qf[ks] = *(const bf16x8*)(Z + (size_t)(qtok0 + w * 16 + fr) * PIN + h * 64 + ks * 32 + fq * 8);
  if (lat)
    for (int i = tid; i < 465; i += 256) rpbs[i] = p.in[11][(size_t)(l * 8 + h) * 465 + i];
  float m_run = -3e38f, l_run = 0.f;
  f32x4 o[4];
#pragma unroll
  for (int d = 0; d < 4; ++d) o[d] = f32x4{0.f, 0.f, 0.f, 0.f};
  const int ntiles = lat ? 16 : 4;
  const int row_start = lat ? clampi(r - 4, 0, 24) : 0;
  const int cbs = lat ? clampi(w * 16 - 8, 0, 32) : 0;
  for (int ti = 0; ti < ntiles; ++ti) {
    __syncthreads();
    const bool ctxtile = lat && ti < 8;
    if (ctxtile) {
      const float* kc = p.in[2] + ((((size_t)b * 2 + l) * 8 + h) * 512 + ti * 64) * 64;
      const float* vc = p.in[3] + ((((size_t)b * 2 + l) * 8 + h) * 512 + ti * 64) * 64;
      {
        const int key = tid >> 2, dp = (tid & 3) * 16;
        float t[16];
#pragma unroll
        for (int c = 0; c < 4; ++c) *(float4*)(t + c * 4) = *(const float4*)(kc + key * 64 + dp + c * 4);
        *(uint4*)(Ks + key * 72 + dp) = pack8(t);
        *(uint4*)(Ks + key * 72 + dp + 8) = pack8(t + 8);
      }
      {
        const int key = tid & 63, dp = (tid >> 6) * 16;
        float t[16];
#pragma unroll
        for (int c = 0; c < 4; ++c) *(float4*)(t + c * 4) = *(const float4*)(vc + key * 64 + dp + c * 4);
#pragma unroll
        for (int i = 0; i < 16; ++i) VT[(dp + i) * 72 + key] = f2bf(t[i]);
      }
    } else {
      const int trow = lat ? (row_start + ti - 8) : ti;
      const u16* zr = Z + (size_t)(seqbase + trow * 64) * PIN;
      {
        const int key = tid >> 2, dp = (tid & 3) * 16;
        const u16* src = zr + (size_t)key * PIN + 512 + h * 64 + dp;
        *(uint4*)(Ks + key * 72 + dp) = *(const uint4*)src;
        *(uint4*)(Ks + key * 72 + dp + 8) = *(const uint4*)(src + 8);
      }
      {
        const int key = tid & 63, dp = (tid >> 6) * 16;
        const u16* src = zr + (size_t)key * PIN + 1024 + h * 64 + dp;
        uint4 r0 = *(const uint4*)src, r1 = *(const uint4*)(src + 8);
        const u16* a0 = (const u16*)&r0;
        const u16* a1 = (const u16*)&r1;
#pragma unroll
        for (int i = 0; i < 8; ++i) { VT[(dp + i) * 72 + key] = a0[i]; VT[(dp + 8 + i) * 72 + key] = a1[i]; }
      }
    }
    __syncthreads();
    const bool win = lat && !ctxtile;
    const int nsteps = win ? 1 : 2;
    for (int st = 0; st < nsteps; ++st) {
      const int ko = win ? cbs : st * 32;
      f32x4 s0 = f32x4{0.f, 0.f, 0.f, 0.f}, s1 = s0;
#pragma unroll
      for (int ks = 0; ks < 2; ++ks) {
        bf16x8 a0 = *(const bf16x8*)(Ks + (ko + fr) * 72 + ks * 32 + fq * 8);
        bf16x8 a1 = *(const bf16x8*)(Ks + (ko + 16 + fr) * 72 + ks * 32 + fq * 8);
        s0 = mfma16(a0, qf[ks], s0);
        s1 = mfma16(a1, qf[ks], s1);
      }
      float sv[8];
#pragma unroll
      for (int j = 0; j < 4; ++j) { sv[j] = s0[j] * 0.125f; sv[4 + j] = s1[j] * 0.125f; }
      if (win) {
        const int qc = w * 16 + fr;
        const int dr = (row_start + ti - 8) - r + 7;
        const int qs = clampi(qc - 8, 0, 48);
#pragma unroll
        for (int e = 0; e < 8; ++e) {
          int kc_ = ko + ((e < 4) ? (fq * 4 + e) : (16 + fq * 4 + e - 4));
          int dc = clampi(kc_ - qc, -15, 15) + 15;
          int rel = kc_ - qs;
          sv[e] = (rel >= 0 && rel < 16) ? (sv[e] + rpbs[dr * 31 + dc]) : -1e30f;
        }
      }
      float mx = sv[0];
#pragma unroll
      for (int e = 1; e < 8; ++e) mx = fmaxf(mx, sv[e]);
      mx = fmaxf(mx, __shfl_xor(mx, 16));
      mx = fmaxf(mx, __shfl_xor(mx, 32));
      const float m_new = fmaxf(m_run, mx);
      const float alpha = __expf(m_run - m_new);
      float pe[8], ps = 0.f;
#pragma unroll
      for (int e = 0; e < 8; ++e) { pe[e] = __expf(sv[e] - m_new); ps += pe[e]; }
      l_run = l_run * alpha + ps;
      m_run = m_new;
#pragma unroll
      for (int d = 0; d < 4; ++d) o[d] *= alpha;
      uint4 pk = pack8(pe);
      bf16x8 pb = __builtin_bit_cast(bf16x8, pk);
#pragma unroll
      for (int d = 0; d < 4; ++d) {
        uint2 lo = *(const uint2*)(VT + (d * 16 + fr) * 72 + ko + fq * 4);
        uint2 hi = *(const uint2*)(VT + (d * 16 + fr) * 72 + ko + 16 + fq * 4);
        uint4 vv; vv.x = lo.x; vv.y = lo.y; vv.z = hi.x; vv.w = hi.y;
        o[d] = mfma16(__builtin_bit_cast(bf16x8, vv), pb, o[d]);
      }
    }
  }
  float lt = l_run + __shfl_xor(l_run, 16);
  lt += __shfl_xor(lt, 32);
  const float inv = 1.f / lt;
  u16* ONA = (u16*)(p.ws + OFF_ONA);
  const int tok = qtok0 + w * 16 + fr;
#pragma unroll
  for (int d = 0; d < 4; ++d) {
    uint2 ov; ov.x = cvtpk(o[d][0] * inv, o[d][1] * inv); ov.y = cvtpk(o[d][2] * inv, o[d][3] * inv);
    *(uint2*)(ONA + (size_t)tok * 512 + h * 64 + d * 16 + fq * 4) = ov;
  }
}

constexpr int MIX_NSCAN_LAT = 128, MIX_NSCAN_CTX = 256, MIX_NATT = 1024, MIX_NRET = 512;
constexpr int MIX_TOTAL = MIX_NSCAN_CTX + MIX_NATT + MIX_NRET;
#ifndef ONLYP
#define ONLYP -1
#endif
#define PH_ON(x) (ONLYP < 0 || ONLYP == (x))
DEVI void mix_scan_item(const Params& p, int l, int it, unsigned char* sm) {
  int ch = it >> 2, rq = it & 3;
  if (PH_ON(12)) scan_run<4>(p, l, true, ch >> 4, ch & 7, (ch >> 3) & 1, rq * 16, sm);
}
DEVI void mix_item(const Params& p, int l, int it, unsigned char* sm) {
  if (it < 256) { if (PH_ON(15)) ret3_item(p, l, it, sm); return; }
  it -= 256;
  if (it < MIX_NSCAN_CTX) { if (PH_ON(13)) scan_run<16>(p, l, false, it >> 4, it & 7, (it >> 3) & 1, 0, sm); return; }
  it -= MIX_NSCAN_CTX;
  if (it < MIX_NATT) { if (PH_ON(14)) attn_item(p, l, it, sm); return; }
  it -= MIX_NATT;
  if (PH_ON(15)) ret3_item(p, l, 256 + it, sm);
}

DEVI void fin_item(const Params& p, int l, int it0) {
  const int tid = TIDX;
#pragma unroll 8
  for (int sub = 0; sub < 8; ++sub) {
  const int it = it0 * 8 + sub;
  const int tok = it * 2 + (tid >> 7), c4 = (tid & 127) * 4;
  const size_t o = (size_t)tok * 512 + c4;
  float4 a = *(const float4*)((const float*)(p.ws + OFF_OF) + o);
  float4 b = *(const float4*)((const float*)(p.ws + OFF_OF) + (size_t)NTOK * 512 + o);
  float x[4] = {a.x + b.x, a.y + b.y, a.z + b.z, a.w + b.w};
  float mu = row16_sum(x[0] + x[1] + x[2] + x[3]) * (1.f / 64.f);
  float q = 0.f;
#pragma unroll
  for (int i = 0; i < 4; ++i) { float d = x[i] - mu; q += d * d; }
  float rs = rsqrtf(row16_sum(q) * (1.f / 64.f) + 64e-5f);
  float4 gw = *(const float4*)(p.in[24] + l * 512 + c4), gb = *(const float4*)(p.in[25] + l * 512 + c4);
  float gwv[4] = {gw.x, gw.y, gw.z, gw.w}, gbv[4] = {gb.x, gb.y, gb.z, gb.w};
  float bon[4], g[4];
  unpack4(*(const uint2*)((const u16*)(p.ws + OFF_RWBON) + o), bon);
  unpack4(*(const uint2*)((const u16*)(p.ws + OFF_RWG) + o), g);
  float y[4];
#pragma unroll
  for (int i = 0; i < 4; ++i) y[i] = ((x[i] - mu) * rs * gwv[i] + gbv[i] + bon[i]) * g[i];
  uint2 ov; ov.x = cvtpk(y[0], y[1]); ov.y = cvtpk(y[2], y[3]);
  *(uint2*)((u16*)(p.ws + OFF_ORW) + o) = ov;
  }
}

DEVI void ln2_item(const Params& p, int l, int it0) {
  const int lane = TIDX & 63, w = TIDX >> 6;
#pragma unroll 2
  for (int sub = 0; sub < 4; ++sub) {
  const int it = it0 * 4 + sub;
  const int tok = it * 4 + w;
  const float* y = (const float*)(p.ws + OFF_Y) + (size_t)tok * 1024;
  const float* mod = (const float*)(p.ws + OFF_MOD) + ((size_t)l * 3 + modrow(tok)) * 6144;
  float v[16];
  float s = 0.f;
#pragma unroll
  for (int i = 0; i < 4; ++i) { *(float4*)(v + i * 4) = *(const float4*)(y + lane * 4 + 256 * i); }
#pragma unroll
  for (int i = 0; i < 16; ++i) s += v[i];
  float mu = wave_sum(s) * (1.f / 1024.f);
  float q = 0.f;
#pragma unroll
  for (int i = 0; i < 16; ++i) { float d = v[i] - mu; q += d * d; }
  float rs = rsqrtf(wave_sum(q) * (1.f / 1024.f) + 1e-5f);
  float* X1 = (float*)(p.ws + OFF_X1) + (size_t)tok * 1024;
  s = 0.f;
#pragma unroll
  for (int i = 0; i < 4; ++i) {
    int c = lane * 4 + 256 * i;
    float4 g = *(const float4*)(p.in[28] + l * 1024 + c), bb = *(const float4*)(p.in[29] + l * 1024 + c);
    v[i * 4 + 0] = (v[i * 4 + 0] - mu) * rs * g.x + bb.x;
    v[i * 4 + 1] = (v[i * 4 + 1] - mu) * rs * g.y + bb.y;
    v[i * 4 + 2] = (v[i * 4 + 2] - mu) * rs * g.z + bb.z;
    v[i * 4 + 3] = (v[i * 4 + 3] - mu) * rs * g.w + bb.w;
    *(float4*)(X1 + c) = *(float4*)(v + i * 4);
    s += v[i * 4] + v[i * 4 + 1] + v[i * 4 + 2] + v[i * 4 + 3];
  }
  mu = wave_sum(s) * (1.f / 1024.f);
  q = 0.f;
#pragma unroll
  for (int i = 0; i < 16; ++i) { float d = v[i] - mu; q += d * d; }
  rs = rsqrtf(wave_sum(q) * (1.f / 1024.f) + 1e-5f);
  u16* H2 = (u16*)(p.ws + OFF_H2) + (size_t)tok * 1024;
#pragma unroll
  for (int i = 0; i < 4; ++i) {
    int c = lane * 4 + 256 * i;
    float4 sh = *(const float4*)(mod + 3072 + c), sc = *(const float4*)(mod + 4096 + c);
    uint2 o;
    o.x = cvtpk((v[i * 4] - mu) * rs * (1.f + sc.x) + sh.x, (v[i * 4 + 1] - mu) * rs * (1.f + sc.y) + sh.y);
    o.y = cvtpk((v[i * 4 + 2] - mu) * rs * (1.f + sc.z) + sh.z, (v[i * 4 + 3] - mu) * rs * (1.f + sc.w) + sh.w);
    *(uint2*)(H2 + c) = o;
  }
  }
}

DEVI int f2ord(float f) { int i = __float_as_int(f); return i ^ ((i >> 31) & 0x7fffffff); }
DEVI float ord2f(int i) { return __int_as_float(i ^ ((i >> 31) & 0x7fffffff)); }
DEVI void insert16(int (&t)[16], int x) {
#pragma unroll
  for (int i = 0; i < 16; ++i) { int hi = max(t[i], x); x = min(t[i], x); t[i] = hi; }
}
DEVI void insert16x2(int (&ta)[16], int xa, int (&tb)[16], int xb) {
#pragma unroll
  for (int i = 0; i < 16; ++i) {
    int ha = max(ta[i], xa), hb = max(tb[i], xb);
    xa = min(ta[i], xa); xb = min(tb[i], xb);
    ta[i] = ha; tb[i] = hb;
  }
}
DEVI void route_item(const Params& p, int l, int it, unsigned char* sm) {
  const int tid = TIDX, lane = tid & 63, w = tid >> 6;
  const int g = w >> 1, pp = w & 1;
  const int tb = it >> 3, h = it & 7;
  const int tok = tb * 128 + g * 64 + lane;
  float* kl = (float*)sm;
  const float* Q = (const float*)(p.ws + OFF_Q) + (size_t)tok * 1024 + h * 128 + pp * 64;
  float q[64];
#pragma unroll
  for (int i = 0; i < 16; ++i) *(float4*)(q + i * 4) = *(const float4*)(Q + i * 4);
  int T[16], TB[16];
#pragma unroll
  for (int i = 0; i < 16; ++i) { T[i] = (int)0x80000000; TB[i] = (int)0x80000000; }
  const float* keys = p.in[33] + (size_t)((l * 8 + h) * 2) * 8192;
  for (int half = 0; half < 2; ++half) {
    __syncthreads();
#pragma unroll
    for (int i = 0; i < 8; ++i) {
      int e = (i * 256 + tid) * 4;
      int ps = e >> 12, r = e & 4095;
      *(float4*)(kl + e) = *(const float4*)(keys + (size_t)ps * 8192 + half * 4096 + r);
    }
    __syncthreads();
    const float* kb = kl + pp * 4096;
#pragma unroll 1
    for (int k = 0; k < 64; k += 2) {
      const float* kp = kb + k * 64;
      typedef float f2 __attribute__((ext_vector_type(2)));
      f2 s01 = {0.f, 0.f}, s23 = {0.f, 0.f}, u01 = {0.f, 0.f}, u23 = {0.f, 0.f};
#pragma unroll
      for (int dh = 0; dh < 64; dh += 32) {
        float4 kv[8], kw[8];
#pragma unroll
        for (int i = 0; i < 8; ++i) { kv[i] = *(const float4*)(kp + dh + i * 4); kw[i] = *(const float4*)(kp + 64 + dh + i * 4); }
        asm volatile("" ::: "memory");
#pragma unroll
        for (int i = 0; i < 8; ++i) {
          const int d = dh + i * 4;
          const f2 qlo = {q[d], q[d + 1]}, qhi = {q[d + 2], q[d + 3]};
          const f2 klo = {kv[i].x, kv[i].y}, khi = {kv[i].z, kv[i].w}, wlo = {kw[i].x, kw[i].y}, whi = {kw[i].z, kw[i].w};
          s01 += qlo * klo; s23 += qhi * khi;
          u01 += qlo * wlo; u23 += qhi * whi;
        }
      }
      const float s0 = s01.x, s1 = s01.y, s2 = s23.x, s3 = s23.y, u0 = u01.x, u1 = u01.y, u2 = u23.x, u3 = u23.y;
      const int ka = half * 64 + k;
      const int ba = (f2ord((s0 + s1) + (s2 + s3)) & ~127) | (127 - ka);
      const int bb = (f2ord((u0 + u1) + (u2 + u3)) & ~127) | (127 - (ka + 1));
      insert16x2(T, ba, TB, bb);
    }
  }
#pragma unroll
  for (int i = 0; i < 16; ++i) insert16(T, TB[i]);
  __syncthreads();
  int* xb = (int*)sm;
  if (pp == 1) {
#pragma unroll
    for (int i = 0; i < 16; ++i) xb[(g * 16 + i) * 64 + lane] = T[i];
  }
  __syncthreads();
  if (pp == 0) {
    int T1[16];
#pragma unroll
    for (int i = 0; i < 16; ++i) T1[i] = xb[(g * 16 + i) * 64 + lane];
    int F[16];
#pragma unroll
    for (int i = 0; i < 16; ++i) F[i] = (int)0x80000000;
#pragma unroll
    for (int i = 0; i < 16; ++i) {
#pragma unroll
      for (int j = 0; j < 16; ++j) {
        if ((i + 1) * (j + 1) <= 16) {
          float c = ord2f(T[i] & ~127) + ord2f(T1[j] & ~127);
          int bits = (f2ord(c) & ~255) | (255 - (i * 16 + j));
          insert16(F, bits);
        }
      }
    }
    float fs[16], den = 0.f;
    const float f0 = ord2f(F[0] & ~255);
#pragma unroll
    for (int i = 0; i < 16; ++i) { fs[i] = __expf(ord2f(F[i] & ~255) - f0); den += fs[i]; }
    const float inv = 1.f / den;
    int* EIDX = (int*)(p.ws + OFF_EIDX) + (size_t)tok * 128 + h * 16;
    float* GATE = (float*)(p.ws + OFF_GATE) + (size_t)tok * 128 + h * 16;
    int eo[16]; float go[16];
#pragma unroll
    for (int i = 0; i < 16; ++i) {
      int pos = 255 - (F[i] & 255);
      int i0 = pos >> 4, j0 = pos & 15;
      int k0 = 0, k1 = 0;
#pragma unroll
      for (int c = 0; c < 16; ++c) {
        int a0 = 127 - (T[c] & 127), a1 = 127 - (T1[c] & 127);
        k0 = (i0 == c) ? a0 : k0;
        k1 = (j0 == c) ? a1 : k1;
      }
      eo[i] = k0 * 128 + k1;
      go[i] = fs[i] * inv;
    }
#pragma unroll
    for (int i = 0; i < 16; i += 4) {
      *(int4*)(EIDX + i) = make_int4(eo[i], eo[i + 1], eo[i + 2], eo[i + 3]);
      *(float4*)(GATE + i) = make_float4(go[i], go[i + 1], go[i + 2], go[i + 3]);
    }
  }
}

DEVI void fp8x16_to_f32(int4 r, float* f) {
  const int w[4] = {r.x, r.y, r.z, r.w};
#pragma unroll
  for (int i = 0; i < 4; ++i) {
    f32x2_ lo = __builtin_amdgcn_cvt_pk_f32_fp8(w[i], false);
    f32x2_ hi = __builtin_amdgcn_cvt_pk_f32_fp8(w[i], true);
    f[i * 4] = lo.x; f[i * 4 + 1] = lo.y; f[i * 4 + 2] = hi.x; f[i * 4 + 3] = hi.y;
  }
}
DEVI void expert_item(const Params& p, int l, int it) {
  const int lane = TIDX & 63;
  const int w = __builtin_amdgcn_readfirstlane(TIDX >> 6);
  const int tok = it * 4 + w;
  const u16* H2 = (const u16*)(p.ws + OFF_H2) + (size_t)tok * 1024;
  float hv[16];
  unpack8(*(const uint4*)(H2 + lane * 16), hv);
  unpack8(*(const uint4*)(H2 + lane * 16 + 8), hv + 8);
  const int* EIDX = (const int*)(p.ws + OFF_EIDX) + (size_t)tok * 128;
  const float* GATE = (const float*)(p.ws + OFF_GATE) + (size_t)tok * 128;
  const unsigned char* UB = (const unsigned char*)(p.ws + OFF_UB) + (size_t)l * UV_LSTRIDE;
  const unsigned char* VB = (const unsigned char*)(p.ws + OFF_VB) + (size_t)l * UV_LSTRIDE;
  const float* USC = (const float*)(p.ws + OFF_SC) + (0 * 2 + l) * 16384;
  const float* VSC = (const float*)(p.ws + OFF_SC) + (1 * 2 + l) * 16384;
  float f[16];
#pragma unroll
  for (int i = 0; i < 16; ++i) f[i] = 0.f;
  const int ei0 = EIDX[lane], ei1 = EIDX[64 + lane];
  const float ga0 = GATE[lane] * VSC[ei0], ga1 = GATE[64 + lane] * VSC[ei1];
  const float us0 = USC[ei0], us1 = USC[ei1];
  float dl0 = 0.f, dl1 = 0.f;
  int4 ba[8], bb[8];
#define ROW_LOAD(BUF, BASE, G)                                                                       \
  {                                                                                                  \
    const int src_ = ((G) < 8) ? ei0 : ei1;                                                          \
    _Pragma("unroll") for (int j = 0; j < 8; ++j) {                                                  \
      const int idx = __builtin_amdgcn_readlane(src_, (((G) & 7) << 3) + j);                         \
      BUF[j] = *(const int4*)(BASE + (size_t)idx * 1024 + lane * 16);                                \
    }                                                                                                \
  }
#define U_COMP(BUF, G)                                                                               \
  {                                                                                                  \
    const bool lo_ = (G) < 8;                                                                        \
    _Pragma("unroll") for (int j = 0; j < 8; ++j) {                                                  \
      const int ln_ = (((G) & 7) << 3) + j;                                                          \
      float uu[16];                                                                                  \
      fp8x16_to_f32(BUF[j], uu);                                                                     \
      float d0 = 0.f, d1 = 0.f;                                                                      \
      _Pragma("unroll") for (int i = 0; i < 16; i += 2) { d0 += uu[i] * hv[i]; d1 += uu[i + 1] * hv[i + 1]; } \
      float dd = row16_sum(d0 + d1);                                                                 \
      const float r0 = __int_as_float(__builtin_amdgcn_readlane(__float_as_int(dd), 0));            \
      const float r1 = __int_as_float(__builtin_amdgcn_readlane(__float_as_int(dd), 16));           \
      const float r2 = __int_as_float(__builtin_amdgcn_readlane(__float_as_int(dd), 32));           \
      const float r3 = __int_as_float(__builtin_amdgcn_readlane(__float_as_int(dd), 48));           \
      const float d = (r0 + r1) + (r2 + r3);                                                         \
      dl0 = (lo_ && lane == ln_) ? d : dl0;                                                          \
      dl1 = (!lo_ && lane == ln_) ? d : dl1;                                                         \
    }                                                                                                \
  }
#define V_COMP(BUF, G)                                                                               \
  {                                                                                                  \
    const float asrc_ = ((G) < 8) ? act0 : act1;                                                     \
    _Pragma("unroll") for (int j = 0; j < 8; ++j) {                                                  \
      const int ln_ = (((G) & 7) << 3) + j;                                                          \
      const float act = __int_as_float(__builtin_amdgcn_readlane(__float_as_int(asrc_), ln_));      \
      float vv[16];                                                                                  \
      fp8x16_to_f32(BUF[j], vv);                                                                     \
      _Pragma("unroll") for (int i = 0; i < 16; ++i) f[i] += act * vv[i];                            \
    }                                                                                                \
  }
  ROW_LOAD(ba, UB, 0);
#pragma unroll 1
  for (int g = 0; g < 16; g += 2) {
    ROW_LOAD(bb, UB, g + 1);
    U_COMP(ba, g);
    if (g + 2 < 16) { ROW_LOAD(ba, UB, g + 2); } else { ROW_LOAD(ba, VB, 0); }
    U_COMP(bb, g + 1);
  }
  const float x0 = dl0 * us0, x1 = dl1 * us1;
  const float act0 = 0.5f * x0 * (1.f + erff(x0 * 0.70710678118654752f)) * ga0;
  const float act1 = 0.5f * x1 * (1.f + erff(x1 * 0.70710678118654752f)) * ga1;
#pragma unroll 1
  for (int g = 0; g < 16; g += 2) {
    ROW_LOAD(bb, VB, g + 1);
    V_COMP(ba, g);
    if (g + 2 < 16) ROW_LOAD(ba, VB, g + 2);
    V_COMP(bb, g + 1);
  }
#undef ROW_LOAD
#undef U_COMP
#undef V_COMP
  const float* X1 = (const float*)(p.ws + OFF_X1) + (size_t)tok * 1024 + lane * 16;
  const float* mod = (const float*)(p.ws + OFF_MOD) + ((size_t)l * 3 + modrow(tok)) * 6144 + lane * 16;
  float y[16];
  float s = 0.f;
#pragma unroll
  for (int c = 0; c < 4; ++c) {
    float4 x = *(const float4*)(X1 + c * 4), gt = *(const float4*)(mod + 5120 + c * 4);
    int o = c * 4;
    y[o] = ALPHA * x.x + gt.x * f[o]; y[o + 1] = ALPHA * x.y + gt.y * f[o + 1];
    y[o + 2] = ALPHA * x.z + gt.z * f[o + 2]; y[o + 3] = ALPHA * x.w + gt.w * f[o + 3];
    s += y[o] + y[o + 1] + y[o + 2] + y[o + 3];
  }
  float mu = wave_sum(s) * (1.f / 1024.f);
  float q = 0.f;
#pragma unroll
  for (int i = 0; i < 16; ++i) { float d = y[i] - mu; q += d * d; }
  float rs = rsqrtf(wave_sum(q) * (1.f / 1024.f) + 1e-5f);
  float* xo = ((l == 1) ? ((float*)p.out + OUT_Y + (size_t)tok * 1024) : ((float*)(p.ws + OFF_X) + (size_t)tok * 1024)) + lane * 16;
  s = 0.f;
#pragma unroll
  for (int c = 0; c < 4; ++c) {
    int o = c * 4;
    float4 g = *(const float4*)(p.in[30] + l * 1024 + lane * 16 + o), bb = *(const float4*)(p.in[31] + l * 1024 + lane * 16 + o);
    y[o] = (y[o] - mu) * rs * g.x + bb.x; y[o + 1] = (y[o + 1] - mu) * rs * g.y + bb.y;
    y[o + 2] = (y[o + 2] - mu) * rs * g.z + bb.z; y[o + 3] = (y[o + 3] - mu) * rs * g.w + bb.w;
    *(float4*)(xo + o) = make_float4(y[o], y[o + 1], y[o + 2], y[o + 3]);
    s += y[o] + y[o + 1] + y[o + 2] + y[o + 3];
  }
  if (l == 0) {
    const float* mod1 = (const float*)(p.ws + OFF_MOD) + ((size_t)3 + modrow(tok)) * 6144 + lane * 16;
    mu = wave_sum(s) * (1.f / 1024.f);
    q = 0.f;
#pragma unroll
    for (int i = 0; i < 16; ++i) { float d = y[i] - mu; q += d * d; }
    rs = rsqrtf(wave_sum(q) * (1.f / 1024.f) + 1e-5f);
    u16* H = (u16*)(p.ws + OFF_H) + (size_t)tok * 1024 + lane * 16;
    float t[16];
#pragma unroll
    for (int c = 0; c < 4; ++c) {
      float4 sh = *(const float4*)(mod1 + c * 4), sc = *(const float4*)(mod1 + 1024 + c * 4);
      int o = c * 4;
      t[o] = (y[o] - mu) * rs * (1.f + sc.x) + sh.x; t[o + 1] = (y[o + 1] - mu) * rs * (1.f + sc.y) + sh.y;
      t[o + 2] = (y[o + 2] - mu) * rs * (1.f + sc.z) + sh.z; t[o + 3] = (y[o + 3] - mu) * rs * (1.f + sc.w) + sh.w;
    }
    *(uint4*)(H) = pack8(t);
    *(uint4*)(H + 8) = pack8(t + 8);
  }
}

constexpr int NPHASES = 22;
DEVI int phase_total(int idx) {
  if (idx == 0) return P0_TOTAL;
  if (idx == 1) return 2048;
  const int l = (idx - 2) / 10, t = (idx - 2) % 10;
  switch (t) {
    case 0: return 0;
    case 1: return 512 + 512;
    case 2: return MIX_TOTAL + (l == 0 ? (P0_NT + P0_NUV) : 0);
    case 3: return 512;
    case 4: return 0;
    case 5: return 0;
    case 6: return 512;
    case 7: return 0;
    case 8: return 512;
    default: return 2048;
  }
}
DEVI int phase_xcd_total(int idx) {
  if (idx < 2) return 0;
  const int t = (idx - 2) % 10;
  if (t == 0) return 504;
  if (t == 4 || t == 5 || t == 7) return 64;
  return 0;
}
DEVI void phase_item_x(const Params& p, int idx, int xcd, int q, unsigned char* sm) {
  const int l = (idx - 2) / 10, t = (idx - 2) % 10;
  const int it = (q >> 3) * 64 + xcd * 8 + (q & 7);
  if (t == 0) { if (PH_ON(2)) g1_item(p, l, it, sm); }
  else if (t == 4) { if (PH_ON(6)) g2_item(p, l, it, sm); }
  else if (t == 5) { if (PH_ON(7)) g3_item(p, l, it, sm); }
  else { if (PH_ON(9)) g4_item(p, l, it, sm); }
}
DEVI void phase_item(const Params& p, int idx, int it, unsigned char* sm) {
  if (idx == 0) { if (PH_ON(0)) phase0_item(p, it, sm); return; }
  if (idx == 1) { if (PH_ON(1)) ln1_item(p, it); return; }
  const int l = (idx - 2) / 10, t = (idx - 2) % 10;
  switch (t) {
    case 0: break;
    case 1: if (it < 512) { if (PH_ON(3)) rwprep_item(p, l, it); } else { if (PH_ON(4)) ret1_item(p, l, it - 512, sm); } break;
    case 2:
      if (it < MIX_TOTAL) mix_item(p, l, it, sm);
      else if (it < MIX_TOTAL + P0_NT) p0_tiles(p, 1, it - MIX_TOTAL, sm);
      else convert_uv_item(p, 1, it - MIX_TOTAL - P0_NT);
      break;
    case 3: if (PH_ON(5)) fin_item(p, l, it); break;
    case 4: break;
    case 5: break;
    case 6: if (PH_ON(8)) ln2_item(p, l, it); break;
    case 7: break;
    case 8: if (PH_ON(10)) route_item(p, l, it, sm); break;
    default: if (PH_ON(11)) expert_item(p, l, it); break;
  }
}

#define XB_TMO      128
#define XB_XCNT(j)  (256  + 64 * (j))
#define XB_XSUB(j)  (1280 + 64 * (j))
#define XB_XGEN(j)  (2304 + 64 * (j))
#define XB_TOP      3328
#define XB_TOPGEN   3392
#define XCD_BAR_WORDS 3456
#define XB_SPIN_CAP (1u << 18)
#define LAS __attribute__((address_space(3)))
DEVI unsigned xb_ld(unsigned* p) { return __hip_atomic_load(p, __ATOMIC_RELAXED, __HIP_MEMORY_SCOPE_AGENT); }
DEVI unsigned xb_add(unsigned* p, unsigned v) { return __hip_atomic_fetch_add(p, v, __ATOMIC_RELAXED, __HIP_MEMORY_SCOPE_AGENT); }
DEVI unsigned xb_xcc_id() { return (unsigned)__builtin_amdgcn_s_getreg((3 << 11) | 20) & 0xFu; }
#define XB_SPIN(cond, bar) do { unsigned _sp = 0; while (cond) { __builtin_amdgcn_s_sleep(1); \
    if ((++_sp & 255u) == 0u) { if (xb_ld(&(bar)[XB_TMO])) break; if (_sp > XB_SPIN_CAP) { atomicAdd(&(bar)[XB_TMO], 1u); break; } } } } while (0)
struct XcdBarrier { unsigned* bar; unsigned x; volatile LAS unsigned* st; };
DEVI XcdBarrier xcd_barrier_post(unsigned* bar, volatile LAS unsigned* st) {
  XcdBarrier b; b.bar = bar; b.x = xb_xcc_id(); b.st = st;
  if (threadIdx.x == 0) (void)xb_add(&bar[XB_XCNT(b.x)], 1u);
  return b;
}
DEVI void xcd_barrier_complete(unsigned* bar, unsigned x, unsigned& nloc, unsigned& nx) {
  const unsigned G = gridDim.x * gridDim.y * gridDim.z;
  unsigned sum, cnt, mine, sp = 0u;
  for (;;) {
    sum = 0u; cnt = 0u; mine = 0u;
#pragma unroll
    for (unsigned j = 0; j < 16; ++j) { const unsigned c = xb_ld(&bar[XB_XCNT(j)]); sum += c; cnt += (c > 0u) ? 1u : 0u; mine = (j == x) ? c : mine; }
    if (sum == G) break;
    __builtin_amdgcn_s_sleep(1);
    if ((++sp & 255u) == 0u) { if (xb_ld(&bar[XB_TMO])) break; if (sp > XB_SPIN_CAP) { atomicAdd(&bar[XB_TMO], 1u); break; } }
  }
  nloc = mine > 0u ? mine : 1u; nx = cnt > 0u ? cnt : 1u;
}
DEVI void xcd_barrier(const XcdBarrier& b) {
  asm volatile("s_waitcnt vmcnt(0)" ::: "memory");
  __syncthreads();
  if (threadIdx.x == 0) {
    unsigned* bar = b.bar;
    __builtin_amdgcn_s_waitcnt(0);
    unsigned nloc = b.st[0], nx = b.st[1];
    if (nloc == 0u) { xcd_barrier_complete(bar, b.x, nloc, nx); b.st[0] = nloc; b.st[1] = nx; }
    const unsigned old = xb_add(&bar[XB_XSUB(b.x)], 1u);
    const unsigned gen = old / nloc;
    if (old + 1u == (gen + 1u) * nloc) {
      __builtin_amdgcn_fence(__ATOMIC_RELEASE, "agent");
      asm volatile("s_waitcnt vmcnt(0)" ::: "memory");
      const unsigned og = xb_add(&bar[XB_TOP], 1u);
      const unsigned tg = og / nx;
      if (og + 1u == (tg + 1u) * nx) xb_add(&bar[XB_TOPGEN], 1u);
      else XB_SPIN(xb_ld(&bar[XB_TOPGEN]) == tg, bar);
      __builtin_amdgcn_fence(__ATOMIC_ACQUIRE, "agent");
      xb_add(&bar[XB_XGEN(b.x)], 1u);
      asm volatile("s_waitcnt vmcnt(0)" ::: "memory");
    } else {
      XB_SPIN(xb_ld(&bar[XB_XGEN(b.x)]) == gen, bar);
      __builtin_amdgcn_fence(__ATOMIC_ACQUIRE, "agent");
      asm volatile("s_waitcnt vmcnt(0)" ::: "memory");
    }
  }
  __syncthreads();
}

__global__ void __launch_bounds__(256, 2) __attribute__((amdgpu_waves_per_eu(2, 2))) mega_kernel(KArgs ka, int ph_lo, int ph_hi) {
  __shared__ __attribute__((aligned(16))) unsigned char sm[57344];
  __shared__ int s_item;
  __shared__ g_cf32* s_in[36];
  __shared__ __attribute__((aligned(16))) unsigned s_xb[4];
  cg::grid_group grid = cg::this_grid();
  if (threadIdx.x < 4) s_xb[threadIdx.x] = 0u;
  __shared__ int s_first;
  if (threadIdx.x == 0) {
    const unsigned hw = (unsigned)__builtin_amdgcn_s_getreg((31 << 11) | 4);
    const unsigned key = (xb_xcc_id() << 8) | ((hw >> 8) & 0xFFu);
    s_first = (atomicAdd((int*)(ka.ws + OFF_CUT) + key, 1) == 0) ? 1 : 0;
  }
  if (threadIdx.x < 36) {
    const float* const* kp = (const float* const*)__builtin_amdgcn_kernarg_segment_ptr();
    s_in[threadIdx.x] = (g_cf32*)kp[threadIdx.x];
  }
  __syncthreads();
  Params p;
  p.in.t = s_in; p.out = (g_f32*)ka.out; p.ws = (g_u8*)ka.ws;
  int* ctr = (int*)(p.ws + OFF_CTR);
  const XcdBarrier xb = xcd_barrier_post((unsigned*)(p.ws + OFF_BAR), (volatile LAS unsigned*)s_xb);
  for (int idx = ph_lo; idx < ph_hi; ++idx) {
    const int total = phase_total(idx);
#ifdef PROBE_T
    const int ptype = idx < 2 ? idx : 2 + (idx - 2) % 10;
    const int reps = (ptype == PROBE_T) ? 2 : 1;
#else
    const int reps = 1;
#endif
    for (int rep = 0; rep < reps; ++rep) {
      const bool is_mix = (idx >= 2) && ((idx - 2) % 10 == 2);
      auto scan_queue = [&]() {
        const int l_ = (idx - 2) / 10;
        while (true) {
          __syncthreads();
          if (TIDX == 0) s_item = atomicAdd(&ctr[960 + (rep * 2 + l_) * 8 + (blockIdx.x & 7)], 1);
          __syncthreads();
          const int it = s_item * 8 + (blockIdx.x & 7);
          if (it >= MIX_NSCAN_LAT) break;
          Params q = p;
          asm volatile("" : "+s"(q.ws));
          asm volatile("" : "+s"(q.out));
          asm volatile("" : "+s"(q.in.t));
          mix_scan_item(q, l_, it, sm);
        }
      };
      if (is_mix && s_first) scan_queue();
      const int nx = phase_xcd_total(idx);
      if (nx) {
        const int xcd = blockIdx.x & 7;
        while (true) {
          __syncthreads();
          if (TIDX == 0) s_item = atomicAdd(&ctr[64 + (idx + 32 * rep) * 8 + xcd], 1);
          __syncthreads();
          const int q_ = s_item;
          if (q_ >= nx) break;
          Params q = p;
          asm volatile("" : "+s"(q.ws));
          asm volatile("" : "+s"(q.out));
          asm volatile("" : "+s"(q.in.t));
          phase_item_x(q, idx, xcd, q_, sm);
        }
      }
      while (true) {
        __syncthreads();
        if (TIDX == 0) s_item = atomicAdd(&ctr[512 + (idx + 32 * rep) * 8 + (blockIdx.x & 7)], 1);
        __syncthreads();
        const int it = s_item * 8 + (blockIdx.x & 7);
        if (it >= total) break;
        Params q = p;
        asm volatile("" : "+s"(q.ws));
        asm volatile("" : "+s"(q.out));
        asm volatile("" : "+s"(q.in.t));
        phase_item(q, idx, it, sm);
      }
      if (is_mix) scan_queue();
      if (rep + 1 < reps) xcd_barrier(xb);
    }
    if (idx + 1 < ph_hi) {
      if (ph_lo < 0) grid.sync();
      xcd_barrier(xb);
    }
  }
}

#ifndef MULTI_LAUNCH
#define MULTI_LAUNCH 0
#endif

extern "C" void kernel_launch(void* const* d_in, const int* in_sizes, int n_in, void* d_out, int out_size, void* d_ws,
                              size_t ws_size, hipStream_t stream) {
  static int grid_blocks = 0;
  if (!grid_blocks) {
    int dev = 0, cus = 0, per_cu = 0;
    hipGetDevice(&dev);
    hipDeviceGetAttribute(&cus, hipDeviceAttributeMultiprocessorCount, dev);
    hipOccupancyMaxActiveBlocksPerMultiprocessor(&per_cu, mega_kernel, 256, 0);
    if (per_cu > 2) per_cu = 2;
    if (per_cu < 1) per_cu = 1;
    grid_blocks = cus * per_cu;
  }
  KArgs p{};
  for (int i = 0; i < 36; ++i) p.in[i] = (const float*)d_in[i];
  p.out = (float*)d_out;
  p.ws = (unsigned char*)d_ws;
  if (ws_size < OFF_END) { fprintf(stderr, "workspace too small: %zu < %zu\n", ws_size, (size_t)OFF_END); return; }
  hipMemsetAsync(d_ws, 0, 4096, stream);
  hipMemsetAsync((unsigned char*)d_ws + OFF_BAR, 0, 16384, stream);
  hipMemsetAsync((unsigned char*)d_ws + OFF_CUT, 0, 8192, stream);
#if MULTI_LAUNCH
  for (int ph = 0; ph < NPHASES; ++ph) {
    hipLaunchKernelGGL(mega_kernel, dim3(grid_blocks), dim3(256), 0, stream, p, ph, ph + 1);
  }
#else
  int lo = 0, hi = NPHASES;
  void* args[] = {&p, &lo, &hi};
  hipError_t e = hipLaunchCooperativeKernel((void*)mega_kernel, dim3(grid_blocks), dim3(256), args, 0, stream);
  if (e != hipSuccess) fprintf(stderr, "cooperative launch failed: %s (grid %d)\n", hipGetErrorString(e), grid_blocks);
#endif
}
```
